# Optimizing an MI355X kernel written in HIP

```python
import math
import jax, jax.numpy as jnp
from jax import lax
import numpy as np

D_MODEL = 2048
BATCH = 4
SEQ = 2048
DEPTH = 4

MIX = D_MODEL // 4
N_BRANCH = 4
RMS_EPS = 1e-6
ATT_HEADS = 8
ATT_HEAD_DIM = MIX // ATT_HEADS
ROT_DIM = ATT_HEAD_DIM // 4
ROPE_THETA = 500000.0
IDX_HEADS = 4
IDX_DIM = 64
TOPK_MAX = 256
Q_BLOCK = 128
RWKV_HEADS = 8
RWKV_HEAD_DIM = MIX // RWKV_HEADS
DECAY_LORA = 96
AAA_LORA = 96
GATE_LORA = 256
GN_EPS = 64e-5
POOL_GROUPS = 4
POOL_GROUP_DIM = MIX // POOL_GROUPS
POOL_WINDOWS = (2, 4, 8, 16)
SSM_GROUP_DIM = 16
SSM_GROUPS = MIX // SSM_GROUP_DIM
SSM_STATE = 64
D_FF = 5504
CONV_W = 3
A_COLS = 3 * MIX + IDX_HEADS * IDX_DIM + IDX_DIM + IDX_HEADS
B_COLS = 3 * MIX + DECAY_LORA + AAA_LORA + GATE_LORA
C_COLS = MIX
D_COLS = MIX
G_COLS = N_BRANCH * D_MODEL
IN_COLS = A_COLS + B_COLS + C_COLS + D_COLS + G_COLS

kernel_name = "hybrid_gated_dsa_rwkv7_pool_s5"


def _split(z, sizes):
    return jnp.split(z, [int(i) for i in np.cumsum(sizes)[:-1]], axis=-1)


def _shift_right(z, n):
    return jnp.pad(z, ((0, 0), (n, 0), (0, 0)))[:, : z.shape[1]]


def rms_norm(x, g):
    xf = x.astype(jnp.float32)
    y = xf * lax.rsqrt(jnp.mean(xf * xf, axis=-1, keepdims=True) + RMS_EPS)
    return (y * g.astype(jnp.float32)).astype(x.dtype)


def rope_tables(positions, dtype):
    inv = ROPE_THETA ** (-jnp.arange(0, ROT_DIM, 2, dtype=jnp.float32) / ROT_DIM)
    ang = positions.astype(jnp.float32)[..., None] * inv
    return jnp.cos(ang)[:, :, None, :].astype(dtype), jnp.sin(ang)[:, :, None, :].astype(dtype)


def partial_rope(x, cos, sin):
    half = ROT_DIM // 2
    x1 = x[..., :half]
    x2 = x[..., half:ROT_DIM]
    return jnp.concatenate([x1 * cos - x2 * sin, x2 * cos + x1 * sin, x[..., ROT_DIM:]], axis=-1)


def dsa_attention(q, k, v, q_idx, k_idx, w_idx):
    bsz, seq = q.shape[0], q.shape[1]
    n_sel = min(TOPK_MAX, seq // 4)
    n_blk = seq // Q_BLOCK
    key_pos = jnp.arange(seq)
    gather = jax.vmap(lambda src, ix: src[ix])

    def block(i):
        start = i * Q_BLOCK
        qb = lax.dynamic_slice_in_dim(q, start, Q_BLOCK, axis=1)
        qib = lax.dynamic_slice_in_dim(q_idx, start, Q_BLOCK, axis=1)
        wb = lax.dynamic_slice_in_dim(w_idx, start, Q_BLOCK, axis=1).astype(jnp.float32) * IDX_HEADS ** -0.5
        qpos = start + jnp.arange(Q_BLOCK)
        rel = jax.nn.relu(jnp.einsum('bthd,bsd->bths', qib, k_idx).astype(jnp.float32) * IDX_DIM ** -0.5)
        score = jnp.einsum('bth,bths->bts', wb, rel)
        causal = key_pos[None, :] <= qpos[:, None]
        score = jnp.where(causal[None], score, -jnp.inf)
        _, sel = lax.top_k(score, n_sel)
        kg = gather(k, sel)
        vg = gather(v, sel)
        logits = jnp.einsum('bthd,btkhd->bhtk', qb, kg).astype(jnp.float32) * ATT_HEAD_DIM ** -0.5
        valid = sel <= qpos[None, :, None]
        logits = jnp.where(valid[:, None], logits, -jnp.inf)
        p = jax.nn.softmax(logits, axis=-1)
        return jnp.einsum('bhtk,btkhd->bthd', p, vg.astype(jnp.float32))

    out = lax.map(block, jnp.arange(n_blk))
    out = jnp.moveaxis(out, 0, 1).reshape(bsz, seq, ATT_HEADS * ATT_HEAD_DIM)
    return out.astype(q.dtype)


def rwkv7_mix(z, mu, w0, w2, a0, a2, g2, k_k, k_a, r_k, lnx_g, lnx_b):
    bsz, seq = z.shape[0], z.shape[1]
    H, N = RWKV_HEADS, RWKV_HEAD_DIM
    f32 = jnp.float32
    z = z + (_shift_right(z, 1) - z) * mu
    r, k, v, lw, la, lg = _split(z, [MIX, MIX, MIX, DECAY_LORA, AAA_LORA, GATE_LORA])
    wlog = -jax.nn.softplus(-(w0 + jnp.tanh(lw) @ w2)) - 0.5
    decay = jnp.exp(-jnp.exp(wlog.astype(f32)))
    a = jax.nn.sigmoid(a0 + la @ a2)
    g = jax.nn.sigmoid(lg) @ g2
    heads = lambda t: t.astype(f32).reshape(bsz, seq, H, N)
    kk = heads(k * k_k)
    kk = kk / jnp.maximum(jnp.sqrt(jnp.sum(kk * kk, axis=-1, keepdims=True)), 1e-12)
    k = k * (1.0 + (a - 1.0) * k_a)
    rh, kh, vh, wh, ah = heads(r), heads(k), heads(v), heads(decay), heads(a)
    to_t = lambda t: jnp.moveaxis(t, 1, 0)

    def step(state, inp):
        r_t, w_t, k_t, v_t, a_t, b_t = inp
        sa = jnp.einsum('bhij,bhj->bhi', state, a_t)
        state = state * w_t[:, :, None, :] + sa[..., None] * b_t[:, :, None, :] + v_t[..., None] * k_t[:, :, None, :]
        return state, jnp.einsum('bhij,bhj->bhi', state, r_t)

    state0 = jnp.zeros((bsz, H, N, N), f32)
    _, y = lax.scan(step, state0, (to_t(rh), to_t(wh), to_t(kh), to_t(vh), to_t(-kk), to_t(kk * ah)))
    y = jnp.moveaxis(y, 0, 1)
    mean = jnp.mean(y, axis=-1, keepdims=True)
    var = jnp.mean(jnp.square(y - mean), axis=-1, keepdims=True)
    yn = ((y - mean) * lax.rsqrt(var + GN_EPS)).reshape(bsz, seq, MIX) * lnx_g + lnx_b
    bonus = (jnp.sum(rh * kh * r_k.astype(f32).reshape(H, N), axis=-1, keepdims=True) * vh).reshape(bsz, seq, MIX)
    return ((yn + bonus) * g).astype(z.dtype)


def multiscale_pool(z, pool_w, pool_scale):
    f32 = jnp.float32
    seq = z.shape[1]
    zf = z.astype(f32)
    cs = jnp.cumsum(zf, axis=1)
    count_base = jnp.arange(1, seq + 1, dtype=f32)[None, :, None]
    zg = jnp.split(zf, POOL_GROUPS, axis=-1)
    csg = jnp.split(cs, POOL_GROUPS, axis=-1)
    outs = []
    for gi, win in enumerate(POOL_WINDOWS):
        win_sum = csg[gi] - _shift_right(csg[gi], win)
        outs.append(win_sum / jnp.minimum(count_base, float(win)) - zg[gi])
    d = jnp.stack(outs, axis=2)
    y = jnp.einsum('bsgc,gcd->bsgd', d, pool_w.astype(f32)).reshape(z.shape)
    return (y * pool_scale).astype(z.dtype)


def s5_ssm(u, a_re, a_im, log_dt, b_re, b_im, c_re, c_im, d_skip, w_glu, b_glu):
    bsz, seq = u.shape[0], u.shape[1]
    f32 = jnp.float32
    uf = u.astype(f32).reshape(bsz, seq, SSM_GROUPS, SSM_GROUP_DIM)
    lam = lax.complex(a_re.astype(f32), a_im.astype(f32))
    dt = jnp.exp(log_dt.astype(f32))[:, None]
    lam_bar = jnp.exp(lam * dt)
    bmat = lax.complex(b_re.astype(f32), b_im.astype(f32))
    b_bar = ((lam_bar - 1.0) / lam)[..., None] * bmat
    bu = jnp.einsum('gpc,bsgc->bsgp', b_bar, uf.astype(jnp.complex64))
    a_seq = jnp.broadcast_to(lam_bar, bu.shape)

    def combine(e1, e2):
        a1, b1 = e1
        a2, b2 = e2
        return a2 * a1, a2 * b1 + b2

    _, states = lax.associative_scan(combine, (a_seq, bu), axis=1)
    cmat = lax.complex(c_re.astype(f32), c_im.astype(f32))
    y = jnp.real(jnp.einsum('gcp,bsgp->bsgc', cmat, states)) + d_skip.astype(f32).reshape(SSM_GROUPS, SSM_GROUP_DIM) * uf
    y = jax.nn.gelu(y.reshape(bsz, seq, MIX))
    out = y * jax.nn.sigmoid(y @ w_glu.astype(f32) + b_glu)
    return out.astype(u.dtype)


def conv_ffn(h, w_up, conv_w, conv_b, w_down):
    seq = h.shape[1]
    u = h @ w_up
    up = jnp.pad(u, ((0, 0), (CONV_W - 1, 0), (0, 0)))
    uc = conv_b + sum(conv_w[j] * up[:, j:j + seq] for j in range(CONV_W))
    gate, val = jnp.split(uc, 2, axis=-1)
    return (jax.nn.silu(gate) * val) @ w_down


def setup_inputs(seed: int = 0) -> dict:
    key = jax.random.key(seed)
    ks = jax.random.split(key, 40)
    f32 = jnp.float32
    nrm = lambda k, shape, s: jax.random.normal(k, shape, f32) * s
    L = DEPTH
    return {
        "x": nrm(ks[0], (BATCH, SEQ, D_MODEL), 1.0),
        "positions": jnp.arange(SEQ, dtype=jnp.int32)[None, :] + jax.random.randint(ks[1], (BATCH, 1), 0, 1024, dtype=jnp.int32),
        "norm_mix": 1.0 + nrm(ks[2], (L, D_MODEL), 0.02),
        "w_in": nrm(ks[3], (L, D_MODEL, IN_COLS), D_MODEL ** -0.5),
        "b_gate": nrm(ks[4], (L, G_COLS), 0.02),
        "idx_k_norm": 1.0 + nrm(ks[5], (L, IDX_DIM), 0.02),
        "rwkv_mu": jax.random.uniform(ks[6], (L, B_COLS), f32),
        "rwkv_w0": jax.random.uniform(ks[7], (L, MIX), f32, -6.0, 1.0),
        "rwkv_w2": nrm(ks[8], (L, DECAY_LORA, MIX), DECAY_LORA ** -0.5),
        "rwkv_a0": nrm(ks[9], (L, MIX), 0.1),
        "rwkv_a2": nrm(ks[10], (L, AAA_LORA, MIX), AAA_LORA ** -0.5),
        "rwkv_g2": nrm(ks[11], (L, GATE_LORA, MIX), GATE_LORA ** -0.5),
        "rwkv_k_k": 0.85 + nrm(ks[12], (L, MIX), 0.1),
        "rwkv_k_a": 1.0 + nrm(ks[13], (L, MIX), 0.1),
        "rwkv_r_k": nrm(ks[14], (L, MIX), 0.1),
        "rwkv_lnx_g": 1.0 + nrm(ks[15], (L, MIX), 0.02),
        "rwkv_lnx_b": nrm(ks[16], (L, MIX), 0.02),
        "pool_w": nrm(ks[17], (L, POOL_GROUPS, POOL_GROUP_DIM, POOL_GROUP_DIM), POOL_GROUP_DIM ** -0.5),
        "pool_scale": 1.0 + nrm(ks[18], (L, MIX), 0.1),
        "ssm_a_re": -0.5 + nrm(ks[19], (L, SSM_GROUPS, SSM_STATE), 1e-3),
        "ssm_a_im": math.pi * jnp.arange(SSM_STATE, dtype=f32)[None, None, :] + nrm(ks[20], (L, SSM_GROUPS, SSM_STATE), 1e-3),
        "ssm_log_dt": jax.random.uniform(ks[21], (L, SSM_GROUPS), f32, math.log(1e-3), math.log(1e-1)),
        "ssm_b_re": nrm(ks[22], (L, SSM_GROUPS, SSM_STATE, SSM_GROUP_DIM), (2 * SSM_GROUP_DIM) ** -0.5),
        "ssm_b_im": nrm(ks[23], (L, SSM_GROUPS, SSM_STATE, SSM_GROUP_DIM), (2 * SSM_GROUP_DIM) ** -0.5),
        "ssm_c_re": nrm(ks[24], (L, SSM_GROUPS, SSM_GROUP_DIM, SSM_STATE), SSM_STATE ** -0.5),
        "ssm_c_im": nrm(ks[25], (L, SSM_GROUPS, SSM_GROUP_DIM, SSM_STATE), SSM_STATE ** -0.5),
        "ssm_d": nrm(ks[26], (L, MIX), 1.0),
        "ssm_w_glu": nrm(ks[27], (L, MIX, MIX), MIX ** -0.5),
        "ssm_b_glu": nrm(ks[28], (L, MIX), 0.02),
        "w_branch": nrm(ks[29], (L, N_BRANCH, MIX, D_MODEL), MIX ** -0.5),
        "w_out": nrm(ks[30], (L, D_MODEL, D_MODEL), 0.5 * D_MODEL ** -0.5),
        "norm_ffn": 1.0 + nrm(ks[31], (L, D_MODEL), 0.02),
        "w_up": nrm(ks[32], (L, D_MODEL, 2 * D_FF), D_MODEL ** -0.5),
        "conv_w": nrm(ks[33], (L, CONV_W, 2 * D_FF), CONV_W ** -0.5),
        "conv_b": nrm(ks[34], (L, 2 * D_FF), 0.02),
        "w_down": nrm(ks[35], (L, D_FF, D_MODEL), 0.5 * D_FF ** -0.5),
        "norm_final": 1.0 + nrm(ks[36], (D_MODEL,), 0.02),
    }


def reference(x, positions, norm_mix, w_in, b_gate, idx_k_norm, rwkv_mu, rwkv_w0, rwkv_w2, rwkv_a0, rwkv_a2,
              rwkv_g2, rwkv_k_k, rwkv_k_a, rwkv_r_k, rwkv_lnx_g, rwkv_lnx_b, pool_w, pool_scale, ssm_a_re,
              ssm_a_im, ssm_log_dt, ssm_b_re, ssm_b_im, ssm_c_re, ssm_c_im, ssm_d, ssm_w_glu, ssm_b_glu,
              w_branch, w_out, norm_ffn, w_up, conv_w, conv_b, w_down, norm_final):
    bsz, seq = x.shape[0], x.shape[1]
    cos, sin = rope_tables(positions, x.dtype)
    y = x
    for l in range(DEPTH):
        h = rms_norm(y, norm_mix[l])
        z = h @ w_in[l]
        za, zb, zc, zd, zg = _split(z, [A_COLS, B_COLS, C_COLS, D_COLS, G_COLS])
        q, k, v, qi, ki, wi = _split(za, [MIX, MIX, MIX, IDX_HEADS * IDX_DIM, IDX_DIM, IDX_HEADS])
        q = partial_rope(q.reshape(bsz, seq, ATT_HEADS, ATT_HEAD_DIM), cos, sin)
        k = partial_rope(k.reshape(bsz, seq, ATT_HEADS, ATT_HEAD_DIM), cos, sin)
        v = v.reshape(bsz, seq, ATT_HEADS, ATT_HEAD_DIM)
        qi = partial_rope(qi.reshape(bsz, seq, IDX_HEADS, IDX_DIM), cos, sin)
        ki = partial_rope(rms_norm(ki, idx_k_norm[l])[:, :, None, :], cos, sin)[:, :, 0, :]
        ya = dsa_attention(q, k, v, qi, ki, wi)
        yb = rwkv7_mix(zb, rwkv_mu[l], rwkv_w0[l], rwkv_w2[l], rwkv_a0[l], rwkv_a2[l], rwkv_g2[l],
                       rwkv_k_k[l], rwkv_k_a[l], rwkv_r_k[l], rwkv_lnx_g[l], rwkv_lnx_b[l])
        yc = multiscale_pool(zc, pool_w[l], pool_scale[l])
        yd = s5_ssm(zd, ssm_a_re[l], ssm_a_im[l], ssm_log_dt[l], ssm_b_re[l], ssm_b_im[l],
                    ssm_c_re[l], ssm_c_im[l], ssm_d[l], ssm_w_glu[l], ssm_b_glu[l])
        mix = jnp.stack([ya, yb, yc, yd], axis=2)
        proj = jnp.einsum('bsnc,ncd->bsnd', mix, w_branch[l])
        gates = jax.nn.sigmoid(zg + b_gate[l]).reshape(bsz, seq, N_BRANCH, D_MODEL)
        merged = jnp.einsum('bsnd,bsnd->bsd', gates, proj)
        y = y + merged @ w_out[l]
        y = y + conv_ffn(rms_norm(y, norm_ffn[l]), w_up[l], conv_w[l], conv_b[l], w_down[l])
    return rms_norm(y, norm_final)
```

```cpp
#include <hip/hip_runtime.h>
#include <cstdio>
#include <cstdint>

#ifndef MK_N_LAUNCHES
#define MK_N_LAUNCHES 0
#endif

#define LAS __attribute__((address_space(3)))
#define GAS __attribute__((address_space(1)))
typedef unsigned short bf16_t;
typedef short bf16x8 __attribute__((ext_vector_type(8)));
typedef short s16x4 __attribute__((ext_vector_type(4)));
typedef float f32x4 __attribute__((ext_vector_type(4)));
typedef float f32x2 __attribute__((ext_vector_type(2)));
typedef float f32x16 __attribute__((ext_vector_type(16)));
typedef unsigned u32x4 __attribute__((ext_vector_type(4)));
typedef unsigned u32x2 __attribute__((ext_vector_type(2)));
#define DI __device__ __forceinline__

constexpr int NB = 4, SEQ = 2048, DM = 2048, MTOK = NB * SEQ, NL = 4, MIX = 512, DFF = 5504, DFF2 = 2 * DFF;
constexpr int IN_COLS = 13060, NZ = 13312, ZS_COLS = 5120, GCOLS = 8192;
constexpr int B_COLS = 1984;
constexpr int ZO_R = 0, ZO_K = 512, ZO_V = 1024, ZO_LW = 1536, ZO_LA = 1632, ZO_LG = 1728;
constexpr int ZO_Q = 2048, ZO_AK = 2560, ZO_AV = 3072, ZO_QI = 3584, ZO_KI = 3840, ZO_WI = 3904, ZO_C = 4096, ZO_D = 4608;
constexpr float RMS_EPS = 1e-6f, GN_EPS = 64e-5f;

constexpr size_t MiB = 1u << 20;
constexpr size_t WS_CTL = 0, CTL_ZERO_BYTES = 1 * MiB;
constexpr size_t WS_ROPE = 1 * MiB;
constexpr size_t WS_PARTA = 2 * MiB;
constexpr size_t WS_PARTB = 3 * MiB;
constexpr size_t WS_SSTATE = 4 * MiB;
constexpr size_t WS_WI = 5 * MiB;
constexpr size_t WS_KI = 6 * MiB;
constexpr size_t WS_MASK = 7 * MiB;
constexpr size_t WS_QI = 9 * MiB;
constexpr size_t WS_Q = 13 * MiB;
constexpr size_t WS_K = 21 * MiB;
constexpr size_t WS_VT = 29 * MiB;
constexpr size_t WS_Y = 37 * MiB;
constexpr size_t WS_YB = 101 * MiB;
constexpr size_t WS_MIX = 133 * MiB;
constexpr size_t WS_MERGED = 165 * MiB;
constexpr size_t WS_YS = 197 * MiB;
constexpr size_t WS_YSB = 213 * MiB;
constexpr size_t WS_RW = 221 * MiB;
constexpr size_t RW_STRIDE = 16 * MiB;
constexpr size_t WS_SC = 333 * MiB;
constexpr size_t WS_MF = 1368 * MiB;
constexpr size_t WS_ZS = 461 * MiB;
constexpr size_t WS_G = 621 * MiB;
constexpr size_t WS_U = 461 * MiB;
constexpr size_t WS_ACT = 749 * MiB;
constexpr size_t WS_WT = 836 * MiB;
constexpr size_t WT_IN = 0, WT_BR = 52 * MiB, WT_OUT = 60 * MiB, WT_UP = 68 * MiB, WT_DOWN = 111 * MiB, WT_GLU = 111 * MiB + 22544384, WT_LAYER = 133 * MiB;
constexpr size_t WS_END = WS_MF + 192 * MiB;
static_assert(WS_WT + 4 * WT_LAYER == WS_MF, "ws map");
static_assert(WT_GLU + 524288 <= WT_LAYER, "wt map");
static_assert(WS_U + (size_t)MTOK * DFF2 * 2 <= WS_ACT && WS_ACT + (size_t)MTOK * DFF * 2 <= WS_WT, "ws map");

constexpr int CW_BAR = 4096;

constexpr int RING_BYTES = 131072;
constexpr int MISC_OFF = RING_BYTES;
constexpr int RST_OFF = RING_BYTES + 1024;
constexpr int LDS_BYTES = 147456;
constexpr int NWAVES = 8, NTHR = 512;

DI unsigned f2bf(float f) { unsigned u = __builtin_bit_cast(unsigned, f); return (u + 0x7fffu + ((u >> 16) & 1u)) >> 16; }
DI unsigned cvt_pk_bf16(float lo, float hi);
DI unsigned pk2(float lo, float hi) { return cvt_pk_bf16(lo, hi); }
DI float bf2f(unsigned b) { return __builtin_bit_cast(float, b << 16); }
typedef __bf16 bf16x2v __attribute__((ext_vector_type(2)));
DI unsigned cvt_pk_bf16(float lo, float hi) { const f32x2 v = {lo, hi}; const bf16x2v b = __builtin_convertvector(v, bf16x2v); return __builtin_bit_cast(unsigned, b); }
DI float wave_sum(float v) {
#pragma unroll
    for (int o = 1; o < 64; o <<= 1) v += __shfl_xor(v, o);
    return v;
}
DI float sigmoidf_(float x) { return __builtin_amdgcn_rcpf(1.0f + __expf(-x)); }
#define LDS_WAIT() asm volatile("s_waitcnt lgkmcnt(0)" ::: "memory")
#define VM_WAIT() asm volatile("s_waitcnt vmcnt(0)" ::: "memory")
#define MFMA32(a, b, c) __builtin_amdgcn_mfma_f32_32x32x16_bf16((a), (b), (c), 0, 0, 0)

#define XB_TMO      128
#define XB_XCNT(j)  (256  + 64 * (j))
#define XB_XSUB(j)  (1280 + 64 * (j))
#define XB_XGEN(j)  (2304 + 64 * (j))
#define XB_TOP      3328
#define XB_TOPGEN   3392
#define XCD_BAR_WORDS 3456
#define XB_SPIN_CAP (1u << 21)
DI unsigned xb_ld(unsigned* p)              { return __hip_atomic_load(p, __ATOMIC_RELAXED, __HIP_MEMORY_SCOPE_AGENT); }
DI unsigned xb_add(unsigned* p, unsigned v) { return __hip_atomic_fetch_add(p, v, __ATOMIC_RELAXED, __HIP_MEMORY_SCOPE_AGENT); }
DI unsigned xb_xcc_id() { return (unsigned)__builtin_amdgcn_s_getreg((3 << 11) | 20) & 0xFu; }
#define XB_SPIN(cond, bar) do { unsigned _sp = 0; while (cond) { __builtin_amdgcn_s_sleep(1); \
    if ((++_sp & 255u) == 0u) { if (xb_ld(&(bar)[XB_TMO])) break; if (_sp > XB_SPIN_CAP) { atomicAdd(&(bar)[XB_TMO], 1u); break; } } } } while (0)
struct XcdBarrier { unsigned* bar; unsigned x; volatile LAS unsigned* st; };
DI XcdBarrier xcd_barrier_post(unsigned* bar, volatile LAS unsigned* st) {
    XcdBarrier b; b.bar = bar; b.x = xb_xcc_id(); b.st = st;
    if (threadIdx.x == 0) (void)xb_add(&bar[XB_XCNT(b.x)], 1u);
    return b;
}
DI void xcd_barrier_complete(unsigned* bar, unsigned x, unsigned& nloc, unsigned& nx) {
    const unsigned G = gridDim.x * gridDim.y * gridDim.z;
    unsigned sum, cnt, mine, sp = 0u;
    for (;;) {
        sum = 0u; cnt = 0u; mine = 0u;
#pragma unroll
        for (unsigned j = 0; j < 16; ++j) { const unsigned c = xb_ld(&bar[XB_XCNT(j)]); sum += c; cnt += (c > 0u) ? 1u : 0u; mine = (j == x) ? c : mine; }
        if (sum == G) break;
        __builtin_amdgcn_s_sleep(1);
        if ((++sp & 255u) == 0u) { if (xb_ld(&bar[XB_TMO])) break; if (sp > XB_SPIN_CAP) { atomicAdd(&bar[XB_TMO], 1u); break; } }
    }
    nloc = mine > 0u ? mine : 1u; nx = cnt > 0u ? cnt : 1u;
}
DI void xcd_barrier(const XcdBarrier& b) {
    asm volatile("s_waitcnt vmcnt(0)" ::: "memory");
    __syncthreads();
    if (threadIdx.x == 0) {
        unsigned* bar = b.bar;
        __builtin_amdgcn_s_waitcnt(0);
        unsigned nloc = b.st[0], nx = b.st[1];
        if (nloc == 0u) { xcd_barrier_complete(bar, b.x, nloc, nx); b.st[0] = nloc; b.st[1] = nx; }
        const unsigned old = xb_add(&bar[XB_XSUB(b.x)], 1u);
        const unsigned gen = old / nloc;
        if (old + 1u == (gen + 1u) * nloc) {
            __builtin_amdgcn_fence(__ATOMIC_RELEASE, "agent");
            asm volatile("s_waitcnt vmcnt(0)" ::: "memory");
            const unsigned og = xb_add(&bar[XB_TOP], 1u);
            const unsigned tg = og / nx;
            if (og + 1u == (tg + 1u) * nx) xb_add(&bar[XB_TOPGEN], 1u);
            else XB_SPIN(xb_ld(&bar[XB_TOPGEN]) == tg, bar);
            __builtin_amdgcn_fence(__ATOMIC_ACQUIRE, "agent");
            xb_add(&bar[XB_XGEN(b.x)], 1u);
            asm volatile("s_waitcnt vmcnt(0)" ::: "memory");
        } else {
            XB_SPIN(xb_ld(&bar[XB_XGEN(b.x)]) == gen, bar);
            __builtin_amdgcn_fence(__ATOMIC_ACQUIRE, "agent");
            asm volatile("s_waitcnt vmcnt(0)" ::: "memory");
        }
    }
    __syncthreads();
}

namespace pg8 {
constexpr int BM = 256, BK = 64, HALF = 128, HTB = HALF * BK * 2, STAGE_BYTES = 8 * HTB, NXCD = 8, WGM = 8;
DI int lds_byte(int r, int c) { const int st = (r >> 4) * 2 + (c >> 5), rr = r & 15, cc = c & 31, ob = rr * 64 + cc * 2; return st * 1024 + (ob ^ (((ob >> 9) & 1) << 5)); }
DI void stage_rc(int b, int& R, int& C) { const int st = b / 1024, sb = b % 1024, swz = sb ^ (((sb >> 9) & 1) << 5); R = (st >> 1) * 16 + swz / 64; C = (st & 1) * 32 + (swz % 64) / 2; }
DI int perm32(int rho) { const int n = rho >> 4, i = rho & 15; return 8 * (i >> 2) + 4 * n + (i & 3); }

struct Unit { int pm, pn, sub; long offA, offB; };
struct Gemm { const bf16_t* A; const bf16_t* Bt; int lda, ldb, K; };

struct Order {
    int nM, nN, nwg, G, c, lda, ldb, nsub, subA, subB;
    DI void init(int nM_, int nN_, int G_, int c_, int lda_, int ldb_, int nsub_ = 1, int subA_ = 0, int subB_ = 0) { nM = nM_; nN = nN_; nwg = nM * nN; G = G_; c = c_; lda = lda_; ldb = ldb_; nsub = nsub_; subA = subA_; subB = subB_; }
    DI bool next(int i, Unit& u) const {
        const int ti = i / nsub, sub = i - ti * nsub;
        const long L = (long)ti * G + c; if (L >= nwg) return false;
        int wgid = (int)L; { const int q = nwg / NXCD, r = nwg % NXCD, xcd = wgid % NXCD, off = wgid / NXCD; wgid = (xcd < r ? xcd * (q + 1) : r * (q + 1) + (xcd - r) * q) + off; }
        const int nig = WGM * nN, gid = wgid / nig, fm = gid * WGM, gsz = (nM - fm) < WGM ? (nM - fm) : WGM;
        u.pm = fm + ((wgid % nig) % gsz); u.pn = (wgid % nig) / gsz; u.sub = sub;
        u.offA = ((long)u.pm * BM * lda + (long)sub * subA) * 2; u.offB = ((long)u.pn * BM + (long)sub * subB) * (long)ldb * 2;
        return true;
    }
};

template <class Epi, class Sched, bool ALIGN_EPI>
DI void gemm_phase(LAS unsigned char* lds, const int tid, const Gemm g, const Sched& S, const Epi& E) {
    const int wid = __builtin_amdgcn_readfirstlane(tid >> 6), lane = tid & 63, wr = wid >> 2, wc = wid & 3, fr = lane & 15, fq = lane >> 4;
    const int K = g.K, nt = K / BK;
    unsigned voffA[2], voffB[2];
#pragma unroll
    for (int i = 0; i < 2; ++i) { int R, C; stage_rc(tid * 16 + i * 8192, R, C); const int Rb = Epi::PERM ? ((R & ~31) + perm32(R & 31)) : R;
        voffA[i] = (unsigned)(R * g.lda + C) * 2u; voffB[i] = (unsigned)(Rb * g.ldb + C) * 2u; }
    const size_t kstep = (size_t)(BK * 2);
    const size_t hstepA = (size_t)HALF * g.lda * 2, hstepB = (size_t)HALF * g.ldb * 2;
    const unsigned ldsw = (unsigned)wid * 1024u;
    const int aoff = lds_byte(wr * 64 + fr, fq * 8), boff = lds_byte(wc * 32 + fr, fq * 8);
#define PG8_SA(b, h) (((b) * 2 + (h)) * HTB)
#define PG8_SB(b, h) ((4 + (b) * 2 + (h)) * HTB)
#define PG8_STAGE(bufoff, gbase, voff) do { _Pragma("unroll") for (int _i = 0; _i < 2; ++_i) \
        __builtin_amdgcn_global_load_lds((const unsigned*)((const char*)(gbase) + (voff)[_i]), (LAS unsigned*)(lds + (bufoff) + ldsw + _i * 8192), 16, 0, 0); } while (0)
#define PG8_LDA(dst, b, h) do { _Pragma("unroll") for (int m = 0; m < 4; ++m) _Pragma("unroll") for (int k = 0; k < 2; ++k) dst[m][k] = *(const LAS bf16x8*)(lds + PG8_SA(b, h) + aoff + m * 2048 + k * 1024); } while (0)
#define PG8_LDB(dst, b, h) do { _Pragma("unroll") for (int n = 0; n < 2; ++n) _Pragma("unroll") for (int k = 0; k < 2; ++k) dst[n][k] = *(const LAS bf16x8*)(lds + PG8_SB(b, h) + boff + n * 2048 + k * 1024); } while (0)
#define PG8_MMA(ai, bj, At, Bt) do { __builtin_amdgcn_s_setprio(1); _Pragma("unroll") for (int m = 0; m < 4; ++m) _Pragma("unroll") for (int n = 0; n < 2; ++n) _Pragma("unroll") for (int k = 0; k < 2; ++k) \
        acc[ai][bj][m][n] = __builtin_amdgcn_mfma_f32_16x16x32_bf16(Bt[n][k], At[m][k], acc[ai][bj][m][n], 0, 0, 0); __builtin_amdgcn_s_setprio(0); } while (0)
#define PG8_WAIT_V(n) asm volatile("s_waitcnt vmcnt(" #n ")" ::: "memory")
#define PG8_WAIT_L(n) asm volatile("s_waitcnt lgkmcnt(" #n ")" ::: "memory")
#define PG8_BAR __builtin_amdgcn_s_barrier()
#define PG8_SCHED __builtin_amdgcn_sched_barrier(0)
    Unit cur, nxt; int ui = 0;
    if (!S.next(0, cur)) return;
    f32x4 acc[2][2][4][2];
#pragma unroll
    for (int a = 0; a < 2; ++a)
#pragma unroll
        for (int b = 0; b < 2; ++b)
#pragma unroll
            for (int m = 0; m < 4; ++m)
#pragma unroll
                for (int n = 0; n < 2; ++n) acc[a][b][m][n] = (f32x4){0.f, 0.f, 0.f, 0.f};
    bf16x8 At[4][2], B0[2][2], B1[2][2];
    const char* cA = (const char*)g.A + cur.offA; const char* cB = (const char*)g.Bt + cur.offB;
    PG8_STAGE(PG8_SB(0, 0), cB, voffB); PG8_STAGE(PG8_SB(0, 1), cB + hstepB, voffB); PG8_STAGE(PG8_SA(0, 0), cA, voffA); PG8_STAGE(PG8_SA(0, 1), cA + hstepA, voffA);
    if (wr == 1) PG8_BAR;
    PG8_WAIT_V(2); PG8_BAR;
    PG8_STAGE(PG8_SB(1, 0), cB + kstep, voffB); PG8_STAGE(PG8_SA(1, 0), cA + kstep, voffA); PG8_STAGE(PG8_SB(1, 1), cB + hstepB + kstep, voffB);
    PG8_WAIT_V(6); PG8_BAR;
    for (;;) {
        const bool has_next = S.next(ui + 1, nxt);
        const char* nA = has_next ? (const char*)g.A + nxt.offA : cA; const char* nB = has_next ? (const char*)g.Bt + nxt.offB : cB;
        for (int t = 0; t < nt; t += 2) {
            const bool last = (t == nt - 2);
            const char* a1 = cA + (size_t)(t + 1) * kstep;
            const char* a2 = last ? nA : cA + (size_t)(t + 2) * kstep; const char* b2 = last ? nB : cB + (size_t)(t + 2) * kstep;
            const char* a3 = a2 + kstep; const char* b3 = b2 + kstep;
            PG8_LDB(B0, 0, 0); PG8_LDB(B1, 0, 1); PG8_SCHED; PG8_LDA(At, 0, 0); PG8_STAGE(PG8_SA(1, 1), a1 + hstepA, voffA);
            PG8_WAIT_V(8); PG8_WAIT_L(0); PG8_BAR; PG8_MMA(0, 0, At, B0); PG8_MMA(0, 1, At, B1); PG8_BAR; PG8_SCHED;
            PG8_LDA(At, 0, 1); PG8_STAGE(PG8_SB(0, 0), b2, voffB); PG8_STAGE(PG8_SB(0, 1), b2 + hstepB, voffB); PG8_STAGE(PG8_SA(0, 0), a2, voffA);
            PG8_WAIT_V(8); PG8_WAIT_L(0); PG8_BAR; PG8_MMA(1, 0, At, B0); PG8_MMA(1, 1, At, B1); PG8_BAR; PG8_SCHED;
            PG8_LDB(B0, 1, 0); PG8_LDB(B1, 1, 1); PG8_SCHED; PG8_LDA(At, 1, 0); PG8_STAGE(PG8_SA(0, 1), a2 + hstepA, voffA);
            PG8_WAIT_V(8); PG8_WAIT_L(0); PG8_BAR; PG8_MMA(0, 0, At, B0); PG8_MMA(0, 1, At, B1); PG8_BAR; PG8_SCHED;
            PG8_LDA(At, 1, 1); PG8_STAGE(PG8_SB(1, 0), b3, voffB); PG8_STAGE(PG8_SB(1, 1), b3 + hstepB, voffB); PG8_STAGE(PG8_SA(1, 0), a3, voffA);
            PG8_WAIT_V(8); PG8_WAIT_L(0); PG8_BAR; PG8_MMA(1, 0, At, B0); PG8_MMA(1, 1, At, B1); PG8_BAR; PG8_SCHED;
        }
        if constexpr (ALIGN_EPI) { if (wr == 0) PG8_BAR; }
        E(acc, cur, wr, wc, fr, fq);
        if (!has_next) break;
#pragma unroll
        for (int a = 0; a < 2; ++a)
#pragma unroll
            for (int b = 0; b < 2; ++b)
#pragma unroll
                for (int m = 0; m < 4; ++m)
#pragma unroll
                    for (int n = 0; n < 2; ++n) acc[a][b][m][n] = (f32x4){0.f, 0.f, 0.f, 0.f};
        cur = nxt; cA = nA; cB = nB; ++ui;
        if constexpr (ALIGN_EPI) { if (wr == 1) PG8_BAR; }
    }
    PG8_WAIT_V(0);
    if constexpr (!ALIGN_EPI) { if (wr == 0) PG8_BAR; }
    PG8_BAR;
#undef PG8_SA
#undef PG8_SB
#undef PG8_STAGE
#undef PG8_LDA
#undef PG8_LDB
#undef PG8_MMA
#undef PG8_WAIT_V
#undef PG8_WAIT_L
#undef PG8_BAR
#undef PG8_SCHED
}

typedef const f32x4 (&AccRef)[2][2][4][2];
DI float row_scale_slow(const float* part, int row) { float s = 0.f; for (int i = 0; i < 32; ++i) s += part[(size_t)row * 32 + i]; return 1.0f / sqrtf(s * (1.0f / DM) + RMS_EPS); }

struct EpiZ {
    static constexpr bool PERM = true;
    float* ZS; bf16_t* G; const float* bgate; const float* part; const LAS float* rsT; int pm0;
    DI void operator()(AccRef acc, const Unit& u, int wr, int wc, int fr, int fq) const {
#pragma unroll
        for (int ai = 0; ai < 2; ++ai)
#pragma unroll
            for (int m = 0; m < 4; ++m) {
                const int lr = ai * HALF + wr * 64 + m * 16 + fr, row = u.pm * BM + lr;
                const float s = (u.pm == pm0) ? rsT[lr] : row_scale_slow(part, row);
#pragma unroll
                for (int bj = 0; bj < 2; ++bj) {
                    const int col0 = u.pn * BM + bj * HALF + wc * 32 + 8 * fq;
                    f32x4 v0 = acc[ai][bj][m][0] * s, v1 = acc[ai][bj][m][1] * s;
                    if (u.pn < 20) { float* p = ZS + (size_t)row * ZS_COLS + col0; *(f32x4*)p = v0; *(f32x4*)(p + 4) = v1; }
                    else { const int gc = col0 - ZS_COLS; const f32x4 b0 = *(const f32x4*)(bgate + gc), b1 = *(const f32x4*)(bgate + gc + 4);
                        v0 += b0; v1 += b1;
                        u32x4 w; w.x = cvt_pk_bf16(sigmoidf_(v0[0]), sigmoidf_(v0[1])); w.y = cvt_pk_bf16(sigmoidf_(v0[2]), sigmoidf_(v0[3]));
                        w.z = cvt_pk_bf16(sigmoidf_(v1[0]), sigmoidf_(v1[1])); w.w = cvt_pk_bf16(sigmoidf_(v1[2]), sigmoidf_(v1[3]));
                        *(u32x4*)(G + (size_t)row * GCOLS + gc) = w; }
                }
            }
    }
};
struct EpiU {
    static constexpr bool PERM = true;
    bf16_t* U; int ldc; const float* part; const LAS float* rsT; int pm0;
    DI void operator()(AccRef acc, const Unit& u, int wr, int wc, int fr, int fq) const {
#pragma unroll
        for (int ai = 0; ai < 2; ++ai)
#pragma unroll
            for (int m = 0; m < 4; ++m) {
                const int lr = ai * HALF + wr * 64 + m * 16 + fr, row = u.pm * BM + lr;
                const float s = (u.pm == pm0) ? rsT[lr] : row_scale_slow(part, row);
#pragma unroll
                for (int bj = 0; bj < 2; ++bj) {
                    const int col0 = u.pn * BM + bj * HALF + wc * 32 + 8 * fq;
                    const f32x4 v0 = acc[ai][bj][m][0] * s, v1 = acc[ai][bj][m][1] * s;
                    u32x4 w; w.x = cvt_pk_bf16(v0[0], v0[1]); w.y = cvt_pk_bf16(v0[2], v0[3]); w.z = cvt_pk_bf16(v1[0], v1[1]); w.w = cvt_pk_bf16(v1[2], v1[3]);
                    *(u32x4*)(U + (size_t)row * ldc + col0) = w;
                }
            }
    }
};
struct EpiRes {
    static constexpr bool PERM = false;
    const float* Yin; float* Y; bf16_t* YB; float* part;
    DI void operator()(AccRef acc, const Unit& u, int wr, int wc, int fr, int fq) const {
#pragma unroll
        for (int ai = 0; ai < 2; ++ai)
#pragma unroll
            for (int m = 0; m < 4; ++m) {
                const int row = u.pm * BM + ai * HALF + wr * 64 + m * 16 + fr;
                float ss = 0.f;
#pragma unroll
                for (int bj = 0; bj < 2; ++bj)
#pragma unroll
                    for (int n = 0; n < 2; ++n) {
                        const int col = u.pn * BM + bj * HALF + wc * 32 + 16 * n + 4 * fq;
                        const size_t o = (size_t)row * DM + col;
                        const f32x4 y = *(const f32x4*)(Yin + o) + acc[ai][bj][m][n];
                        *(f32x4*)(Y + o) = y;
                        u32x2 w; w.x = cvt_pk_bf16(y[0], y[1]); w.y = cvt_pk_bf16(y[2], y[3]);
                        *(u32x2*)(YB + o) = w;
                        ss += (y[0] * y[0] + y[1] * y[1]) + (y[2] * y[2] + y[3] * y[3]);
                    }
                ss += __shfl_xor(ss, 16); ss += __shfl_xor(ss, 32);
                if (fq == 0) part[(size_t)row * 32 + u.pn * 4 + wc] = ss;
            }
    }
};
struct EpiGlu {
    static constexpr bool PERM = true;
    const float* YS; const float* bias; bf16_t* MIXp;
    DI void operator()(AccRef acc, const Unit& u, int wr, int wc, int fr, int fq) const {
#pragma unroll
        for (int ai = 0; ai < 2; ++ai)
#pragma unroll
            for (int m = 0; m < 4; ++m) {
                const int row = u.pm * BM + ai * HALF + wr * 64 + m * 16 + fr;
#pragma unroll
                for (int bj = 0; bj < 2; ++bj) {
                    const int col0 = u.pn * BM + bj * HALF + wc * 32 + 8 * fq;
                    const f32x4 b0 = *(const f32x4*)(bias + col0), b1 = *(const f32x4*)(bias + col0 + 4);
                    const f32x4 y0 = *(const f32x4*)(YS + (size_t)row * MIX + col0), y1 = *(const f32x4*)(YS + (size_t)row * MIX + col0 + 4);
                    const f32x4 v0 = acc[ai][bj][m][0] + b0, v1 = acc[ai][bj][m][1] + b1;
                    u32x4 w; w.x = cvt_pk_bf16(y0[0] * sigmoidf_(v0[0]), y0[1] * sigmoidf_(v0[1])); w.y = cvt_pk_bf16(y0[2] * sigmoidf_(v0[2]), y0[3] * sigmoidf_(v0[3]));
                    w.z = cvt_pk_bf16(y1[0] * sigmoidf_(v1[0]), y1[1] * sigmoidf_(v1[1])); w.w = cvt_pk_bf16(y1[2] * sigmoidf_(v1[2]), y1[3] * sigmoidf_(v1[3]));
                    *(u32x4*)(MIXp + (size_t)row * (4 * MIX) + 3 * MIX + col0) = w;
                }
            }
    }
};
struct EpiMerge {
    static constexpr bool PERM = true;
    const bf16_t* G; float* MF; bf16_t* MERGED;
    DI void operator()(AccRef acc, const Unit& u, int wr, int wc, int fr, int fq) const {
#pragma unroll
        for (int ai = 0; ai < 2; ++ai)
#pragma unroll
            for (int m = 0; m < 4; ++m) {
                const int row = u.pm * BM + ai * HALF + wr * 64 + m * 16 + fr;
#pragma unroll
                for (int bj = 0; bj < 2; ++bj) {
                    const int col0 = u.pn * BM + bj * HALF + wc * 32 + 8 * fq;
                    const u32x4 gw = *(const u32x4*)(G + (size_t)row * GCOLS + u.sub * DM + col0);
                    f32x4 v0 = acc[ai][bj][m][0], v1 = acc[ai][bj][m][1];
                    v0[0] *= bf2f(gw.x & 0xffffu); v0[1] *= bf2f(gw.x >> 16); v0[2] *= bf2f(gw.y & 0xffffu); v0[3] *= bf2f(gw.y >> 16);
                    v1[0] *= bf2f(gw.z & 0xffffu); v1[1] *= bf2f(gw.z >> 16); v1[2] *= bf2f(gw.w & 0xffffu); v1[3] *= bf2f(gw.w >> 16);
                    float* p = MF + (size_t)row * DM + col0;
                    constexpr size_t SL = (size_t)MTOK * DM;
                    if (u.sub < 3) { *(f32x4*)(p + u.sub * SL) = v0; *(f32x4*)(p + u.sub * SL + 4) = v1; }
                    else { v0 += (*(const f32x4*)p + *(const f32x4*)(p + SL)) + *(const f32x4*)(p + 2 * SL); v1 += (*(const f32x4*)(p + 4) + *(const f32x4*)(p + SL + 4)) + *(const f32x4*)(p + 2 * SL + 4);
                        u32x4 w; w.x = cvt_pk_bf16(v0[0], v0[1]); w.y = cvt_pk_bf16(v0[2], v0[3]); w.z = cvt_pk_bf16(v1[0], v1[1]); w.w = cvt_pk_bf16(v1[2], v1[3]);
                        *(u32x4*)(MERGED + (size_t)row * DM + col0) = w; }
                }
            }
    }
};
}

struct Frame { LAS unsigned char* lds; int tid, lane, wave, bid, G; };

DI Frame fresh(const Frame& F0) { Frame F = F0; int tid = F0.tid, bid = F0.bid, G = F0.G, wave = F0.wave; unsigned lo = (unsigned)(size_t)F0.lds;
    asm volatile("" : "+v"(tid)); asm volatile("" : "+s"(bid), "+s"(G), "+s"(wave), "+s"(lo));
    F.tid = tid; F.lane = tid & 63; F.wave = wave; F.bid = bid; F.G = G; F.lds = (LAS unsigned char*)(size_t)lo; return F; }
DI unsigned char* fresh_ptr(unsigned char* p) { asm volatile("" : "+s"(p)); return p; }
DI void rs_table(const Frame& F, const float* part, int pm) {
    LAS float* rsT = (LAS float*)(F.lds + RST_OFF);
    if (F.tid < 256) { const int row = pm * 256 + F.tid; float s = 0.f;
#pragma unroll
        for (int i = 0; i < 8; ++i) { const f32x4 v = *(const f32x4*)(part + (size_t)row * 32 + 4 * i); s += (v[0] + v[1]) + (v[2] + v[3]); }
        rsT[F.tid] = 1.0f / sqrtf(s * (1.0f / DM) + RMS_EPS); }
    __syncthreads();
}

DI int head_perm(int c) { const int h = c >> 6, p = c & 63; const int dim = p < 16 ? ((p >> 1) + 8 * (p & 1)) : p; return (h << 6) + dim; }
DI int zin_colmap(int n) {
    if (n < B_COLS) return 1860 + n;
    if (n < 2048) return -1;
    if (n < 2560) return head_perm(n - 2048);
    if (n < 3072) return 512 + head_perm(n - 2560);
    if (n < 3584) return 1024 + (n - 3072);
    if (n < 3840) return 1536 + head_perm(n - 3584);
    if (n < 3904) return 1792 + head_perm(n - 3840);
    if (n < 3908) return 1856 + (n - 3904);
    if (n < 4096) return -1;
    if (n < 4608) return 3844 + (n - 4096);
    if (n < 5120) return 4356 + (n - 4608);
    return 4868 + (n - 5120);
}
template <int MODE>
DI void tr_item(const float* W, int ldw, const float* ksc, bf16_t* WT, int K, LAS float* scr, int kb, int nb, int lane) {
    const int k0 = 64 * kb, n0 = 32 * nb, nn = n0 + (lane & 31);
    const int col = MODE == 1 ? zin_colmap(nn) : nn;
#pragma unroll 8
    for (int i = 0; i < 32; ++i) { const int kk = 2 * i + (lane >> 5); float v = 0.f;
        if (col >= 0) { v = W[(size_t)(k0 + kk) * ldw + col]; if (ksc) v *= ksc[k0 + kk]; }
        scr[kk * 33 + (lane & 31)] = v; }
    LDS_WAIT(); asm volatile("" ::: "memory");
    const int c = lane & 7;
#pragma unroll
    for (int j = 0; j < 4; ++j) { const int n = (lane >> 3) + 8 * j; const LAS float* s = scr + (8 * c) * 33 + n;
        u32x4 o; o.x = pk2(s[0 * 33], s[1 * 33]); o.y = pk2(s[2 * 33], s[3 * 33]); o.z = pk2(s[4 * 33], s[5 * 33]); o.w = pk2(s[6 * 33], s[7 * 33]);
        *(u32x4*)(WT + (size_t)(n0 + n) * K + k0 + 8 * c) = o; }
    LDS_WAIT(); asm volatile("" ::: "memory");
}
struct InTab { const float* p[37]; };
#define CAS __attribute__((address_space(4)))
typedef const float* fptr_t;
struct In { CAS const fptr_t* t; DI fptr_t operator[](int i) const { return t[i]; } };
DI In in_fresh(In in) { CAS const fptr_t* t = in.t; asm volatile("" : "+s"(t)); In r; r.t = t; return r; }
DI void p0_prologue(const Frame& F, const In& in, unsigned char* ws) {
    LAS float* scr = (LAS float*)(F.lds + F.wave * 16384);
    const int gw = F.bid * NWAVES + F.wave, NGW = F.G * NWAVES;
    constexpr int I_IN = 32 * (NZ / 32), I_BR = 4 * 8 * 64, I_OUT = 32 * 64, I_UP = 32 * (DFF2 / 32), I_DN = 86 * 64, I_GLU = 8 * 16;
    constexpr int I_LAYER = I_IN + I_BR + I_OUT + I_UP + I_DN + I_GLU;
    for (int it = gw; it < NL * I_LAYER; it += NGW) {
        const int l = it / I_LAYER; int r = it - l * I_LAYER;
        unsigned char* wt = ws + WS_WT + (size_t)l * WT_LAYER;
        if (r < I_IN) { const int nbk = NZ / 32; tr_item<1>(in[3] + (size_t)l * DM * IN_COLS, IN_COLS, in[2] + l * DM, (bf16_t*)(wt + WT_IN), DM, scr, r / nbk, r % nbk, F.lane); continue; } r -= I_IN;
        if (r < I_BR) { const int n = r / 512, rr = r % 512; tr_item<0>(in[29] + ((size_t)l * 4 + n) * MIX * DM, DM, nullptr, (bf16_t*)(wt + WT_BR) + (size_t)n * DM * MIX, MIX, scr, rr / 64, rr % 64, F.lane); continue; } r -= I_BR;
        if (r < I_OUT) { tr_item<0>(in[30] + (size_t)l * DM * DM, DM, nullptr, (bf16_t*)(wt + WT_OUT), DM, scr, r / 64, r % 64, F.lane); continue; } r -= I_OUT;
        if (r < I_UP) { const int nbk = DFF2 / 32; tr_item<0>(in[32] + (size_t)l * DM * DFF2, DFF2, in[31] + l * DM, (bf16_t*)(wt + WT_UP), DM, scr, r / nbk, r % nbk, F.lane); continue; } r -= I_UP;
        if (r < I_DN) { tr_item<0>(in[35] + (size_t)l * DFF * DM, DM, nullptr, (bf16_t*)(wt + WT_DOWN), DFF, scr, r / 64, r % 64, F.lane); continue; } r -= I_DN;
        tr_item<0>(in[27] + (size_t)l * MIX * MIX, MIX, nullptr, (bf16_t*)(wt + WT_GLU), MIX, scr, r / 16, r % 16, F.lane);
    }
    const int* pos = (const int*)in[1];
    float* rope = (float*)(ws + WS_ROPE);
    for (int e = F.bid * NTHR + F.tid; e < MTOK * 8; e += F.G * NTHR) { const int m = e >> 3, i = e & 7;
        const float inv = exp2f(-(float)i * 0.125f * 18.931568569324174f);
        const float ang = (float)pos[m] * inv; float sn, cs; sincosf(ang, &sn, &cs);
        rope[m * 16 + i] = cs; rope[m * 16 + 8 + i] = sn; }
    const float* x = in[0]; bf16_t* YB = (bf16_t*)(ws + WS_YB); float* pa = (float*)(ws + WS_PARTA);
    for (int m = gw; m < MTOK; m += NGW) { float s = 0.f;
#pragma unroll
        for (int j = 0; j < 8; ++j) { const f32x4 v = *(const f32x4*)(x + (size_t)m * DM + (j * 64 + F.lane) * 4); s += (v[0] * v[0] + v[1] * v[1]) + (v[2] * v[2] + v[3] * v[3]);
            u32x2 w; w.x = pk2(v[0], v[1]); w.y = pk2(v[2], v[3]); *(u32x2*)(YB + (size_t)m * DM + (j * 64 + F.lane) * 4) = w; }
        s = wave_sum(s);
        if (F.lane < 32) pa[(size_t)m * 32 + F.lane] = (F.lane == 0) ? s : 0.f; }
}

DI void dsa_prep_item(const Frame& F, unsigned char* ws, const float* idxg, int item) {
    const float* ZS = (const float*)(ws + WS_ZS); const float* rope = (const float*)(ws + WS_ROPE);
    bf16_t* Q = (bf16_t*)(ws + WS_Q); bf16_t* Kb = (bf16_t*)(ws + WS_K); bf16_t* VT = (bf16_t*)(ws + WS_VT); bf16_t* QI = (bf16_t*)(ws + WS_QI); bf16_t* KI = (bf16_t*)(ws + WS_KI); float* WI = (float*)(ws + WS_WI);
    const int m0 = item * 64;
    for (int e = F.tid; e < 64 * 640; e += NTHR) { const int t = e / 640, pc = e % 640; const int m = m0 + t;
        int zc, oc; bf16_t* dst; int ld; float sc = 1.f;
        if (pc < 256) { zc = ZO_Q + 2 * pc; oc = 2 * pc; dst = Q; ld = 512; sc = 0.125f; }
        else if (pc < 512) { zc = ZO_AK + 2 * (pc - 256); oc = 2 * (pc - 256); dst = Kb; ld = 512; }
        else { zc = ZO_QI + 2 * (pc - 512); oc = 2 * (pc - 512); dst = QI; ld = 256; }
        const f32x2 v = *(const f32x2*)(ZS + (size_t)m * ZS_COLS + zc); float a = v[0], b = v[1];
        const int p = oc & 63;
        if (p < 16) { const float cs = rope[m * 16 + (p >> 1)], sn = rope[m * 16 + 8 + (p >> 1)]; const float a2 = a * cs - b * sn, b2 = b * cs + a * sn; a = a2; b = b2; }
        *(unsigned*)(dst + (size_t)m * ld + oc) = pk2(a * sc, b * sc); }
    for (int tt = 0; tt < 8; ++tt) { const int m = m0 + F.wave * 8 + tt;
        const float xv = ZS[(size_t)m * ZS_COLS + ZO_KI + F.lane];
        const float ss = wave_sum(xv * xv);
        const int dim = F.lane < 16 ? ((F.lane >> 1) + 8 * (F.lane & 1)) : F.lane;
        float y = xv * (1.0f / sqrtf(ss * (1.0f / 64.f) + RMS_EPS)) * idxg[dim];
        const float pr = __shfl_xor(y, 1);
        if (F.lane < 16) { const float cs = rope[m * 16 + (F.lane >> 1)], sn = rope[m * 16 + 8 + (F.lane >> 1)]; y = (F.lane & 1) ? (y * cs + pr * sn) : (y * cs - pr * sn); }
        KI[(size_t)m * 64 + F.lane] = (bf16_t)f2bf(y);
        if (F.lane < 4) WI[(size_t)m * 4 + F.lane] = ZS[(size_t)m * ZS_COLS + ZO_WI + F.lane]; }
    LAS unsigned char* L = F.lds;
    for (int e = F.tid; e < 64 * 128; e += NTHR) { const int t = e >> 7, c4 = (e & 127) * 4;
        const f32x4 v = *(const f32x4*)(ZS + (size_t)(m0 + t) * ZS_COLS + ZO_AV + c4);
        u32x2 w; w.x = pk2(v[0], v[1]); w.y = pk2(v[2], v[3]); *(LAS u32x2*)(L + t * 1040 + c4 * 2) = w; }
    __syncthreads();
    { const int b = m0 / SEQ, s0 = m0 % SEQ;
      for (int e = F.tid; e < 512 * 8; e += NTHR) { const int c = e >> 3, oct = e & 7;
          unsigned short vals[8];
#pragma unroll
          for (int j = 0; j < 8; ++j) vals[j] = *(const LAS unsigned short*)(L + (oct * 8 + j) * 1040 + c * 2);
          u32x4 o; o.x = vals[0] | ((unsigned)vals[1] << 16); o.y = vals[2] | ((unsigned)vals[3] << 16); o.z = vals[4] | ((unsigned)vals[5] << 16); o.w = vals[6] | ((unsigned)vals[7] << 16);
          *(u32x4*)(VT + ((size_t)(b * 512 + c)) * SEQ + s0 + oct * 8) = o; } }
    __syncthreads();
}

DI float softplusf_(float x) { return fmaxf(x, 0.f) + log1pf(__expf(-fabsf(x))); }
DI void rwkv_prep_item(const Frame& F, unsigned char* ws, const In& in, int l, int item) {
    const float* ZS = (const float*)(ws + WS_ZS);
    const float* mu = in[6] + l * B_COLS; const float* w0 = in[7] + l * MIX; const float* w2 = in[8] + (size_t)l * 96 * MIX; const float* a0 = in[9] + l * MIX;
    const float* a2 = in[10] + (size_t)l * 96 * MIX; const float* g2 = in[11] + (size_t)l * 256 * MIX; const float* k_k = in[12] + l * MIX; const float* k_a = in[13] + l * MIX;
    float* RW = (float*)(ws + WS_RW); constexpr size_t RS = RW_STRIDE / 4;
    const int m0 = item * 32; const bool first = (m0 % SEQ) == 0;
    LAS float* LW = (LAS float*)F.lds;
    LAS float* LA = LW + 96 * 32;
    LAS float* LG = LA + 96 * 32;
    for (int e = F.tid; e < 32 * 448; e += NTHR) { const int t = e / 448, c = e % 448; const int m = m0 + t, zc = ZO_LW + c;
        const float z = ZS[(size_t)m * ZS_COLS + zc]; const float zp = (first && t == 0) ? 0.f : ZS[(size_t)(m - 1) * ZS_COLS + zc];
        const float xs = z + (zp - z) * mu[zc];
        if (c < 96) LW[c * 32 + t] = tanhf(xs); else if (c < 192) LA[(c - 96) * 32 + t] = xs; else LG[(c - 192) * 32 + t] = sigmoidf_(xs); }
    __syncthreads();
    const int j = F.tid;
    const float muR = mu[ZO_R + j], muK = mu[ZO_K + j], muV = mu[ZO_V + j];
    const float w0j = w0[j], a0j = a0[j], kkj = k_k[j], kaj = k_a[j];
#pragma unroll 1
    for (int half = 0; half < 2; ++half) {
        float dw[16], da[16], dg[16];
#pragma unroll
        for (int t = 0; t < 16; ++t) { dw[t] = 0.f; da[t] = 0.f; dg[t] = 0.f; }
#pragma unroll 2
        for (int k = 0; k < 96; ++k) { const float wv = w2[k * MIX + j], av = a2[k * MIX + j];
#pragma unroll
            for (int q = 0; q < 4; ++q) { const f32x4 x = *(const LAS f32x4*)(LW + k * 32 + half * 16 + 4 * q), y = *(const LAS f32x4*)(LA + k * 32 + half * 16 + 4 * q);
#pragma unroll
                for (int i = 0; i < 4; ++i) { dw[4 * q + i] += x[i] * wv; da[4 * q + i] += y[i] * av; } } }
#pragma unroll 2
        for (int k = 0; k < 256; ++k) { const float gv = g2[k * MIX + j];
#pragma unroll
            for (int q = 0; q < 4; ++q) { const f32x4 x = *(const LAS f32x4*)(LG + k * 32 + half * 16 + 4 * q);
#pragma unroll
                for (int i = 0; i < 4; ++i) dg[4 * q + i] += x[i] * gv; } }
        const int mb = m0 + half * 16;
        float pr, pk, pv;
        if (first && half == 0) { pr = 0.f; pk = 0.f; pv = 0.f; }
        else { const float* zp = ZS + (size_t)(mb - 1) * ZS_COLS; pr = zp[ZO_R + j]; pk = zp[ZO_K + j]; pv = zp[ZO_V + j]; }
#pragma unroll
        for (int t = 0; t < 16; ++t) { const int m = mb + t; const float* zr = ZS + (size_t)m * ZS_COLS;
            const float zr_ = zr[ZO_R + j], zk_ = zr[ZO_K + j], zv_ = zr[ZO_V + j];
            const float r = zr_ + (pr - zr_) * muR, k = zk_ + (pk - zk_) * muK, v = zv_ + (pv - zv_) * muV;
            pr = zr_; pk = zk_; pv = zv_;
            const float wlog = -softplusf_(-(w0j + dw[t])) - 0.5f;
            const float decay = expf(-expf(wlog));
            const float a = sigmoidf_(a0j + da[t]);
            const float kkr = k * kkj;
            const float nrm = sqrtf(wave_sum(kkr * kkr));
            const float kk = kkr / fmaxf(nrm, 1e-12f);
            const float k2 = k * (1.0f + (a - 1.0f) * kaj);
            const size_t o = (size_t)m * MIX + j;
            RW[0 * RS + o] = r; RW[1 * RS + o] = decay; RW[2 * RS + o] = k2; RW[3 * RS + o] = v; RW[4 * RS + o] = -kk; RW[5 * RS + o] = kk * a; RW[6 * RS + o] = dg[t]; }
    }
    __syncthreads();
}

DI void pool_item(const Frame& F, unsigned char* ws, const In& in, int l, int item) {
    const float* ZS = (const float*)(ws + WS_ZS); bf16_t* MIXp = (bf16_t*)(ws + WS_MIX);
    const float* pw = in[17] + (size_t)l * 4 * 128 * 128; const float* psc = in[18] + l * MIX;
    const int m0 = item * 16, t0 = m0 % SEQ;
    LAS float* Z = (LAS float*)F.lds;
    LAS float* DT = Z + 31 * 512;
    for (int e = F.tid; e < 31 * 128; e += NTHR) { const int r = e >> 7, c4 = (e & 127) * 4; const int ta = t0 - 15 + r;
        f32x4 v = (f32x4){0.f, 0.f, 0.f, 0.f};
        if (ta >= 0) v = *(const f32x4*)(ZS + (size_t)(m0 - 15 + r) * ZS_COLS + ZO_C + c4);
        *(LAS f32x4*)(Z + r * 512 + c4) = v; }
    __syncthreads();
    const int j = F.tid, gi = j >> 7, win = 2 << gi;
    for (int t = 0; t < 16; ++t) { float s = 0.f;
        for (int i = 0; i < win; ++i) s += Z[(15 + t - i) * 512 + j];
        const int cnt = (t0 + t + 1) < win ? (t0 + t + 1) : win;
        DT[j * 16 + t] = s / (float)cnt - Z[(15 + t) * 512 + j]; }
    __syncthreads();
    float acc[16];
#pragma unroll
    for (int t = 0; t < 16; ++t) acc[t] = 0.f;
    const int dcol = j & 127;
#pragma unroll 2
    for (int k = 0; k < 128; ++k) { const float wv = pw[((size_t)gi * 128 + k) * 128 + dcol];
#pragma unroll
        for (int q = 0; q < 4; ++q) { const f32x4 x = *(const LAS f32x4*)(DT + (gi * 128 + k) * 16 + 4 * q);
#pragma unroll
            for (int i = 0; i < 4; ++i) acc[4 * q + i] += x[i] * wv; } }
    const float sc = psc[j];
#pragma unroll
    for (int t = 0; t < 16; ++t) MIXp[(size_t)(m0 + t) * (4 * MIX) + 2 * MIX + j] = (bf16_t)f2bf(acc[t] * sc);
    __syncthreads();
}

struct SsmCoef { float lr, li; float br[16], bi[16]; };
DI void ssm_coef(const In& in, int l, int g, int p, SsmCoef& c) {
    const float are = in[19][((size_t)l * 32 + g) * 64 + p], aim = in[20][((size_t)l * 32 + g) * 64 + p];
    const float dt = expf(in[21][l * 32 + g]);
    const float er = expf(are * dt); float sn, cs; sincosf(aim * dt, &sn, &cs);
    c.lr = er * cs; c.li = er * sn;
    const float nr = c.lr - 1.0f, ni = c.li, den = are * are + aim * aim;
    const float cr = (nr * are + ni * aim) / den, ci = (ni * are - nr * aim) / den;
    const float* bre = in[22] + (((size_t)l * 32 + g) * 64 + p) * 16; const float* bim = in[23] + (((size_t)l * 32 + g) * 64 + p) * 16;
#pragma unroll
    for (int k = 0; k < 16; ++k) { const float x = bre[k], y = bim[k]; c.br[k] = cr * x - ci * y; c.bi[k] = cr * y + ci * x; }
}
DI void ssm_pass1_item(const Frame& F, unsigned char* ws, const In& in, int l, int item) {
    const float* ZS = (const float*)(ws + WS_ZS); float* SST = (float*)(ws + WS_SSTATE);
    const int wt = item * 8 + F.wave, b = wt >> 9, g = (wt >> 4) & 31, ch = wt & 15, p = F.lane;
    SsmCoef c; ssm_coef(in, l, g, p, c);
    LAS float* UL = (LAS float*)(F.lds + F.wave * 8192);
    const int mb = b * SEQ + ch * 128;
#pragma unroll
    for (int i = 0; i < 8; ++i) { const int e = i * 64 + F.lane, t = e >> 2, q = e & 3;
        *(LAS f32x4*)(UL + t * 16 + q * 4) = *(const f32x4*)(ZS + (size_t)(mb + t) * ZS_COLS + ZO_D + g * 16 + q * 4); }
    LDS_WAIT(); asm volatile("" ::: "memory");
    float xr = 0.f, xi = 0.f;
#pragma unroll 2
    for (int t = 0; t < 128; ++t) { float bur = 0.f, bui = 0.f;
#pragma unroll
        for (int q = 0; q < 4; ++q) { const f32x4 u = *(const LAS f32x4*)(UL + t * 16 + q * 4);
#pragma unroll
            for (int i = 0; i < 4; ++i) { bur += c.br[4 * q + i] * u[i]; bui += c.bi[4 * q + i] * u[i]; } }
        const float nr = c.lr * xr - c.li * xi + bur, ni = c.lr * xi + c.li * xr + bui; xr = nr; xi = ni; }
    *(f32x2*)(SST + ((size_t)wt * 64 + p) * 2) = (f32x2){xr, xi};
    LDS_WAIT(); asm volatile("" ::: "memory");
}
DI float gelu_tanh(float y) { const float u = 0.7978845608028654f * (y + 0.044715f * y * y * y); return 0.5f * y * (1.0f + tanhf(u)); }
DI void ssm_pass3_item(const Frame& F, unsigned char* ws, const In& in, int l, int item) {
    const float* ZS = (const float*)(ws + WS_ZS); const float* SST = (const float*)(ws + WS_SSTATE);
    float* YS = (float*)(ws + WS_YS); bf16_t* YSB = (bf16_t*)(ws + WS_YSB);
    const int wt = item * 8 + F.wave, b = wt >> 9, g = (wt >> 4) & 31, ch = wt & 15, p = F.lane;
    SsmCoef c; ssm_coef(in, l, g, p, c);
    LAS float* CL = (LAS float*)(F.lds + 98304);
    { const float* cre = in[24] + ((size_t)l * 32 + g) * 16 * 64; const float* cim = in[25] + ((size_t)l * 32 + g) * 16 * 64;
      for (int e = F.tid; e < 1024; e += NTHR) { const int cc = e >> 6, pp = e & 63; *(LAS f32x2*)(CL + cc * 132 + pp * 2) = (f32x2){cre[e], cim[e]}; } }
    __syncthreads();
    float l128r = c.lr, l128i = c.li;
#pragma unroll
    for (int i = 0; i < 7; ++i) { const float nr = l128r * l128r - l128i * l128i, ni = 2.f * l128r * l128i; l128r = nr; l128i = ni; }
    float xr = 0.f, xi = 0.f;
    for (int cc = 0; cc < ch; ++cc) { const f32x2 e = *(const f32x2*)(SST + ((size_t)(wt - ch + cc) * 64 + p) * 2);
        const float nr = l128r * xr - l128i * xi + e[0], ni = l128r * xi + l128i * xr + e[1]; xr = nr; xi = ni; }
    LAS float* UL = (LAS float*)(F.lds + F.wave * 12288);
    LAS float* XS = UL + 256;
    const int mb = b * SEQ + ch * 128;
    const float dsk = in[26][l * MIX + g * 16 + (F.lane & 15)];
    for (int sc = 0; sc < 8; ++sc) {
        { const int t = F.lane >> 2, q = F.lane & 3;
          *(LAS f32x4*)(UL + t * 16 + q * 4) = *(const f32x4*)(ZS + (size_t)(mb + sc * 16 + t) * ZS_COLS + ZO_D + g * 16 + q * 4); }
        LDS_WAIT(); asm volatile("" ::: "memory");
#pragma unroll 2
        for (int t = 0; t < 16; ++t) { float bur = 0.f, bui = 0.f;
#pragma unroll
            for (int q = 0; q < 4; ++q) { const f32x4 u = *(const LAS f32x4*)(UL + t * 16 + q * 4);
#pragma unroll
                for (int i = 0; i < 4; ++i) { bur += c.br[4 * q + i] * u[i]; bui += c.bi[4 * q + i] * u[i]; } }
            const float nr = c.lr * xr - c.li * xi + bur, ni = c.lr * xi + c.li * xr + bui; xr = nr; xi = ni;
            *(LAS f32x2*)(XS + (t * 64 + p) * 2) = (f32x2){xr, xi}; }
        LDS_WAIT(); asm volatile("" ::: "memory");
        const int cc = F.lane & 15, tq = F.lane >> 4;
        float y[4] = {0.f, 0.f, 0.f, 0.f};
#pragma unroll 4
        for (int pp = 0; pp < 64; pp += 2) { const f32x4 cv = *(const LAS f32x4*)(CL + cc * 132 + pp * 2);
#pragma unroll
            for (int jj = 0; jj < 4; ++jj) { const f32x4 xv = *(const LAS f32x4*)(XS + ((tq * 4 + jj) * 64 + pp) * 2);
                y[jj] += cv[0] * xv[0] - cv[1] * xv[1] + cv[2] * xv[2] - cv[3] * xv[3]; } }
#pragma unroll
        for (int jj = 0; jj < 4; ++jj) { const int t = tq * 4 + jj; const int m = mb + sc * 16 + t;
            const float yy = gelu_tanh(y[jj] + dsk * UL[t * 16 + cc]);
            YS[(size_t)m * MIX + g * 16 + cc] = yy; YSB[(size_t)m * MIX + g * 16 + cc] = (bf16_t)f2bf(yy); }
        LDS_WAIT(); asm volatile("" ::: "memory");
    }
    __syncthreads();
}

DI void rwkv_scan_item(const Frame& F, unsigned char* ws, const In& in, int l, int item) {
    const float* RW = (const float*)(ws + WS_RW); constexpr size_t RS = RW_STRIDE / 4;
    bf16_t* MIXp = (bf16_t*)(ws + WS_MIX);
    const float* r_k = in[14] + l * MIX; const float* lng = in[15] + l * MIX; const float* lnb = in[16] + l * MIX;
    constexpr int TC = 16;
    LAS float* ST = (LAS float*)F.lds;
    LAS float* YL = ST + 2 * 6 * TC * 64;
    const int pr = F.wave >> 2, rq = F.wave & 3, ri = F.lane >> 2, jq = F.lane & 3, row = rq * 16 + ri;
    const int bh0 = item * 2;
    float S[16];
#pragma unroll
    for (int k = 0; k < 16; ++k) S[k] = 0.f;
    for (int c0 = 0; c0 < SEQ; c0 += TC) {
        for (int e = F.tid; e < 2 * 6 * TC * 16; e += NTHR) { const int q = e & 15, t = (e >> 4) % TC, a = (e / (16 * TC)) % 6, pp = e / (16 * TC * 6);
            const int bh = bh0 + pp, b = bh >> 3, h = bh & 7;
            *(LAS f32x4*)(ST + ((pp * 6 + a) * TC + t) * 64 + q * 4) = *(const f32x4*)(RW + a * RS + (size_t)(b * SEQ + c0 + t) * MIX + h * 64 + q * 4); }
        __syncthreads();
        const LAS float* P = ST + pr * 6 * TC * 64;
#pragma unroll 1
        for (int t = 0; t < TC; ++t) {
            const LAS float* rr = P + (0 * TC + t) * 64 + jq * 16; const LAS float* ww = P + (1 * TC + t) * 64 + jq * 16; const LAS float* kk = P + (2 * TC + t) * 64 + jq * 16;
            const LAS float* aa = P + (4 * TC + t) * 64 + jq * 16; const LAS float* bb = P + (5 * TC + t) * 64 + jq * 16;
            const float v = P[(3 * TC + t) * 64 + row];
            float sa = 0.f;
#pragma unroll
            for (int q = 0; q < 4; ++q) { const f32x4 a4 = *(const LAS f32x4*)(aa + 4 * q);
#pragma unroll
                for (int i = 0; i < 4; ++i) sa += S[4 * q + i] * a4[i]; }
            sa += __shfl_xor(sa, 1); sa += __shfl_xor(sa, 2);
            float y = 0.f;
#pragma unroll
            for (int q = 0; q < 4; ++q) { const f32x4 w4 = *(const LAS f32x4*)(ww + 4 * q), b4 = *(const LAS f32x4*)(bb + 4 * q), k4 = *(const LAS f32x4*)(kk + 4 * q), r4 = *(const LAS f32x4*)(rr + 4 * q);
#pragma unroll
                for (int i = 0; i < 4; ++i) { const float s = S[4 * q + i] * w4[i] + (sa * b4[i] + v * k4[i]); S[4 * q + i] = s; y += s * r4[i]; } }
            y += __shfl_xor(y, 1); y += __shfl_xor(y, 2);
            if (jq == 0) YL[(pr * TC + t) * 64 + row] = y;
        }
        __syncthreads();
        for (int gq = 0; gq < (2 * TC) / 8; ++gq) { const int gi = F.wave * ((2 * TC) / 8) + gq, pp = gi / TC, t = gi % TC;
            const int bh = bh0 + pp, b = bh >> 3, h = bh & 7, m = b * SEQ + c0 + t, ch = h * 64 + F.lane;
            const float y = YL[(pp * TC + t) * 64 + F.lane];
            const float mean = wave_sum(y) * (1.f / 64.f); const float d = y - mean; const float var = wave_sum(d * d) * (1.f / 64.f);
            const float yn = d * (1.0f / sqrtf(var + GN_EPS)) * lng[ch] + lnb[ch];
            const LAS float* Pp = ST + pp * 6 * TC * 64;
            const float rj = Pp[(0 * TC + t) * 64 + F.lane], kj = Pp[(2 * TC + t) * 64 + F.lane], vj = Pp[(3 * TC + t) * 64 + F.lane];
            const float bon = wave_sum(rj * kj * r_k[ch]) * vj;
            const float gt = RW[6 * RS + (size_t)m * MIX + ch];
            MIXp[(size_t)m * (4 * MIX) + MIX + ch] = (bf16_t)f2bf((yn + bon) * gt); }
        __syncthreads();
    }
}

DI unsigned fkey(float v) { unsigned u = __builtin_bit_cast(unsigned, v); if (u == 0x80000000u) u = 0u; return (u & 0x80000000u) ? ~u : (u | 0x80000000u); }
DI bf16x8 pack8(float a0, float a1, float a2, float a3, float a4, float a5, float a6, float a7) {
    u32x4 p; p.x = pk2(a0, a1); p.y = pk2(a2, a3); p.z = pk2(a4, a5); p.w = pk2(a6, a7); return __builtin_bit_cast(bf16x8, p); }
DI void dsa_item(const Frame& F, unsigned char* ws, int item) {
    const bf16_t* Q = (const bf16_t*)(ws + WS_Q); const bf16_t* Kb = (const bf16_t*)(ws + WS_K); const bf16_t* VT = (const bf16_t*)(ws + WS_VT);
    const bf16_t* QI = (const bf16_t*)(ws + WS_QI); const bf16_t* KI = (const bf16_t*)(ws + WS_KI); const float* WI = (const float*)(ws + WS_WI);
    float* SC = (float*)(ws + WS_SC); unsigned* MASK = (unsigned*)(ws + WS_MASK); bf16_t* MIXp = (bf16_t*)(ws + WS_MIX);
    const int b = item >> 6, qb = item & 63, q0 = qb * 32, m0 = b * SEQ + q0;
    const int r = F.lane & 31, hh = F.lane >> 5;
    {
        bf16x8 qf[4][4]; float wv[4];
#pragma unroll
        for (int hd = 0; hd < 4; ++hd) { wv[hd] = WI[(size_t)(m0 + r) * 4 + hd];
#pragma unroll
            for (int s = 0; s < 4; ++s) qf[hd][s] = *(const bf16x8*)(QI + (size_t)(m0 + r) * 256 + hd * 64 + 16 * s + 8 * hh); }
        for (int kt = F.wave; kt <= qb; kt += 8) {
            bf16x8 kf[4];
#pragma unroll
            for (int s = 0; s < 4; ++s) kf[s] = *(const bf16x8*)(KI + (size_t)(b * SEQ + kt * 32 + r) * 64 + 16 * s + 8 * hh);
            f32x16 sc;
#pragma unroll
            for (int i = 0; i < 16; ++i) sc[i] = 0.f;
#pragma unroll
            for (int hd = 0; hd < 4; ++hd) { f32x16 a;
#pragma unroll
                for (int i = 0; i < 16; ++i) a[i] = 0.f;
#pragma unroll
                for (int s = 0; s < 4; ++s) a = MFMA32(kf[s], qf[hd][s], a);
#pragma unroll
                for (int i = 0; i < 16; ++i) sc[i] += wv[hd] * fmaxf(a[i], 0.f); }
#pragma unroll
            for (int g = 0; g < 4; ++g) *(f32x4*)(SC + (size_t)(m0 + r) * SEQ + kt * 32 + 8 * g + 4 * hh) = (f32x4){sc[4 * g], sc[4 * g + 1], sc[4 * g + 2], sc[4 * g + 3]};
        }
    }
    VM_WAIT(); __syncthreads();
    {
        LAS unsigned* KL = (LAS unsigned*)(F.lds + F.wave * 8192);
        for (int qq = 0; qq < 4; ++qq) {
            const int rq = F.wave * 4 + qq, t = q0 + rq, m = m0 + rq;
            unsigned* mrow = MASK + (size_t)m * 64;
            const int nj = (t >> 6) + 1;
            if (t + 1 <= 256) {
                for (int j = 0; j < 32; ++j) { const unsigned long long bm = __ballot(F.lane + 64 * j <= t); if (F.lane == 0) { mrow[2 * j] = (unsigned)bm; mrow[2 * j + 1] = (unsigned)(bm >> 32); } }
            } else {
                for (int j = 0; j < nj; ++j) { const int s = F.lane + 64 * j; unsigned k = 0u; if (s <= t) k = fkey(SC[(size_t)m * SEQ + s]); KL[j * 64 + F.lane] = k; }
                LDS_WAIT(); asm volatile("" ::: "memory");
                unsigned T = 0u;
                for (int bit = 31; bit >= 0; --bit) { const unsigned cand = T | (1u << bit); int cnt = 0;
#pragma unroll 4
                    for (int j = 0; j < nj; ++j) cnt += __popcll(__ballot(KL[j * 64 + F.lane] >= cand));
                    if (cnt >= 256) T = cand; }
                int cgt = 0;
#pragma unroll 4
                for (int j = 0; j < nj; ++j) cgt += __popcll(__ballot(KL[j * 64 + F.lane] > T));
                const int need = 256 - cgt; int run = 0;
                const unsigned long long lt = (1ull << F.lane) - 1ull;
                for (int j = 0; j < 32; ++j) {
                    unsigned long long bm = 0ull;
                    if (j < nj) { const unsigned k = KL[j * 64 + F.lane]; const unsigned long long eq = __ballot(k == T), gt = __ballot(k > T);
                        const int pre = run + __popcll(eq & lt);
                        const unsigned long long se = __ballot(k == T && pre < need);
                        bm = gt | se; run += __popcll(eq); }
                    if (F.lane == 0) { mrow[2 * j] = (unsigned)bm; mrow[2 * j + 1] = (unsigned)(bm >> 32); } }
                LDS_WAIT(); asm volatile("" ::: "memory");
            }
        }
    }
    VM_WAIT(); __syncthreads();
    {
        const int hd = F.wave;
        bf16x8 qf[4];
#pragma unroll
        for (int s = 0; s < 4; ++s) qf[s] = *(const bf16x8*)(Q + (size_t)(m0 + r) * 512 + hd * 64 + 16 * s + 8 * hh);
        f32x16 o0, o1;
#pragma unroll
        for (int i = 0; i < 16; ++i) { o0[i] = 0.f; o1[i] = 0.f; }
        float mrun = -1e30f, lrun = 0.f;
        const bf16_t* vbase = VT + ((size_t)(b * 8 + hd) * 64 + r) * SEQ;
        for (int kt = 0; kt <= qb; ++kt) {
            bf16x8 kf[4];
#pragma unroll
            for (int s = 0; s < 4; ++s) kf[s] = *(const bf16x8*)(Kb + (size_t)(b * SEQ + kt * 32 + r) * 512 + hd * 64 + 16 * s + 8 * hh);
            const unsigned mw = MASK[(size_t)(m0 + r) * 64 + kt];
            f32x16 sa;
#pragma unroll
            for (int i = 0; i < 16; ++i) sa[i] = 0.f;
#pragma unroll
            for (int s = 0; s < 4; ++s) sa = MFMA32(kf[s], qf[s], sa);
            float mx = -1e30f;
#pragma unroll
            for (int i = 0; i < 16; ++i) { const int kr = (i & 3) + 8 * (i >> 2) + 4 * hh; const bool on = (mw >> kr) & 1u; sa[i] = on ? sa[i] : -1e30f; mx = fmaxf(mx, sa[i]); }
            mx = fmaxf(mx, __shfl_xor(mx, 32));
            const float mnew = fmaxf(mrun, mx), alpha = __expf(mrun - mnew);
            float p[16], ps = 0.f;
#pragma unroll
            for (int i = 0; i < 16; ++i) { p[i] = (sa[i] > -1e29f) ? __expf(sa[i] - mnew) : 0.f; ps += p[i]; }
            lrun = lrun * alpha + ps; mrun = mnew;
#pragma unroll
            for (int i = 0; i < 16; ++i) { o0[i] *= alpha; o1[i] *= alpha; }
#pragma unroll
            for (int s2 = 0; s2 < 2; ++s2) {
                const bf16x8 pb = pack8(p[8 * s2], p[8 * s2 + 1], p[8 * s2 + 2], p[8 * s2 + 3], p[8 * s2 + 4], p[8 * s2 + 5], p[8 * s2 + 6], p[8 * s2 + 7]);
                const bf16_t* vp = vbase + kt * 32 + 16 * s2 + 4 * hh;
                const s16x4 a0 = *(const s16x4*)(vp), a1 = *(const s16x4*)(vp + 8);
                const s16x4 c0 = *(const s16x4*)(vp + (size_t)32 * SEQ), c1 = *(const s16x4*)(vp + (size_t)32 * SEQ + 8);
                const bf16x8 vf0 = __builtin_shufflevector(a0, a1, 0, 1, 2, 3, 4, 5, 6, 7), vf1 = __builtin_shufflevector(c0, c1, 0, 1, 2, 3, 4, 5, 6, 7);
                o0 = MFMA32(vf0, pb, o0); o1 = MFMA32(vf1, pb, o1);
            }
        }
        const float inv = 1.0f / (lrun + __shfl_xor(lrun, 32));
        bf16_t* orow = MIXp + (size_t)(m0 + r) * (4 * MIX) + hd * 64;
#pragma unroll
        for (int g = 0; g < 4; ++g) {
            u32x2 w0; w0.x = pk2(o0[4 * g] * inv, o0[4 * g + 1] * inv); w0.y = pk2(o0[4 * g + 2] * inv, o0[4 * g + 3] * inv);
            u32x2 w1; w1.x = pk2(o1[4 * g] * inv, o1[4 * g + 1] * inv); w1.y = pk2(o1[4 * g + 2] * inv, o1[4 * g + 3] * inv);
            *(u32x2*)(orow + 8 * g + 4 * hh) = w0; *(u32x2*)(orow + 32 + 8 * g + 4 * hh) = w1; }
    }
    __syncthreads();
}

DI float siluf_(float x) { return x * sigmoidf_(x); }
DI void conv_phase(const Frame& F, unsigned char* ws, const In& in, int l) {
    const bf16_t* U = (const bf16_t*)(ws + WS_U); bf16_t* ACT = (bf16_t*)(ws + WS_ACT);
    const float* cw = in[33] + (size_t)l * 3 * DFF2; const float* cb = in[34] + (size_t)l * DFF2;
    constexpr int NCG = DFF / 8;
    const long total = (long)NCG * (MTOK / 32);
    for (long e = (long)F.bid * NTHR + F.tid; e < total; e += (long)F.G * NTHR) {
        const int cg = (int)(e % NCG), tg = (int)(e / NCG); const int f0 = cg * 8, m0 = tg * 32; const bool first = (m0 % SEQ) == 0;
        float wg[3][8], wv[3][8], bg[8], bv[8];
#pragma unroll
        for (int j = 0; j < 3; ++j)
#pragma unroll
            for (int i = 0; i < 8; ++i) { wg[j][i] = cw[(size_t)j * DFF2 + f0 + i]; wv[j][i] = cw[(size_t)j * DFF2 + DFF + f0 + i]; }
#pragma unroll
        for (int i = 0; i < 8; ++i) { bg[i] = cb[f0 + i]; bv[i] = cb[DFF + f0 + i]; }
        float g1[8], g2[8], v1[8], v2[8];
#pragma unroll
        for (int i = 0; i < 8; ++i) { g1[i] = 0.f; g2[i] = 0.f; v1[i] = 0.f; v2[i] = 0.f; }
        if (!first) {
            const u32x4 a = *(const u32x4*)(U + (size_t)(m0 - 1) * DFF2 + f0), b = *(const u32x4*)(U + (size_t)(m0 - 2) * DFF2 + f0);
            const u32x4 c = *(const u32x4*)(U + (size_t)(m0 - 1) * DFF2 + DFF + f0), d = *(const u32x4*)(U + (size_t)(m0 - 2) * DFF2 + DFF + f0);
#pragma unroll
            for (int i = 0; i < 4; ++i) { g1[2 * i] = bf2f(a[i] & 0xffffu); g1[2 * i + 1] = bf2f(a[i] >> 16); g2[2 * i] = bf2f(b[i] & 0xffffu); g2[2 * i + 1] = bf2f(b[i] >> 16);
                v1[2 * i] = bf2f(c[i] & 0xffffu); v1[2 * i + 1] = bf2f(c[i] >> 16); v2[2 * i] = bf2f(d[i] & 0xffffu); v2[2 * i + 1] = bf2f(d[i] >> 16); }
        }
#pragma unroll 2
        for (int t = 0; t < 32; ++t) {
            const u32x4 a = *(const u32x4*)(U + (size_t)(m0 + t) * DFF2 + f0), c = *(const u32x4*)(U + (size_t)(m0 + t) * DFF2 + DFF + f0);
            float g0[8], v0[8], o[8];
#pragma unroll
            for (int i = 0; i < 4; ++i) { g0[2 * i] = bf2f(a[i] & 0xffffu); g0[2 * i + 1] = bf2f(a[i] >> 16); v0[2 * i] = bf2f(c[i] & 0xffffu); v0[2 * i + 1] = bf2f(c[i] >> 16); }
#pragma unroll
            for (int i = 0; i < 8; ++i) { const float gc = bg[i] + wg[0][i] * g2[i] + wg[1][i] * g1[i] + wg[2][i] * g0[i]; const float vc = bv[i] + wv[0][i] * v2[i] + wv[1][i] * v1[i] + wv[2][i] * v0[i];
                o[i] = siluf_(gc) * vc; g2[i] = g1[i]; g1[i] = g0[i]; v2[i] = v1[i]; v1[i] = v0[i]; }
            u32x4 w; w.x = pk2(o[0], o[1]); w.y = pk2(o[2], o[3]); w.z = pk2(o[4], o[5]); w.w = pk2(o[6], o[7]);
            *(u32x4*)(ACT + (size_t)(m0 + t) * DFF + f0) = w;
        }
    }
}

DI void final_phase(const Frame& F, unsigned char* ws, const float* gfin, float* out) {
    const float* Y = (const float*)(ws + WS_Y); const float* part = (const float*)(ws + WS_PARTA);
    const int gw = F.bid * NWAVES + F.wave, NGW = F.G * NWAVES;
    for (int m = gw; m < MTOK; m += NGW) {
        float s = (F.lane < 32) ? part[(size_t)m * 32 + F.lane] : 0.f; s = wave_sum(s);
        const float rs = 1.0f / sqrtf(s * (1.0f / DM) + RMS_EPS);
#pragma unroll
        for (int j = 0; j < 8; ++j) { const int c = (j * 64 + F.lane) * 4; const f32x4 v = *(const f32x4*)(Y + (size_t)m * DM + c), g = *(const f32x4*)(gfin + c);
            *(f32x4*)(out + (size_t)m * DM + c) = v * rs * g; }
    }
}

struct Args { InTab in; float* out; unsigned char* ws; int ph_lo, ph_hi; };
constexpr int PH_PER_LAYER = 9, N_PHASES = 1 + NL * PH_PER_LAYER + 1;

__global__ void __launch_bounds__(NTHR, 2) hybrid_fwd(Args args) {
    extern __shared__ __attribute__((aligned(16))) unsigned char lds_raw[];
    Frame F0; F0.lds = (LAS unsigned char*)lds_raw; F0.tid = threadIdx.x; F0.lane = F0.tid & 63; F0.wave = __builtin_amdgcn_readfirstlane(F0.tid >> 6); F0.bid = blockIdx.x; F0.G = gridDim.x;
    unsigned char* ws0 = args.ws; In in0; in0.t = (CAS const fptr_t*)__builtin_amdgcn_kernarg_segment_ptr();
    const int lo = args.ph_lo, hi = args.ph_hi;
    volatile LAS unsigned* MISC = (volatile LAS unsigned*)(F0.lds + MISC_OFF);
    if (F0.tid < 16) MISC[F0.tid] = 0u;
    __syncthreads();
    XcdBarrier bar; bar.bar = (unsigned*)(ws0 + WS_CTL) + CW_BAR; bar.x = 0; bar.st = nullptr;
    const bool multi = (hi - lo) > 1;
    if (multi) bar = xcd_barrier_post((unsigned*)(ws0 + WS_CTL) + CW_BAR, MISC + 8);
#ifndef SUBMASK
#define SUBMASK 7
#endif
#ifndef PHMASK
#define PHMASK 0xFFFFFFFFu
#endif
#define IN_PH(k) (lo <= (k) && (k) < hi)
#define ON(j) ((PHMASK >> (j)) & 1u)
#define LAYER_PTRS unsigned char* wt = ws + WS_WT + (size_t)l * WT_LAYER; float* Y = (float*)(ws + WS_Y); bf16_t* YB = (bf16_t*)(ws + WS_YB); float* PA = (float*)(ws + WS_PARTA); float* PB = (float*)(ws + WS_PARTB); const LAS float* rsT = (const LAS float*)(F.lds + RST_OFF); (void)wt; (void)Y; (void)YB; (void)PA; (void)PB; (void)rsT;
#define SEAM(k) do { if (IN_PH(k) && IN_PH((k) + 1)) xcd_barrier(bar); } while (0)

    if (ON(0) && IN_PH(0)) { const In in = in_fresh(in0); const Frame F = fresh(F0); unsigned char* ws = fresh_ptr(ws0); p0_prologue(F, in, ws); }
    SEAM(0);

    for (int l = 0; l < NL; ++l) {
        const int pb = 1 + l * PH_PER_LAYER;
        if (ON(1) && IN_PH(pb + 0)) { const In in = in_fresh(in0); const Frame F = fresh(F0); unsigned char* ws = fresh_ptr(ws0); LAYER_PTRS
            pg8::Gemm g{YB, (const bf16_t*)(wt + WT_IN), DM, DM, DM}; pg8::Order S; S.init(MTOK / 256, NZ / 256, F.G, F.bid, DM, DM);
            pg8::Unit u0; int pm0 = -1; if (S.next(0, u0)) pm0 = u0.pm;
            if (pm0 >= 0) rs_table(F, PA, pm0); else __syncthreads();
            pg8::EpiZ E{(float*)(ws + WS_ZS), (bf16_t*)(ws + WS_G), in[4] + (size_t)l * GCOLS, PA, rsT, pm0};
            pg8::gemm_phase<pg8::EpiZ, pg8::Order, true>(F.lds, F.tid, g, S, E);
        }
        SEAM(pb + 0);
        if (ON(2) && IN_PH(pb + 1)) { const In in = in_fresh(in0); const Frame F = fresh(F0); unsigned char* ws = fresh_ptr(ws0); LAYER_PTRS
            for (int it = F.bid; it < 1152; it += F.G) {
                if (it < 128) dsa_prep_item(F, ws, in[5] + l * 64, it);
                else if (it < 384) rwkv_prep_item(F, ws, in, l, it - 128);
                else if (it < 896) pool_item(F, ws, in, l, it - 384);
                else ssm_pass1_item(F, ws, in, l, it - 896);
            }
        }
        SEAM(pb + 1);
        if (ON(3) && IN_PH(pb + 2)) { const In in = in_fresh(in0); const Frame F = fresh(F0); unsigned char* ws = fresh_ptr(ws0); LAYER_PTRS
            const bool split = F.G >= 64;
            if (SUBMASK & 1) { const Frame Fa = fresh(F0);
                if (split) { if (Fa.bid < 16) rwkv_scan_item(Fa, ws, in, l, Fa.bid); }
                else for (int it = Fa.bid; it < 16; it += Fa.G) rwkv_scan_item(Fa, ws, in, l, it); }
            if (!split || F.bid >= 16) {
                if (SUBMASK & 2) { const Frame Fb = fresh(F0); const int nb = split ? Fb.G - 16 : Fb.G, b0 = split ? Fb.bid - 16 : Fb.bid;
                    for (int it = b0; it < 256; it += nb) { const int b = it & 3, qb = 63 - (it >> 2); dsa_item(Fb, ws, b * 64 + qb); } }
                if (SUBMASK & 4) { const Frame Fc = fresh(F0); const int nb = split ? Fc.G - 16 : Fc.G, b0 = split ? Fc.bid - 16 : Fc.bid;
                    for (int it = b0; it < 256; it += nb) ssm_pass3_item(Fc, fresh_ptr(ws0), in_fresh(in0), l, it); }
            }
        }
        SEAM(pb + 2);
        if (ON(4) && IN_PH(pb + 3)) { const In in = in_fresh(in0); const Frame F = fresh(F0); unsigned char* ws = fresh_ptr(ws0); LAYER_PTRS
            pg8::Gemm g{(const bf16_t*)(ws + WS_YSB), (const bf16_t*)(wt + WT_GLU), MIX, MIX, MIX}; pg8::Order S; S.init(MTOK / 256, MIX / 256, F.G, F.bid, MIX, MIX);
            pg8::EpiGlu E{(const float*)(ws + WS_YS), in[28] + l * MIX, (bf16_t*)(ws + WS_MIX)};
            pg8::gemm_phase<pg8::EpiGlu, pg8::Order, true>(F.lds, F.tid, g, S, E);
        }
        SEAM(pb + 3);
        if (ON(5) && IN_PH(pb + 4)) { const In in = in_fresh(in0); const Frame F = fresh(F0); unsigned char* ws = fresh_ptr(ws0); LAYER_PTRS
            pg8::Gemm g{(const bf16_t*)(ws + WS_MIX), (const bf16_t*)(wt + WT_BR), 4 * MIX, MIX, MIX}; pg8::Order S; S.init(MTOK / 256, DM / 256, F.G, F.bid, 4 * MIX, MIX, 4, MIX, DM);
            pg8::EpiMerge E{(const bf16_t*)(ws + WS_G), (float*)(ws + WS_MF), (bf16_t*)(ws + WS_MERGED)};
            pg8::gemm_phase<pg8::EpiMerge, pg8::Order, true>(F.lds, F.tid, g, S, E);
        }
        SEAM(pb + 4);
        if (ON(6) && IN_PH(pb + 5)) { const In in = in_fresh(in0); const Frame F = fresh(F0); unsigned char* ws = fresh_ptr(ws0); LAYER_PTRS
            pg8::Gemm g{(const bf16_t*)(ws + WS_MERGED), (const bf16_t*)(wt + WT_OUT), DM, DM, DM}; pg8::Order S; S.init(MTOK / 256, DM / 256, F.G, F.bid, DM, DM);
            pg8::EpiRes E{l == 0 ? in[0] : Y, Y, YB, PB};
            pg8::gemm_phase<pg8::EpiRes, pg8::Order, true>(F.lds, F.tid, g, S, E);
        }
        SEAM(pb + 5);
        if (ON(7) && IN_PH(pb + 6)) { const In in = in_fresh(in0); const Frame F = fresh(F0); unsigned char* ws = fresh_ptr(ws0); LAYER_PTRS
            pg8::Gemm g{YB, (const bf16_t*)(wt + WT_UP), DM, DM, DM}; pg8::Order S; S.init(MTOK / 256, DFF2 / 256, F.G, F.bid, DM, DM);
            pg8::Unit u0; int pm0 = -1; if (S.next(0, u0)) pm0 = u0.pm;
            if (pm0 >= 0) rs_table(F, PB, pm0); else __syncthreads();
            pg8::EpiU E{(bf16_t*)(ws + WS_U), DFF2, PB, rsT, pm0};
            pg8::gemm_phase<pg8::EpiU, pg8::Order, true>(F.lds, F.tid, g, S, E);
        }
        SEAM(pb + 6);
        if (ON(8) && IN_PH(pb + 7)) { const In in = in_fresh(in0); const Frame F = fresh(F0); unsigned char* ws = fresh_ptr(ws0); LAYER_PTRS conv_phase(F, ws, in, l); }
        SEAM(pb + 7);
        if (ON(9) && IN_PH(pb + 8)) { const In in = in_fresh(in0); const Frame F = fresh(F0); unsigned char* ws = fresh_ptr(ws0); LAYER_PTRS
            pg8::Gemm g{(const bf16_t*)(ws + WS_ACT), (const bf16_t*)(wt + WT_DOWN), DFF, DFF, DFF}; pg8::Order S; S.init(MTOK / 256, DM / 256, F.G, F.bid, DFF, DFF);
            pg8::EpiRes E{Y, Y, YB, PA};
            pg8::gemm_phase<pg8::EpiRes, pg8::Order, true>(F.lds, F.tid, g, S, E);
        }
        SEAM(pb + 8);
    }
    if (ON(10) && IN_PH(N_PHASES - 1)) { const In in = in_fresh(in0); const Frame F = fresh(F0); unsigned char* ws = fresh_ptr(ws0); final_phase(F, ws, in[36], args.out); }
#ifdef DBG_STOP
    if (lo == 100) { const Frame F = fresh(F0); unsigned char* ws = fresh_ptr(ws0);
        for (size_t e = (size_t)F.bid * NTHR + F.tid; e < (size_t)MTOK * DM; e += (size_t)F.G * NTHR) {
            const int m = (int)(e / DM), c = (int)(e % DM); float v;
            if (DBG_BUF == 0) v = bf2f(((const bf16_t*)(ws + WS_MIX))[e]);
            else if (DBG_BUF == 1) v = ((const float*)(ws + WS_ZS))[(size_t)m * ZS_COLS + c];
            else if (DBG_BUF == 2) v = ((const float*)(ws + WS_ZS))[(size_t)m * ZS_COLS + 2048 + c];
            else if (DBG_BUF == 3) v = bf2f(((const bf16_t*)(ws + WS_G))[(size_t)m * GCOLS + c]);
            else if (DBG_BUF == 4) v = ((const float*)(ws + WS_Y))[e];
            else v = bf2f(((const bf16_t*)(ws + WS_MERGED))[e]);
            args.out[e] = v; } }
#endif
#undef IN_PH
#undef SEAM
}

extern "C" void kernel_launch(void* const* d_in, const int* in_sizes, int n_in, void* d_out, int out_size, void* d_ws, size_t ws_size, hipStream_t stream) {
    static int grid = 0;
    if (grid == 0) {
        if (n_in != 37 || out_size != MTOK * DM || ws_size < WS_END) { fprintf(stderr, "kernel_launch: unexpected problem (n_in %d, out %d, ws %zu < %zu)\n", n_in, out_size, ws_size, (size_t)WS_END); grid = -1; return; }
        int dev = 0, cus = 0, per_cu = 0;
        if (hipGetDevice(&dev) != hipSuccess || hipDeviceGetAttribute(&cus, hipDeviceAttributeMultiprocessorCount, dev) != hipSuccess) { grid = -1; return; }
        if (hipFuncSetAttribute((const void*)hybrid_fwd, hipFuncAttributeMaxDynamicSharedMemorySize, LDS_BYTES) != hipSuccess) { fprintf(stderr, "kernel_launch: hipFuncSetAttribute failed\n"); grid = -1; return; }
        if (hipOccupancyMaxActiveBlocksPerMultiprocessor(&per_cu, (const void*)hybrid_fwd, NTHR, LDS_BYTES) != hipSuccess || per_cu < 1) fprintf(stderr, "kernel_launch: occupancy query says %d\n", per_cu);
        (void)hipGetLastError();
        grid = cus;
    }
    if (grid < 0) return;
    (void)hipMemsetAsync((char*)d_ws + WS_CTL, 0, CTL_ZERO_BYTES, stream);
    Args a{};
    for (int i = 0; i < 37; ++i) a.in.p[i] = (const float*)d_in[i];
    a.out = (float*)d_out; a.ws = (unsigned char*)d_ws;
#ifdef DBG_STOP
    for (int k = 0; k < DBG_STOP; ++k) { a.ph_lo = k; a.ph_hi = k + 1; hipLaunchKernelGGL(hybrid_fwd, dim3(grid), dim3(NTHR), LDS_BYTES, stream, a); }
    a.ph_lo = 100; a.ph_hi = 101; hipLaunchKernelGGL(hybrid_fwd, dim3(grid), dim3(NTHR), LDS_BYTES, stream, a);
#elif MK_N_LAUNCHES == 1
    a.ph_lo = 0; a.ph_hi = N_PHASES;
    hipLaunchKernelGGL(hybrid_fwd, dim3(grid), dim3(NTHR), LDS_BYTES, stream, a);
#else
    for (int k = 0; k < N_PHASES; ++k) { a.ph_lo = k; a.ph_hi = k + 1; hipLaunchKernelGGL(hybrid_fwd, dim3(grid), dim3(NTHR), LDS_BYTES, stream, a); }
#endif
}
```

```cpp
#include <hip/hip_runtime.h>
#include <cstdio>
#include <cstdint>

#ifndef MK_N_LAUNCHES
#define MK_N_LAUNCHES 1
#endif

#define LAS __attribute__((address_space(3)))
#define GAS __attribute__((address_space(1)))
typedef unsigned short bf16_t;
typedef short bf16x8 __attribute__((ext_vector_type(8)));
typedef short s16x4 __attribute__((ext_vector_type(4)));
typedef float f32x4 __attribute__((ext_vector_type(4)));
typedef float f32x2 __attribute__((ext_vector_type(2)));
typedef float f32x16 __attribute__((ext_vector_type(16)));
typedef unsigned u32x4 __attribute__((ext_vector_type(4)));
typedef unsigned u32x2 __attribute__((ext_vector_type(2)));
#define DI __device__ __forceinline__

constexpr int NB = 4, SEQ = 2048, DM = 2048, MTOK = NB * SEQ, NL = 4, MIX = 512, DFF = 5504, DFF2 = 2 * DFF;
constexpr int IN_COLS = 13060, NZ = 13312, ZS_COLS = 5120, GCOLS = 8192;
constexpr int B_COLS = 1984;
constexpr int ZO_R = 0, ZO_K = 512, ZO_V = 1024, ZO_LW = 1536, ZO_LA = 1632, ZO_LG = 1728;
constexpr int ZO_Q = 2048, ZO_AK = 2560, ZO_AV = 3072, ZO_QI = 3584, ZO_KI = 3840, ZO_WI = 3904, ZO_C = 4096, ZO_D = 4608;
constexpr float RMS_EPS = 1e-6f, GN_EPS = 64e-5f;

constexpr size_t MiB = 1u << 20;
constexpr size_t WS_CTL = 0, CTL_ZERO_BYTES = 1 * MiB;
constexpr size_t WS_ROPE = 1 * MiB;
constexpr size_t WS_PARTA = 2 * MiB;
constexpr size_t WS_PARTB = 3 * MiB;
constexpr size_t WS_SSTATE = 4 * MiB;
constexpr size_t WS_WI = 5 * MiB;
constexpr size_t WS_KI = 6 * MiB;
constexpr size_t WS_MASK = 7 * MiB;
constexpr size_t WS_QI = 9 * MiB;
constexpr size_t WS_Q = 13 * MiB;
constexpr size_t WS_K = 21 * MiB;
constexpr size_t WS_VT = 29 * MiB;
constexpr size_t WS_Y = 37 * MiB;
constexpr size_t WS_YB = 101 * MiB;
constexpr size_t WS_MIX = 133 * MiB;
constexpr size_t WS_MERGED = 165 * MiB;
constexpr size_t WS_YS = 197 * MiB;
constexpr size_t WS_YSB = 213 * MiB;
constexpr size_t WS_RW = 221 * MiB;
constexpr size_t RW_STRIDE = 16 * MiB;
constexpr size_t WS_SC = 333 * MiB;
constexpr size_t WS_MF = 1368 * MiB;
constexpr size_t WS_ZS = 461 * MiB;
constexpr size_t WS_G = 621 * MiB;
constexpr size_t WS_U = 461 * MiB;
constexpr size_t WS_ACT = 749 * MiB;
constexpr size_t WS_WT = 836 * MiB;
constexpr size_t WT_IN = 0, WT_BR = 52 * MiB, WT_OUT = 60 * MiB, WT_UP = 68 * MiB, WT_DOWN = 111 * MiB, WT_GLU = 111 * MiB + 22544384, WT_LAYER = 133 * MiB;
constexpr size_t WS_YRAW = WS_MF + 192 * MiB;
constexpr size_t WS_END = WS_YRAW + 16 * MiB;
static_assert(WS_WT + 4 * WT_LAYER == WS_MF, "ws map");
static_assert(WT_GLU + 524288 <= WT_LAYER, "wt map");
static_assert(WS_U + (size_t)MTOK * DFF2 * 2 <= WS_ACT && WS_ACT + (size_t)MTOK * DFF * 2 <= WS_WT, "ws map");

constexpr int CW_BAR = 4096;

constexpr int RING_BYTES = 131072;
constexpr int MISC_OFF = RING_BYTES;
constexpr int RST_OFF = RING_BYTES + 1024;
constexpr int LDS_BYTES = 147456;
constexpr int NWAVES = 8, NTHR = 512;

DI unsigned f2bf(float f) { unsigned u = __builtin_bit_cast(unsigned, f); return (u + 0x7fffu + ((u >> 16) & 1u)) >> 16; }
DI unsigned cvt_pk_bf16(float lo, float hi);
DI unsigned pk2(float lo, float hi) { return cvt_pk_bf16(lo, hi); }
DI float bf2f(unsigned b) { return __builtin_bit_cast(float, b << 16); }
typedef __bf16 bf16x2v __attribute__((ext_vector_type(2)));
DI unsigned cvt_pk_bf16(float lo, float hi) { const f32x2 v = {lo, hi}; const bf16x2v b = __builtin_convertvector(v, bf16x2v); return __builtin_bit_cast(unsigned, b); }
DI float wave_sum(float v) {
#pragma unroll
    for (int o = 1; o < 64; o <<= 1) v += __shfl_xor(v, o);
    return v;
}
DI float sigmoidf_(float x) { return __builtin_amdgcn_rcpf(1.0f + __expf(-x)); }
#define LDS_WAIT() asm volatile("s_waitcnt lgkmcnt(0)" ::: "memory")
#define VM_WAIT() asm volatile("s_waitcnt vmcnt(0)" ::: "memory")
#define MFMA32(a, b, c) __builtin_amdgcn_mfma_f32_32x32x16_bf16((a), (b), (c), 0, 0, 0)

#define XB_TMO      128
#define XB_XCNT(j)  (256  + 64 * (j))
#define XB_XSUB(j)  (1280 + 64 * (j))
#define XB_XGEN(j)  (2304 + 64 * (j))
#define XB_TOP      3328
#define XB_TOPGEN   3392
#define XCD_BAR_WORDS 3456
#define XB_SPIN_CAP (1u << 21)
DI unsigned xb_ld(unsigned* p)              { return __hip_atomic_load(p, __ATOMIC_RELAXED, __HIP_MEMORY_SCOPE_AGENT); }
DI unsigned xb_add(unsigned* p, unsigned v) { return __hip_atomic_fetch_add(p, v, __ATOMIC_RELAXED, __HIP_MEMORY_SCOPE_AGENT); }
DI unsigned xb_xcc_id() { return (unsigned)__builtin_amdgcn_s_getreg((3 << 11) | 20) & 0xFu; }
#define XB_SPIN(cond, bar) do { unsigned _sp = 0; while (cond) { __builtin_amdgcn_s_sleep(1); \
    if ((++_sp & 255u) == 0u) { if (xb_ld(&(bar)[XB_TMO])) break; if (_sp > XB_SPIN_CAP) { atomicAdd(&(bar)[XB_TMO], 1u); break; } } } } while (0)
struct XcdBarrier { unsigned* bar; unsigned x; volatile LAS unsigned* st; };
DI XcdBarrier xcd_barrier_post(unsigned* bar, volatile LAS unsigned* st) {
    XcdBarrier b; b.bar = bar; b.x = xb_xcc_id(); b.st = st;
    if (threadIdx.x == 0) (void)xb_add(&bar[XB_XCNT(b.x)], 1u);
    return b;
}
DI void xcd_barrier_complete(unsigned* bar, unsigned x, unsigned& nloc, unsigned& nx) {
    const unsigned G = gridDim.x * gridDim.y * gridDim.z;
    unsigned sum, cnt, mine, sp = 0u;
    for (;;) {
        sum = 0u; cnt = 0u; mine = 0u;
#pragma unroll
        for (unsigned j = 0; j < 16; ++j) { const unsigned c = xb_ld(&bar[XB_XCNT(j)]); sum += c; cnt += (c > 0u) ? 1u : 0u; mine = (j == x) ? c : mine; }
        if (sum == G) break;
        __builtin_amdgcn_s_sleep(1);
        if ((++sp & 255u) == 0u) { if (xb_ld(&bar[XB_TMO])) break; if (sp > XB_SPIN_CAP) { atomicAdd(&bar[XB_TMO], 1u); break; } }
    }
    nloc = mine > 0u ? mine : 1u; nx = cnt > 0u ? cnt : 1u;
}
DI void xcd_barrier(const XcdBarrier& b) {
    asm volatile("s_waitcnt vmcnt(0)" ::: "memory");
    __syncthreads();
    if (threadIdx.x == 0) {
        unsigned* bar = b.bar;
        __builtin_amdgcn_s_waitcnt(0);
        unsigned nloc = b.st[0], nx = b.st[1];
        if (nloc == 0u) { xcd_barrier_complete(bar, b.x, nloc, nx); b.st[0] = nloc; b.st[1] = nx; }
        const unsigned old = xb_add(&bar[XB_XSUB(b.x)], 1u);
        const unsigned gen = old / nloc;
        if (old + 1u == (gen + 1u) * nloc) {
            __builtin_amdgcn_fence(__ATOMIC_RELEASE, "agent");
            asm volatile("s_waitcnt vmcnt(0)" ::: "memory");
            const unsigned og = xb_add(&bar[XB_TOP], 1u);
            const unsigned tg = og / nx;
            if (og + 1u == (tg + 1u) * nx) xb_add(&bar[XB_TOPGEN], 1u);
            else XB_SPIN(xb_ld(&bar[XB_TOPGEN]) == tg, bar);
            __builtin_amdgcn_fence(__ATOMIC_ACQUIRE, "agent");
            xb_add(&bar[XB_XGEN(b.x)], 1u);
            asm volatile("s_waitcnt vmcnt(0)" ::: "memory");
        } else {
            XB_SPIN(xb_ld(&bar[XB_XGEN(b.x)]) == gen, bar);
            __builtin_amdgcn_fence(__ATOMIC_ACQUIRE, "agent");
            asm volatile("s_waitcnt vmcnt(0)" ::: "memory");
        }
    }
    __syncthreads();
}

namespace pg8 {
constexpr int BM = 256, BK = 64, HALF = 128, HTB = HALF * BK * 2, STAGE_BYTES = 8 * HTB, NXCD = 8, WGM = 8;
DI int lds_byte(int r, int c) { const int st = (r >> 4) * 2 + (c >> 5), rr = r & 15, cc = c & 31, ob = rr * 64 + cc * 2; return st * 1024 + (ob ^ (((ob >> 9) & 1) << 5)); }
DI void stage_rc(int b, int& R, int& C) { const int st = b / 1024, sb = b % 1024, swz = sb ^ (((sb >> 9) & 1) << 5); R = (st >> 1) * 16 + swz / 64; C = (st & 1) * 32 + (swz % 64) / 2; }
DI int perm32(int rho) { const int n = rho >> 4, i = rho & 15; return 8 * (i >> 2) + 4 * n + (i & 3); }

struct Unit { int pm, pn, sub; long offA, offB; };
struct Gemm { const bf16_t* A; const bf16_t* Bt; int lda, ldb, K; };

struct Order {
    int nM, nN, nwg, G, c, lda, ldb, nsub, subA, subB;
    DI void init(int nM_, int nN_, int G_, int c_, int lda_, int ldb_, int nsub_ = 1, int subA_ = 0, int subB_ = 0) { nM = nM_; nN = nN_; nwg = nM * nN; G = G_; c = c_; lda = lda_; ldb = ldb_; nsub = nsub_; subA = subA_; subB = subB_; }
    DI bool next(int i, Unit& u) const {
        const int ti = i / nsub, sub = i - ti * nsub;
        const long L = (long)ti * G + c; if (L >= nwg) return false;
        int wgid = (int)L; { const int q = nwg / NXCD, r = nwg % NXCD, xcd = wgid % NXCD, off = wgid / NXCD; wgid = (xcd < r ? xcd * (q + 1) : r * (q + 1) + (xcd - r) * q) + off; }
        const int nig = WGM * nN, gid = wgid / nig, fm = gid * WGM, gsz = (nM - fm) < WGM ? (nM - fm) : WGM;
        u.pm = fm + ((wgid % nig) % gsz); u.pn = (wgid % nig) / gsz; u.sub = sub;
        u.offA = ((long)u.pm * BM * lda + (long)sub * subA) * 2; u.offB = ((long)u.pn * BM + (long)sub * subB) * (long)ldb * 2;
        return true;
    }
};

template <class Epi, class Sched, bool ALIGN_EPI>
DI void gemm_phase(LAS unsigned char* lds, const int tid, const Gemm g, const Sched& S, const Epi& E) {
    const int wid = __builtin_amdgcn_readfirstlane(tid >> 6), lane = tid & 63, wr = wid >> 2, wc = wid & 3, fr = lane & 15, fq = lane >> 4;
    const int K = g.K, nt = K / BK;
    unsigned voffA[2], voffB[2];
#pragma unroll
    for (int i = 0; i < 2; ++i) { int R, C; stage_rc(tid * 16 + i * 8192, R, C); const int Rb = Epi::PERM ? ((R & ~31) + perm32(R & 31)) : R;
        voffA[i] = (unsigned)(R * g.lda + C) * 2u; voffB[i] = (unsigned)(Rb * g.ldb + C) * 2u; }
    const size_t kstep = (size_t)(BK * 2);
    const size_t hstepA = (size_t)HALF * g.lda * 2, hstepB = (size_t)HALF * g.ldb * 2;
    const unsigned ldsw = (unsigned)wid * 1024u;
    const int aoff = lds_byte(wr * 64 + fr, fq * 8), boff = lds_byte(wc * 32 + fr, fq * 8);
#define PG8_SA(b, h) (((b) * 2 + (h)) * HTB)
#define PG8_SB(b, h) ((4 + (b) * 2 + (h)) * HTB)
#define PG8_STAGE(bufoff, gbase, voff) do { _Pragma("unroll") for (int _i = 0; _i < 2; ++_i) \
        __builtin_amdgcn_global_load_lds((const unsigned*)((const char*)(gbase) + (voff)[_i]), (LAS unsigned*)(lds + (bufoff) + ldsw + _i * 8192), 16, 0, 0); } while (0)
#define PG8_LDA(dst, b, h) do { _Pragma("unroll") for (int m = 0; m < 4; ++m) _Pragma("unroll") for (int k = 0; k < 2; ++k) dst[m][k] = *(const LAS bf16x8*)(lds + PG8_SA(b, h) + aoff + m * 2048 + k * 1024); } while (0)
#define PG8_LDB(dst, b, h) do { _Pragma("unroll") for (int n = 0; n < 2; ++n) _Pragma("unroll") for (int k = 0; k < 2; ++k) dst[n][k] = *(const LAS bf16x8*)(lds + PG8_SB(b, h) + boff + n * 2048 + k * 1024); } while (0)
#define PG8_MMA(ai, bj, At, Bt) do { __builtin_amdgcn_s_setprio(1); _Pragma("unroll") for (int m = 0; m < 4; ++m) _Pragma("unroll") for (int n = 0; n < 2; ++n) _Pragma("unroll") for (int k = 0; k < 2; ++k) \
        acc[ai][bj][m][n] = __builtin_amdgcn_mfma_f32_16x16x32_bf16(Bt[n][k], At[m][k], acc[ai][bj][m][n], 0, 0, 0); __builtin_amdgcn_s_setprio(0); } while (0)
#define PG8_WAIT_V(n) asm volatile("s_waitcnt vmcnt(" #n ")" ::: "memory")
#define PG8_WAIT_L(n) asm volatile("s_waitcnt lgkmcnt(" #n ")" ::: "memory")
#define PG8_BAR __builtin_amdgcn_s_barrier()
#define PG8_SCHED __builtin_amdgcn_sched_barrier(0)
    Unit cur, nxt; int ui = 0;
    if (!S.next(0, cur)) return;
    f32x4 acc[2][2][4][2];
#pragma unroll
    for (int a = 0; a < 2; ++a)
#pragma unroll
        for (int b = 0; b < 2; ++b)
#pragma unroll
            for (int m = 0; m < 4; ++m)
#pragma unroll
                for (int n = 0; n < 2; ++n) acc[a][b][m][n] = (f32x4){0.f, 0.f, 0.f, 0.f};
    bf16x8 At[4][2], B0[2][2], B1[2][2];
    const char* cA = (const char*)g.A + cur.offA; const char* cB = (const char*)g.Bt + cur.offB;
    PG8_STAGE(PG8_SB(0, 0), cB, voffB); PG8_STAGE(PG8_SB(0, 1), cB + hstepB, voffB); PG8_STAGE(PG8_SA(0, 0), cA, voffA); PG8_STAGE(PG8_SA(0, 1), cA + hstepA, voffA);
    if (wr == 1) PG8_BAR;
    PG8_WAIT_V(2); PG8_BAR;
    PG8_STAGE(PG8_SB(1, 0), cB + kstep, voffB); PG8_STAGE(PG8_SA(1, 0), cA + kstep, voffA); PG8_STAGE(PG8_SB(1, 1), cB + hstepB + kstep, voffB);
    PG8_WAIT_V(6); PG8_BAR;
    for (;;) {
        const bool has_next = S.next(ui + 1, nxt);
        const char* nA = has_next ? (const char*)g.A + nxt.offA : cA; const char* nB = has_next ? (const char*)g.Bt + nxt.offB : cB;
        for (int t = 0; t < nt; t += 2) {
            const bool last = (t == nt - 2);
            const char* a1 = cA + (size_t)(t + 1) * kstep;
            const char* a2 = last ? nA : cA + (size_t)(t + 2) * kstep; const char* b2 = last ? nB : cB + (size_t)(t + 2) * kstep;
            const char* a3 = a2 + kstep; const char* b3 = b2 + kstep;
            PG8_LDB(B0, 0, 0); PG8_LDB(B1, 0, 1); PG8_SCHED; PG8_LDA(At, 0, 0); PG8_STAGE(PG8_SA(1, 1), a1 + hstepA, voffA);
            PG8_WAIT_V(8); PG8_WAIT_L(0); PG8_BAR; PG8_MMA(0, 0, At, B0); PG8_MMA(0, 1, At, B1); PG8_BAR; PG8_SCHED;
            PG8_LDA(At, 0, 1); PG8_STAGE(PG8_SB(0, 0), b2, voffB); PG8_STAGE(PG8_SB(0, 1), b2 + hstepB, voffB); PG8_STAGE(PG8_SA(0, 0), a2, voffA);
            PG8_WAIT_V(8); PG8_WAIT_L(0); PG8_BAR; PG8_MMA(1, 0, At, B0); PG8_MMA(1, 1, At, B1); PG8_BAR; PG8_SCHED;
            PG8_LDB(B0, 1, 0); PG8_LDB(B1, 1, 1); PG8_SCHED; PG8_LDA(At, 1, 0); PG8_STAGE(PG8_SA(0, 1), a2 + hstepA, voffA);
            PG8_WAIT_V(8); PG8_WAIT_L(0); PG8_BAR; PG8_MMA(0, 0, At, B0); PG8_MMA(0, 1, At, B1); PG8_BAR; PG8_SCHED;
            PG8_LDA(At, 1, 1); PG8_STAGE(PG8_SB(1, 0), b3, voffB); PG8_STAGE(PG8_SB(1, 1), b3 + hstepB, voffB); PG8_STAGE(PG8_SA(1, 0), a3, voffA);
            PG8_WAIT_V(8); PG8_WAIT_L(0); PG8_BAR; PG8_MMA(1, 0, At, B0); PG8_MMA(1, 1, At, B1); PG8_BAR; PG8_SCHED;
        }
        if constexpr (ALIGN_EPI) { if (wr == 0) PG8_BAR; }
        E(acc, cur, wr, wc, fr, fq);
        if (!has_next) break;
#pragma unroll
        for (int a = 0; a < 2; ++a)
#pragma unroll
            for (int b = 0; b < 2; ++b)
#pragma unroll
                for (int m = 0; m < 4; ++m)
#pragma unroll
                    for (int n = 0; n < 2; ++n) acc[a][b][m][n] = (f32x4){0.f, 0.f, 0.f, 0.f};
        cur = nxt; cA = nA; cB = nB; ++ui;
        if constexpr (ALIGN_EPI) { if (wr == 1) PG8_BAR; }
    }
    PG8_WAIT_V(0);
    if constexpr (!ALIGN_EPI) { if (wr == 0) PG8_BAR; }
    PG8_BAR;
#undef PG8_SA
#undef PG8_SB
#undef PG8_STAGE
#undef PG8_LDA
#undef PG8_LDB
#undef PG8_MMA
#undef PG8_WAIT_V
#undef PG8_WAIT_L
#undef PG8_BAR
#undef PG8_SCHED
}

typedef const f32x4 (&AccRef)[2][2][4][2];
DI float row_scale_slow(const float* part, int row) { float s = 0.f; for (int i = 0; i < 32; ++i) s += part[(size_t)row * 32 + i]; return 1.0f / sqrtf(s * (1.0f / DM) + RMS_EPS); }

struct EpiZ {
    static constexpr bool PERM = true;
    float* ZS; bf16_t* G; const float* bgate; const float* part; const LAS float* rsT; int pm0;
    DI void operator()(AccRef acc, const Unit& u, int wr, int wc, int fr, int fq) const {
#pragma unroll
        for (int ai = 0; ai < 2; ++ai)
#pragma unroll
            for (int m = 0; m < 4; ++m) {
                const int lr = ai * HALF + wr * 64 + m * 16 + fr, row = u.pm * BM + lr;
                const float s = (u.pm == pm0) ? rsT[lr] : row_scale_slow(part, row);
#pragma unroll
                for (int bj = 0; bj < 2; ++bj) {
                    const int col0 = u.pn * BM + bj * HALF + wc * 32 + 8 * fq;
                    f32x4 v0 = acc[ai][bj][m][0] * s, v1 = acc[ai][bj][m][1] * s;
                    if (u.pn < 20) { float* p = ZS + (size_t)row * ZS_COLS + col0; *(f32x4*)p = v0; *(f32x4*)(p + 4) = v1; }
                    else { const int gc = col0 - ZS_COLS; const f32x4 b0 = *(const f32x4*)(bgate + gc), b1 = *(const f32x4*)(bgate + gc + 4);
                        v0 += b0; v1 += b1;
                        u32x4 w; w.x = cvt_pk_bf16(sigmoidf_(v0[0]), sigmoidf_(v0[1])); w.y = cvt_pk_bf16(sigmoidf_(v0[2]), sigmoidf_(v0[3]));
                        w.z = cvt_pk_bf16(sigmoidf_(v1[0]), sigmoidf_(v1[1])); w.w = cvt_pk_bf16(sigmoidf_(v1[2]), sigmoidf_(v1[3]));
                        *(u32x4*)(G + (size_t)row * GCOLS + gc) = w; }
                }
            }
    }
};
struct EpiU {
    static constexpr bool PERM = true;
    bf16_t* U; int ldc; const float* part; const LAS float* rsT; int pm0;
    DI void operator()(AccRef acc, const Unit& u, int wr, int wc, int fr, int fq) const {
#pragma unroll
        for (int ai = 0; ai < 2; ++ai)
#pragma unroll
            for (int m = 0; m < 4; ++m) {
                const int lr = ai * HALF + wr * 64 + m * 16 + fr, row = u.pm * BM + lr;
                const float s = (u.pm == pm0) ? rsT[lr] : row_scale_slow(part, row);
#pragma unroll
                for (int bj = 0; bj < 2; ++bj) {
                    const int col0 = u.pn * BM + bj * HALF + wc * 32 + 8 * fq;
                    const f32x4 v0 = acc[ai][bj][m][0] * s, v1 = acc[ai][bj][m][1] * s;
                    u32x4 w; w.x = cvt_pk_bf16(v0[0], v0[1]); w.y = cvt_pk_bf16(v0[2], v0[3]); w.z = cvt_pk_bf16(v1[0], v1[1]); w.w = cvt_pk_bf16(v1[2], v1[3]);
                    *(u32x4*)(U + (size_t)row * ldc + col0) = w;
                }
            }
    }
};
struct EpiRes {
    static constexpr bool PERM = false;
    const float* Yin; float* Y; bf16_t* YB; float* part;
    DI void operator()(AccRef acc, const Unit& u, int wr, int wc, int fr, int fq) const {
#pragma unroll
        for (int ai = 0; ai < 2; ++ai)
#pragma unroll
            for (int m = 0; m < 4; ++m) {
                const int row = u.pm * BM + ai * HALF + wr * 64 + m * 16 + fr;
                float ss = 0.f;
#pragma unroll
                for (int bj = 0; bj < 2; ++bj)
#pragma unroll
                    for (int n = 0; n < 2; ++n) {
                        const int col = u.pn * BM + bj * HALF + wc * 32 + 16 * n + 4 * fq;
                        const size_t o = (size_t)row * DM + col;
                        const f32x4 y = *(const f32x4*)(Yin + o) + acc[ai][bj][m][n];
                        *(f32x4*)(Y + o) = y;
                        u32x2 w; w.x = cvt_pk_bf16(y[0], y[1]); w.y = cvt_pk_bf16(y[2], y[3]);
                        *(u32x2*)(YB + o) = w;
                        ss += (y[0] * y[0] + y[1] * y[1]) + (y[2] * y[2] + y[3] * y[3]);
                    }
                ss += __shfl_xor(ss, 16); ss += __shfl_xor(ss, 32);
                if (fq == 0) part[(size_t)row * 32 + u.pn * 4 + wc] = ss;
            }
    }
};
struct EpiGlu {
    static constexpr bool PERM = true;
    const float* YS; const float* bias; bf16_t* MIXp;
    DI void operator()(AccRef acc, const Unit& u, int wr, int wc, int fr, int fq) const {
#pragma unroll
        for (int ai = 0; ai < 2; ++ai)
#pragma unroll
            for (int m = 0; m < 4; ++m) {
                const int row = u.pm * BM + ai * HALF + wr * 64 + m * 16 + fr;
#pragma unroll
                for (int bj = 0; bj < 2; ++bj) {
                    const int col0 = u.pn * BM + bj * HALF + wc * 32 + 8 * fq;
                    const f32x4 b0 = *(const f32x4*)(bias + col0), b1 = *(const f32x4*)(bias + col0 + 4);
                    const f32x4 y0 = *(const f32x4*)(YS + (size_t)row * MIX + col0), y1 = *(const f32x4*)(YS + (size_t)row * MIX + col0 + 4);
                    const f32x4 v0 = acc[ai][bj][m][0] + b0, v1 = acc[ai][bj][m][1] + b1;
                    u32x4 w; w.x = cvt_pk_bf16(y0[0] * sigmoidf_(v0[0]), y0[1] * sigmoidf_(v0[1])); w.y = cvt_pk_bf16(y0[2] * sigmoidf_(v0[2]), y0[3] * sigmoidf_(v0[3]));
                    w.z = cvt_pk_bf16(y1[0] * sigmoidf_(v1[0]), y1[1] * sigmoidf_(v1[1])); w.w = cvt_pk_bf16(y1[2] * sigmoidf_(v1[2]), y1[3] * sigmoidf_(v1[3]));
                    *(u32x4*)(MIXp + (size_t)row * (4 * MIX) + 3 * MIX + col0) = w;
                }
            }
    }
};
struct EpiMerge {
    static constexpr bool PERM = true;
    const bf16_t* G; float* MF; bf16_t* MERGED;
    DI void operator()(AccRef acc, const Unit& u, int wr, int wc, int fr, int fq) const {
#pragma unroll
        for (int ai = 0; ai < 2; ++ai)
#pragma unroll
            for (int m = 0; m < 4; ++m) {
                const int row = u.pm * BM + ai * HALF + wr * 64 + m * 16 + fr;
#pragma unroll
                for (int bj = 0; bj < 2; ++bj) {
                    const int col0 = u.pn * BM + bj * HALF + wc * 32 + 8 * fq;
                    const u32x4 gw = *(const u32x4*)(G + (size_t)row * GCOLS + u.sub * DM + col0);
                    f32x4 v0 = acc[ai][bj][m][0], v1 = acc[ai][bj][m][1];
                    v0[0] *= bf2f(gw.x & 0xffffu); v0[1] *= bf2f(gw.x >> 16); v0[2] *= bf2f(gw.y & 0xffffu); v0[3] *= bf2f(gw.y >> 16);
                    v1[0] *= bf2f(gw.z & 0xffffu); v1[1] *= bf2f(gw.z >> 16); v1[2] *= bf2f(gw.w & 0xffffu); v1[3] *= bf2f(gw.w >> 16);
                    float* p = MF + (size_t)row * DM + col0;
                    constexpr size_t SL = (size_t)MTOK * DM;
                    if (u.sub < 3) { *(f32x4*)(p + u.sub * SL) = v0; *(f32x4*)(p + u.sub * SL + 4) = v1; }
                    else { v0 += (*(const f32x4*)p + *(const f32x4*)(p + SL)) + *(const f32x4*)(p + 2 * SL); v1 += (*(const f32x4*)(p + 4) + *(const f32x4*)(p + SL + 4)) + *(const f32x4*)(p + 2 * SL + 4);
                        u32x4 w; w.x = cvt_pk_bf16(v0[0], v0[1]); w.y = cvt_pk_bf16(v0[2], v0[3]); w.z = cvt_pk_bf16(v1[0], v1[1]); w.w = cvt_pk_bf16(v1[2], v1[3]);
                        *(u32x4*)(MERGED + (size_t)row * DM + col0) = w; }
                }
            }
    }
};
}

struct Frame { LAS unsigned char* lds; int tid, lane, wave, bid, G; };

DI Frame fresh(const Frame& F0) { Frame F = F0; int tid = F0.tid, bid = F0.bid, G = F0.G, wave = F0.wave; unsigned lo = (unsigned)(size_t)F0.lds;
    asm volatile("" : "+v"(tid)); asm volatile("" : "+s"(bid), "+s"(G), "+s"(wave), "+s"(lo));
    F.tid = tid; F.lane = tid & 63; F.wave = wave; F.bid = bid; F.G = G; F.lds = (LAS unsigned char*)(size_t)lo; return F; }
DI unsigned char* fresh_ptr(unsigned char* p) { size_t z = 0; asm volatile("" : "+s"(z)); return p + z; }
DI void rs_table(const Frame& F, const float* part, int pm) {
    LAS float* rsT = (LAS float*)(F.lds + RST_OFF);
    if (F.tid < 256) { const int row = pm * 256 + F.tid; float s = 0.f;
#pragma unroll
        for (int i = 0; i < 8; ++i) { const f32x4 v = *(const f32x4*)(part + (size_t)row * 32 + 4 * i); s += (v[0] + v[1]) + (v[2] + v[3]); }
        rsT[F.tid] = 1.0f / sqrtf(s * (1.0f / DM) + RMS_EPS); }
    __syncthreads();
}

DI int head_perm(int c) { const int h = c >> 6, p = c & 63; const int dim = p < 16 ? ((p >> 1) + 8 * (p & 1)) : p; return (h << 6) + dim; }
DI int zin_colmap(int n) {
    if (n < B_COLS) return 1860 + n;
    if (n < 2048) return -1;
    if (n < 2560) return head_perm(n - 2048);
    if (n < 3072) return 512 + head_perm(n - 2560);
    if (n < 3584) return 1024 + (n - 3072);
    if (n < 3840) return 1536 + head_perm(n - 3584);
    if (n < 3904) return 1792 + head_perm(n - 3840);
    if (n < 3908) return 1856 + (n - 3904);
    if (n < 4096) return -1;
    if (n < 4608) return 3844 + (n - 4096);
    if (n < 5120) return 4356 + (n - 4608);
    return 4868 + (n - 5120);
}
template <int MODE>
DI void tr_item(const float* W, int ldw, const float* ksc, bf16_t* WT, int K, LAS float* scr, int kb, int nb, int lane) {
    const int k0 = 64 * kb, n0 = 32 * nb, nn = n0 + (lane & 31);
    const int col = MODE == 1 ? zin_colmap(nn) : nn;
#pragma unroll 8
    for (int i = 0; i < 32; ++i) { const int kk = 2 * i + (lane >> 5); float v = 0.f;
        if (col >= 0) { v = W[(size_t)(k0 + kk) * ldw + col]; if (ksc) v *= ksc[k0 + kk]; }
        scr[kk * 33 + (lane & 31)] = v; }
    LDS_WAIT(); asm volatile("" ::: "memory");
    const int c = lane & 7;
#pragma unroll
    for (int j = 0; j < 4; ++j) { const int n = (lane >> 3) + 8 * j; const LAS float* s = scr + (8 * c) * 33 + n;
        u32x4 o; o.x = pk2(s[0 * 33], s[1 * 33]); o.y = pk2(s[2 * 33], s[3 * 33]); o.z = pk2(s[4 * 33], s[5 * 33]); o.w = pk2(s[6 * 33], s[7 * 33]);
        *(u32x4*)(WT + (size_t)(n0 + n) * K + k0 + 8 * c) = o; }
    LDS_WAIT(); asm volatile("" ::: "memory");
}
struct InTab { const float* p[37]; };
#define CAS __attribute__((address_space(4)))
typedef const float* fptr_t;
typedef GAS const float* gfptr_t;
struct In { CAS const gfptr_t* t; DI fptr_t operator[](int i) const { return (fptr_t)t[i]; } };
DI In in_fresh(In in) { CAS const gfptr_t* t = in.t; asm volatile("" : "+s"(t)); In r; r.t = t; return r; }
DI void p0_prologue(const Frame& F, const In& in, unsigned char* ws) {
    LAS float* scr = (LAS float*)(F.lds + F.wave * 16384);
    const int gw = F.bid * NWAVES + F.wave, NGW = F.G * NWAVES;
    constexpr int I_IN = 32 * (NZ / 32), I_BR = 4 * 8 * 64, I_OUT = 32 * 64, I_UP = 32 * (DFF2 / 32), I_DN = 86 * 64, I_GLU = 8 * 16;
    constexpr int I_LAYER = I_IN + I_BR + I_OUT + I_UP + I_DN + I_GLU;
    for (int it = gw; it < NL * I_LAYER; it += NGW) {
        const int l = it / I_LAYER; int r = it - l * I_LAYER;
        unsigned char* wt = ws + WS_WT + (size_t)l * WT_LAYER;
        if (r < I_IN) { const int nbk = NZ / 32; tr_item<1>(in[3] + (size_t)l * DM * IN_COLS, IN_COLS, in[2] + l * DM, (bf16_t*)(wt + WT_IN), DM, scr, r / nbk, r % nbk, F.lane); continue; } r -= I_IN;
        if (r < I_BR) { const int n = r / 512, rr = r % 512; tr_item<0>(in[29] + ((size_t)l * 4 + n) * MIX * DM, DM, nullptr, (bf16_t*)(wt + WT_BR) + (size_t)n * DM * MIX, MIX, scr, rr / 64, rr % 64, F.lane); continue; } r -= I_BR;
        if (r < I_OUT) { tr_item<0>(in[30] + (size_t)l * DM * DM, DM, nullptr, (bf16_t*)(wt + WT_OUT), DM, scr, r / 64, r % 64, F.lane); continue; } r -= I_OUT;
        if (r < I_UP) { const int nbk = DFF2 / 32; tr_item<0>(in[32] + (size_t)l * DM * DFF2, DFF2, in[31] + l * DM, (bf16_t*)(wt + WT_UP), DM, scr, r / nbk, r % nbk, F.lane); continue; } r -= I_UP;
        if (r < I_DN) { tr_item<0>(in[35] + (size_t)l * DFF * DM, DM, nullptr, (bf16_t*)(wt + WT_DOWN), DFF, scr, r / 64, r % 64, F.lane); continue; } r -= I_DN;
        tr_item<0>(in[27] + (size_t)l * MIX * MIX, MIX, nullptr, (bf16_t*)(wt + WT_GLU), MIX, scr, r / 16, r % 16, F.lane);
    }
    const int* pos = (const int*)in[1];
    float* rope = (float*)(ws + WS_ROPE);
    for (int e = F.bid * NTHR + F.tid; e < MTOK * 8; e += F.G * NTHR) { const int m = e >> 3, i = e & 7;
        const float inv = exp2f(-(float)i * 0.125f * 18.931568569324174f);
        const float ang = (float)pos[m] * inv; float sn, cs; sincosf(ang, &sn, &cs);
        rope[m * 16 + i] = cs; rope[m * 16 + 8 + i] = sn; }
    const float* x = in[0]; bf16_t* YB = (bf16_t*)(ws + WS_YB); float* pa = (float*)(ws + WS_PARTA);
    for (int m = gw; m < MTOK; m += NGW) { float s = 0.f;
#pragma unroll
        for (int j = 0; j < 8; ++j) { const f32x4 v = *(const f32x4*)(x + (size_t)m * DM + (j * 64 + F.lane) * 4); s += (v[0] * v[0] + v[1] * v[1]) + (v[2] * v[2] + v[3] * v[3]);
            u32x2 w; w.x = pk2(v[0], v[1]); w.y = pk2(v[2], v[3]); *(u32x2*)(YB + (size_t)m * DM + (j * 64 + F.lane) * 4) = w; }
        s = wave_sum(s);
        if (F.lane < 32) pa[(size_t)m * 32 + F.lane] = (F.lane == 0) ? s : 0.f; }
}

DI void dsa_prep_item(const Frame& F, unsigned char* ws, const float* idxg, int item) {
    const float* ZS = (const float*)(ws + WS_ZS); const float* rope = (const float*)(ws + WS_ROPE);
    bf16_t* Q = (bf16_t*)(ws + WS_Q); bf16_t* Kb = (bf16_t*)(ws + WS_K); bf16_t* VT = (bf16_t*)(ws + WS_VT); bf16_t* QI = (bf16_t*)(ws + WS_QI); bf16_t* KI = (bf16_t*)(ws + WS_KI); float* WI = (float*)(ws + WS_WI);
    const int m0 = item * 64;
    for (int e = F.tid; e < 64 * 640; e += NTHR) { const int t = e / 640, pc = e % 640; const int m = m0 + t;
        int zc, oc; bf16_t* dst; int ld; float sc = 1.f;
        if (pc < 256) { zc = ZO_Q + 2 * pc; oc = 2 * pc; dst = Q; ld = 512; sc = 0.125f; }
        else if (pc < 512) { zc = ZO_AK + 2 * (pc - 256); oc = 2 * (pc - 256); dst = Kb; ld = 512; }
        else { zc = ZO_QI + 2 * (pc - 512); oc = 2 * (pc - 512); dst = QI; ld = 256; }
        const f32x2 v = *(const f32x2*)(ZS + (size_t)m * ZS_COLS + zc); float a = v[0], b = v[1];
        const int p = oc & 63;
        if (p < 16) { const float cs = rope[m * 16 + (p >> 1)], sn = rope[m * 16 + 8 + (p >> 1)]; const float a2 = a * cs - b * sn, b2 = b * cs + a * sn; a = a2; b = b2; }
        *(unsigned*)(dst + (size_t)m * ld + oc) = pk2(a * sc, b * sc); }
    for (int tt = 0; tt < 8; ++tt) { const int m = m0 + F.wave * 8 + tt;
        const float xv = ZS[(size_t)m * ZS_COLS + ZO_KI + F.lane];
        const float ss = wave_sum(xv * xv);
        const int dim = F.lane < 16 ? ((F.lane >> 1) + 8 * (F.lane & 1)) : F.lane;
        float y = xv * (1.0f / sqrtf(ss * (1.0f / 64.f) + RMS_EPS)) * idxg[dim];
        const float pr = __shfl_xor(y, 1);
        if (F.lane < 16) { const float cs = rope[m * 16 + (F.lane >> 1)], sn = rope[m * 16 + 8 + (F.lane >> 1)]; y = (F.lane & 1) ? (y * cs + pr * sn) : (y * cs - pr * sn); }
        KI[(size_t)m * 64 + F.lane] = (bf16_t)f2bf(y);
        if (F.lane < 4) WI[(size_t)m * 4 + F.lane] = ZS[(size_t)m * ZS_COLS + ZO_WI + F.lane]; }
    LAS unsigned char* L = F.lds;
    for (int e = F.tid; e < 64 * 128; e += NTHR) { const int t = e >> 7, c4 = (e & 127) * 4;
        const f32x4 v = *(const f32x4*)(ZS + (size_t)(m0 + t) * ZS_COLS + ZO_AV + c4);
        u32x2 w; w.x = pk2(v[0], v[1]); w.y = pk2(v[2], v[3]); *(LAS u32x2*)(L + t * 1040 + c4 * 2) = w; }
    __syncthreads();
    { const int b = m0 / SEQ, s0 = m0 % SEQ;
      for (int e = F.tid; e < 512 * 8; e += NTHR) { const int c = e >> 3, oct = e & 7;
          unsigned short vals[8];
#pragma unroll
          for (int j = 0; j < 8; ++j) vals[j] = *(const LAS unsigned short*)(L + (oct * 8 + j) * 1040 + c * 2);
          u32x4 o; o.x = vals[0] | ((unsigned)vals[1] << 16); o.y = vals[2] | ((unsigned)vals[3] << 16); o.z = vals[4] | ((unsigned)vals[5] << 16); o.w = vals[6] | ((unsigned)vals[7] << 16);
          *(u32x4*)(VT + ((size_t)(b * 512 + c)) * SEQ + s0 + oct * 8) = o; } }
    __syncthreads();
}

DI float softplusf_(float x) { return fmaxf(x, 0.f) + log1pf(__expf(-fabsf(x))); }
DI void rwkv_prep_item(const Frame& F, unsigned char* ws, const In& in, int l, int item) {
    const float* ZS = (const float*)(ws + WS_ZS);
    const float* mu = in[6] + l * B_COLS; const float* w0 = in[7] + l * MIX; const float* w2 = in[8] + (size_t)l * 96 * MIX; const float* a0 = in[9] + l * MIX;
    const float* a2 = in[10] + (size_t)l * 96 * MIX; const float* g2 = in[11] + (size_t)l * 256 * MIX; const float* k_k = in[12] + l * MIX; const float* k_a = in[13] + l * MIX;
    float* RW = (float*)(ws + WS_RW); constexpr size_t RS = RW_STRIDE / 4;
    const int m0 = item * 32; const bool first = (m0 % SEQ) == 0;
    LAS float* LW = (LAS float*)F.lds;
    LAS float* LA = LW + 96 * 32;
    LAS float* LG = LA + 96 * 32;
    for (int e = F.tid; e < 32 * 448; e += NTHR) { const int t = e / 448, c = e % 448; const int m = m0 + t, zc = ZO_LW + c;
        const float z = ZS[(size_t)m * ZS_COLS + zc]; const float zp = (first && t == 0) ? 0.f : ZS[(size_t)(m - 1) * ZS_COLS + zc];
        const float xs = z + (zp - z) * mu[zc];
        if (c < 96) LW[c * 32 + t] = tanhf(xs); else if (c < 192) LA[(c - 96) * 32 + t] = xs; else LG[(c - 192) * 32 + t] = sigmoidf_(xs); }
    __syncthreads();
    const int j = F.tid;
    const float muR = mu[ZO_R + j], muK = mu[ZO_K + j], muV = mu[ZO_V + j];
    const float w0j = w0[j], a0j = a0[j], kkj = k_k[j], kaj = k_a[j];
#pragma unroll 1
    for (int half = 0; half < 2; ++half) {
        float dw[16], da[16], dg[16];
#pragma unroll
        for (int t = 0; t < 16; ++t) { dw[t] = 0.f; da[t] = 0.f; dg[t] = 0.f; }
#pragma unroll 2
        for (int k = 0; k < 96; ++k) { const float wv = w2[k * MIX + j], av = a2[k * MIX + j];
#pragma unroll
            for (int q = 0; q < 4; ++q) { const f32x4 x = *(const LAS f32x4*)(LW + k * 32 + half * 16 + 4 * q), y = *(const LAS f32x4*)(LA + k * 32 + half * 16 + 4 * q);
#pragma unroll
                for (int i = 0; i < 4; ++i) { dw[4 * q + i] += x[i] * wv; da[4 * q + i] += y[i] * av; } } }
#pragma unroll 2
        for (int k = 0; k < 256; ++k) { const float gv = g2[k * MIX + j];
#pragma unroll
            for (int q = 0; q < 4; ++q) { const f32x4 x = *(const LAS f32x4*)(LG + k * 32 + half * 16 + 4 * q);
#pragma unroll
                for (int i = 0; i < 4; ++i) dg[4 * q + i] += x[i] * gv; } }
        const int mb = m0 + half * 16;
        float pr, pk, pv;
        if (first && half == 0) { pr = 0.f; pk = 0.f; pv = 0.f; }
        else { const float* zp = ZS + (size_t)(mb - 1) * ZS_COLS; pr = zp[ZO_R + j]; pk = zp[ZO_K + j]; pv = zp[ZO_V + j]; }
#pragma unroll
        for (int t = 0; t < 16; ++t) { const int m = mb + t; const float* zr = ZS + (size_t)m * ZS_COLS;
            const float zr_ = zr[ZO_R + j], zk_ = zr[ZO_K + j], zv_ = zr[ZO_V + j];
            const float r = zr_ + (pr - zr_) * muR, k = zk_ + (pk - zk_) * muK, v = zv_ + (pv - zv_) * muV;
            pr = zr_; pk = zk_; pv = zv_;
            const float wlog = -softplusf_(-(w0j + dw[t])) - 0.5f;
            const float decay = expf(-expf(wlog));
            const float a = sigmoidf_(a0j + da[t]);
            const float kkr = k * kkj;
            const float nrm = sqrtf(wave_sum(kkr * kkr));
            const float kk = kkr / fmaxf(nrm, 1e-12f);
            const float k2 = k * (1.0f + (a - 1.0f) * kaj);
            const size_t o = (size_t)m * MIX + j;
            RW[0 * RS + o] = r; RW[1 * RS + o] = decay; RW[2 * RS + o] = k2; RW[3 * RS + o] = v; RW[4 * RS + o] = -kk; RW[5 * RS + o] = kk * a; RW[6 * RS + o] = dg[t]; }
    }
    __syncthreads();
}

DI void pool_item(const Frame& F, unsigned char* ws, const In& in, int l, int item) {
    const float* ZS = (const float*)(ws + WS_ZS); bf16_t* MIXp = (bf16_t*)(ws + WS_MIX);
    const float* pw = in[17] + (size_t)l * 4 * 128 * 128; const float* psc = in[18] + l * MIX;
    const int m0 = item * 16, t0 = m0 % SEQ;
    LAS float* Z = (LAS float*)F.lds;
    LAS float* DT = Z + 31 * 512;
    for (int e = F.tid; e < 31 * 128; e += NTHR) { const int r = e >> 7, c4 = (e & 127) * 4; const int ta = t0 - 15 + r;
        f32x4 v = (f32x4){0.f, 0.f, 0.f, 0.f};
        if (ta >= 0) v = *(const f32x4*)(ZS + (size_t)(m0 - 15 + r) * ZS_COLS + ZO_C + c4);
        *(LAS f32x4*)(Z + r * 512 + c4) = v; }
    __syncthreads();
    const int j = F.tid, gi = j >> 7, win = 2 << gi;
    for (int t = 0; t < 16; ++t) { float s = 0.f;
        for (int i = 0; i < win; ++i) s += Z[(15 + t - i) * 512 + j];
        const int cnt = (t0 + t + 1) < win ? (t0 + t + 1) : win;
        DT[j * 16 + t] = s / (float)cnt - Z[(15 + t) * 512 + j]; }
    __syncthreads();
    float acc[16];
#pragma unroll
    for (int t = 0; t < 16; ++t) acc[t] = 0.f;
    const int dcol = j & 127;
#pragma unroll 2
    for (int k = 0; k < 128; ++k) { const float wv = pw[((size_t)gi * 128 + k) * 128 + dcol];
#pragma unroll
        for (int q = 0; q < 4; ++q) { const f32x4 x = *(const LAS f32x4*)(DT + (gi * 128 + k) * 16 + 4 * q);
#pragma unroll
            for (int i = 0; i < 4; ++i) acc[4 * q + i] += x[i] * wv; } }
    const float sc = psc[j];
#pragma unroll
    for (int t = 0; t < 16; ++t) MIXp[(size_t)(m0 + t) * (4 * MIX) + 2 * MIX + j] = (bf16_t)f2bf(acc[t] * sc);
    __syncthreads();
}

struct SsmCoef { float lr, li; float br[16], bi[16]; };
DI void ssm_coef(const In& in, int l, int g, int p, SsmCoef& c) {
    const float are = in[19][((size_t)l * 32 + g) * 64 + p], aim = in[20][((size_t)l * 32 + g) * 64 + p];
    const float dt = expf(in[21][l * 32 + g]);
    const float er = expf(are * dt); float sn, cs; sincosf(aim * dt, &sn, &cs);
    c.lr = er * cs; c.li = er * sn;
    const float nr = c.lr - 1.0f, ni = c.li, den = are * are + aim * aim;
    const float cr = (nr * are + ni * aim) / den, ci = (ni * are - nr * aim) / den;
    const float* bre = in[22] + (((size_t)l * 32 + g) * 64 + p) * 16; const float* bim = in[23] + (((size_t)l * 32 + g) * 64 + p) * 16;
#pragma unroll
    for (int k = 0; k < 16; ++k) { const float x = bre[k], y = bim[k]; c.br[k] = cr * x - ci * y; c.bi[k] = cr * y + ci * x; }
}
DI void ssm_pass1_item(const Frame& F, unsigned char* ws, const In& in, int l, int item) {
    const float* ZS = (const float*)(ws + WS_ZS); float* SST = (float*)(ws + WS_SSTATE);
    const int wt = item * 8 + F.wave, b = wt >> 9, g = (wt >> 4) & 31, ch = wt & 15, p = F.lane;
    SsmCoef c; ssm_coef(in, l, g, p, c);
    LAS float* UL = (LAS float*)(F.lds + F.wave * 8192);
    const int mb = b * SEQ + ch * 128;
#pragma unroll
    for (int i = 0; i < 8; ++i) { const int e = i * 64 + F.lane, t = e >> 2, q = e & 3;
        *(LAS f32x4*)(UL + t * 16 + q * 4) = *(const f32x4*)(ZS + (size_t)(mb + t) * ZS_COLS + ZO_D + g * 16 + q * 4); }
    LDS_WAIT(); asm volatile("" ::: "memory");
    float xr = 0.f, xi = 0.f;
#pragma unroll 2
    for (int t = 0; t < 128; ++t) { float bur = 0.f, bui = 0.f;
#pragma unroll
        for (int q = 0; q < 4; ++q) { const f32x4 u = *(const LAS f32x4*)(UL + t * 16 + q * 4);
#pragma unroll
            for (int i = 0; i < 4; ++i) { bur += c.br[4 * q + i] * u[i]; bui += c.bi[4 * q + i] * u[i]; } }
        const float nr = c.lr * xr - c.li * xi + bur, ni = c.lr * xi + c.li * xr + bui; xr = nr; xi = ni; }
    *(f32x2*)(SST + ((size_t)wt * 64 + p) * 2) = (f32x2){xr, xi};
    LDS_WAIT(); asm volatile("" ::: "memory");
}
DI float gelu_tanh(float y) { const float u = 0.7978845608028654f * (y + 0.044715f * y * y * y); return 0.5f * y * (1.0f + tanhf(u)); }
DI void ssm_pass3_item(const Frame& F, unsigned char* ws, const In& in, int l, int item) {
    const float* ZS = (const float*)(ws + WS_ZS); const float* SST = (const float*)(ws + WS_SSTATE);
    float* YS = (float*)(ws + WS_YS); bf16_t* YSB = (bf16_t*)(ws + WS_YSB);
    const int wt = item * 8 + F.wave, b = wt >> 9, g = (wt >> 4) & 31, ch = wt & 15, p = F.lane;
    SsmCoef c; ssm_coef(in, l, g, p, c);
    LAS float* CL = (LAS float*)(F.lds + 98304);
    { const float* cre = in[24] + ((size_t)l * 32 + g) * 16 * 64; const float* cim = in[25] + ((size_t)l * 32 + g) * 16 * 64;
      for (int e = F.tid; e < 1024; e += NTHR) { const int cc = e >> 6, pp = e & 63; *(LAS f32x2*)(CL + cc * 132 + pp * 2) = (f32x2){cre[e], cim[e]}; } }
    __syncthreads();
    float l128r = c.lr, l128i = c.li;
#pragma unroll
    for (int i = 0; i < 7; ++i) { const float nr = l128r * l128r - l128i * l128i, ni = 2.f * l128r * l128i; l128r = nr; l128i = ni; }
    float xr = 0.f, xi = 0.f;
    for (int cc = 0; cc < ch; ++cc) { const f32x2 e = *(const f32x2*)(SST + ((size_t)(wt - ch + cc) * 64 + p) * 2);
        const float nr = l128r * xr - l128i * xi + e[0], ni = l128r * xi + l128i * xr + e[1]; xr = nr; xi = ni; }
    LAS float* UL = (LAS float*)(F.lds + F.wave * 12288);
    LAS float* XS = UL + 256;
    const int mb = b * SEQ + ch * 128;
    const float dsk = in[26][l * MIX + g * 16 + (F.lane & 15)];
    for (int sc = 0; sc < 8; ++sc) {
        { const int t = F.lane >> 2, q = F.lane & 3;
          *(LAS f32x4*)(UL + t * 16 + q * 4) = *(const f32x4*)(ZS + (size_t)(mb + sc * 16 + t) * ZS_COLS + ZO_D + g * 16 + q * 4); }
        LDS_WAIT(); asm volatile("" ::: "memory");
#pragma unroll 2
        for (int t = 0; t < 16; ++t) { float bur = 0.f, bui = 0.f;
#pragma unroll
            for (int q = 0; q < 4; ++q) { const f32x4 u = *(const LAS f32x4*)(UL + t * 16 + q * 4);
#pragma unroll
                for (int i = 0; i < 4; ++i) { bur += c.br[4 * q + i] * u[i]; bui += c.bi[4 * q + i] * u[i]; } }
            const float nr = c.lr * xr - c.li * xi + bur, ni = c.lr * xi + c.li * xr + bui; xr = nr; xi = ni;
            *(LAS f32x2*)(XS + (t * 64 + p) * 2) = (f32x2){xr, xi}; }
        LDS_WAIT(); asm volatile("" ::: "memory");
        const int cc = F.lane & 15, tq = F.lane >> 4;
        float y[4] = {0.f, 0.f, 0.f, 0.f};
#pragma unroll 4
        for (int pp = 0; pp < 64; pp += 2) { const f32x4 cv = *(const LAS f32x4*)(CL + cc * 132 + pp * 2);
#pragma unroll
            for (int jj = 0; jj < 4; ++jj) { const f32x4 xv = *(const LAS f32x4*)(XS + ((tq * 4 + jj) * 64 + pp) * 2);
                y[jj] += cv[0] * xv[0] - cv[1] * xv[1] + cv[2] * xv[2] - cv[3] * xv[3]; } }
#pragma unroll
        for (int jj = 0; jj < 4; ++jj) { const int t = tq * 4 + jj; const int m = mb + sc * 16 + t;
            const float yy = gelu_tanh(y[jj] + dsk * UL[t * 16 + cc]);
            YS[(size_t)m * MIX + g * 16 + cc] = yy; YSB[(size_t)m * MIX + g * 16 + cc] = (bf16_t)f2bf(yy); }
        LDS_WAIT(); asm volatile("" ::: "memory");
    }
    __syncthreads();
}

template <int CTRL> DI float dpp_xadd(float x) { const int r = __builtin_amdgcn_update_dpp(0, __builtin_bit_cast(int, x), CTRL, 0xF, 0xF, true); return x + __builtin_bit_cast(float, r); }
DI float row16_sum(float x) { x = dpp_xadd<0xB1>(x); x = dpp_xadd<0x4E>(x); x = dpp_xadd<0x141>(x); x = dpp_xadd<0x140>(x); return x; }
DI void rwkv_scan_item(const Frame& F, unsigned char* ws, int item) {
    const float* RW = (const float*)(ws + WS_RW); constexpr size_t RS = RW_STRIDE / 4;
    float* YRAW = (float*)(ws + WS_YS);
    YRAW = (float*)(ws + WS_YRAW);
    constexpr int TC = 32, NCH = SEQ / TC;
    const int bh = item >> 1, half = item & 1, b = bh >> 3, h = bh & 7;
    const int ri = F.lane >> 4, jq = F.lane & 15, row = half * 32 + F.wave * 4 + ri;
    LAS float* BUF = (LAS float*)F.lds;
    constexpr int BUFSZ = 6 * TC * 64;
    const int st = F.tid >> 4, sq = F.tid & 15;
    const float* gsrc = RW + (size_t)(b * SEQ + st) * MIX + h * 64 + 4 * sq;
    f32x4 pre[6];
#pragma unroll
    for (int a = 0; a < 6; ++a) pre[a] = *(const f32x4*)(gsrc + a * RS);
#pragma unroll
    for (int a = 0; a < 6; ++a) *(LAS f32x4*)(BUF + (a * TC + st) * 64 + 4 * sq) = pre[a];
    __syncthreads();
    float S0 = 0.f, S1 = 0.f, S2 = 0.f, S3 = 0.f;
    float* yout = YRAW + (size_t)(b * SEQ) * MIX + h * 64 + row;
#pragma unroll 1
    for (int c = 0; c < NCH; ++c) {
        if (c + 1 < NCH) {
#pragma unroll
            for (int a = 0; a < 6; ++a) pre[a] = *(const f32x4*)(gsrc + a * RS + (size_t)(c + 1) * TC * MIX);
        }
        const LAS float* P = BUF + (c & 1) * BUFSZ;
#pragma unroll 1
        for (int t16 = 0; t16 < TC; t16 += 16) {
            float ykeep = 0.f;
#pragma unroll
            for (int tt = 0; tt < 16; ++tt) { const int t = t16 + tt;
                const f32x4 a4 = *(const LAS f32x4*)(P + (4 * TC + t) * 64 + 4 * jq);
                const f32x4 k4 = *(const LAS f32x4*)(P + (2 * TC + t) * 64 + 4 * jq);
                const float v = P[(3 * TC + t) * 64 + row];
                const f32x4 b4 = *(const LAS f32x4*)(P + (5 * TC + t) * 64 + 4 * jq);
                const f32x4 w4 = *(const LAS f32x4*)(P + (1 * TC + t) * 64 + 4 * jq);
                const f32x4 r4 = *(const LAS f32x4*)(P + (0 * TC + t) * 64 + 4 * jq);
                float sa = (S0 * a4[0] + S1 * a4[1]) + (S2 * a4[2] + S3 * a4[3]);
                sa = row16_sum(sa);
                S0 = S0 * w4[0] + (sa * b4[0] + v * k4[0]); S1 = S1 * w4[1] + (sa * b4[1] + v * k4[1]);
                S2 = S2 * w4[2] + (sa * b4[2] + v * k4[2]); S3 = S3 * w4[3] + (sa * b4[3] + v * k4[3]);
                float y = (S0 * r4[0] + S1 * r4[1]) + (S2 * r4[2] + S3 * r4[3]);
                y = row16_sum(y);
                ykeep = (tt == jq) ? y : ykeep; }
            yout[(size_t)(c * TC + t16 + jq) * MIX] = ykeep;
        }
        if (c + 1 < NCH) {
            LAS float* Q = BUF + ((c + 1) & 1) * BUFSZ;
#pragma unroll
            for (int a = 0; a < 6; ++a) *(LAS f32x4*)(Q + (a * TC + st) * 64 + 4 * sq) = pre[a];
        }
        __syncthreads();
    }
}
DI void rwkv_post_rows(const Frame& F, unsigned char* ws, const In& in, int l, int w0, int nw) {
    const float* RW = (const float*)(ws + WS_RW); constexpr size_t RS = RW_STRIDE / 4;
    const float* YRAW = (const float*)(ws + WS_YRAW); bf16_t* MIXp = (bf16_t*)(ws + WS_MIX);
    const float* r_k = in[14] + l * MIX; const float* lng = in[15] + l * MIX; const float* lnb = in[16] + l * MIX;
    for (int e = w0; e < MTOK * 8; e += nw) { const int m = e >> 3, h = e & 7, ch = h * 64 + F.lane; const size_t o = (size_t)m * MIX + ch;
        const float y = YRAW[o];
        const float mean = wave_sum(y) * (1.f / 64.f); const float d = y - mean; const float var = wave_sum(d * d) * (1.f / 64.f);
        const float yn = d * (1.0f / sqrtf(var + GN_EPS)) * lng[ch] + lnb[ch];
        const float bon = wave_sum(RW[0 * RS + o] * RW[2 * RS + o] * r_k[ch]) * RW[3 * RS + o];
        MIXp[(size_t)m * (4 * MIX) + MIX + ch] = (bf16_t)f2bf((yn + bon) * RW[6 * RS + o]); }
}

DI unsigned fkey(float v) { unsigned u = __builtin_bit_cast(unsigned, v); if (u == 0x80000000u) u = 0u; return (u & 0x80000000u) ? ~u : (u | 0x80000000u); }
DI bf16x8 pack8(float a0, float a1, float a2, float a3, float a4, float a5, float a6, float a7) {
    u32x4 p; p.x = pk2(a0, a1); p.y = pk2(a2, a3); p.z = pk2(a4, a5); p.w = pk2(a6, a7); return __builtin_bit_cast(bf16x8, p); }
DI void dsa_item(const Frame& F, unsigned char* ws, int item) {
    const bf16_t* Q = (const bf16_t*)(ws + WS_Q); const bf16_t* Kb = (const bf16_t*)(ws + WS_K); const bf16_t* VT = (const bf16_t*)(ws + WS_VT);
    const bf16_t* QI = (const bf16_t*)(ws + WS_QI); const bf16_t* KI = (const bf16_t*)(ws + WS_KI); const float* WI = (const float*)(ws + WS_WI);
    float* SC = (float*)(ws + WS_SC); unsigned* MASK = (unsigned*)(ws + WS_MASK); bf16_t* MIXp = (bf16_t*)(ws + WS_MIX);
    const int b = item >> 6, qb = item & 63, q0 = qb * 32, m0 = b * SEQ + q0;
    const int r = F.lane & 31, hh = F.lane >> 5;
    {
        bf16x8 qf[4][4]; float wv[4];
#pragma unroll
        for (int hd = 0; hd < 4; ++hd) { wv[hd] = WI[(size_t)(m0 + r) * 4 + hd];
#pragma unroll
            for (int s = 0; s < 4; ++s) qf[hd][s] = *(const bf16x8*)(QI + (size_t)(m0 + r) * 256 + hd * 64 + 16 * s + 8 * hh); }
        for (int kt = F.wave; kt <= qb; kt += 8) {
            bf16x8 kf[4];
#pragma unroll
            for (int s = 0; s < 4; ++s) kf[s] = *(const bf16x8*)(KI + (size_t)(b * SEQ + kt * 32 + r) * 64 + 16 * s + 8 * hh);
            f32x16 sc;
#pragma unroll
            for (int i = 0; i < 16; ++i) sc[i] = 0.f;
#pragma unroll
            for (int hd = 0; hd < 4; ++hd) { f32x16 a;
#pragma unroll
                for (int i = 0; i < 16; ++i) a[i] = 0.f;
#pragma unroll
                for (int s = 0; s < 4; ++s) a = MFMA32(kf[s], qf[hd][s], a);
#pragma unroll
                for (int i = 0; i < 16; ++i) sc[i] += wv[hd] * fmaxf(a[i], 0.f); }
#pragma unroll
            for (int g = 0; g < 4; ++g) *(f32x4*)(SC + (size_t)(m0 + r) * SEQ + kt * 32 + 8 * g + 4 * hh) = (f32x4){sc[4 * g], sc[4 * g + 1], sc[4 * g + 2], sc[4 * g + 3]};
        }
    }
    VM_WAIT(); __syncthreads();
    {
        LAS unsigned* KL = (LAS unsigned*)(F.lds + F.wave * 8192);
        for (int qq = 0; qq < 4; ++qq) {
            const int rq = F.wave * 4 + qq, t = q0 + rq, m = m0 + rq;
            unsigned* mrow = MASK + (size_t)m * 64;
            const int nj = (t >> 6) + 1;
            if (t + 1 <= 256) {
                for (int j = 0; j < 32; ++j) { const unsigned long long bm = __ballot(F.lane + 64 * j <= t); if (F.lane == 0) { mrow[2 * j] = (unsigned)bm; mrow[2 * j + 1] = (unsigned)(bm >> 32); } }
            } else {
                for (int j = 0; j < nj; ++j) { const int s = F.lane + 64 * j; unsigned k = 0u; if (s <= t) k = fkey(SC[(size_t)m * SEQ + s]); KL[j * 64 + F.lane] = k; }
                LDS_WAIT(); asm volatile("" ::: "memory");
                unsigned T = 0u;
                for (int bit = 31; bit >= 0; --bit) { const unsigned cand = T | (1u << bit); int cnt = 0;
#pragma unroll 4
                    for (int j = 0; j < nj; ++j) cnt += __popcll(__ballot(KL[j * 64 + F.lane] >= cand));
                    if (cnt >= 256) T = cand; }
                int cgt = 0;
#pragma unroll 4
                for (int j = 0; j < nj; ++j) cgt += __popcll(__ballot(KL[j * 64 + F.lane] > T));
                const int need = 256 - cgt; int run = 0;
                const unsigned long long lt = (1ull << F.lane) - 1ull;
                for (int j = 0; j < 32; ++j) {
                    unsigned long long bm = 0ull;
                    if (j < nj) { const unsigned k = KL[j * 64 + F.lane]; const unsigned long long eq = __ballot(k == T), gt = __ballot(k > T);
                        const int pre = run + __popcll(eq & lt);
                        const unsigned long long se = __ballot(k == T && pre < need);
                        bm = gt | se; run += __popcll(eq); }
                    if (F.lane == 0) { mrow[2 * j] = (unsigned)bm; mrow[2 * j + 1] = (unsigned)(bm >> 32); } }
                LDS_WAIT(); asm volatile("" ::: "memory");
            }
        }
    }
    VM_WAIT(); __syncthreads();
    {
        const int hd = F.wave;
        bf16x8 qf[4];
#pragma unroll
        for (int s = 0; s < 4; ++s) qf[s] = *(const bf16x8*)(Q + (size_t)(m0 + r) * 512 + hd * 64 + 16 * s + 8 * hh);
        f32x16 o0, o1;
#pragma unroll
        for (int i = 0; i < 16; ++i) { o0[i] = 0.f; o1[i] = 0.f; }
        float mrun = -1e30f, lrun = 0.f;
        const bf16_t* vbase = VT + ((size_t)(b * 8 + hd) * 64 + r) * SEQ;
        for (int kt = 0; kt <= qb; ++kt) {
            bf16x8 kf[4];
#pragma unroll
            for (int s = 0; s < 4; ++s) kf[s] = *(const bf16x8*)(Kb + (size_t)(b * SEQ + kt * 32 + r) * 512 + hd * 64 + 16 * s + 8 * hh);
            const unsigned mw = MASK[(size_t)(m0 + r) * 64 + kt];
            f32x16 sa;
#pragma unroll
            for (int i = 0; i < 16; ++i) sa[i] = 0.f;
#pragma unroll
            for (int s = 0; s < 4; ++s) sa = MFMA32(kf[s], qf[s], sa);
            float mx = -1e30f;
#pragma unroll
            for (int i = 0; i < 16; ++i) { const int kr = (i & 3) + 8 * (i >> 2) + 4 * hh; const bool on = (mw >> kr) & 1u; sa[i] = on ? sa[i] : -1e30f; mx = fmaxf(mx, sa[i]); }
            mx = fmaxf(mx, __shfl_xor(mx, 32));
            const float mnew = fmaxf(mrun, mx), alpha = __expf(mrun - mnew);
            float p[16], ps = 0.f;
#pragma unroll
            for (int i = 0; i < 16; ++i) { p[i] = (sa[i] > -1e29f) ? __expf(sa[i] - mnew) : 0.f; ps += p[i]; }
            lrun = lrun * alpha + ps; mrun = mnew;
#pragma unroll
            for (int i = 0; i < 16; ++i) { o0[i] *= alpha; o1[i] *= alpha; }
#pragma unroll
            for (int s2 = 0; s2 < 2; ++s2) {
                const bf16x8 pb = pack8(p[8 * s2], p[8 * s2 + 1], p[8 * s2 + 2], p[8 * s2 + 3], p[8 * s2 + 4], p[8 * s2 + 5], p[8 * s2 + 6], p[8 * s2 + 7]);
                const bf16_t* vp = vbase + kt * 32 + 16 * s2 + 4 * hh;
                const s16x4 a0 = *(const s16x4*)(vp), a1 = *(const s16x4*)(vp + 8);
                const s16x4 c0 = *(const s16x4*)(vp + (size_t)32 * SEQ), c1 = *(const s16x4*)(vp + (size_t)32 * SEQ + 8);
                const bf16x8 vf0 = __builtin_shufflevector(a0, a1, 0, 1, 2, 3, 4, 5, 6, 7), vf1 = __builtin_shufflevector(c0, c1, 0, 1, 2, 3, 4, 5, 6, 7);
                o0 = MFMA32(vf0, pb, o0); o1 = MFMA32(vf1, pb, o1);
            }
        }
        const float inv = 1.0f / (lrun + __shfl_xor(lrun, 32));
        bf16_t* orow = MIXp + (size_t)(m0 + r) * (4 * MIX) + hd * 64;
#pragma unroll
        for (int g = 0; g < 4; ++g) {
            u32x2 w0; w0.x = pk2(o0[4 * g] * inv, o0[4 * g + 1] * inv); w0.y = pk2(o0[4 * g + 2] * inv, o0[4 * g + 3] * inv);
            u32x2 w1; w1.x = pk2(o1[4 * g] * inv, o1[4 * g + 1] * inv); w1.y = pk2(o1[4 * g + 2] * inv, o1[4 * g + 3] * inv);
            *(u32x2*)(orow + 8 * g + 4 * hh) = w0; *(u32x2*)(orow + 32 + 8 * g + 4 * hh) = w1; }
    }
    __syncthreads();
}

DI float siluf_(float x) { return x * sigmoidf_(x); }
DI void conv_phase(const Frame& F, unsigned char* ws, const In& in, int l) {
    const bf16_t* U = (const bf16_t*)(ws + WS_U); bf16_t* ACT = (bf16_t*)(ws + WS_ACT);
    const float* cw = in[33] + (size_t)l * 3 * DFF2; const float* cb = in[34] + (size_t)l * DFF2;
    constexpr int NCG = DFF / 8;
    const long total = (long)NCG * (MTOK / 32);
    for (long e = (long)F.bid * NTHR + F.tid; e < total; e += (long)F.G * NTHR) {
        const int cg = (int)(e % NCG), tg = (int)(e / NCG); const int f0 = cg * 8, m0 = tg * 32; const bool first = (m0 % SEQ) == 0;
        float wg[3][8], wv[3][8], bg[8], bv[8];
#pragma unroll
        for (int j = 0; j < 3; ++j)
#pragma unroll
            for (int i = 0; i < 8; ++i) { wg[j][i] = cw[(size_t)j * DFF2 + f0 + i]; wv[j][i] = cw[(size_t)j * DFF2 + DFF + f0 + i]; }
#pragma unroll
        for (int i = 0; i < 8; ++i) { bg[i] = cb[f0 + i]; bv[i] = cb[DFF + f0 + i]; }
        float g1[8], g2[8], v1[8], v2[8];
#pragma unroll
        for (int i = 0; i < 8; ++i) { g1[i] = 0.f; g2[i] = 0.f; v1[i] = 0.f; v2[i] = 0.f; }
        if (!first) {
            const u32x4 a = *(const u32x4*)(U + (size_t)(m0 - 1) * DFF2 + f0), b = *(const u32x4*)(U + (size_t)(m0 - 2) * DFF2 + f0);
            const u32x4 c = *(const u32x4*)(U + (size_t)(m0 - 1) * DFF2 + DFF + f0), d = *(const u32x4*)(U + (size_t)(m0 - 2) * DFF2 + DFF + f0);
#pragma unroll
            for (int i = 0; i < 4; ++i) { g1[2 * i] = bf2f(a[i] & 0xffffu); g1[2 * i + 1] = bf2f(a[i] >> 16); g2[2 * i] = bf2f(b[i] & 0xffffu); g2[2 * i + 1] = bf2f(b[i] >> 16);
                v1[2 * i] = bf2f(c[i] & 0xffffu); v1[2 * i + 1] = bf2f(c[i] >> 16); v2[2 * i] = bf2f(d[i] & 0xffffu); v2[2 * i + 1] = bf2f(d[i] >> 16); }
        }
#pragma unroll 2
        for (int t = 0; t < 32; ++t) {
            const u32x4 a = *(const u32x4*)(U + (size_t)(m0 + t) * DFF2 + f0), c = *(const u32x4*)(U + (size_t)(m0 + t) * DFF2 + DFF + f0);
            float g0[8], v0[8], o[8];
#pragma unroll
            for (int i = 0; i < 4; ++i) { g0[2 * i] = bf2f(a[i] & 0xffffu); g0[2 * i + 1] = bf2f(a[i] >> 16); v0[2 * i] = bf2f(c[i] & 0xffffu); v0[2 * i + 1] = bf2f(c[i] >> 16); }
#pragma unroll
            for (int i = 0; i < 8; ++i) { const float gc = bg[i] + wg[0][i] * g2[i] + wg[1][i] * g1[i] + wg[2][i] * g0[i]; const float vc = bv[i] + wv[0][i] * v2[i] + wv[1][i] * v1[i] + wv[2][i] * v0[i];
                o[i] = siluf_(gc) * vc; g2[i] = g1[i]; g1[i] = g0[i]; v2[i] = v1[i]; v1[i] = v0[i]; }
            u32x4 w; w.x = pk2(o[0], o[1]); w.y = pk2(o[2], o[3]); w.z = pk2(o[4], o[5]); w.w = pk2(o[6], o[7]);
            *(u32x4*)(ACT + (size_t)(m0 + t) * DFF + f0) = w;
        }
    }
}

DI void final_phase(const Frame& F, unsigned char* ws, const float* gfin, float* out) {
    const float* Y = (const float*)(ws + WS_Y); const float* part = (const float*)(ws + WS_PARTA);
    const int gw = F.bid * NWAVES + F.wave, NGW = F.G * NWAVES;
    for (int m = gw; m < MTOK; m += NGW) {
        float s = (F.lane < 32) ? part[(size_t)m * 32 + F.lane] : 0.f; s = wave_sum(s);
        const float rs = 1.0f / sqrtf(s * (1.0f / DM) + RMS_EPS);
#pragma unroll
        for (int j = 0; j < 8; ++j) { const int c = (j * 64 + F.lane) * 4; const f32x4 v = *(const f32x4*)(Y + (size_t)m * DM + c), g = *(const f32x4*)(gfin + c);
            *(f32x4*)(out + (size_t)m * DM + c) = v * rs * g; }
    }
}

struct Args { InTab in; float* out; unsigned char* ws; int ph_lo, ph_hi; };
constexpr int PH_PER_LAYER = 9, N_PHASES = 1 + NL * PH_PER_LAYER + 1;

__global__ void __launch_bounds__(NTHR, 2) hybrid_fwd(Args args) {
    extern __shared__ __attribute__((aligned(16))) unsigned char lds_raw[];
    Frame F0; F0.lds = (LAS unsigned char*)lds_raw; F0.tid = threadIdx.x; F0.lane = F0.tid & 63; F0.wave = __builtin_amdgcn_readfirstlane(F0.tid >> 6); F0.bid = blockIdx.x; F0.G = gridDim.x;
    unsigned char* ws0 = args.ws; In in0; in0.t = (CAS const gfptr_t*)__builtin_amdgcn_kernarg_segment_ptr();
    const int lo = args.ph_lo, hi = args.ph_hi;
    volatile LAS unsigned* MISC = (volatile LAS unsigned*)(F0.lds + MISC_OFF);
    if (F0.tid < 16) MISC[F0.tid] = 0u;
    __syncthreads();
    XcdBarrier bar; bar.bar = (unsigned*)(ws0 + WS_CTL) + CW_BAR; bar.x = 0; bar.st = nullptr;
    const bool multi = (hi - lo) > 1;
    if (multi) bar = xcd_barrier_post((unsigned*)(ws0 + WS_CTL) + CW_BAR, MISC + 8);
#ifndef SUBMASK
#define SUBMASK 7
#endif
#ifndef DUPMASK
#define DUPMASK 0u
#endif
#define NREP(j) (((DUPMASK >> (j)) & 1u) ? 2 : 1)
#ifndef PHMASK
#define PHMASK 0xFFFFFFFFu
#endif
#define IN_PH(k) (lo <= (k) && (k) < hi)
#define ON(j) ((PHMASK >> (j)) & 1u)
#define LAYER_PTRS unsigned char* wt = ws + WS_WT + (size_t)l * WT_LAYER; float* Y = (float*)(ws + WS_Y); bf16_t* YB = (bf16_t*)(ws + WS_YB); float* PA = (float*)(ws + WS_PARTA); float* PB = (float*)(ws + WS_PARTB); const LAS float* rsT = (const LAS float*)(F.lds + RST_OFF); (void)wt; (void)Y; (void)YB; (void)PA; (void)PB; (void)rsT;
#define SEAM(k) do { if (IN_PH(k) && IN_PH((k) + 1)) xcd_barrier(bar); } while (0)

    if (ON(0) && IN_PH(0)) for (int rep = 0; rep < NREP(0); ++rep) { if (rep) xcd_barrier(bar); const In in = in_fresh(in0); const Frame F = fresh(F0); unsigned char* ws = fresh_ptr(ws0); p0_prologue(F, in, ws); }
    SEAM(0);

    for (int l = 0; l < NL; ++l) {
        const int pb = 1 + l * PH_PER_LAYER;
        if (ON(1) && IN_PH(pb + 0)) for (int rep = 0; rep < NREP(1); ++rep) { if (rep) xcd_barrier(bar); const In in = in_fresh(in0); const Frame F = fresh(F0); unsigned char* ws = fresh_ptr(ws0); LAYER_PTRS
            pg8::Gemm g{YB, (const bf16_t*)(wt + WT_IN), DM, DM, DM}; pg8::Order S; S.init(MTOK / 256, NZ / 256, F.G, F.bid, DM, DM);
            pg8::Unit u0; int pm0 = -1; if (S.next(0, u0)) pm0 = u0.pm;
            if (pm0 >= 0) rs_table(F, PA, pm0); else __syncthreads();
            pg8::EpiZ E{(float*)(ws + WS_ZS), (bf16_t*)(ws + WS_G), in[4] + (size_t)l * GCOLS, PA, rsT, pm0};
            pg8::gemm_phase<pg8::EpiZ, pg8::Order, true>(F.lds, F.tid, g, S, E);
        }
        SEAM(pb + 0);
        if (ON(2) && IN_PH(pb + 1)) for (int rep = 0; rep < NREP(2); ++rep) { if (rep) xcd_barrier(bar); const In in = in_fresh(in0); const Frame F = fresh(F0); unsigned char* ws = fresh_ptr(ws0); LAYER_PTRS
            for (int it = F.bid; it < 1152; it += F.G) {
                if (it < 128) dsa_prep_item(F, ws, in[5] + l * 64, it);
                else if (it < 384) rwkv_prep_item(F, ws, in, l, it - 128);
                else if (it < 896) pool_item(F, ws, in, l, it - 384);
                else ssm_pass1_item(F, ws, in, l, it - 896);
            }
        }
        SEAM(pb + 1);
        if (ON(3) && IN_PH(pb + 2)) for (int rep = 0; rep < NREP(3); ++rep) { if (rep) xcd_barrier(bar); const In in = in_fresh(in0); const Frame F = fresh(F0); unsigned char* ws = fresh_ptr(ws0); LAYER_PTRS
            const bool split = F.G >= 128; const int nrw = split ? 64 : 0;
            if (SUBMASK & 1) { const Frame Fa = fresh(F0);
                if (split) { if (Fa.bid < 64) rwkv_scan_item(Fa, ws, Fa.bid); }
                else for (int it = Fa.bid; it < 64; it += Fa.G) rwkv_scan_item(Fa, ws, it); }
            if (F.bid >= nrw) {
                if (SUBMASK & 2) { const Frame Fb = fresh(F0); const int nb = Fb.G - nrw, b0 = Fb.bid - nrw;
                    for (int it = b0; it < 256; it += nb) { const int b = it & 3, qb = 63 - (it >> 2); dsa_item(Fb, ws, b * 64 + qb); } }
                if (SUBMASK & 4) { const Frame Fc = fresh(F0); const int nb = Fc.G - nrw, b0 = Fc.bid - nrw;
                    for (int it = b0; it < 256; it += nb) ssm_pass3_item(Fc, fresh_ptr(ws0), in_fresh(in0), l, it); }
            }
        }
        SEAM(pb + 2);
        if (ON(4) && IN_PH(pb + 3)) for (int rep = 0; rep < NREP(4); ++rep) { if (rep) xcd_barrier(bar); const In in = in_fresh(in0); const Frame F = fresh(F0); unsigned char* ws = fresh_ptr(ws0); LAYER_PTRS
            pg8::Gemm g{(const bf16_t*)(ws + WS_YSB), (const bf16_t*)(wt + WT_GLU), MIX, MIX, MIX}; pg8::Order S; S.init(MTOK / 256, MIX / 256, F.G, F.bid, MIX, MIX);
            pg8::EpiGlu E{(const float*)(ws + WS_YS), in[28] + l * MIX, (bf16_t*)(ws + WS_MIX)};
            pg8::gemm_phase<pg8::EpiGlu, pg8::Order, true>(F.lds, F.tid, g, S, E);
            { const Frame Fp = fresh(F0); const int ng = (Fp.G > 64) ? 64 : 0;
              if (Fp.bid >= ng) rwkv_post_rows(Fp, fresh_ptr(ws0), in_fresh(in0), l, (Fp.bid - ng) * NWAVES + Fp.wave, (Fp.G - ng) * NWAVES); }
        }
        SEAM(pb + 3);
        if (ON(5) && IN_PH(pb + 4)) for (int rep = 0; rep < NREP(5); ++rep) { if (rep) xcd_barrier(bar); const In in = in_fresh(in0); const Frame F = fresh(F0); unsigned char* ws = fresh_ptr(ws0); LAYER_PTRS
            pg8::Gemm g{(const bf16_t*)(ws + WS_MIX), (const bf16_t*)(wt + WT_BR), 4 * MIX, MIX, MIX}; pg8::Order S; S.init(MTOK / 256, DM / 256, F.G, F.bid, 4 * MIX, MIX, 4, MIX, DM);
            pg8::EpiMerge E{(const bf16_t*)(ws + WS_G), (float*)(ws + WS_MF), (bf16_t*)(ws + WS_MERGED)};
            pg8::gemm_phase<pg8::EpiMerge, pg8::Order, true>(F.lds, F.tid, g, S, E);
        }
        SEAM(pb + 4);
        if (ON(6) && IN_PH(pb + 5)) for (int rep = 0; rep < NREP(6); ++rep) { if (rep) xcd_barrier(bar); const In in = in_fresh(in0); const Frame F = fresh(F0); unsigned char* ws = fresh_ptr(ws0); LAYER_PTRS
            pg8::Gemm g{(const bf16_t*)(ws + WS_MERGED), (const bf16_t*)(wt + WT_OUT), DM, DM, DM}; pg8::Order S; S.init(MTOK / 256, DM / 256, F.G, F.bid, DM, DM);
            pg8::EpiRes E{l == 0 ? in[0] : Y, Y, YB, PB};
            pg8::gemm_phase<pg8::EpiRes, pg8::Order, true>(F.lds, F.tid, g, S, E);
        }
        SEAM(pb + 5);
        if (ON(7) && IN_PH(pb + 6)) for (int rep = 0; rep < NREP(7); ++rep) { if (rep) xcd_barrier(bar); const In in = in_fresh(in0); const Frame F = fresh(F0); unsigned char* ws = fresh_ptr(ws0); LAYER_PTRS
            pg8::Gemm g{YB, (const bf16_t*)(wt + WT_UP), DM, DM, DM}; pg8::Order S; S.init(MTOK / 256, DFF2 / 256, F.G, F.bid, DM, DM);
            pg8::Unit u0; int pm0 = -1; if (S.next(0, u0)) pm0 = u0.pm;
            if (pm0 >= 0) rs_table(F, PB, pm0); else __syncthreads();
            pg8::EpiU E{(bf16_t*)(ws + WS_U), DFF2, PB, rsT, pm0};
            pg8::gemm_phase<pg8::EpiU, pg8::Order, true>(F.lds, F.tid, g, S, E);
        }
        SEAM(pb + 6);
        if (ON(8) && IN_PH(pb + 7)) for (int rep = 0; rep < NREP(8); ++rep) { if (rep) xcd_barrier(bar); const In in = in_fresh(in0); const Frame F = fresh(F0); unsigned char* ws = fresh_ptr(ws0); LAYER_PTRS conv_phase(F, ws, in, l); }
        SEAM(pb + 7);
        if (ON(9) && IN_PH(pb + 8)) for (int rep = 0; rep < NREP(9); ++rep) { if (rep) xcd_barrier(bar); const In in = in_fresh(in0); const Frame F = fresh(F0); unsigned char* ws = fresh_ptr(ws0); LAYER_PTRS
            pg8::Gemm g{(const bf16_t*)(ws + WS_ACT), (const bf16_t*)(wt + WT_DOWN), DFF, DFF, DFF}; pg8::Order S; S.init(MTOK / 256, DM / 256, F.G, F.bid, DFF, DFF);
            pg8::EpiRes E{Y, Y, YB, PA};
            pg8::gemm_phase<pg8::EpiRes, pg8::Order, true>(F.lds, F.tid, g, S, E);
        }
        SEAM(pb + 8);
    }
    if (ON(10) && IN_PH(N_PHASES - 1)) { const In in = in_fresh(in0); const Frame F = fresh(F0); unsigned char* ws = fresh_ptr(ws0); final_phase(F, ws, in[36], args.out); }
#ifdef DBG_STOP
    if (lo == 100) { const Frame F = fresh(F0); unsigned char* ws = fresh_ptr(ws0);
        for (size_t e = (size_t)F.bid * NTHR + F.tid; e < (size_t)MTOK * DM; e += (size_t)F.G * NTHR) {
            const int m = (int)(e / DM), c = (int)(e % DM); float v;
            if (DBG_BUF == 0) v = bf2f(((const bf16_t*)(ws + WS_MIX))[e]);
            else if (DBG_BUF == 1) v = ((const float*)(ws + WS_ZS))[(size_t)m * ZS_COLS + c];
            else if (DBG_BUF == 2) v = ((const float*)(ws + WS_ZS))[(size_t)m * ZS_COLS + 2048 + c];
            else if (DBG_BUF == 3) v = bf2f(((const bf16_t*)(ws + WS_G))[(size_t)m * GCOLS + c]);
            else if (DBG_BUF == 4) v = ((const float*)(ws + WS_Y))[e];
            else v = bf2f(((const bf16_t*)(ws + WS_MERGED))[e]);
            args.out[e] = v; } }
#endif
#undef IN_PH
#undef SEAM
}

extern "C" void kernel_launch(void* const* d_in, const int* in_sizes, int n_in, void* d_out, int out_size, void* d_ws, size_t ws_size, hipStream_t stream) {
    static int grid = 0;
    if (grid == 0) {
        if (n_in != 37 || out_size != MTOK * DM || ws_size < WS_END) { fprintf(stderr, "kernel_launch: unexpected problem (n_in %d, out %d, ws %zu < %zu)\n", n_in, out_size, ws_size, (size_t)WS_END); grid = -1; return; }
        int dev = 0, cus = 0, per_cu = 0;
        if (hipGetDevice(&dev) != hipSuccess || hipDeviceGetAttribute(&cus, hipDeviceAttributeMultiprocessorCount, dev) != hipSuccess) { grid = -1; return; }
        if (hipFuncSetAttribute((const void*)hybrid_fwd, hipFuncAttributeMaxDynamicSharedMemorySize, LDS_BYTES) != hipSuccess) { fprintf(stderr, "kernel_launch: hipFuncSetAttribute failed\n"); grid = -1; return; }
        if (hipOccupancyMaxActiveBlocksPerMultiprocessor(&per_cu, (const void*)hybrid_fwd, NTHR, LDS_BYTES) != hipSuccess || per_cu < 1) fprintf(stderr, "kernel_launch: occupancy query says %d\n", per_cu);
        (void)hipGetLastError();
        grid = cus;
    }
    if (grid < 0) return;
    (void)hipMemsetAsync((char*)d_ws + WS_CTL, 0, CTL_ZERO_BYTES, stream);
    Args a{};
    for (int i = 0; i < 37; ++i) a.in.p[i] = (const float*)d_in[i];
    a.out = (float*)d_out; a.ws = (unsigned char*)d_ws;
#ifdef DBG_STOP
    for (int k = 0; k < DBG_STOP; ++k) { a.ph_lo = k; a.ph_hi = k + 1; hipLaunchKernelGGL(hybrid_fwd, dim3(grid), dim3(NTHR), LDS_BYTES, stream, a); }
    a.ph_lo = 100; a.ph_hi = 101; hipLaunchKernelGGL(hybrid_fwd, dim3(grid), dim3(NTHR), LDS_BYTES, stream, a);
#elif MK_N_LAUNCHES == 1
    a.ph_lo = 0; a.ph_hi = N_PHASES;
    hipLaunchKernelGGL(hybrid_fwd, dim3(grid), dim3(NTHR), LDS_BYTES, stream, a);
#else
    for (int k = 0; k < N_PHASES; ++k) { a.ph_lo = k; a.ph_hi = k + 1; hipLaunchKernelGGL(hybrid_fwd, dim3(grid), dim3(NTHR), LDS_BYTES, stream, a); }
#endif
}
```

```cpp
#include <hip/hip_runtime.h>
#include <cstdio>
#include <cstdint>

#ifndef MK_N_LAUNCHES
#define MK_N_LAUNCHES 1
#endif

#define LAS __attribute__((address_space(3)))
#define GAS __attribute__((address_space(1)))
typedef unsigned short bf16_t;
typedef short bf16x8 __attribute__((ext_vector_type(8)));
typedef short s16x4 __attribute__((ext_vector_type(4)));
typedef float f32x4 __attribute__((ext_vector_type(4)));
typedef float f32x2 __attribute__((ext_vector_type(2)));
typedef float f32x16 __attribute__((ext_vector_type(16)));
typedef unsigned u32x4 __attribute__((ext_vector_type(4)));
typedef unsigned u32x2 __attribute__((ext_vector_type(2)));
#define DI __device__ __forceinline__

constexpr int NB = 4, SEQ = 2048, DM = 2048, MTOK = NB * SEQ, NL = 4, MIX = 512, DFF = 5504, DFF2 = 2 * DFF;
constexpr int IN_COLS = 13060, NZ = 13312, ZS_COLS = 5120, GCOLS = 8192;
constexpr int B_COLS = 1984;
constexpr int ZO_R = 0, ZO_K = 512, ZO_V = 1024, ZO_LW = 1536, ZO_LA = 1632, ZO_LG = 1728;
constexpr int ZO_Q = 2048, ZO_AK = 2560, ZO_AV = 3072, ZO_QI = 3584, ZO_KI = 3840, ZO_WI = 3904, ZO_C = 4096, ZO_D = 4608;
constexpr float RMS_EPS = 1e-6f, GN_EPS = 64e-5f;

constexpr size_t MiB = 1u << 20;
constexpr size_t WS_CTL = 0, CTL_ZERO_BYTES = 1 * MiB;
constexpr size_t WS_ROPE = 1 * MiB;
constexpr size_t WS_PARTA = 2 * MiB;
constexpr size_t WS_PARTB = 3 * MiB;
constexpr size_t WS_SSTATE = 4 * MiB;
constexpr size_t WS_WI = 5 * MiB;
constexpr size_t WS_KI = 6 * MiB;
constexpr size_t WS_MASK = 7 * MiB;
constexpr size_t WS_QI = 9 * MiB;
constexpr size_t WS_Q = 13 * MiB;
constexpr size_t WS_K = 21 * MiB;
constexpr size_t WS_VT = 29 * MiB;
constexpr size_t WS_Y = 37 * MiB;
constexpr size_t WS_YB = 101 * MiB;
constexpr size_t WS_MIX = 133 * MiB;
constexpr size_t WS_MERGED = 165 * MiB;
constexpr size_t WS_YS = 197 * MiB;
constexpr size_t WS_YSB = 213 * MiB;
constexpr size_t WS_RW = 221 * MiB;
constexpr size_t RW_STRIDE = 16 * MiB;
constexpr size_t WS_SC = 333 * MiB;
constexpr size_t WS_MF = 1368 * MiB;
constexpr size_t WS_ZS = 461 * MiB;
constexpr size_t WS_G = 621 * MiB;
constexpr size_t WS_U = 461 * MiB;
constexpr size_t WS_ACT = 749 * MiB;
constexpr size_t WS_WT = 836 * MiB;
constexpr size_t WT_IN = 0, WT_BR = 52 * MiB, WT_OUT = 60 * MiB, WT_UP = 68 * MiB, WT_DOWN = 111 * MiB, WT_GLU = 111 * MiB + 22544384, WT_LAYER = 133 * MiB;
constexpr size_t WS_YRAW = WS_MF + 192 * MiB;
constexpr size_t WS_WTL = WS_YRAW + 16 * MiB;
constexpr size_t WS_END = WS_WTL + 2 * MiB;
static_assert(WS_WT + 4 * WT_LAYER == WS_MF, "ws map");
static_assert(WT_GLU + 524288 <= WT_LAYER, "wt map");
static_assert(WS_U + (size_t)MTOK * DFF2 * 2 <= WS_ACT && WS_ACT + (size_t)MTOK * DFF * 2 <= WS_WT, "ws map");

constexpr int CW_BAR = 4096;

constexpr int RING_BYTES = 131072;
constexpr int MISC_OFF = RING_BYTES;
constexpr int RST_OFF = RING_BYTES + 1024;
constexpr int LDS_BYTES = 147456;
constexpr int NWAVES = 8, NTHR = 512;

DI unsigned f2bf(float f) { unsigned u = __builtin_bit_cast(unsigned, f); return (u + 0x7fffu + ((u >> 16) & 1u)) >> 16; }
DI unsigned cvt_pk_bf16(float lo, float hi);
DI unsigned pk2(float lo, float hi) { return cvt_pk_bf16(lo, hi); }
DI float bf2f(unsigned b) { return __builtin_bit_cast(float, b << 16); }
typedef __bf16 bf16x2v __attribute__((ext_vector_type(2)));
DI unsigned cvt_pk_bf16(float lo, float hi) { const f32x2 v = {lo, hi}; const bf16x2v b = __builtin_convertvector(v, bf16x2v); return __builtin_bit_cast(unsigned, b); }
DI float wave_sum(float v) {
#pragma unroll
    for (int o = 1; o < 64; o <<= 1) v += __shfl_xor(v, o);
    return v;
}
template <int CTRL> DI float dpp_xadd(float x) { const int r = __builtin_amdgcn_update_dpp(0, __builtin_bit_cast(int, x), CTRL, 0xF, 0xF, true); return x + __builtin_bit_cast(float, r); }
DI float row16_sum(float x) { x = dpp_xadd<0xB1>(x); x = dpp_xadd<0x4E>(x); x = dpp_xadd<0x141>(x); x = dpp_xadd<0x140>(x); return x; }
DI float sigmoidf_(float x) { return __builtin_amdgcn_rcpf(1.0f + __expf(-x)); }
#define LDS_WAIT() asm volatile("s_waitcnt lgkmcnt(0)" ::: "memory")
#define VM_WAIT() asm volatile("s_waitcnt vmcnt(0)" ::: "memory")
#define MFMA32(a, b, c) __builtin_amdgcn_mfma_f32_32x32x16_bf16((a), (b), (c), 0, 0, 0)

#define XB_TMO      128
#define XB_XCNT(j)  (256  + 64 * (j))
#define XB_XSUB(j)  (1280 + 64 * (j))
#define XB_XGEN(j)  (2304 + 64 * (j))
#define XB_TOP      3328
#define XB_TOPGEN   3392
#define XCD_BAR_WORDS 3456
#define XB_SPIN_CAP (1u << 21)
DI unsigned xb_ld(unsigned* p)              { return __hip_atomic_load(p, __ATOMIC_RELAXED, __HIP_MEMORY_SCOPE_AGENT); }
DI unsigned xb_add(unsigned* p, unsigned v) { return __hip_atomic_fetch_add(p, v, __ATOMIC_RELAXED, __HIP_MEMORY_SCOPE_AGENT); }
DI unsigned xb_xcc_id() { return (unsigned)__builtin_amdgcn_s_getreg((3 << 11) | 20) & 0xFu; }
#define XB_SPIN(cond, bar) do { unsigned _sp = 0; while (cond) { __builtin_amdgcn_s_sleep(1); \
    if ((++_sp & 255u) == 0u) { if (xb_ld(&(bar)[XB_TMO])) break; if (_sp > XB_SPIN_CAP) { atomicAdd(&(bar)[XB_TMO], 1u); break; } } } } while (0)
struct XcdBarrier { unsigned* bar; unsigned x; volatile LAS unsigned* st; };
DI XcdBarrier xcd_barrier_post(unsigned* bar, volatile LAS unsigned* st) {
    XcdBarrier b; b.bar = bar; b.x = xb_xcc_id(); b.st = st;
    if (threadIdx.x == 0) (void)xb_add(&bar[XB_XCNT(b.x)], 1u);
    return b;
}
DI void xcd_barrier_complete(unsigned* bar, unsigned x, unsigned& nloc, unsigned& nx) {
    const unsigned G = gridDim.x * gridDim.y * gridDim.z;
    unsigned sum, cnt, mine, sp = 0u;
    for (;;) {
        sum = 0u; cnt = 0u; mine = 0u;
#pragma unroll
        for (unsigned j = 0; j < 16; ++j) { const unsigned c = xb_ld(&bar[XB_XCNT(j)]); sum += c; cnt += (c > 0u) ? 1u : 0u; mine = (j == x) ? c : mine; }
        if (sum == G) break;
        __builtin_amdgcn_s_sleep(1);
        if ((++sp & 255u) == 0u) { if (xb_ld(&bar[XB_TMO])) break; if (sp > XB_SPIN_CAP) { atomicAdd(&bar[XB_TMO], 1u); break; } }
    }
    nloc = mine > 0u ? mine : 1u; nx = cnt > 0u ? cnt : 1u;
}
DI void xcd_barrier(const XcdBarrier& b) {
    asm volatile("s_waitcnt vmcnt(0)" ::: "memory");
    __syncthreads();
    if (threadIdx.x == 0) {
        unsigned* bar = b.bar;
        __builtin_amdgcn_s_waitcnt(0);
        unsigned nloc = b.st[0], nx = b.st[1];
        if (nloc == 0u) { xcd_barrier_complete(bar, b.x, nloc, nx); b.st[0] = nloc; b.st[1] = nx; }
        const unsigned old = xb_add(&bar[XB_XSUB(b.x)], 1u);
        const unsigned gen = old / nloc;
        if (old + 1u == (gen + 1u) * nloc) {
            __builtin_amdgcn_fence(__ATOMIC_RELEASE, "agent");
            asm volatile("s_waitcnt vmcnt(0)" ::: "memory");
            const unsigned og = xb_add(&bar[XB_TOP], 1u);
            const unsigned tg = og / nx;
            if (og + 1u == (tg + 1u) * nx) xb_add(&bar[XB_TOPGEN], 1u);
            else XB_SPIN(xb_ld(&bar[XB_TOPGEN]) == tg, bar);
            __builtin_amdgcn_fence(__ATOMIC_ACQUIRE, "agent");
            xb_add(&bar[XB_XGEN(b.x)], 1u);
            asm volatile("s_waitcnt vmcnt(0)" ::: "memory");
        } else {
            XB_SPIN(xb_ld(&bar[XB_XGEN(b.x)]) == gen, bar);
            __builtin_amdgcn_fence(__ATOMIC_ACQUIRE, "agent");
            asm volatile("s_waitcnt vmcnt(0)" ::: "memory");
        }
    }
    __syncthreads();
}

namespace pg8 {
constexpr int BM = 256, BK = 64, HALF = 128, HTB = HALF * BK * 2, STAGE_BYTES = 8 * HTB, NXCD = 8, WGM = 8;
DI int lds_byte(int r, int c) { const int st = (r >> 4) * 2 + (c >> 5), rr = r & 15, cc = c & 31, ob = rr * 64 + cc * 2; return st * 1024 + (ob ^ (((ob >> 9) & 1) << 5)); }
DI void stage_rc(int b, int& R, int& C) { const int st = b / 1024, sb = b % 1024, swz = sb ^ (((sb >> 9) & 1) << 5); R = (st >> 1) * 16 + swz / 64; C = (st & 1) * 32 + (swz % 64) / 2; }
DI int perm32(int rho) { const int n = rho >> 4, i = rho & 15; return 8 * (i >> 2) + 4 * n + (i & 3); }

struct Unit { int pm, pn, sub; long offA, offB; };
struct Gemm { const bf16_t* A; const bf16_t* Bt; int lda, ldb, K; };

struct Order {
    int nM, nN, nwg, G, c, lda, ldb, nsub, subA, subB;
    DI void init(int nM_, int nN_, int G_, int c_, int lda_, int ldb_, int nsub_ = 1, int subA_ = 0, int subB_ = 0) { nM = nM_; nN = nN_; nwg = nM * nN; G = G_; c = c_; lda = lda_; ldb = ldb_; nsub = nsub_; subA = subA_; subB = subB_; }
    DI bool next(int i, Unit& u) const {
        const int ti = i / nsub, sub = i - ti * nsub;
        const long L = (long)ti * G + c; if (L >= nwg) return false;
        int wgid = (int)L; { const int q = nwg / NXCD, r = nwg % NXCD, xcd = wgid % NXCD, off = wgid / NXCD; wgid = (xcd < r ? xcd * (q + 1) : r * (q + 1) + (xcd - r) * q) + off; }
        const int nig = WGM * nN, gid = wgid / nig, fm = gid * WGM, gsz = (nM - fm) < WGM ? (nM - fm) : WGM;
        u.pm = fm + ((wgid % nig) % gsz); u.pn = (wgid % nig) / gsz; u.sub = sub;
        u.offA = ((long)u.pm * BM * lda + (long)sub * subA) * 2; u.offB = ((long)u.pn * BM + (long)sub * subB) * (long)ldb * 2;
        return true;
    }
};

struct OrderLin {
    int c, G, nu, pnbase, lda, ldb;
    DI bool next(int i, Unit& u) const { const int v = c + i * G; if (v >= nu) return false; u.pm = v & 31; u.pn = pnbase + (v >> 5); u.sub = 0;
        u.offA = (long)u.pm * BM * lda * 2; u.offB = (long)u.pn * BM * (long)ldb * 2; return true; }
};
template <class Epi, class Sched, bool ALIGN_EPI>
DI void gemm_phase(LAS unsigned char* lds, const int tid, const Gemm g, const Sched& S, const Epi& E) {
    const int wid = __builtin_amdgcn_readfirstlane(tid >> 6), lane = tid & 63, wr = wid >> 2, wc = wid & 3, fr = lane & 15, fq = lane >> 4;
    const int K = g.K, nt = K / BK;
    unsigned voffA[2], voffB[2];
#pragma unroll
    for (int i = 0; i < 2; ++i) { int R, C; stage_rc(tid * 16 + i * 8192, R, C); const int Rb = Epi::PERM ? ((R & ~31) + perm32(R & 31)) : R;
        voffA[i] = (unsigned)(R * g.lda + C) * 2u; voffB[i] = (unsigned)(Rb * g.ldb + C) * 2u; }
    const size_t kstep = (size_t)(BK * 2);
    const size_t hstepA = (size_t)HALF * g.lda * 2, hstepB = (size_t)HALF * g.ldb * 2;
    const unsigned ldsw = (unsigned)wid * 1024u;
    const int aoff = lds_byte(wr * 64 + fr, fq * 8), boff = lds_byte(wc * 32 + fr, fq * 8);
#define PG8_SA(b, h) (((b) * 2 + (h)) * HTB)
#define PG8_SB(b, h) ((4 + (b) * 2 + (h)) * HTB)
#define PG8_STAGE(bufoff, gbase, voff) do { _Pragma("unroll") for (int _i = 0; _i < 2; ++_i) \
        __builtin_amdgcn_global_load_lds((const unsigned*)((const char*)(gbase) + (voff)[_i]), (LAS unsigned*)(lds + (bufoff) + ldsw + _i * 8192), 16, 0, 0); } while (0)
#define PG8_LDA(dst, b, h) do { _Pragma("unroll") for (int m = 0; m < 4; ++m) _Pragma("unroll") for (int k = 0; k < 2; ++k) dst[m][k] = *(const LAS bf16x8*)(lds + PG8_SA(b, h) + aoff + m * 2048 + k * 1024); } while (0)
#define PG8_LDB(dst, b, h) do { _Pragma("unroll") for (int n = 0; n < 2; ++n) _Pragma("unroll") for (int k = 0; k < 2; ++k) dst[n][k] = *(const LAS bf16x8*)(lds + PG8_SB(b, h) + boff + n * 2048 + k * 1024); } while (0)
#define PG8_MMA(ai, bj, At, Bt) do { __builtin_amdgcn_s_setprio(1); _Pragma("unroll") for (int m = 0; m < 4; ++m) _Pragma("unroll") for (int n = 0; n < 2; ++n) _Pragma("unroll") for (int k = 0; k < 2; ++k) \
        acc[ai][bj][m][n] = __builtin_amdgcn_mfma_f32_16x16x32_bf16(Bt[n][k], At[m][k], acc[ai][bj][m][n], 0, 0, 0); __builtin_amdgcn_s_setprio(0); } while (0)
#define PG8_WAIT_V(n) asm volatile("s_waitcnt vmcnt(" #n ")" ::: "memory")
#define PG8_WAIT_L(n) asm volatile("s_waitcnt lgkmcnt(" #n ")" ::: "memory")
#define PG8_BAR __builtin_amdgcn_s_barrier()
#define PG8_SCHED __builtin_amdgcn_sched_barrier(0)
    Unit cur, nxt; int ui = 0;
    if (!S.next(0, cur)) return;
    f32x4 acc[2][2][4][2];
#pragma unroll
    for (int a = 0; a < 2; ++a)
#pragma unroll
        for (int b = 0; b < 2; ++b)
#pragma unroll
            for (int m = 0; m < 4; ++m)
#pragma unroll
                for (int n = 0; n < 2; ++n) acc[a][b][m][n] = (f32x4){0.f, 0.f, 0.f, 0.f};
    bf16x8 At[4][2], B0[2][2], B1[2][2];
    const char* cA = (const char*)g.A + cur.offA; const char* cB = (const char*)g.Bt + cur.offB;
    PG8_STAGE(PG8_SB(0, 0), cB, voffB); PG8_STAGE(PG8_SB(0, 1), cB + hstepB, voffB); PG8_STAGE(PG8_SA(0, 0), cA, voffA); PG8_STAGE(PG8_SA(0, 1), cA + hstepA, voffA);
    if (wr == 1) PG8_BAR;
    PG8_WAIT_V(2); PG8_BAR;
    PG8_STAGE(PG8_SB(1, 0), cB + kstep, voffB); PG8_STAGE(PG8_SA(1, 0), cA + kstep, voffA); PG8_STAGE(PG8_SB(1, 1), cB + hstepB + kstep, voffB);
    PG8_WAIT_V(6); PG8_BAR;
    for (;;) {
        const bool has_next = S.next(ui + 1, nxt);
        const char* nA = has_next ? (const char*)g.A + nxt.offA : cA; const char* nB = has_next ? (const char*)g.Bt + nxt.offB : cB;
        for (int t = 0; t < nt; t += 2) {
            const bool last = (t == nt - 2);
            const char* a1 = cA + (size_t)(t + 1) * kstep;
            const char* a2 = last ? nA : cA + (size_t)(t + 2) * kstep; const char* b2 = last ? nB : cB + (size_t)(t + 2) * kstep;
            const char* a3 = a2 + kstep; const char* b3 = b2 + kstep;
            PG8_LDB(B0, 0, 0); PG8_LDB(B1, 0, 1); PG8_SCHED; PG8_LDA(At, 0, 0); PG8_STAGE(PG8_SA(1, 1), a1 + hstepA, voffA);
            PG8_WAIT_V(8); PG8_WAIT_L(0); PG8_BAR; PG8_MMA(0, 0, At, B0); PG8_MMA(0, 1, At, B1); PG8_BAR; PG8_SCHED;
            PG8_LDA(At, 0, 1); PG8_STAGE(PG8_SB(0, 0), b2, voffB); PG8_STAGE(PG8_SB(0, 1), b2 + hstepB, voffB); PG8_STAGE(PG8_SA(0, 0), a2, voffA);
            PG8_WAIT_V(8); PG8_WAIT_L(0); PG8_BAR; PG8_MMA(1, 0, At, B0); PG8_MMA(1, 1, At, B1); PG8_BAR; PG8_SCHED;
            PG8_LDB(B0, 1, 0); PG8_LDB(B1, 1, 1); PG8_SCHED; PG8_LDA(At, 1, 0); PG8_STAGE(PG8_SA(0, 1), a2 + hstepA, voffA);
            PG8_WAIT_V(8); PG8_WAIT_L(0); PG8_BAR; PG8_MMA(0, 0, At, B0); PG8_MMA(0, 1, At, B1); PG8_BAR; PG8_SCHED;
            PG8_LDA(At, 1, 1); PG8_STAGE(PG8_SB(1, 0), b3, voffB); PG8_STAGE(PG8_SB(1, 1), b3 + hstepB, voffB); PG8_STAGE(PG8_SA(1, 0), a3, voffA);
            PG8_WAIT_V(8); PG8_WAIT_L(0); PG8_BAR; PG8_MMA(1, 0, At, B0); PG8_MMA(1, 1, At, B1); PG8_BAR; PG8_SCHED;
        }
        if constexpr (ALIGN_EPI) { if (wr == 0) PG8_BAR; }
        E(acc, cur, wr, wc, fr, fq);
        if (!has_next) break;
#pragma unroll
        for (int a = 0; a < 2; ++a)
#pragma unroll
            for (int b = 0; b < 2; ++b)
#pragma unroll
                for (int m = 0; m < 4; ++m)
#pragma unroll
                    for (int n = 0; n < 2; ++n) acc[a][b][m][n] = (f32x4){0.f, 0.f, 0.f, 0.f};
        cur = nxt; cA = nA; cB = nB; ++ui;
        if constexpr (ALIGN_EPI) { if (wr == 1) PG8_BAR; }
    }
    PG8_WAIT_V(0);
    if constexpr (!ALIGN_EPI) { if (wr == 0) PG8_BAR; }
    PG8_BAR;
#undef PG8_SA
#undef PG8_SB
#undef PG8_STAGE
#undef PG8_LDA
#undef PG8_LDB
#undef PG8_MMA
#undef PG8_WAIT_V
#undef PG8_WAIT_L
#undef PG8_BAR
#undef PG8_SCHED
}

typedef const f32x4 (&AccRef)[2][2][4][2];
DI float row_scale_slow(const float* part, int row) { float s = 0.f; for (int i = 0; i < 32; ++i) s += part[(size_t)row * 32 + i]; return 1.0f / sqrtf(s * (1.0f / DM) + RMS_EPS); }

struct EpiZ {
    static constexpr bool PERM = true;
    float* ZS; bf16_t* G; const float* bgate; const float* part; const LAS float* rsT; int pm0;
    DI void operator()(AccRef acc, const Unit& u, int wr, int wc, int fr, int fq) const {
#pragma unroll
        for (int ai = 0; ai < 2; ++ai)
#pragma unroll
            for (int m = 0; m < 4; ++m) {
                const int lr = ai * HALF + wr * 64 + m * 16 + fr, row = u.pm * BM + lr;
                const float s = (u.pm == pm0) ? rsT[lr] : row_scale_slow(part, row);
#pragma unroll
                for (int bj = 0; bj < 2; ++bj) {
                    const int col0 = u.pn * BM + bj * HALF + wc * 32 + 8 * fq;
                    f32x4 v0 = acc[ai][bj][m][0] * s, v1 = acc[ai][bj][m][1] * s;
                    if (u.pn < 20) { float* p = ZS + (size_t)row * ZS_COLS + col0; *(f32x4*)p = v0; *(f32x4*)(p + 4) = v1; }
                    else { const int gc = col0 - ZS_COLS; const f32x4 b0 = *(const f32x4*)(bgate + gc), b1 = *(const f32x4*)(bgate + gc + 4);
                        v0 += b0; v1 += b1;
                        u32x4 w; w.x = cvt_pk_bf16(sigmoidf_(v0[0]), sigmoidf_(v0[1])); w.y = cvt_pk_bf16(sigmoidf_(v0[2]), sigmoidf_(v0[3]));
                        w.z = cvt_pk_bf16(sigmoidf_(v1[0]), sigmoidf_(v1[1])); w.w = cvt_pk_bf16(sigmoidf_(v1[2]), sigmoidf_(v1[3]));
                        *(u32x4*)(G + (size_t)row * GCOLS + gc) = w; }
                }
            }
    }
};
struct EpiU {
    static constexpr bool PERM = true;
    bf16_t* U; int ldc; const float* part; const LAS float* rsT; int pm0;
    DI void operator()(AccRef acc, const Unit& u, int wr, int wc, int fr, int fq) const {
#pragma unroll
        for (int ai = 0; ai < 2; ++ai)
#pragma unroll
            for (int m = 0; m < 4; ++m) {
                const int lr = ai * HALF + wr * 64 + m * 16 + fr, row = u.pm * BM + lr;
                const float s = (u.pm == pm0) ? rsT[lr] : row_scale_slow(part, row);
#pragma unroll
                for (int bj = 0; bj < 2; ++bj) {
                    const int col0 = u.pn * BM + bj * HALF + wc * 32 + 8 * fq;
                    const f32x4 v0 = acc[ai][bj][m][0] * s, v1 = acc[ai][bj][m][1] * s;
                    u32x4 w; w.x = cvt_pk_bf16(v0[0], v0[1]); w.y = cvt_pk_bf16(v0[2], v0[3]); w.z = cvt_pk_bf16(v1[0], v1[1]); w.w = cvt_pk_bf16(v1[2], v1[3]);
                    *(u32x4*)(U + (size_t)row * ldc + col0) = w;
                }
            }
    }
};
struct EpiRes {
    static constexpr bool PERM = false;
    const float* Yin; float* Y; bf16_t* YB; float* part;
    DI void operator()(AccRef acc, const Unit& u, int wr, int wc, int fr, int fq) const {
#pragma unroll
        for (int ai = 0; ai < 2; ++ai)
#pragma unroll
            for (int m = 0; m < 4; ++m) {
                const int row = u.pm * BM + ai * HALF + wr * 64 + m * 16 + fr;
                float ss = 0.f;
#pragma unroll
                for (int bj = 0; bj < 2; ++bj)
#pragma unroll
                    for (int n = 0; n < 2; ++n) {
                        const int col = u.pn * BM + bj * HALF + wc * 32 + 16 * n + 4 * fq;
                        const size_t o = (size_t)row * DM + col;
                        const f32x4 y = *(const f32x4*)(Yin + o) + acc[ai][bj][m][n];
                        *(f32x4*)(Y + o) = y;
                        u32x2 w; w.x = cvt_pk_bf16(y[0], y[1]); w.y = cvt_pk_bf16(y[2], y[3]);
                        *(u32x2*)(YB + o) = w;
                        ss += (y[0] * y[0] + y[1] * y[1]) + (y[2] * y[2] + y[3] * y[3]);
                    }
                ss += __shfl_xor(ss, 16); ss += __shfl_xor(ss, 32);
                if (fq == 0) part[(size_t)row * 32 + u.pn * 4 + wc] = ss;
            }
    }
};
struct EpiGlu {
    static constexpr bool PERM = true;
    const float* YS; const float* bias; bf16_t* MIXp;
    DI void operator()(AccRef acc, const Unit& u, int wr, int wc, int fr, int fq) const {
#pragma unroll
        for (int ai = 0; ai < 2; ++ai)
#pragma unroll
            for (int m = 0; m < 4; ++m) {
                const int row = u.pm * BM + ai * HALF + wr * 64 + m * 16 + fr;
#pragma unroll
                for (int bj = 0; bj < 2; ++bj) {
                    const int col0 = u.pn * BM + bj * HALF + wc * 32 + 8 * fq;
                    const f32x4 b0 = *(const f32x4*)(bias + col0), b1 = *(const f32x4*)(bias + col0 + 4);
                    const f32x4 y0 = *(const f32x4*)(YS + (size_t)row * MIX + col0), y1 = *(const f32x4*)(YS + (size_t)row * MIX + col0 + 4);
                    const f32x4 v0 = acc[ai][bj][m][0] + b0, v1 = acc[ai][bj][m][1] + b1;
                    u32x4 w; w.x = cvt_pk_bf16(y0[0] * sigmoidf_(v0[0]), y0[1] * sigmoidf_(v0[1])); w.y = cvt_pk_bf16(y0[2] * sigmoidf_(v0[2]), y0[3] * sigmoidf_(v0[3]));
                    w.z = cvt_pk_bf16(y1[0] * sigmoidf_(v1[0]), y1[1] * sigmoidf_(v1[1])); w.w = cvt_pk_bf16(y1[2] * sigmoidf_(v1[2]), y1[3] * sigmoidf_(v1[3]));
                    *(u32x4*)(MIXp + (size_t)row * (4 * MIX) + 3 * MIX + col0) = w;
                }
            }
    }
};
struct EpiMerge {
    static constexpr bool PERM = true;
    const bf16_t* G; float* MF; bf16_t* MERGED;
    DI void operator()(AccRef acc, const Unit& u, int wr, int wc, int fr, int fq) const {
#pragma unroll
        for (int ai = 0; ai < 2; ++ai)
#pragma unroll
            for (int m = 0; m < 4; ++m) {
                const int row = u.pm * BM + ai * HALF + wr * 64 + m * 16 + fr;
#pragma unroll
                for (int bj = 0; bj < 2; ++bj) {
                    const int col0 = u.pn * BM + bj * HALF + wc * 32 + 8 * fq;
                    const u32x4 gw = *(const u32x4*)(G + (size_t)row * GCOLS + u.sub * DM + col0);
                    f32x4 v0 = acc[ai][bj][m][0], v1 = acc[ai][bj][m][1];
                    v0[0] *= bf2f(gw.x & 0xffffu); v0[1] *= bf2f(gw.x >> 16); v0[2] *= bf2f(gw.y & 0xffffu); v0[3] *= bf2f(gw.y >> 16);
                    v1[0] *= bf2f(gw.z & 0xffffu); v1[1] *= bf2f(gw.z >> 16); v1[2] *= bf2f(gw.w & 0xffffu); v1[3] *= bf2f(gw.w >> 16);
                    float* p = MF + (size_t)row * DM + col0;
                    constexpr size_t SL = (size_t)MTOK * DM;
                    if (u.sub < 3) { *(f32x4*)(p + u.sub * SL) = v0; *(f32x4*)(p + u.sub * SL + 4) = v1; }
                    else { v0 += (*(const f32x4*)p + *(const f32x4*)(p + SL)) + *(const f32x4*)(p + 2 * SL); v1 += (*(const f32x4*)(p + 4) + *(const f32x4*)(p + SL + 4)) + *(const f32x4*)(p + 2 * SL + 4);
                        u32x4 w; w.x = cvt_pk_bf16(v0[0], v0[1]); w.y = cvt_pk_bf16(v0[2], v0[3]); w.z = cvt_pk_bf16(v1[0], v1[1]); w.w = cvt_pk_bf16(v1[2], v1[3]);
                        *(u32x4*)(MERGED + (size_t)row * DM + col0) = w; }
                }
            }
    }
};
}

struct Frame { LAS unsigned char* lds; int tid, lane, wave, bid, G; };

DI Frame fresh(const Frame& F0) { Frame F = F0; int tid = F0.tid, bid = F0.bid, G = F0.G, wave = F0.wave; unsigned lo = (unsigned)(size_t)F0.lds;
    asm volatile("" : "+v"(tid)); asm volatile("" : "+s"(bid), "+s"(G), "+s"(wave), "+s"(lo));
    F.tid = tid; F.lane = tid & 63; F.wave = wave; F.bid = bid; F.G = G; F.lds = (LAS unsigned char*)(size_t)lo; return F; }
DI unsigned char* fresh_ptr(unsigned char* p) { size_t z = 0; asm volatile("" : "+s"(z)); return p + z; }
DI void rs_table(const Frame& F, const float* part, int pm) {
    LAS float* rsT = (LAS float*)(F.lds + RST_OFF);
    if (F.tid < 256) { const int row = pm * 256 + F.tid; float s = 0.f;
#pragma unroll
        for (int i = 0; i < 8; ++i) { const f32x4 v = *(const f32x4*)(part + (size_t)row * 32 + 4 * i); s += (v[0] + v[1]) + (v[2] + v[3]); }
        rsT[F.tid] = 1.0f / sqrtf(s * (1.0f / DM) + RMS_EPS); }
    __syncthreads();
}

DI int head_perm(int c) { const int h = c >> 6, p = c & 63; const int dim = p < 16 ? ((p >> 1) + 8 * (p & 1)) : p; return (h << 6) + dim; }
DI int zin_colmap(int n) {
    if (n < B_COLS) return 1860 + n;
    if (n < 2048) return -1;
    if (n < 2560) return head_perm(n - 2048);
    if (n < 3072) return 512 + head_perm(n - 2560);
    if (n < 3584) return 1024 + (n - 3072);
    if (n < 3840) return 1536 + head_perm(n - 3584);
    if (n < 3904) return 1792 + head_perm(n - 3840);
    if (n < 3908) return 1856 + (n - 3904);
    if (n < 4096) return -1;
    if (n < 4608) return 3844 + (n - 4096);
    if (n < 5120) return 4356 + (n - 4608);
    return 4868 + (n - 5120);
}
template <int MODE>
DI void tr_item(const float* W, int ldw, const float* ksc, bf16_t* WT, int K, LAS float* scr, int kb, int nb, int lane) {
    const int k0 = 64 * kb, n0 = 32 * nb, nn = n0 + (lane & 31);
    const int col = MODE == 1 ? zin_colmap(nn) : nn;
#pragma unroll 8
    for (int i = 0; i < 32; ++i) { const int kk = 2 * i + (lane >> 5); float v = 0.f;
        if (col >= 0) { v = W[(size_t)(k0 + kk) * ldw + col]; if (ksc) v *= ksc[k0 + kk]; }
        scr[kk * 33 + (lane & 31)] = v; }
    LDS_WAIT(); asm volatile("" ::: "memory");
    const int c = lane & 7;
#pragma unroll
    for (int j = 0; j < 4; ++j) { const int n = (lane >> 3) + 8 * j; const LAS float* s = scr + (8 * c) * 33 + n;
        u32x4 o; o.x = pk2(s[0 * 33], s[1 * 33]); o.y = pk2(s[2 * 33], s[3 * 33]); o.z = pk2(s[4 * 33], s[5 * 33]); o.w = pk2(s[6 * 33], s[7 * 33]);
        *(u32x4*)(WT + (size_t)(n0 + n) * K + k0 + 8 * c) = o; }
    LDS_WAIT(); asm volatile("" ::: "memory");
}
struct InTab { const float* p[37]; };
#define CAS __attribute__((address_space(4)))
typedef const float* fptr_t;
typedef GAS const float* gfptr_t;
struct In { CAS const gfptr_t* t; DI fptr_t operator[](int i) const { return (fptr_t)t[i]; } };
DI In in_fresh(In in) { CAS const gfptr_t* t = in.t; asm volatile("" : "+s"(t)); In r; r.t = t; return r; }
DI void p0_prologue(const Frame& F, const In& in, unsigned char* ws) {
    LAS float* scr = (LAS float*)(F.lds + F.wave * 16384);
    const int gw = F.bid * NWAVES + F.wave, NGW = F.G * NWAVES;
    constexpr int I_IN = 32 * (NZ / 32), I_BR = 4 * 8 * 64, I_OUT = 32 * 64, I_UP = 32 * (DFF2 / 32), I_DN = 86 * 64, I_GLU = 8 * 16;
    constexpr int I_LAYER = I_IN + I_BR + I_OUT + I_UP + I_DN + I_GLU;
    for (int it = gw; it < NL * I_LAYER; it += NGW) {
        const int l = it / I_LAYER; int r = it - l * I_LAYER;
        unsigned char* wt = ws + WS_WT + (size_t)l * WT_LAYER;
        if (r < I_IN) { const int nbk = NZ / 32; tr_item<1>(in[3] + (size_t)l * DM * IN_COLS, IN_COLS, in[2] + l * DM, (bf16_t*)(wt + WT_IN), DM, scr, r / nbk, r % nbk, F.lane); continue; } r -= I_IN;
        if (r < I_BR) { const int n = r / 512, rr = r % 512; tr_item<0>(in[29] + ((size_t)l * 4 + n) * MIX * DM, DM, nullptr, (bf16_t*)(wt + WT_BR) + (size_t)n * DM * MIX, MIX, scr, rr / 64, rr % 64, F.lane); continue; } r -= I_BR;
        if (r < I_OUT) { tr_item<0>(in[30] + (size_t)l * DM * DM, DM, nullptr, (bf16_t*)(wt + WT_OUT), DM, scr, r / 64, r % 64, F.lane); continue; } r -= I_OUT;
        if (r < I_UP) { const int nbk = DFF2 / 32; tr_item<0>(in[32] + (size_t)l * DM * DFF2, DFF2, in[31] + l * DM, (bf16_t*)(wt + WT_UP), DM, scr, r / nbk, r % nbk, F.lane); continue; } r -= I_UP;
        if (r < I_DN) { tr_item<0>(in[35] + (size_t)l * DFF * DM, DM, nullptr, (bf16_t*)(wt + WT_DOWN), DFF, scr, r / 64, r % 64, F.lane); continue; } r -= I_DN;
        tr_item<0>(in[27] + (size_t)l * MIX * MIX, MIX, nullptr, (bf16_t*)(wt + WT_GLU), MIX, scr, r / 16, r % 16, F.lane);
    }
    { bf16_t* WTL = (bf16_t*)(ws + WS_WTL);
      for (int e = F.bid * NTHR + F.tid; e < NL * 56 * MIX; e += F.G * NTHR) { const int n = e % MIX, k8 = (e / MIX) % 56, l = e / (MIX * 56); const int k0 = k8 * 8;
          const float* src = k0 < 96 ? in[8] + ((size_t)l * 96 + k0) * MIX : (k0 < 192 ? in[10] + ((size_t)l * 96 + (k0 - 96)) * MIX : in[11] + ((size_t)l * 256 + (k0 - 192)) * MIX);
          u32x4 o; o.x = pk2(src[n], src[MIX + n]); o.y = pk2(src[2 * MIX + n], src[3 * MIX + n]); o.z = pk2(src[4 * MIX + n], src[5 * MIX + n]); o.w = pk2(src[6 * MIX + n], src[7 * MIX + n]);
          *(u32x4*)(WTL + ((size_t)l * MIX + n) * 448 + k0) = o; } }
    const int* pos = (const int*)in[1];
    float* rope = (float*)(ws + WS_ROPE);
    for (int e = F.bid * NTHR + F.tid; e < MTOK * 8; e += F.G * NTHR) { const int m = e >> 3, i = e & 7;
        const float inv = exp2f(-(float)i * 0.125f * 18.931568569324174f);
        const float ang = (float)pos[m] * inv; float sn, cs; sincosf(ang, &sn, &cs);
        rope[m * 16 + i] = cs; rope[m * 16 + 8 + i] = sn; }
    const float* x = in[0]; bf16_t* YB = (bf16_t*)(ws + WS_YB); float* pa = (float*)(ws + WS_PARTA);
    for (int m = gw; m < MTOK; m += NGW) { float s = 0.f;
#pragma unroll
        for (int j = 0; j < 8; ++j) { const f32x4 v = *(const f32x4*)(x + (size_t)m * DM + (j * 64 + F.lane) * 4); s += (v[0] * v[0] + v[1] * v[1]) + (v[2] * v[2] + v[3] * v[3]);
            u32x2 w; w.x = pk2(v[0], v[1]); w.y = pk2(v[2], v[3]); *(u32x2*)(YB + (size_t)m * DM + (j * 64 + F.lane) * 4) = w; }
        s = wave_sum(s);
        if (F.lane < 32) pa[(size_t)m * 32 + F.lane] = (F.lane == 0) ? s : 0.f; }
}

DI void dsa_prep_item(const Frame& F, unsigned char* ws, const float* idxg, int item) {
    const float* ZS = (const float*)(ws + WS_ZS); const float* rope = (const float*)(ws + WS_ROPE);
    bf16_t* Q = (bf16_t*)(ws + WS_Q); bf16_t* Kb = (bf16_t*)(ws + WS_K); bf16_t* VT = (bf16_t*)(ws + WS_VT); bf16_t* QI = (bf16_t*)(ws + WS_QI); bf16_t* KI = (bf16_t*)(ws + WS_KI); float* WI = (float*)(ws + WS_WI);
    const int m0 = item * 64;
    for (int e = F.tid; e < 64 * 640; e += NTHR) { const int t = e / 640, pc = e % 640; const int m = m0 + t;
        int zc, oc; bf16_t* dst; int ld; float sc = 1.f;
        if (pc < 256) { zc = ZO_Q + 2 * pc; oc = 2 * pc; dst = Q; ld = 512; sc = 0.125f; }
        else if (pc < 512) { zc = ZO_AK + 2 * (pc - 256); oc = 2 * (pc - 256); dst = Kb; ld = 512; }
        else { zc = ZO_QI + 2 * (pc - 512); oc = 2 * (pc - 512); dst = QI; ld = 256; }
        const f32x2 v = *(const f32x2*)(ZS + (size_t)m * ZS_COLS + zc); float a = v[0], b = v[1];
        const int p = oc & 63;
        if (p < 16) { const float cs = rope[m * 16 + (p >> 1)], sn = rope[m * 16 + 8 + (p >> 1)]; const float a2 = a * cs - b * sn, b2 = b * cs + a * sn; a = a2; b = b2; }
        *(unsigned*)(dst + (size_t)m * ld + oc) = pk2(a * sc, b * sc); }
    for (int tt = 0; tt < 8; ++tt) { const int m = m0 + F.wave * 8 + tt;
        const float xv = ZS[(size_t)m * ZS_COLS + ZO_KI + F.lane];
        const float ss = wave_sum(xv * xv);
        const int dim = F.lane < 16 ? ((F.lane >> 1) + 8 * (F.lane & 1)) : F.lane;
        float y = xv * (1.0f / sqrtf(ss * (1.0f / 64.f) + RMS_EPS)) * idxg[dim];
        const float pr = __shfl_xor(y, 1);
        if (F.lane < 16) { const float cs = rope[m * 16 + (F.lane >> 1)], sn = rope[m * 16 + 8 + (F.lane >> 1)]; y = (F.lane & 1) ? (y * cs + pr * sn) : (y * cs - pr * sn); }
        KI[(size_t)m * 64 + F.lane] = (bf16_t)f2bf(y);
        if (F.lane < 4) WI[(size_t)m * 4 + F.lane] = ZS[(size_t)m * ZS_COLS + ZO_WI + F.lane]; }
    LAS unsigned char* L = F.lds;
    for (int e = F.tid; e < 64 * 128; e += NTHR) { const int t = e >> 7, c4 = (e & 127) * 4;
        const f32x4 v = *(const f32x4*)(ZS + (size_t)(m0 + t) * ZS_COLS + ZO_AV + c4);
        u32x2 w; w.x = pk2(v[0], v[1]); w.y = pk2(v[2], v[3]); *(LAS u32x2*)(L + t * 1040 + c4 * 2) = w; }
    __syncthreads();
    { const int b = m0 / SEQ, s0 = m0 % SEQ;
      for (int e = F.tid; e < 512 * 8; e += NTHR) { const int c = e >> 3, oct = e & 7;
          unsigned short vals[8];
#pragma unroll
          for (int j = 0; j < 8; ++j) vals[j] = *(const LAS unsigned short*)(L + (oct * 8 + j) * 1040 + c * 2);
          u32x4 o; o.x = vals[0] | ((unsigned)vals[1] << 16); o.y = vals[2] | ((unsigned)vals[3] << 16); o.z = vals[4] | ((unsigned)vals[5] << 16); o.w = vals[6] | ((unsigned)vals[7] << 16);
          *(u32x4*)(VT + ((size_t)(b * 512 + c)) * SEQ + s0 + oct * 8) = o; } }
    __syncthreads();
}

DI float softplusf_(float x) { return fmaxf(x, 0.f) + __logf(1.0f + __expf(-fabsf(x))); }
DI float tanhf_(float x) { return 1.0f - 2.0f * __builtin_amdgcn_rcpf(1.0f + __expf(2.0f * x)); }
DI float half32_sum(float x) { x = row16_sum(x); return x + __shfl_xor(x, 16); }
DI void rwkv_prep_item(const Frame& F, unsigned char* ws, const In& in, int l, int item) {
    const float* ZS = (const float*)(ws + WS_ZS);
    const float* mu = in[6] + l * B_COLS; const float* w0 = in[7] + l * MIX; const float* a0 = in[9] + l * MIX; const float* k_k = in[12] + l * MIX; const float* k_a = in[13] + l * MIX;
    const bf16_t* WTL = (const bf16_t*)(ws + WS_WTL) + (size_t)l * MIX * 448;
    float* RW = (float*)(ws + WS_RW); constexpr size_t RS = RW_STRIDE / 4;
    const int m0 = item * 32; const bool first = (m0 % SEQ) == 0;
    constexpr int XP = 456;
    LAS bf16_t* X = (LAS bf16_t*)F.lds;
    for (int e = F.tid; e < 32 * 448; e += NTHR) { const int t = e / 448, c = e % 448; const int m = m0 + t, zc = ZO_LW + c;
        const float z = ZS[(size_t)m * ZS_COLS + zc]; const float zp = (first && t == 0) ? 0.f : ZS[(size_t)(m - 1) * ZS_COLS + zc];
        const float xs = z + (zp - z) * mu[zc];
        X[t * XP + c] = (bf16_t)f2bf(c < 96 ? tanhf_(xs) : (c < 192 ? xs : sigmoidf_(xs))); }
    __syncthreads();
    const int r = F.lane & 31, hh = F.lane >> 5, h = F.wave;
    float inv[16];
#pragma unroll
    for (int i = 0; i < 16; ++i) inv[i] = 0.f;
#pragma unroll
    for (int nt = 0; nt < 2; ++nt) { const int n = h * 64 + nt * 32 + r; const float muK = mu[ZO_K + n], kkn = k_k[n];
#pragma unroll
        for (int g = 0; g < 4; ++g) { const int tb = 8 * g + 4 * hh;
            float pk = (first && tb == 0) ? 0.f : ZS[(size_t)(m0 + tb - 1) * ZS_COLS + ZO_K + n];
#pragma unroll
            for (int j = 0; j < 4; ++j) { const float zk_ = ZS[(size_t)(m0 + tb + j) * ZS_COLS + ZO_K + n]; const float k = (zk_ + (pk - zk_) * muK) * kkn; pk = zk_; inv[4 * g + j] += k * k; } } }
#pragma unroll
    for (int i = 0; i < 16; ++i) inv[i] = 1.0f / fmaxf(sqrtf(half32_sum(inv[i])), 1e-12f);
    const LAS bf16_t* xa = X + r * XP + 8 * hh;
#pragma unroll 1
    for (int nt = 0; nt < 2; ++nt) { const int n = h * 64 + nt * 32 + r; const bf16_t* wrow = WTL + (size_t)n * 448 + 8 * hh;
        f32x16 aw, aa, ag;
#pragma unroll
        for (int i = 0; i < 16; ++i) { aw[i] = 0.f; aa[i] = 0.f; ag[i] = 0.f; }
#pragma unroll
        for (int s2 = 0; s2 < 6; ++s2) { aw = MFMA32(*(const LAS bf16x8*)(xa + 16 * s2), *(const bf16x8*)(wrow + 16 * s2), aw);
                                         aa = MFMA32(*(const LAS bf16x8*)(xa + 96 + 16 * s2), *(const bf16x8*)(wrow + 96 + 16 * s2), aa); }
#pragma unroll
        for (int s2 = 0; s2 < 16; ++s2) ag = MFMA32(*(const LAS bf16x8*)(xa + 192 + 16 * s2), *(const bf16x8*)(wrow + 192 + 16 * s2), ag);
        const float muR = mu[ZO_R + n], muK = mu[ZO_K + n], muV = mu[ZO_V + n], w0n = w0[n], a0n = a0[n], kkn = k_k[n], kan = k_a[n];
#pragma unroll
        for (int g = 0; g < 4; ++g) { const int tb = 8 * g + 4 * hh;
            float pr, pk, pv;
            if (first && tb == 0) { pr = 0.f; pk = 0.f; pv = 0.f; }
            else { const float* zp = ZS + (size_t)(m0 + tb - 1) * ZS_COLS; pr = zp[ZO_R + n]; pk = zp[ZO_K + n]; pv = zp[ZO_V + n]; }
#pragma unroll
            for (int j = 0; j < 4; ++j) { const int i = 4 * g + j, m = m0 + tb + j; const float* zr = ZS + (size_t)m * ZS_COLS;
                const float zr_ = zr[ZO_R + n], zk_ = zr[ZO_K + n], zv_ = zr[ZO_V + n];
                const float rr = zr_ + (pr - zr_) * muR, k = zk_ + (pk - zk_) * muK, v = zv_ + (pv - zv_) * muV;
                pr = zr_; pk = zk_; pv = zv_;
                const float wlog = -softplusf_(-(w0n + aw[i])) - 0.5f;
                const float decay = __expf(-__expf(wlog));
                const float a = sigmoidf_(a0n + aa[i]);
                const float kk = k * kkn * inv[i];
                const size_t o = (size_t)m * MIX + n;
                RW[0 * RS + o] = rr; RW[1 * RS + o] = decay; RW[2 * RS + o] = k * (1.0f + (a - 1.0f) * kan); RW[3 * RS + o] = v; RW[4 * RS + o] = -kk; RW[5 * RS + o] = kk * a; RW[6 * RS + o] = ag[i]; } } }
    __syncthreads();
}

DI void pool_item(const Frame& F, unsigned char* ws, const In& in, int l, int item) {
    const float* ZS = (const float*)(ws + WS_ZS); bf16_t* MIXp = (bf16_t*)(ws + WS_MIX);
    const float* pw = in[17] + (size_t)l * 4 * 128 * 128; const float* psc = in[18] + l * MIX;
    const int m0 = item * 16, t0 = m0 % SEQ;
    LAS float* Z = (LAS float*)F.lds;
    LAS float* DT = Z + 31 * 512;
    for (int e = F.tid; e < 31 * 128; e += NTHR) { const int r = e >> 7, c4 = (e & 127) * 4; const int ta = t0 - 15 + r;
        f32x4 v = (f32x4){0.f, 0.f, 0.f, 0.f};
        if (ta >= 0) v = *(const f32x4*)(ZS + (size_t)(m0 - 15 + r) * ZS_COLS + ZO_C + c4);
        *(LAS f32x4*)(Z + r * 512 + c4) = v; }
    __syncthreads();
    const int j = F.tid, gi = j >> 7, win = 2 << gi;
    for (int t = 0; t < 16; ++t) { float s = 0.f;
        for (int i = 0; i < win; ++i) s += Z[(15 + t - i) * 512 + j];
        const int cnt = (t0 + t + 1) < win ? (t0 + t + 1) : win;
        DT[j * 16 + t] = s / (float)cnt - Z[(15 + t) * 512 + j]; }
    __syncthreads();
    float acc[16];
#pragma unroll
    for (int t = 0; t < 16; ++t) acc[t] = 0.f;
    const int dcol = j & 127;
#pragma unroll 2
    for (int k = 0; k < 128; ++k) { const float wv = pw[((size_t)gi * 128 + k) * 128 + dcol];
#pragma unroll
        for (int q = 0; q < 4; ++q) { const f32x4 x = *(const LAS f32x4*)(DT + (gi * 128 + k) * 16 + 4 * q);
#pragma unroll
            for (int i = 0; i < 4; ++i) acc[4 * q + i] += x[i] * wv; } }
    const float sc = psc[j];
#pragma unroll
    for (int t = 0; t < 16; ++t) MIXp[(size_t)(m0 + t) * (4 * MIX) + 2 * MIX + j] = (bf16_t)f2bf(acc[t] * sc);
    __syncthreads();
}

struct SsmCoef { float lr, li; float br[16], bi[16]; };
DI void ssm_coef(const In& in, int l, int g, int p, SsmCoef& c) {
    const float are = in[19][((size_t)l * 32 + g) * 64 + p], aim = in[20][((size_t)l * 32 + g) * 64 + p];
    const float dt = expf(in[21][l * 32 + g]);
    const float er = expf(are * dt); float sn, cs; sincosf(aim * dt, &sn, &cs);
    c.lr = er * cs; c.li = er * sn;
    const float nr = c.lr - 1.0f, ni = c.li, den = are * are + aim * aim;
    const float cr = (nr * are + ni * aim) / den, ci = (ni * are - nr * aim) / den;
    const float* bre = in[22] + (((size_t)l * 32 + g) * 64 + p) * 16; const float* bim = in[23] + (((size_t)l * 32 + g) * 64 + p) * 16;
#pragma unroll
    for (int k = 0; k < 16; ++k) { const float x = bre[k], y = bim[k]; c.br[k] = cr * x - ci * y; c.bi[k] = cr * y + ci * x; }
}
DI void ssm_pass1_item(const Frame& F, unsigned char* ws, const In& in, int l, int item) {
    const float* ZS = (const float*)(ws + WS_ZS); float* SST = (float*)(ws + WS_SSTATE);
    const int wt = item * 8 + F.wave, b = wt >> 9, g = (wt >> 4) & 31, ch = wt & 15, p = F.lane;
    SsmCoef c; ssm_coef(in, l, g, p, c);
    LAS float* UL = (LAS float*)(F.lds + F.wave * 8192);
    const int mb = b * SEQ + ch * 128;
#pragma unroll
    for (int i = 0; i < 8; ++i) { const int e = i * 64 + F.lane, t = e >> 2, q = e & 3;
        *(LAS f32x4*)(UL + t * 16 + q * 4) = *(const f32x4*)(ZS + (size_t)(mb + t) * ZS_COLS + ZO_D + g * 16 + q * 4); }
    LDS_WAIT(); asm volatile("" ::: "memory");
    float xr = 0.f, xi = 0.f;
#pragma unroll 2
    for (int t = 0; t < 128; ++t) { float bur = 0.f, bui = 0.f;
#pragma unroll
        for (int q = 0; q < 4; ++q) { const f32x4 u = *(const LAS f32x4*)(UL + t * 16 + q * 4);
#pragma unroll
            for (int i = 0; i < 4; ++i) { bur += c.br[4 * q + i] * u[i]; bui += c.bi[4 * q + i] * u[i]; } }
        const float nr = c.lr * xr - c.li * xi + bur, ni = c.lr * xi + c.li * xr + bui; xr = nr; xi = ni; }
    *(f32x2*)(SST + ((size_t)wt * 64 + p) * 2) = (f32x2){xr, xi};
    LDS_WAIT(); asm volatile("" ::: "memory");
}
DI float gelu_tanh(float y) { const float u = 0.7978845608028654f * (y + 0.044715f * y * y * y); return 0.5f * y * (1.0f + tanhf(u)); }
DI void ssm_pass3_item(const Frame& F, unsigned char* ws, const In& in, int l, int item) {
    const float* ZS = (const float*)(ws + WS_ZS); const float* SST = (const float*)(ws + WS_SSTATE);
    float* YS = (float*)(ws + WS_YS); bf16_t* YSB = (bf16_t*)(ws + WS_YSB);
    const int wt = item * 8 + F.wave, b = wt >> 9, g = (wt >> 4) & 31, ch = wt & 15, p = F.lane;
    SsmCoef c; ssm_coef(in, l, g, p, c);
    LAS float* CL = (LAS float*)(F.lds + 98304);
    { const float* cre = in[24] + ((size_t)l * 32 + g) * 16 * 64; const float* cim = in[25] + ((size_t)l * 32 + g) * 16 * 64;
      for (int e = F.tid; e < 1024; e += NTHR) { const int cc = e >> 6, pp = e & 63; *(LAS f32x2*)(CL + cc * 132 + pp * 2) = (f32x2){cre[e], cim[e]}; } }
    __syncthreads();
    float l128r = c.lr, l128i = c.li;
#pragma unroll
    for (int i = 0; i < 7; ++i) { const float nr = l128r * l128r - l128i * l128i, ni = 2.f * l128r * l128i; l128r = nr; l128i = ni; }
    float xr = 0.f, xi = 0.f;
    for (int cc = 0; cc < ch; ++cc) { const f32x2 e = *(const f32x2*)(SST + ((size_t)(wt - ch + cc) * 64 + p) * 2);
        const float nr = l128r * xr - l128i * xi + e[0], ni = l128r * xi + l128i * xr + e[1]; xr = nr; xi = ni; }
    LAS float* UL = (LAS float*)(F.lds + F.wave * 12288);
    LAS float* XS = UL + 256;
    const int mb = b * SEQ + ch * 128;
    const float dsk = in[26][l * MIX + g * 16 + (F.lane & 15)];
    for (int sc = 0; sc < 8; ++sc) {
        { const int t = F.lane >> 2, q = F.lane & 3;
          *(LAS f32x4*)(UL + t * 16 + q * 4) = *(const f32x4*)(ZS + (size_t)(mb + sc * 16 + t) * ZS_COLS + ZO_D + g * 16 + q * 4); }
        LDS_WAIT(); asm volatile("" ::: "memory");
#pragma unroll 2
        for (int t = 0; t < 16; ++t) { float bur = 0.f, bui = 0.f;
#pragma unroll
            for (int q = 0; q < 4; ++q) { const f32x4 u = *(const LAS f32x4*)(UL + t * 16 + q * 4);
#pragma unroll
                for (int i = 0; i < 4; ++i) { bur += c.br[4 * q + i] * u[i]; bui += c.bi[4 * q + i] * u[i]; } }
            const float nr = c.lr * xr - c.li * xi + bur, ni = c.lr * xi + c.li * xr + bui; xr = nr; xi = ni;
            *(LAS f32x2*)(XS + (t * 64 + p) * 2) = (f32x2){xr, xi}; }
        LDS_WAIT(); asm volatile("" ::: "memory");
        const int cc = F.lane & 15, tq = F.lane >> 4;
        float y[4] = {0.f, 0.f, 0.f, 0.f};
#pragma unroll 4
        for (int pp = 0; pp < 64; pp += 2) { const f32x4 cv = *(const LAS f32x4*)(CL + cc * 132 + pp * 2);
#pragma unroll
            for (int jj = 0; jj < 4; ++jj) { const f32x4 xv = *(const LAS f32x4*)(XS + ((tq * 4 + jj) * 64 + pp) * 2);
                y[jj] += cv[0] * xv[0] - cv[1] * xv[1] + cv[2] * xv[2] - cv[3] * xv[3]; } }
#pragma unroll
        for (int jj = 0; jj < 4; ++jj) { const int t = tq * 4 + jj; const int m = mb + sc * 16 + t;
            const float yy = gelu_tanh(y[jj] + dsk * UL[t * 16 + cc]);
            YS[(size_t)m * MIX + g * 16 + cc] = yy; YSB[(size_t)m * MIX + g * 16 + cc] = (bf16_t)f2bf(yy); }
        LDS_WAIT(); asm volatile("" ::: "memory");
    }
    __syncthreads();
}

DI float vmul_(float a, float b) { float d; asm("v_mul_f32 %0, %1, %2" : "=v"(d) : "v"(a), "v"(b)); return d; }
DI float vfma_(float a, float b, float c) { float d; asm("v_fma_f32 %0, %1, %2, %3" : "=v"(d) : "v"(a), "v"(b), "v"(c)); return d; }
DI void row16_sum2(float& x0, float& x1) {
    asm("s_nop 1\n\t"
        "v_add_f32_dpp %0, %0, %0 quad_perm:[1,0,3,2] row_mask:0xf bank_mask:0xf bound_ctrl:1\n\tv_add_f32_dpp %1, %1, %1 quad_perm:[1,0,3,2] row_mask:0xf bank_mask:0xf bound_ctrl:1\n\ts_nop 0\n\t"
        "v_add_f32_dpp %0, %0, %0 quad_perm:[2,3,0,1] row_mask:0xf bank_mask:0xf bound_ctrl:1\n\tv_add_f32_dpp %1, %1, %1 quad_perm:[2,3,0,1] row_mask:0xf bank_mask:0xf bound_ctrl:1\n\ts_nop 0\n\t"
        "v_add_f32_dpp %0, %0, %0 row_half_mirror row_mask:0xf bank_mask:0xf bound_ctrl:1\n\tv_add_f32_dpp %1, %1, %1 row_half_mirror row_mask:0xf bank_mask:0xf bound_ctrl:1\n\ts_nop 0\n\t"
        "v_add_f32_dpp %0, %0, %0 row_mirror row_mask:0xf bank_mask:0xf bound_ctrl:1\n\tv_add_f32_dpp %1, %1, %1 row_mirror row_mask:0xf bank_mask:0xf bound_ctrl:1\n\ts_nop 1"
        : "+v"(x0), "+v"(x1));
}
DI void rwkv_scan_item(const Frame& F, unsigned char* ws, int item) {
    const float* RW = (const float*)(ws + WS_RW); constexpr size_t RS = RW_STRIDE / 4;
    float* YRAW = (float*)(ws + WS_YRAW);
    constexpr int TC = 32, NCH = SEQ / TC;
    const int b = item >> 3, h = item & 7;
    const int rg = F.lane >> 4, jq = F.lane & 15, row0 = F.wave * 8 + rg * 2;
    LAS float* BUF = (LAS float*)F.lds;
    constexpr int BUFSZ = 6 * TC * 64;
    const int st = F.tid >> 4, sq = F.tid & 15;
    const float* gsrc = RW + (size_t)(b * SEQ + st) * MIX + h * 64 + 4 * sq;
    f32x4 pre[6];
#pragma unroll
    for (int a = 0; a < 6; ++a) pre[a] = *(const f32x4*)(gsrc + a * RS);
#pragma unroll
    for (int a = 0; a < 6; ++a) *(LAS f32x4*)(BUF + (a * TC + st) * 64 + 4 * sq) = pre[a];
    __syncthreads();
    float S0[4] = {0.f, 0.f, 0.f, 0.f}, S1[4] = {0.f, 0.f, 0.f, 0.f};
    float* yout = YRAW + (size_t)(b * SEQ) * MIX + h * 64 + row0;
#pragma unroll 1
    for (int c = 0; c < NCH; ++c) {
        if (c + 1 < NCH) {
#pragma unroll
            for (int a = 0; a < 6; ++a) pre[a] = *(const f32x4*)(gsrc + a * RS + (size_t)(c + 1) * TC * MIX);
        }
        const LAS float* P = BUF + (c & 1) * BUFSZ;
#pragma unroll 1
        for (int t16 = 0; t16 < TC; t16 += 16) {
            float yk0 = 0.f, yk1 = 0.f;
#pragma unroll 4
            for (int tt = 0; tt < 16; ++tt) { const int t = t16 + tt;
                const f32x4 a4 = *(const LAS f32x4*)(P + (4 * TC + t) * 64 + 4 * jq);
                const f32x4 k4 = *(const LAS f32x4*)(P + (2 * TC + t) * 64 + 4 * jq);
                const f32x2 v2 = *(const LAS f32x2*)(P + (3 * TC + t) * 64 + row0);
                const f32x4 b4 = *(const LAS f32x4*)(P + (5 * TC + t) * 64 + 4 * jq);
                const f32x4 w4 = *(const LAS f32x4*)(P + (1 * TC + t) * 64 + 4 * jq);
                const f32x4 r4 = *(const LAS f32x4*)(P + (0 * TC + t) * 64 + 4 * jq);
                float sa0 = vfma_(S0[3], a4[3], vfma_(S0[2], a4[2], vfma_(S0[1], a4[1], vmul_(S0[0], a4[0]))));
                float sa1 = vfma_(S1[3], a4[3], vfma_(S1[2], a4[2], vfma_(S1[1], a4[1], vmul_(S1[0], a4[0]))));
                row16_sum2(sa0, sa1);
#pragma unroll
                for (int i = 0; i < 4; ++i) { S0[i] = vfma_(S0[i], w4[i], vfma_(sa0, b4[i], vmul_(v2[0], k4[i]))); S1[i] = vfma_(S1[i], w4[i], vfma_(sa1, b4[i], vmul_(v2[1], k4[i]))); }
                float y0 = vfma_(S0[3], r4[3], vfma_(S0[2], r4[2], vfma_(S0[1], r4[1], vmul_(S0[0], r4[0]))));
                float y1 = vfma_(S1[3], r4[3], vfma_(S1[2], r4[2], vfma_(S1[1], r4[1], vmul_(S1[0], r4[0]))));
                row16_sum2(y0, y1);
                const bool mine = (tt & 15) == jq;
                yk0 = mine ? y0 : yk0; yk1 = mine ? y1 : yk1; }
            *(f32x2*)(yout + (size_t)(c * TC + t16 + jq) * MIX) = (f32x2){yk0, yk1};
        }
        if (c + 1 < NCH) {
            LAS float* Q = BUF + ((c + 1) & 1) * BUFSZ;
#pragma unroll
            for (int a = 0; a < 6; ++a) *(LAS f32x4*)(Q + (a * TC + st) * 64 + 4 * sq) = pre[a];
        }
        __syncthreads();
    }
}
DI void rwkv_post_rows(const Frame& F, unsigned char* ws, const In& in, int l, int w0, int nw) {
    const float* RW = (const float*)(ws + WS_RW); constexpr size_t RS = RW_STRIDE / 4;
    const float* YRAW = (const float*)(ws + WS_YRAW); bf16_t* MIXp = (bf16_t*)(ws + WS_MIX);
    const float* r_k = in[14] + l * MIX; const float* lng = in[15] + l * MIX; const float* lnb = in[16] + l * MIX;
    for (int e = w0; e < MTOK * 8; e += nw) { const int m = e >> 3, h = e & 7, ch = h * 64 + F.lane; const size_t o = (size_t)m * MIX + ch;
        const float y = YRAW[o];
        const float mean = wave_sum(y) * (1.f / 64.f); const float d = y - mean; const float var = wave_sum(d * d) * (1.f / 64.f);
        const float yn = d * (1.0f / sqrtf(var + GN_EPS)) * lng[ch] + lnb[ch];
        const float bon = wave_sum(RW[0 * RS + o] * RW[2 * RS + o] * r_k[ch]) * RW[3 * RS + o];
        MIXp[(size_t)m * (4 * MIX) + MIX + ch] = (bf16_t)f2bf((yn + bon) * RW[6 * RS + o]); }
}

DI unsigned wave_sum_u32(unsigned x) {
    float f = __builtin_bit_cast(float, x); (void)f;
    int v = (int)x;
    v += __builtin_amdgcn_update_dpp(0, v, 0xB1, 0xF, 0xF, true); v += __builtin_amdgcn_update_dpp(0, v, 0x4E, 0xF, 0xF, true);
    v += __builtin_amdgcn_update_dpp(0, v, 0x141, 0xF, 0xF, true); v += __builtin_amdgcn_update_dpp(0, v, 0x140, 0xF, 0xF, true);
    return (unsigned)(__builtin_amdgcn_readlane(v, 0) + __builtin_amdgcn_readlane(v, 16) + __builtin_amdgcn_readlane(v, 32) + __builtin_amdgcn_readlane(v, 48));
}
DI unsigned fkey(float v) { unsigned u = __builtin_bit_cast(unsigned, v); if (u == 0x80000000u) u = 0u; return (u & 0x80000000u) ? ~u : (u | 0x80000000u); }
DI bf16x8 pack8(float a0, float a1, float a2, float a3, float a4, float a5, float a6, float a7) {
    u32x4 p; p.x = pk2(a0, a1); p.y = pk2(a2, a3); p.z = pk2(a4, a5); p.w = pk2(a6, a7); return __builtin_bit_cast(bf16x8, p); }
struct AttTile { bf16x8 kf[4]; s16x4 vf[8]; unsigned mw; };
DI void att_load(AttTile& T, const bf16_t* kp, const bf16_t* vp, const unsigned* mp, int kt) {
#pragma unroll
    for (int s = 0; s < 4; ++s) T.kf[s] = *(const bf16x8*)(kp + (size_t)kt * 32 * 512 + 16 * s);
#pragma unroll
    for (int s2 = 0; s2 < 2; ++s2) { const bf16_t* v = vp + kt * 32 + 16 * s2;
        T.vf[4 * s2 + 0] = *(const s16x4*)(v); T.vf[4 * s2 + 1] = *(const s16x4*)(v + 8);
        T.vf[4 * s2 + 2] = *(const s16x4*)(v + (size_t)32 * SEQ); T.vf[4 * s2 + 3] = *(const s16x4*)(v + (size_t)32 * SEQ + 8); }
    T.mw = mp[kt];
}
DI void att_tile(const AttTile& T, const bf16x8 (&qf)[4], f32x16& o0, f32x16& o1, float& mrun, float& lrun, int hh) {
    f32x16 sa;
#pragma unroll
    for (int i = 0; i < 16; ++i) sa[i] = 0.f;
#pragma unroll
    for (int s = 0; s < 4; ++s) sa = MFMA32(T.kf[s], qf[s], sa);
    float mx = -1e30f;
#pragma unroll
    for (int i = 0; i < 16; ++i) { const int kr = (i & 3) + 8 * (i >> 2) + 4 * hh; const bool on = (T.mw >> kr) & 1u; sa[i] = on ? sa[i] : -1e30f; mx = fmaxf(mx, sa[i]); }
    mx = fmaxf(mx, __shfl_xor(mx, 32));
    const float mnew = fmaxf(mrun, mx);
    if (__any(mnew > mrun)) {
        const float alpha = __expf(mrun - mnew); lrun *= alpha;
#pragma unroll
        for (int i = 0; i < 16; ++i) { o0[i] *= alpha; o1[i] *= alpha; }
        mrun = mnew; }
    float p[16], ps = 0.f;
#pragma unroll
    for (int i = 0; i < 16; ++i) { p[i] = (sa[i] > -1e29f) ? __expf(sa[i] - mrun) : 0.f; ps += p[i]; }
    lrun += ps;
#pragma unroll
    for (int s2 = 0; s2 < 2; ++s2) {
        const bf16x8 pb = pack8(p[8 * s2], p[8 * s2 + 1], p[8 * s2 + 2], p[8 * s2 + 3], p[8 * s2 + 4], p[8 * s2 + 5], p[8 * s2 + 6], p[8 * s2 + 7]);
        const bf16x8 vf0 = __builtin_shufflevector(T.vf[4 * s2], T.vf[4 * s2 + 1], 0, 1, 2, 3, 4, 5, 6, 7), vf1 = __builtin_shufflevector(T.vf[4 * s2 + 2], T.vf[4 * s2 + 3], 0, 1, 2, 3, 4, 5, 6, 7);
        o0 = MFMA32(vf0, pb, o0); o1 = MFMA32(vf1, pb, o1); }
}
DI void dsa_item(const Frame& F, unsigned char* ws, int item) {
    const bf16_t* Q = (const bf16_t*)(ws + WS_Q); const bf16_t* Kb = (const bf16_t*)(ws + WS_K); const bf16_t* VT = (const bf16_t*)(ws + WS_VT);
    const bf16_t* QI = (const bf16_t*)(ws + WS_QI); const bf16_t* KI = (const bf16_t*)(ws + WS_KI); const float* WI = (const float*)(ws + WS_WI);
    float* SC = (float*)(ws + WS_SC); unsigned* MASK = (unsigned*)(ws + WS_MASK); bf16_t* MIXp = (bf16_t*)(ws + WS_MIX);
    const int b = item >> 6, qb = item & 63, q0 = qb * 32, m0 = b * SEQ + q0;
    const int r = F.lane & 31, hh = F.lane >> 5;
    {
        float wv[4];
#pragma unroll
        for (int hd = 0; hd < 4; ++hd) wv[hd] = WI[(size_t)(m0 + r) * 4 + hd];
        const bf16_t* qip = QI + (size_t)(m0 + r) * 256 + 8 * hh;
        const bf16_t* kip = KI + (size_t)(b * SEQ + r) * 64 + 8 * hh;
        bf16x8 kf[4], kn[4];
        if (F.wave <= qb) {
#pragma unroll
            for (int s = 0; s < 4; ++s) kf[s] = *(const bf16x8*)(kip + (size_t)F.wave * 32 * 64 + 16 * s); }
        for (int kt = F.wave; kt <= qb; kt += 8) {
            if (kt + 8 <= qb) {
#pragma unroll
                for (int s = 0; s < 4; ++s) kn[s] = *(const bf16x8*)(kip + (size_t)(kt + 8) * 32 * 64 + 16 * s); }
            f32x16 sc;
#pragma unroll
            for (int i = 0; i < 16; ++i) sc[i] = 0.f;
#pragma unroll
            for (int hd = 0; hd < 4; ++hd) { f32x16 a; bf16x8 qf[4];
#pragma unroll
                for (int s = 0; s < 4; ++s) qf[s] = *(const bf16x8*)(qip + hd * 64 + 16 * s);
#pragma unroll
                for (int i = 0; i < 16; ++i) a[i] = 0.f;
#pragma unroll
                for (int s = 0; s < 4; ++s) a = MFMA32(kf[s], qf[s], a);
#pragma unroll
                for (int i = 0; i < 16; ++i) sc[i] += wv[hd] * fmaxf(a[i], 0.f); }
#pragma unroll
            for (int g = 0; g < 4; ++g) *(f32x4*)(SC + (size_t)(m0 + r) * SEQ + kt * 32 + 8 * g + 4 * hh) = (f32x4){sc[4 * g], sc[4 * g + 1], sc[4 * g + 2], sc[4 * g + 3]};
#pragma unroll
            for (int s = 0; s < 4; ++s) kf[s] = kn[s];
        }
    }
    VM_WAIT(); __syncthreads();
    for (int qq = 0; qq < 4; ++qq) {
        const int rq = F.wave * 4 + qq, t = q0 + rq, m = m0 + rq;
        unsigned* mrow = MASK + (size_t)m * 64;
        if (t + 1 <= 256) {
            for (int j = 0; j < 32; ++j) { const unsigned long long bm = __ballot(F.lane + 64 * j <= t); if (F.lane == 0) { mrow[2 * j] = (unsigned)bm; mrow[2 * j + 1] = (unsigned)(bm >> 32); } }
        } else {
            unsigned key[32];
#pragma unroll
            for (int j = 0; j < 32; ++j) { const int s = F.lane + 64 * j; key[j] = (s <= t) ? fkey(SC[(size_t)m * SEQ + (s <= t ? s : 0)]) : 0u; }
            unsigned T = 0u;
#pragma unroll 1
            for (int bit = 31; bit >= 0; --bit) { const unsigned cand = T | (1u << bit); unsigned cnt = 0u;
#pragma unroll
                for (int j = 0; j < 32; ++j) cnt += (key[j] >= cand) ? 1u : 0u;
                if (wave_sum_u32(cnt) >= 256u) T = cand; }
            unsigned cg = 0u;
#pragma unroll
            for (int j = 0; j < 32; ++j) cg += (key[j] > T) ? 1u : 0u;
            const int cgt = (int)wave_sum_u32(cg);
            const int need = 256 - cgt; int run = 0;
            const unsigned long long lt = (1ull << F.lane) - 1ull;
#pragma unroll
            for (int j = 0; j < 32; ++j) {
                const unsigned long long eq = __ballot(key[j] == T), gt = __ballot(key[j] > T);
                const int pre = run + __popcll(eq & lt);
                const unsigned long long se = __ballot(key[j] == T && pre < need);
                const unsigned long long bm = gt | se; run += __popcll(eq);
                if (F.lane == 0) { mrow[2 * j] = (unsigned)bm; mrow[2 * j + 1] = (unsigned)(bm >> 32); }
                if ((j & 3) == 3) __builtin_amdgcn_sched_barrier(0); }
        }
    }
    VM_WAIT(); __syncthreads();
    {
        const int hd = F.wave;
        bf16x8 qf[4];
#pragma unroll
        for (int s = 0; s < 4; ++s) qf[s] = *(const bf16x8*)(Q + (size_t)(m0 + r) * 512 + hd * 64 + 16 * s + 8 * hh);
        f32x16 o0, o1;
#pragma unroll
        for (int i = 0; i < 16; ++i) { o0[i] = 0.f; o1[i] = 0.f; }
        float mrun = -1e30f, lrun = 0.f;
        const bf16_t* kp = Kb + (size_t)(b * SEQ + r) * 512 + hd * 64 + 8 * hh;
        const bf16_t* vp = VT + ((size_t)(b * 8 + hd) * 64 + r) * SEQ + 4 * hh;
        const unsigned* mp = MASK + (size_t)(m0 + r) * 64;
        AttTile A, B;
        att_load(A, kp, vp, mp, 0);
        for (int kt = 0; kt <= qb; kt += 2) {
            if (kt + 1 <= qb) att_load(B, kp, vp, mp, kt + 1);
            att_tile(A, qf, o0, o1, mrun, lrun, hh);
            if (kt + 1 <= qb) {
                if (kt + 2 <= qb) att_load(A, kp, vp, mp, kt + 2);
                att_tile(B, qf, o0, o1, mrun, lrun, hh); }
        }
        const float inv = 1.0f / (lrun + __shfl_xor(lrun, 32));
        bf16_t* orow = MIXp + (size_t)(m0 + r) * (4 * MIX) + hd * 64;
#pragma unroll
        for (int g = 0; g < 4; ++g) {
            u32x2 w0; w0.x = pk2(o0[4 * g] * inv, o0[4 * g + 1] * inv); w0.y = pk2(o0[4 * g + 2] * inv, o0[4 * g + 3] * inv);
            u32x2 w1; w1.x = pk2(o1[4 * g] * inv, o1[4 * g + 1] * inv); w1.y = pk2(o1[4 * g + 2] * inv, o1[4 * g + 3] * inv);
            *(u32x2*)(orow + 8 * g + 4 * hh) = w0; *(u32x2*)(orow + 32 + 8 * g + 4 * hh) = w1; }
    }
    __syncthreads();
}

DI float siluf_(float x) { return x * sigmoidf_(x); }
DI void conv_phase(const Frame& F, unsigned char* ws, const In& in, int l) {
    const bf16_t* U = (const bf16_t*)(ws + WS_U); bf16_t* ACT = (bf16_t*)(ws + WS_ACT);
    const float* cw = in[33] + (size_t)l * 3 * DFF2; const float* cb = in[34] + (size_t)l * DFF2;
    constexpr int NCG = DFF / 8;
    const long total = (long)NCG * (MTOK / 32);
    for (long e = (long)F.bid * NTHR + F.tid; e < total; e += (long)F.G * NTHR) {
        const int cg = (int)(e % NCG), tg = (int)(e / NCG); const int f0 = cg * 8, m0 = tg * 32; const bool first = (m0 % SEQ) == 0;
        float wg[3][8], wv[3][8], bg[8], bv[8];
#pragma unroll
        for (int j = 0; j < 3; ++j)
#pragma unroll
            for (int i = 0; i < 8; ++i) { wg[j][i] = cw[(size_t)j * DFF2 + f0 + i]; wv[j][i] = cw[(size_t)j * DFF2 + DFF + f0 + i]; }
#pragma unroll
        for (int i = 0; i < 8; ++i) { bg[i] = cb[f0 + i]; bv[i] = cb[DFF + f0 + i]; }
        float g1[8], g2[8], v1[8], v2[8];
#pragma unroll
        for (int i = 0; i < 8; ++i) { g1[i] = 0.f; g2[i] = 0.f; v1[i] = 0.f; v2[i] = 0.f; }
        if (!first) {
            const u32x4 a = *(const u32x4*)(U + (size_t)(m0 - 1) * DFF2 + f0), b = *(const u32x4*)(U + (size_t)(m0 - 2) * DFF2 + f0);
            const u32x4 c = *(const u32x4*)(U + (size_t)(m0 - 1) * DFF2 + DFF + f0), d = *(const u32x4*)(U + (size_t)(m0 - 2) * DFF2 + DFF + f0);
#pragma unroll
            for (int i = 0; i < 4; ++i) { g1[2 * i] = bf2f(a[i] & 0xffffu); g1[2 * i + 1] = bf2f(a[i] >> 16); g2[2 * i] = bf2f(b[i] & 0xffffu); g2[2 * i + 1] = bf2f(b[i] >> 16);
                v1[2 * i] = bf2f(c[i] & 0xffffu); v1[2 * i + 1] = bf2f(c[i] >> 16); v2[2 * i] = bf2f(d[i] & 0xffffu); v2[2 * i + 1] = bf2f(d[i] >> 16); }
        }
#pragma unroll 2
        for (int t = 0; t < 32; ++t) {
            const u32x4 a = *(const u32x4*)(U + (size_t)(m0 + t) * DFF2 + f0), c = *(const u32x4*)(U + (size_t)(m0 + t) * DFF2 + DFF + f0);
            float g0[8], v0[8], o[8];
#pragma unroll
            for (int i = 0; i < 4; ++i) { g0[2 * i] = bf2f(a[i] & 0xffffu); g0[2 * i + 1] = bf2f(a[i] >> 16); v0[2 * i] = bf2f(c[i] & 0xffffu); v0[2 * i + 1] = bf2f(c[i] >> 16); }
#pragma unroll
            for (int i = 0; i < 8; ++i) { const float gc = bg[i] + wg[0][i] * g2[i] + wg[1][i] * g1[i] + wg[2][i] * g0[i]; const float vc = bv[i] + wv[0][i] * v2[i] + wv[1][i] * v1[i] + wv[2][i] * v0[i];
                o[i] = siluf_(gc) * vc; g2[i] = g1[i]; g1[i] = g0[i]; v2[i] = v1[i]; v1[i] = v0[i]; }
            u32x4 w; w.x = pk2(o[0], o[1]); w.y = pk2(o[2], o[3]); w.z = pk2(o[4], o[5]); w.w = pk2(o[6], o[7]);
            *(u32x4*)(ACT + (size_t)(m0 + t) * DFF + f0) = w;
        }
    }
}

DI void final_phase(const Frame& F, unsigned char* ws, const float* gfin, float* out) {
    const float* Y = (const float*)(ws + WS_Y); const float* part = (const float*)(ws + WS_PARTA);
    const int gw = F.bid * NWAVES + F.wave, NGW = F.G * NWAVES;
    for (int m = gw; m < MTOK; m += NGW) {
        float s = (F.lane < 32) ? part[(size_t)m * 32 + F.lane] : 0.f; s = wave_sum(s);
        const float rs = 1.0f / sqrtf(s * (1.0f / DM) + RMS_EPS);
#pragma unroll
        for (int j = 0; j < 8; ++j) { const int c = (j * 64 + F.lane) * 4; const f32x4 v = *(const f32x4*)(Y + (size_t)m * DM + c), g = *(const f32x4*)(gfin + c);
            *(f32x4*)(out + (size_t)m * DM + c) = v * rs * g; }
    }
}

struct Args { InTab in; float* out; unsigned char* ws; int ph_lo, ph_hi; };
constexpr int ZG1_UNITS = 24 * 32, ZG2_UNITS = 28 * 32;
constexpr int PH_PER_LAYER = 9, N_PHASES = 1 + NL * PH_PER_LAYER + 1;

__global__ void __launch_bounds__(NTHR, 2) hybrid_fwd(Args args) {
    extern __shared__ __attribute__((aligned(16))) unsigned char lds_raw[];
    Frame F0; F0.lds = (LAS unsigned char*)lds_raw; F0.tid = threadIdx.x; F0.lane = F0.tid & 63; F0.wave = __builtin_amdgcn_readfirstlane(F0.tid >> 6); F0.bid = blockIdx.x; F0.G = gridDim.x;
    unsigned char* ws0 = args.ws; In in0; in0.t = (CAS const gfptr_t*)__builtin_amdgcn_kernarg_segment_ptr();
    const int lo = args.ph_lo, hi = args.ph_hi;
    volatile LAS unsigned* MISC = (volatile LAS unsigned*)(F0.lds + MISC_OFF);
    if (F0.tid < 16) MISC[F0.tid] = 0u;
    __syncthreads();
    XcdBarrier bar; bar.bar = (unsigned*)(ws0 + WS_CTL) + CW_BAR; bar.x = 0; bar.st = nullptr;
    const bool multi = (hi - lo) > 1;
    if (multi) bar = xcd_barrier_post((unsigned*)(ws0 + WS_CTL) + CW_BAR, MISC + 8);
#ifndef SUBMASK
#define SUBMASK 7
#endif
#ifndef DUPSUB
#define DUPSUB 0
#endif
#ifndef DUPMASK
#define DUPMASK 0u
#endif
#define NREP(j) (((DUPMASK >> (j)) & 1u) ? 2 : 1)
#ifndef PHMASK
#define PHMASK 0xFFFFFFFFu
#endif
#define IN_PH(k) (lo <= (k) && (k) < hi)
#define ON(j) ((PHMASK >> (j)) & 1u)
#define LAYER_PTRS unsigned char* wt = ws + WS_WT + (size_t)l * WT_LAYER; float* Y = (float*)(ws + WS_Y); bf16_t* YB = (bf16_t*)(ws + WS_YB); float* PA = (float*)(ws + WS_PARTA); float* PB = (float*)(ws + WS_PARTB); const LAS float* rsT = (const LAS float*)(F.lds + RST_OFF); (void)wt; (void)Y; (void)YB; (void)PA; (void)PB; (void)rsT;
#define SEAM(k) do { if (IN_PH(k) && IN_PH((k) + 1)) xcd_barrier(bar); } while (0)

    if (ON(0) && IN_PH(0)) for (int rep = 0; rep < NREP(0); ++rep) { if (rep) xcd_barrier(bar); const In in = in_fresh(in0); const Frame F = fresh(F0); unsigned char* ws = fresh_ptr(ws0); p0_prologue(F, in, ws); }
    SEAM(0);

    for (int l = 0; l < NL; ++l) {
        const int pb = 1 + l * PH_PER_LAYER;
        if (ON(1) && IN_PH(pb + 0)) for (int rep = 0; rep < NREP(1); ++rep) { if (rep) xcd_barrier(bar); const In in = in_fresh(in0); const Frame F = fresh(F0); unsigned char* ws = fresh_ptr(ws0); LAYER_PTRS
            pg8::Gemm g{YB, (const bf16_t*)(wt + WT_IN), DM, DM, DM}; const pg8::OrderLin S{F.bid, F.G, ZG1_UNITS, 0, DM, DM};
            pg8::Unit u0; int pm0 = -1; if (S.next(0, u0)) pm0 = u0.pm;
            if (pm0 >= 0) rs_table(F, PA, pm0); else __syncthreads();
            pg8::EpiZ E{(float*)(ws + WS_ZS), (bf16_t*)(ws + WS_G), in[4] + (size_t)l * GCOLS, PA, rsT, pm0};
            pg8::gemm_phase<pg8::EpiZ, pg8::OrderLin, true>(F.lds, F.tid, g, S, E);
        }
        SEAM(pb + 0);
        if (ON(2) && IN_PH(pb + 1)) for (int rep = 0; rep < NREP(2); ++rep) { if (rep) xcd_barrier(bar); const In in = in_fresh(in0); const Frame F = fresh(F0); unsigned char* ws = fresh_ptr(ws0); LAYER_PTRS
            for (int it = F.bid; it < 1152; it += F.G) {
                if (it < 128) { dsa_prep_item(F, ws, in[5] + l * 64, it); if (DUPSUB & 64) dsa_prep_item(F, ws, in[5] + l * 64, it); }
                else if (it < 384) { rwkv_prep_item(F, ws, in, l, it - 128); if (DUPSUB & 16) rwkv_prep_item(F, ws, in, l, it - 128); }
                else if (it < 896) { pool_item(F, ws, in, l, it - 384); if (DUPSUB & 32) pool_item(F, ws, in, l, it - 384); }
                else { ssm_pass1_item(F, ws, in, l, it - 896); if (DUPSUB & 128) ssm_pass1_item(F, ws, in, l, it - 896); }
            }
        }
        SEAM(pb + 1);
        if (ON(3) && IN_PH(pb + 2)) for (int rep = 0; rep < NREP(3); ++rep) { if (rep) xcd_barrier(bar); const In in = in_fresh(in0); const Frame F = fresh(F0); unsigned char* ws = fresh_ptr(ws0); LAYER_PTRS
            const bool split = F.G >= 128; const int nrw = split ? 32 : 0;
            if (SUBMASK & 1) { const Frame Fa = fresh(F0);
                if (split) { if (Fa.bid < 32) { rwkv_scan_item(Fa, ws, Fa.bid); if (DUPSUB & 1) rwkv_scan_item(Fa, ws, Fa.bid); } }
                else for (int it = Fa.bid; it < 32; it += Fa.G) rwkv_scan_item(Fa, ws, it); }
            if (F.bid >= nrw) {
                if (SUBMASK & 2) { const Frame Fb = fresh(F0); const int nb = Fb.G - nrw, b0 = Fb.bid - nrw;
                    for (int it = b0; it < 256; it += nb) { const int b = it & 3, qb = 63 - (it >> 2); dsa_item(Fb, ws, b * 64 + qb); if (DUPSUB & 2) dsa_item(Fb, ws, b * 64 + qb); } }
                if (SUBMASK & 4) { const Frame Fc = fresh(F0); const int nb = Fc.G - nrw, b0 = Fc.bid - nrw;
                    for (int it = nb - 1 - b0; it < 256; it += nb) { ssm_pass3_item(Fc, fresh_ptr(ws0), in_fresh(in0), l, it); if (DUPSUB & 4) ssm_pass3_item(Fc, fresh_ptr(ws0), in_fresh(in0), l, it); } }
                { const Frame Fd = fresh(F0); unsigned char* wsd = fresh_ptr(ws0); const In ind = in_fresh(in0);
                    unsigned char* wtd = wsd + WS_WT + (size_t)l * WT_LAYER; float* PAd = (float*)(wsd + WS_PARTA);
                    pg8::Gemm g{(const bf16_t*)(wsd + WS_YB), (const bf16_t*)(wtd + WT_IN), DM, DM, DM}; const pg8::OrderLin S{Fd.bid - nrw, Fd.G - nrw, ZG2_UNITS, 24, DM, DM};
                    pg8::Unit u0; int pm0 = -1; if (S.next(0, u0)) pm0 = u0.pm;
                    if (pm0 >= 0) rs_table(Fd, PAd, pm0); else __syncthreads();
                    pg8::EpiZ E{(float*)(wsd + WS_ZS), (bf16_t*)(wsd + WS_G), ind[4] + (size_t)l * GCOLS, PAd, (const LAS float*)(Fd.lds + RST_OFF), pm0};
                    pg8::gemm_phase<pg8::EpiZ, pg8::OrderLin, true>(Fd.lds, Fd.tid, g, S, E); }
            }
        }
        SEAM(pb + 2);
        if (ON(4) && IN_PH(pb + 3)) for (int rep = 0; rep < NREP(4); ++rep) { if (rep) xcd_barrier(bar); const In in = in_fresh(in0); const Frame F = fresh(F0); unsigned char* ws = fresh_ptr(ws0); LAYER_PTRS
            pg8::Gemm g{(const bf16_t*)(ws + WS_YSB), (const bf16_t*)(wt + WT_GLU), MIX, MIX, MIX}; pg8::Order S; S.init(MTOK / 256, MIX / 256, F.G, F.bid, MIX, MIX);
            pg8::EpiGlu E{(const float*)(ws + WS_YS), in[28] + l * MIX, (bf16_t*)(ws + WS_MIX)};
            pg8::gemm_phase<pg8::EpiGlu, pg8::Order, true>(F.lds, F.tid, g, S, E);
            { const Frame Fp = fresh(F0); const int ng = (Fp.G > 64) ? 64 : 0;
              if (Fp.bid >= ng) rwkv_post_rows(Fp, fresh_ptr(ws0), in_fresh(in0), l, (Fp.bid - ng) * NWAVES + Fp.wave, (Fp.G - ng) * NWAVES); }
        }
        SEAM(pb + 3);
        if (ON(5) && IN_PH(pb + 4)) for (int rep = 0; rep < NREP(5); ++rep) { if (rep) xcd_barrier(bar); const In in = in_fresh(in0); const Frame F = fresh(F0); unsigned char* ws = fresh_ptr(ws0); LAYER_PTRS
            pg8::Gemm g{(const bf16_t*)(ws + WS_MIX), (const bf16_t*)(wt + WT_BR), 4 * MIX, MIX, MIX}; pg8::Order S; S.init(MTOK / 256, DM / 256, F.G, F.bid, 4 * MIX, MIX, 4, MIX, DM);
            pg8::EpiMerge E{(const bf16_t*)(ws + WS_G), (float*)(ws + WS_MF), (bf16_t*)(ws + WS_MERGED)};
            pg8::gemm_phase<pg8::EpiMerge, pg8::Order, true>(F.lds, F.tid, g, S, E);
        }
        SEAM(pb + 4);
        if (ON(6) && IN_PH(pb + 5)) for (int rep = 0; rep < NREP(6); ++rep) { if (rep) xcd_barrier(bar); const In in = in_fresh(in0); const Frame F = fresh(F0); unsigned char* ws = fresh_ptr(ws0); LAYER_PTRS
            pg8::Gemm g{(const bf16_t*)(ws + WS_MERGED), (const bf16_t*)(wt + WT_OUT), DM, DM, DM}; pg8::Order S; S.init(MTOK / 256, DM / 256, F.G, F.bid, DM, DM);
            pg8::EpiRes E{l == 0 ? in[0] : Y, Y, YB, PB};
            pg8::gemm_phase<pg8::EpiRes, pg8::Order, true>(F.lds, F.tid, g, S, E);
        }
        SEAM(pb + 5);
        if (ON(7) && IN_PH(pb + 6)) for (int rep = 0; rep < NREP(7); ++rep) { if (rep) xcd_barrier(bar); const In in = in_fresh(in0); const Frame F = fresh(F0); unsigned char* ws = fresh_ptr(ws0); LAYER_PTRS
            pg8::Gemm g{YB, (const bf16_t*)(wt + WT_UP), DM, DM, DM}; pg8::Order S; S.init(MTOK / 256, DFF2 / 256, F.G, F.bid, DM, DM);
            pg8::Unit u0; int pm0 = -1; if (S.next(0, u0)) pm0 = u0.pm;
            if (pm0 >= 0) rs_table(F, PB, pm0); else __syncthreads();
            pg8::EpiU E{(bf16_t*)(ws + WS_U), DFF2, PB, rsT, pm0};
            pg8::gemm_phase<pg8::EpiU, pg8::Order, true>(F.lds, F.tid, g, S, E);
        }
        SEAM(pb + 6);
        if (ON(8) && IN_PH(pb + 7)) for (int rep = 0; rep < NREP(8); ++rep) { if (rep) xcd_barrier(bar); const In in = in_fresh(in0); const Frame F = fresh(F0); unsigned char* ws = fresh_ptr(ws0); LAYER_PTRS conv_phase(F, ws, in, l); }
        SEAM(pb + 7);
        if (ON(9) && IN_PH(pb + 8)) for (int rep = 0; rep < NREP(9); ++rep) { if (rep) xcd_barrier(bar); const In in = in_fresh(in0); const Frame F = fresh(F0); unsigned char* ws = fresh_ptr(ws0); LAYER_PTRS
            pg8::Gemm g{(const bf16_t*)(ws + WS_ACT), (const bf16_t*)(wt + WT_DOWN), DFF, DFF, DFF}; pg8::Order S; S.init(MTOK / 256, DM / 256, F.G, F.bid, DFF, DFF);
            pg8::EpiRes E{Y, Y, YB, PA};
            pg8::gemm_phase<pg8::EpiRes, pg8::Order, true>(F.lds, F.tid, g, S, E);
        }
        SEAM(pb + 8);
    }
    if (ON(10) && IN_PH(N_PHASES - 1)) { const In in = in_fresh(in0); const Frame F = fresh(F0); unsigned char* ws = fresh_ptr(ws0); final_phase(F, ws, in[36], args.out); }
#ifdef DBG_STOP
    if (lo == 100) { const Frame F = fresh(F0); unsigned char* ws = fresh_ptr(ws0);
        for (size_t e = (size_t)F.bid * NTHR + F.tid; e < (size_t)MTOK * DM; e += (size_t)F.G * NTHR) {
            const int m = (int)(e / DM), c = (int)(e % DM); float v;
            if (DBG_BUF == 0) v = bf2f(((const bf16_t*)(ws + WS_MIX))[e]);
            else if (DBG_BUF == 1) v = ((const float*)(ws + WS_ZS))[(size_t)m * ZS_COLS + c];
            else if (DBG_BUF == 2) v = ((const float*)(ws + WS_ZS))[(size_t)m * ZS_COLS + 2048 + c];
            else if (DBG_BUF == 3) v = bf2f(((const bf16_t*)(ws + WS_G))[(size_t)m * GCOLS + c]);
            else if (DBG_BUF == 4) v = ((const float*)(ws + WS_Y))[e];
            else v = bf2f(((const bf16_t*)(ws + WS_MERGED))[e]);
            args.out[e] = v; } }
#endif
#undef IN_PH
#undef SEAM
}

extern "C" void kernel_launch(void* const* d_in, const int* in_sizes, int n_in, void* d_out, int out_size, void* d_ws, size_t ws_size, hipStream_t stream) {
    static int grid = 0;
    if (grid == 0) {
        if (n_in != 37 || out_size != MTOK * DM || ws_size < WS_END) { fprintf(stderr, "kernel_launch: unexpected problem (n_in %d, out %d, ws %zu < %zu)\n", n_in, out_size, ws_size, (size_t)WS_END); grid = -1; return; }
        int dev = 0, cus = 0, per_cu = 0;
        if (hipGetDevice(&dev) != hipSuccess || hipDeviceGetAttribute(&cus, hipDeviceAttributeMultiprocessorCount, dev) != hipSuccess) { grid = -1; return; }
        if (hipFuncSetAttribute((const void*)hybrid_fwd, hipFuncAttributeMaxDynamicSharedMemorySize, LDS_BYTES) != hipSuccess) { fprintf(stderr, "kernel_launch: hipFuncSetAttribute failed\n"); grid = -1; return; }
        if (hipOccupancyMaxActiveBlocksPerMultiprocessor(&per_cu, (const void*)hybrid_fwd, NTHR, LDS_BYTES) != hipSuccess || per_cu < 1) fprintf(stderr, "kernel_launch: occupancy query says %d\n", per_cu);
        (void)hipGetLastError();
        grid = cus;
    }
    if (grid < 0) return;
    (void)hipMemsetAsync((char*)d_ws + WS_CTL, 0, CTL_ZERO_BYTES, stream);
    Args a{};
    for (int i = 0; i < 37; ++i) a.in.p[i] = (const float*)d_in[i];
    a.out = (float*)d_out; a.ws = (unsigned char*)d_ws;
#ifdef DBG_STOP
    for (int k = 0; k < DBG_STOP; ++k) { a.ph_lo = k; a.ph_hi = k + 1; hipLaunchKernelGGL(hybrid_fwd, dim3(grid), dim3(NTHR), LDS_BYTES, stream, a); }
    a.ph_lo = 100; a.ph_hi = 101; hipLaunchKernelGGL(hybrid_fwd, dim3(grid), dim3(NTHR), LDS_BYTES, stream, a);
#elif MK_N_LAUNCHES == 1
    a.ph_lo = 0; a.ph_hi = N_PHASES;
    hipLaunchKernelGGL(hybrid_fwd, dim3(grid), dim3(NTHR), LDS_BYTES, stream, a);
#else
    for (int k = 0; k < N_PHASES; ++k) { a.ph_lo = k; a.ph_hi = k + 1; hipLaunchKernelGGL(hybrid_fwd, dim3(grid), dim3(NTHR), LDS_BYTES, stream, a); }
#endif
}
```

```cpp
#include <hip/hip_runtime.h>
#include <cstdio>
#include <cstdint>

#ifndef MK_N_LAUNCHES
#define MK_N_LAUNCHES 1
#endif

#define LAS __attribute__((address_space(3)))
#define GAS __attribute__((address_space(1)))
typedef unsigned short bf16_t;
typedef short bf16x8 __attribute__((ext_vector_type(8)));
typedef short s16x4 __attribute__((ext_vector_type(4)));
typedef float f32x4 __attribute__((ext_vector_type(4)));
typedef float f32x2 __attribute__((ext_vector_type(2)));
typedef float f32x16 __attribute__((ext_vector_type(16)));
typedef unsigned u32x4 __attribute__((ext_vector_type(4)));
typedef unsigned u32x2 __attribute__((ext_vector_type(2)));
#define DI __device__ __forceinline__

constexpr int NB = 4, SEQ = 2048, DM = 2048, MTOK = NB * SEQ, NL = 4, MIX = 512, DFF = 5504, DFF2 = 2 * DFF;
constexpr int IN_COLS = 13060, NZ = 13312, ZS_COLS = 5120, GCOLS = 8192;
constexpr int B_COLS = 1984;
constexpr int ZO_R = 0, ZO_K = 512, ZO_V = 1024, ZO_LW = 1536, ZO_LA = 1632, ZO_LG = 1728;
constexpr int ZO_Q = 2048, ZO_AK = 2560, ZO_AV = 3072, ZO_QI = 3584, ZO_KI = 3840, ZO_WI = 3904, ZO_C = 4096, ZO_D = 4608;
constexpr float RMS_EPS = 1e-6f, GN_EPS = 64e-5f;

constexpr size_t MiB = 1u << 20;
constexpr size_t WS_CTL = 0, CTL_ZERO_BYTES = 1 * MiB;
constexpr size_t WS_ROPE = 1 * MiB;
constexpr size_t WS_PARTA = 2 * MiB;
constexpr size_t WS_PARTB = 3 * MiB;
constexpr size_t WS_SSTATE = 4 * MiB;
constexpr size_t WS_WI = 5 * MiB;
constexpr size_t WS_KI = 6 * MiB;
constexpr size_t WS_MASK = 7 * MiB;
constexpr size_t WS_QI = 9 * MiB;
constexpr size_t WS_Q = 13 * MiB;
constexpr size_t WS_K = 21 * MiB;
constexpr size_t WS_VT = 29 * MiB;
constexpr size_t WS_Y = 37 * MiB;
constexpr size_t WS_YB = 101 * MiB;
constexpr size_t WS_MIX = 133 * MiB;
constexpr size_t WS_MERGED = 165 * MiB;
constexpr size_t WS_YS = 197 * MiB;
constexpr size_t WS_YSB = 213 * MiB;
constexpr size_t WS_RW = 221 * MiB;
constexpr size_t RW_STRIDE = 16 * MiB;
constexpr size_t WS_SC = 333 * MiB;
constexpr size_t WS_MF = 1368 * MiB;
constexpr size_t WS_ZS = 461 * MiB;
constexpr size_t WS_G = 621 * MiB;
constexpr size_t WS_U = 461 * MiB;
constexpr size_t WS_ACT = 749 * MiB;
constexpr size_t WS_WT = 836 * MiB;
constexpr size_t WT_IN = 0, WT_BR = 52 * MiB, WT_OUT = 60 * MiB, WT_UP = 68 * MiB, WT_DOWN = 111 * MiB, WT_GLU = 111 * MiB + 22544384, WT_LAYER = 133 * MiB;
constexpr size_t WS_YRAW = WS_MF + 192 * MiB;
constexpr size_t WS_WTL = WS_YRAW + 16 * MiB;
constexpr size_t WS_END = WS_WTL + 2 * MiB;
static_assert(WS_WT + 4 * WT_LAYER == WS_MF, "ws map");
static_assert(WT_GLU + 524288 <= WT_LAYER, "wt map");
static_assert(WS_U + (size_t)MTOK * DFF2 * 2 <= WS_ACT && WS_ACT + (size_t)MTOK * DFF * 2 <= WS_WT, "ws map");

constexpr int CW_BAR = 4096;

constexpr int RING_BYTES = 131072;
constexpr int MISC_OFF = RING_BYTES;
constexpr int RST_OFF = RING_BYTES + 1024;
constexpr int LDS_BYTES = 147456;
constexpr int NWAVES = 8, NTHR = 512;

DI unsigned f2bf(float f) { unsigned u = __builtin_bit_cast(unsigned, f); return (u + 0x7fffu + ((u >> 16) & 1u)) >> 16; }
DI unsigned cvt_pk_bf16(float lo, float hi);
DI unsigned pk2(float lo, float hi) { return cvt_pk_bf16(lo, hi); }
DI float bf2f(unsigned b) { return __builtin_bit_cast(float, b << 16); }
typedef __bf16 bf16x2v __attribute__((ext_vector_type(2)));
DI unsigned cvt_pk_bf16(float lo, float hi) { const f32x2 v = {lo, hi}; const bf16x2v b = __builtin_convertvector(v, bf16x2v); return __builtin_bit_cast(unsigned, b); }
DI float wave_sum(float v) {
#pragma unroll
    for (int o = 1; o < 64; o <<= 1) v += __shfl_xor(v, o);
    return v;
}
template <int CTRL> DI float dpp_xadd(float x) { const int r = __builtin_amdgcn_update_dpp(0, __builtin_bit_cast(int, x), CTRL, 0xF, 0xF, true); return x + __builtin_bit_cast(float, r); }
DI float row16_sum(float x) { x = dpp_xadd<0xB1>(x); x = dpp_xadd<0x4E>(x); x = dpp_xadd<0x141>(x); x = dpp_xadd<0x140>(x); return x; }
DI float sigmoidf_(float x) { return __builtin_amdgcn_rcpf(1.0f + __expf(-x)); }
#define LDS_WAIT() asm volatile("s_waitcnt lgkmcnt(0)" ::: "memory")
#define VM_WAIT() asm volatile("s_waitcnt vmcnt(0)" ::: "memory")
#define MFMA32(a, b, c) __builtin_amdgcn_mfma_f32_32x32x16_bf16((a), (b), (c), 0, 0, 0)

#define XB_TMO      128
#define XB_XCNT(j)  (256  + 64 * (j))
#define XB_XSUB(j)  (1280 + 64 * (j))
#define XB_XGEN(j)  (2304 + 64 * (j))
#define XB_TOP      3328
#define XB_TOPGEN   3392
#define XCD_BAR_WORDS 3456
#define XB_SPIN_CAP (1u << 21)
DI unsigned xb_ld(unsigned* p)              { return __hip_atomic_load(p, __ATOMIC_RELAXED, __HIP_MEMORY_SCOPE_AGENT); }
DI unsigned xb_add(unsigned* p, unsigned v) { return __hip_atomic_fetch_add(p, v, __ATOMIC_RELAXED, __HIP_MEMORY_SCOPE_AGENT); }
DI unsigned xb_xcc_id() { return (unsigned)__builtin_amdgcn_s_getreg((3 << 11) | 20) & 0xFu; }
#define XB_SPIN(cond, bar) do { unsigned _sp = 0; while (cond) { __builtin_amdgcn_s_sleep(1); \
    if ((++_sp & 255u) == 0u) { if (xb_ld(&(bar)[XB_TMO])) break; if (_sp > XB_SPIN_CAP) { atomicAdd(&(bar)[XB_TMO], 1u); break; } } } } while (0)
struct XcdBarrier { unsigned* bar; unsigned x; volatile LAS unsigned* st; };
DI XcdBarrier xcd_barrier_post(unsigned* bar, volatile LAS unsigned* st) {
    XcdBarrier b; b.bar = bar; b.x = xb_xcc_id(); b.st = st;
    if (threadIdx.x == 0) (void)xb_add(&bar[XB_XCNT(b.x)], 1u);
    return b;
}
DI void xcd_barrier_complete(unsigned* bar, unsigned x, unsigned& nloc, unsigned& nx) {
    const unsigned G = gridDim.x * gridDim.y * gridDim.z;
    unsigned sum, cnt, mine, sp = 0u;
    for (;;) {
        sum = 0u; cnt = 0u; mine = 0u;
#pragma unroll
        for (unsigned j = 0; j < 16; ++j) { const unsigned c = xb_ld(&bar[XB_XCNT(j)]); sum += c; cnt += (c > 0u) ? 1u : 0u; mine = (j == x) ? c : mine; }
        if (sum == G) break;
        __builtin_amdgcn_s_sleep(1);
        if ((++sp & 255u) == 0u) { if (xb_ld(&bar[XB_TMO])) break; if (sp > XB_SPIN_CAP) { atomicAdd(&bar[XB_TMO], 1u); break; } }
    }
    nloc = mine > 0u ? mine : 1u; nx = cnt > 0u ? cnt : 1u;
}
DI void xcd_barrier(const XcdBarrier& b) {
    asm volatile("s_waitcnt vmcnt(0)" ::: "memory");
    __syncthreads();
    if (threadIdx.x == 0) {
        unsigned* bar = b.bar;
        __builtin_amdgcn_s_waitcnt(0);
        unsigned nloc = b.st[0], nx = b.st[1];
        if (nloc == 0u) { xcd_barrier_complete(bar, b.x, nloc, nx); b.st[0] = nloc; b.st[1] = nx; }
        const unsigned old = xb_add(&bar[XB_XSUB(b.x)], 1u);
        const unsigned gen = old / nloc;
        if (old + 1u == (gen + 1u) * nloc) {
            __builtin_amdgcn_fence(__ATOMIC_RELEASE, "agent");
            asm volatile("s_waitcnt vmcnt(0)" ::: "memory");
            const unsigned og = xb_add(&bar[XB_TOP], 1u);
            const unsigned tg = og / nx;
            if (og + 1u == (tg + 1u) * nx) xb_add(&bar[XB_TOPGEN], 1u);
            else XB_SPIN(xb_ld(&bar[XB_TOPGEN]) == tg, bar);
            __builtin_amdgcn_fence(__ATOMIC_ACQUIRE, "agent");
            xb_add(&bar[XB_XGEN(b.x)], 1u);
            asm volatile("s_waitcnt vmcnt(0)" ::: "memory");
        } else {
            XB_SPIN(xb_ld(&bar[XB_XGEN(b.x)]) == gen, bar);
            __builtin_amdgcn_fence(__ATOMIC_ACQUIRE, "agent");
            asm volatile("s_waitcnt vmcnt(0)" ::: "memory");
        }
    }
    __syncthreads();
}

namespace pg8 {
constexpr int BM = 256, BK = 64, HALF = 128, HTB = HALF * BK * 2, STAGE_BYTES = 8 * HTB, NXCD = 8, WGM = 8;
DI int lds_byte(int r, int c) { const int st = (r >> 4) * 2 + (c >> 5), rr = r & 15, cc = c & 31, ob = rr * 64 + cc * 2; return st * 1024 + (ob ^ (((ob >> 9) & 1) << 5)); }
DI void stage_rc(int b, int& R, int& C) { const int st = b / 1024, sb = b % 1024, swz = sb ^ (((sb >> 9) & 1) << 5); R = (st >> 1) * 16 + swz / 64; C = (st & 1) * 32 + (swz % 64) / 2; }
DI int perm32(int rho) { const int n = rho >> 4, i = rho & 15; return 8 * (i >> 2) + 4 * n + (i & 3); }

struct Unit { int pm, pn, sub; long offA, offB; };
struct Gemm { const bf16_t* A; const bf16_t* Bt; int lda, ldb, K; };

struct Order {
    int nM, nN, nwg, G, c, lda, ldb, nsub, subA, subB;
    DI void init(int nM_, int nN_, int G_, int c_, int lda_, int ldb_, int nsub_ = 1, int subA_ = 0, int subB_ = 0) { nM = nM_; nN = nN_; nwg = nM * nN; G = G_; c = c_; lda = lda_; ldb = ldb_; nsub = nsub_; subA = subA_; subB = subB_; }
    DI bool next(int i, Unit& u) const {
        const int ti = i / nsub, sub = i - ti * nsub;
        const long L = (long)ti * G + c; if (L >= nwg) return false;
        int wgid = (int)L; { const int q = nwg / NXCD, r = nwg % NXCD, xcd = wgid % NXCD, off = wgid / NXCD; wgid = (xcd < r ? xcd * (q + 1) : r * (q + 1) + (xcd - r) * q) + off; }
        const int nig = WGM * nN, gid = wgid / nig, fm = gid * WGM, gsz = (nM - fm) < WGM ? (nM - fm) : WGM;
        u.pm = fm + ((wgid % nig) % gsz); u.pn = (wgid % nig) / gsz; u.sub = sub;
        u.offA = ((long)u.pm * BM * lda + (long)sub * subA) * 2; u.offB = ((long)u.pn * BM + (long)sub * subB) * (long)ldb * 2;
        return true;
    }
};

struct OrderLin {
    int c, G, nu, pnbase, lda, ldb;
    DI bool next(int i, Unit& u) const { const int v = c + i * G; if (v >= nu) return false; u.pm = v & 31; u.pn = pnbase + (v >> 5); u.sub = 0;
        u.offA = (long)u.pm * BM * lda * 2; u.offB = (long)u.pn * BM * (long)ldb * 2; return true; }
};
struct OrderTri {
    int pm, k, pnbase, lda, ldb;
    DI bool next(int i, Unit& u) const { const int cnt = k < 5 ? k + 1 : (k == 5 ? 7 : 6), st = k <= 5 ? (k * (k + 1)) / 2 : 22;
        if (i >= cnt) return false; u.pm = pm; u.pn = pnbase + st + i; u.sub = 0;
        u.offA = (long)u.pm * BM * lda * 2; u.offB = (long)u.pn * BM * (long)ldb * 2; return true; }
};
template <class Epi, class Sched, bool ALIGN_EPI>
DI void gemm_phase(LAS unsigned char* lds, const int tid, const Gemm g, const Sched& S, const Epi& E) {
    const int wid = __builtin_amdgcn_readfirstlane(tid >> 6), lane = tid & 63, wr = wid >> 2, wc = wid & 3, fr = lane & 15, fq = lane >> 4;
    const int K = g.K, nt = K / BK;
    unsigned voffA[2], voffB[2];
#pragma unroll
    for (int i = 0; i < 2; ++i) { int R, C; stage_rc(tid * 16 + i * 8192, R, C); const int Rb = Epi::PERM ? ((R & ~31) + perm32(R & 31)) : R;
        voffA[i] = (unsigned)(R * g.lda + C) * 2u; voffB[i] = (unsigned)(Rb * g.ldb + C) * 2u; }
    const size_t kstep = (size_t)(BK * 2);
    const size_t hstepA = (size_t)HALF * g.lda * 2, hstepB = (size_t)HALF * g.ldb * 2;
    const unsigned ldsw = (unsigned)wid * 1024u;
    const int aoff = lds_byte(wr * 64 + fr, fq * 8), boff = lds_byte(wc * 32 + fr, fq * 8);
#define PG8_SA(b, h) (((b) * 2 + (h)) * HTB)
#define PG8_SB(b, h) ((4 + (b) * 2 + (h)) * HTB)
#define PG8_STAGE(bufoff, gbase, voff) do { _Pragma("unroll") for (int _i = 0; _i < 2; ++_i) \
        __builtin_amdgcn_global_load_lds((const unsigned*)((const char*)(gbase) + (voff)[_i]), (LAS unsigned*)(lds + (bufoff) + ldsw + _i * 8192), 16, 0, 0); } while (0)
#define PG8_LDA(dst, b, h) do { _Pragma("unroll") for (int m = 0; m < 4; ++m) _Pragma("unroll") for (int k = 0; k < 2; ++k) dst[m][k] = *(const LAS bf16x8*)(lds + PG8_SA(b, h) + aoff + m * 2048 + k * 1024); } while (0)
#define PG8_LDB(dst, b, h) do { _Pragma("unroll") for (int n = 0; n < 2; ++n) _Pragma("unroll") for (int k = 0; k < 2; ++k) dst[n][k] = *(const LAS bf16x8*)(lds + PG8_SB(b, h) + boff + n * 2048 + k * 1024); } while (0)
#define PG8_MMA(ai, bj, At, Bt) do { __builtin_amdgcn_s_setprio(1); _Pragma("unroll") for (int m = 0; m < 4; ++m) _Pragma("unroll") for (int n = 0; n < 2; ++n) _Pragma("unroll") for (int k = 0; k < 2; ++k) \
        acc[ai][bj][m][n] = __builtin_amdgcn_mfma_f32_16x16x32_bf16(Bt[n][k], At[m][k], acc[ai][bj][m][n], 0, 0, 0); __builtin_amdgcn_s_setprio(0); } while (0)
#define PG8_WAIT_V(n) asm volatile("s_waitcnt vmcnt(" #n ")" ::: "memory")
#define PG8_WAIT_L(n) asm volatile("s_waitcnt lgkmcnt(" #n ")" ::: "memory")
#define PG8_BAR __builtin_amdgcn_s_barrier()
#define PG8_SCHED __builtin_amdgcn_sched_barrier(0)
    Unit cur, nxt; int ui = 0;
    if (!S.next(0, cur)) return;
    f32x4 acc[2][2][4][2];
#pragma unroll
    for (int a = 0; a < 2; ++a)
#pragma unroll
        for (int b = 0; b < 2; ++b)
#pragma unroll
            for (int m = 0; m < 4; ++m)
#pragma unroll
                for (int n = 0; n < 2; ++n) acc[a][b][m][n] = (f32x4){0.f, 0.f, 0.f, 0.f};
    bf16x8 At[4][2], B0[2][2], B1[2][2];
    const char* cA = (const char*)g.A + cur.offA; const char* cB = (const char*)g.Bt + cur.offB;
    PG8_STAGE(PG8_SB(0, 0), cB, voffB); PG8_STAGE(PG8_SB(0, 1), cB + hstepB, voffB); PG8_STAGE(PG8_SA(0, 0), cA, voffA); PG8_STAGE(PG8_SA(0, 1), cA + hstepA, voffA);
    if (wr == 1) PG8_BAR;
    PG8_WAIT_V(2); PG8_BAR;
    PG8_STAGE(PG8_SB(1, 0), cB + kstep, voffB); PG8_STAGE(PG8_SA(1, 0), cA + kstep, voffA); PG8_STAGE(PG8_SB(1, 1), cB + hstepB + kstep, voffB);
    PG8_WAIT_V(6); PG8_BAR;
    for (;;) {
        const bool has_next = S.next(ui + 1, nxt);
        const char* nA = has_next ? (const char*)g.A + nxt.offA : cA; const char* nB = has_next ? (const char*)g.Bt + nxt.offB : cB;
        for (int t = 0; t < nt; t += 2) {
            const bool last = (t == nt - 2);
            const char* a1 = cA + (size_t)(t + 1) * kstep;
            const char* a2 = last ? nA : cA + (size_t)(t + 2) * kstep; const char* b2 = last ? nB : cB + (size_t)(t + 2) * kstep;
            const char* a3 = a2 + kstep; const char* b3 = b2 + kstep;
            PG8_LDB(B0, 0, 0); PG8_LDB(B1, 0, 1); PG8_SCHED; PG8_LDA(At, 0, 0); PG8_STAGE(PG8_SA(1, 1), a1 + hstepA, voffA);
            PG8_WAIT_V(8); PG8_WAIT_L(0); PG8_BAR; PG8_MMA(0, 0, At, B0); PG8_MMA(0, 1, At, B1); PG8_BAR; PG8_SCHED;
            PG8_LDA(At, 0, 1); PG8_STAGE(PG8_SB(0, 0), b2, voffB); PG8_STAGE(PG8_SB(0, 1), b2 + hstepB, voffB); PG8_STAGE(PG8_SA(0, 0), a2, voffA);
            PG8_WAIT_V(8); PG8_WAIT_L(0); PG8_BAR; PG8_MMA(1, 0, At, B0); PG8_MMA(1, 1, At, B1); PG8_BAR; PG8_SCHED;
            PG8_LDB(B0, 1, 0); PG8_LDB(B1, 1, 1); PG8_SCHED; PG8_LDA(At, 1, 0); PG8_STAGE(PG8_SA(0, 1), a2 + hstepA, voffA);
            PG8_WAIT_V(8); PG8_WAIT_L(0); PG8_BAR; PG8_MMA(0, 0, At, B0); PG8_MMA(0, 1, At, B1); PG8_BAR; PG8_SCHED;
            PG8_LDA(At, 1, 1); PG8_STAGE(PG8_SB(1, 0), b3, voffB); PG8_STAGE(PG8_SB(1, 1), b3 + hstepB, voffB); PG8_STAGE(PG8_SA(1, 0), a3, voffA);
            PG8_WAIT_V(8); PG8_WAIT_L(0); PG8_BAR; PG8_MMA(1, 0, At, B0); PG8_MMA(1, 1, At, B1); PG8_BAR; PG8_SCHED;
        }
        if constexpr (ALIGN_EPI) { if (wr == 0) PG8_BAR; }
        E(acc, cur, wr, wc, fr, fq);
        if (!has_next) break;
#pragma unroll
        for (int a = 0; a < 2; ++a)
#pragma unroll
            for (int b = 0; b < 2; ++b)
#pragma unroll
                for (int m = 0; m < 4; ++m)
#pragma unroll
                    for (int n = 0; n < 2; ++n) acc[a][b][m][n] = (f32x4){0.f, 0.f, 0.f, 0.f};
        cur = nxt; cA = nA; cB = nB; ++ui;
        if constexpr (ALIGN_EPI) { if (wr == 1) PG8_BAR; }
    }
    PG8_WAIT_V(0);
    if constexpr (!ALIGN_EPI) { if (wr == 0) PG8_BAR; }
    PG8_BAR;
#undef PG8_SA
#undef PG8_SB
#undef PG8_STAGE
#undef PG8_LDA
#undef PG8_LDB
#undef PG8_MMA
#undef PG8_WAIT_V
#undef PG8_WAIT_L
#undef PG8_BAR
#undef PG8_SCHED
}

typedef const f32x4 (&AccRef)[2][2][4][2];
DI float row_scale_slow(const float* part, int row) { float s = 0.f; for (int i = 0; i < 32; ++i) s += part[(size_t)row * 32 + i]; return 1.0f / sqrtf(s * (1.0f / DM) + RMS_EPS); }

struct EpiZ {
    static constexpr bool PERM = true;
    float* ZS; bf16_t* G; const float* bgate; const float* part; const LAS float* rsT; int pm0;
    DI void operator()(AccRef acc, const Unit& u, int wr, int wc, int fr, int fq) const {
#pragma unroll
        for (int ai = 0; ai < 2; ++ai)
#pragma unroll
            for (int m = 0; m < 4; ++m) {
                const int lr = ai * HALF + wr * 64 + m * 16 + fr, row = u.pm * BM + lr;
                const float s = (u.pm == pm0) ? rsT[lr] : row_scale_slow(part, row);
#pragma unroll
                for (int bj = 0; bj < 2; ++bj) {
                    const int col0 = u.pn * BM + bj * HALF + wc * 32 + 8 * fq;
                    f32x4 v0 = acc[ai][bj][m][0] * s, v1 = acc[ai][bj][m][1] * s;
                    if (u.pn < 20) { float* p = ZS + (size_t)row * ZS_COLS + col0; *(f32x4*)p = v0; *(f32x4*)(p + 4) = v1; }
                    else { const int gc = col0 - ZS_COLS; const f32x4 b0 = *(const f32x4*)(bgate + gc), b1 = *(const f32x4*)(bgate + gc + 4);
                        v0 += b0; v1 += b1;
                        u32x4 w; w.x = cvt_pk_bf16(sigmoidf_(v0[0]), sigmoidf_(v0[1])); w.y = cvt_pk_bf16(sigmoidf_(v0[2]), sigmoidf_(v0[3]));
                        w.z = cvt_pk_bf16(sigmoidf_(v1[0]), sigmoidf_(v1[1])); w.w = cvt_pk_bf16(sigmoidf_(v1[2]), sigmoidf_(v1[3]));
                        *(u32x4*)(G + (size_t)row * GCOLS + gc) = w; }
                }
            }
    }
};
struct EpiU {
    static constexpr bool PERM = true;
    bf16_t* U; int ldc; const float* part; const LAS float* rsT; int pm0;
    DI void operator()(AccRef acc, const Unit& u, int wr, int wc, int fr, int fq) const {
#pragma unroll
        for (int ai = 0; ai < 2; ++ai)
#pragma unroll
            for (int m = 0; m < 4; ++m) {
                const int lr = ai * HALF + wr * 64 + m * 16 + fr, row = u.pm * BM + lr;
                const float s = (u.pm == pm0) ? rsT[lr] : row_scale_slow(part, row);
#pragma unroll
                for (int bj = 0; bj < 2; ++bj) {
                    const int col0 = u.pn * BM + bj * HALF + wc * 32 + 8 * fq;
                    const f32x4 v0 = acc[ai][bj][m][0] * s, v1 = acc[ai][bj][m][1] * s;
                    u32x4 w; w.x = cvt_pk_bf16(v0[0], v0[1]); w.y = cvt_pk_bf16(v0[2], v0[3]); w.z = cvt_pk_bf16(v1[0], v1[1]); w.w = cvt_pk_bf16(v1[2], v1[3]);
                    *(u32x4*)(U + (size_t)row * ldc + col0) = w;
                }
            }
    }
};
struct EpiRes {
    static constexpr bool PERM = false;
    const float* Yin; float* Y; bf16_t* YB; float* part;
    DI void operator()(AccRef acc, const Unit& u, int wr, int wc, int fr, int fq) const {
#pragma unroll
        for (int ai = 0; ai < 2; ++ai)
#pragma unroll
            for (int m = 0; m < 4; ++m) {
                const int row = u.pm * BM + ai * HALF + wr * 64 + m * 16 + fr;
                float ss = 0.f;
#pragma unroll
                for (int bj = 0; bj < 2; ++bj)
#pragma unroll
                    for (int n = 0; n < 2; ++n) {
                        const int col = u.pn * BM + bj * HALF + wc * 32 + 16 * n + 4 * fq;
                        const size_t o = (size_t)row * DM + col;
                        const f32x4 y = *(const f32x4*)(Yin + o) + acc[ai][bj][m][n];
                        *(f32x4*)(Y + o) = y;
                        u32x2 w; w.x = cvt_pk_bf16(y[0], y[1]); w.y = cvt_pk_bf16(y[2], y[3]);
                        *(u32x2*)(YB + o) = w;
                        ss += (y[0] * y[0] + y[1] * y[1]) + (y[2] * y[2] + y[3] * y[3]);
                    }
                ss += __shfl_xor(ss, 16); ss += __shfl_xor(ss, 32);
                if (fq == 0) part[(size_t)row * 32 + u.pn * 4 + wc] = ss;
            }
    }
};
struct EpiGlu {
    static constexpr bool PERM = true;
    const float* YS; const float* bias; bf16_t* MIXp;
    DI void operator()(AccRef acc, const Unit& u, int wr, int wc, int fr, int fq) const {
#pragma unroll
        for (int ai = 0; ai < 2; ++ai)
#pragma unroll
            for (int m = 0; m < 4; ++m) {
                const int row = u.pm * BM + ai * HALF + wr * 64 + m * 16 + fr;
#pragma unroll
                for (int bj = 0; bj < 2; ++bj) {
                    const int col0 = u.pn * BM + bj * HALF + wc * 32 + 8 * fq;
                    const f32x4 b0 = *(const f32x4*)(bias + col0), b1 = *(const f32x4*)(bias + col0 + 4);
                    const f32x4 y0 = *(const f32x4*)(YS + (size_t)row * MIX + col0), y1 = *(const f32x4*)(YS + (size_t)row * MIX + col0 + 4);
                    const f32x4 v0 = acc[ai][bj][m][0] + b0, v1 = acc[ai][bj][m][1] + b1;
                    u32x4 w; w.x = cvt_pk_bf16(y0[0] * sigmoidf_(v0[0]), y0[1] * sigmoidf_(v0[1])); w.y = cvt_pk_bf16(y0[2] * sigmoidf_(v0[2]), y0[3] * sigmoidf_(v0[3]));
                    w.z = cvt_pk_bf16(y1[0] * sigmoidf_(v1[0]), y1[1] * sigmoidf_(v1[1])); w.w = cvt_pk_bf16(y1[2] * sigmoidf_(v1[2]), y1[3] * sigmoidf_(v1[3]));
                    *(u32x4*)(MIXp + (size_t)row * (4 * MIX) + 3 * MIX + col0) = w;
                }
            }
    }
};
struct EpiMerge {
    static constexpr bool PERM = true;
    const bf16_t* G; float* MF; bf16_t* MERGED;
    DI void operator()(AccRef acc, const Unit& u, int wr, int wc, int fr, int fq) const {
#pragma unroll
        for (int ai = 0; ai < 2; ++ai)
#pragma unroll
            for (int m = 0; m < 4; ++m) {
                const int row = u.pm * BM + ai * HALF + wr * 64 + m * 16 + fr;
#pragma unroll
                for (int bj = 0; bj < 2; ++bj) {
                    const int col0 = u.pn * BM + bj * HALF + wc * 32 + 8 * fq;
                    const u32x4 gw = *(const u32x4*)(G + (size_t)row * GCOLS + u.sub * DM + col0);
                    f32x4 v0 = acc[ai][bj][m][0], v1 = acc[ai][bj][m][1];
                    v0[0] *= bf2f(gw.x & 0xffffu); v0[1] *= bf2f(gw.x >> 16); v0[2] *= bf2f(gw.y & 0xffffu); v0[3] *= bf2f(gw.y >> 16);
                    v1[0] *= bf2f(gw.z & 0xffffu); v1[1] *= bf2f(gw.z >> 16); v1[2] *= bf2f(gw.w & 0xffffu); v1[3] *= bf2f(gw.w >> 16);
                    float* p = MF + (size_t)row * DM + col0;
                    constexpr size_t SL = (size_t)MTOK * DM;
                    if (u.sub < 3) { *(f32x4*)(p + u.sub * SL) = v0; *(f32x4*)(p + u.sub * SL + 4) = v1; }
                    else { v0 += (*(const f32x4*)p + *(const f32x4*)(p + SL)) + *(const f32x4*)(p + 2 * SL); v1 += (*(const f32x4*)(p + 4) + *(const f32x4*)(p + SL + 4)) + *(const f32x4*)(p + 2 * SL + 4);
                        u32x4 w; w.x = cvt_pk_bf16(v0[0], v0[1]); w.y = cvt_pk_bf16(v0[2], v0[3]); w.z = cvt_pk_bf16(v1[0], v1[1]); w.w = cvt_pk_bf16(v1[2], v1[3]);
                        *(u32x4*)(MERGED + (size_t)row * DM + col0) = w; }
                }
            }
    }
};
}

struct Frame { LAS unsigned char* lds; int tid, lane, wave, bid, G; };

DI Frame fresh(const Frame& F0) { Frame F = F0; int tid = F0.tid, bid = F0.bid, G = F0.G, wave = F0.wave; unsigned lo = (unsigned)(size_t)F0.lds;
    asm volatile("" : "+v"(tid)); asm volatile("" : "+s"(bid), "+s"(G), "+s"(wave), "+s"(lo));
    F.tid = tid; F.lane = tid & 63; F.wave = wave; F.bid = bid; F.G = G; F.lds = (LAS unsigned char*)(size_t)lo; return F; }
DI unsigned char* fresh_ptr(unsigned char* p) { size_t z = 0; asm volatile("" : "+s"(z)); return p + z; }
DI void rs_table(const Frame& F, const float* part, int pm) {
    LAS float* rsT = (LAS float*)(F.lds + RST_OFF);
    if (F.tid < 256) { const int row = pm * 256 + F.tid; float s = 0.f;
#pragma unroll
        for (int i = 0; i < 8; ++i) { const f32x4 v = *(const f32x4*)(part + (size_t)row * 32 + 4 * i); s += (v[0] + v[1]) + (v[2] + v[3]); }
        rsT[F.tid] = 1.0f / sqrtf(s * (1.0f / DM) + RMS_EPS); }
    __syncthreads();
}

DI int head_perm(int c) { const int h = c >> 6, p = c & 63; const int dim = p < 16 ? ((p >> 1) + 8 * (p & 1)) : p; return (h << 6) + dim; }
DI int zin_colmap(int n) {
    if (n < B_COLS) return 1860 + n;
    if (n < 2048) return -1;
    if (n < 2560) return head_perm(n - 2048);
    if (n < 3072) return 512 + head_perm(n - 2560);
    if (n < 3584) return 1024 + (n - 3072);
    if (n < 3840) return 1536 + head_perm(n - 3584);
    if (n < 3904) return 1792 + head_perm(n - 3840);
    if (n < 3908) return 1856 + (n - 3904);
    if (n < 4096) return -1;
    if (n < 4608) return 3844 + (n - 4096);
    if (n < 5120) return 4356 + (n - 4608);
    return 4868 + (n - 5120);
}
template <int MODE>
DI void tr_item(const float* W, int ldw, const float* ksc, bf16_t* WT, int K, LAS float* scr, int kb, int nb, int lane) {
    const int k0 = 64 * kb, n0 = 32 * nb, nn = n0 + (lane & 31);
    const int col = MODE == 1 ? zin_colmap(nn) : nn;
    float tv[32];
    if (col >= 0) {
#pragma unroll
        for (int i = 0; i < 32; ++i) tv[i] = W[(size_t)(k0 + 2 * i + (lane >> 5)) * ldw + col];
        if (ksc) {
#pragma unroll
            for (int i = 0; i < 32; ++i) tv[i] *= ksc[k0 + 2 * i + (lane >> 5)]; }
    } else {
#pragma unroll
        for (int i = 0; i < 32; ++i) tv[i] = 0.f; }
#pragma unroll
    for (int i = 0; i < 32; ++i) scr[(2 * i + (lane >> 5)) * 33 + (lane & 31)] = tv[i];
    LDS_WAIT(); asm volatile("" ::: "memory");
    const int c = lane & 7;
#pragma unroll
    for (int j = 0; j < 4; ++j) { const int n = (lane >> 3) + 8 * j; const LAS float* s = scr + (8 * c) * 33 + n;
        u32x4 o; o.x = pk2(s[0 * 33], s[1 * 33]); o.y = pk2(s[2 * 33], s[3 * 33]); o.z = pk2(s[4 * 33], s[5 * 33]); o.w = pk2(s[6 * 33], s[7 * 33]);
        *(u32x4*)(WT + (size_t)(n0 + n) * K + k0 + 8 * c) = o; }
    LDS_WAIT(); asm volatile("" ::: "memory");
}
struct InTab { const float* p[37]; };
#define CAS __attribute__((address_space(4)))
typedef const float* fptr_t;
typedef GAS const float* gfptr_t;
struct In { CAS const gfptr_t* t; DI fptr_t operator[](int i) const { return (fptr_t)t[i]; } };
DI In in_fresh(In in) { CAS const gfptr_t* t = in.t; asm volatile("" : "+s"(t)); In r; r.t = t; return r; }
DI void p0_prologue(const Frame& F, const In& in, unsigned char* ws) {
    LAS float* scr = (LAS float*)(F.lds + F.wave * 16384);
    const int gw = F.bid * NWAVES + F.wave, NGW = F.G * NWAVES;
    constexpr int I_IN = 32 * (NZ / 32), I_BR = 4 * 8 * 64, I_OUT = 32 * 64, I_UP = 32 * (DFF2 / 32), I_DN = 86 * 64, I_GLU = 8 * 16;
    constexpr int I_LAYER = I_IN + I_BR + I_OUT + I_UP + I_DN + I_GLU;
    for (int it = gw; it < NL * I_LAYER; it += NGW) {
        const int l = it / I_LAYER; int r = it - l * I_LAYER;
        unsigned char* wt = ws + WS_WT + (size_t)l * WT_LAYER;
        if (r < I_IN) { const int nbk = NZ / 32; tr_item<1>(in[3] + (size_t)l * DM * IN_COLS, IN_COLS, in[2] + l * DM, (bf16_t*)(wt + WT_IN), DM, scr, r / nbk, r % nbk, F.lane); continue; } r -= I_IN;
        if (r < I_BR) { const int n = r / 512, rr = r % 512; tr_item<0>(in[29] + ((size_t)l * 4 + n) * MIX * DM, DM, nullptr, (bf16_t*)(wt + WT_BR) + (size_t)n * DM * MIX, MIX, scr, rr / 64, rr % 64, F.lane); continue; } r -= I_BR;
        if (r < I_OUT) { tr_item<0>(in[30] + (size_t)l * DM * DM, DM, nullptr, (bf16_t*)(wt + WT_OUT), DM, scr, r / 64, r % 64, F.lane); continue; } r -= I_OUT;
        if (r < I_UP) { const int nbk = DFF2 / 32; tr_item<0>(in[32] + (size_t)l * DM * DFF2, DFF2, in[31] + l * DM, (bf16_t*)(wt + WT_UP), DM, scr, r / nbk, r % nbk, F.lane); continue; } r -= I_UP;
        if (r < I_DN) { tr_item<0>(in[35] + (size_t)l * DFF * DM, DM, nullptr, (bf16_t*)(wt + WT_DOWN), DFF, scr, r / 64, r % 64, F.lane); continue; } r -= I_DN;
        tr_item<0>(in[27] + (size_t)l * MIX * MIX, MIX, nullptr, (bf16_t*)(wt + WT_GLU), MIX, scr, r / 16, r % 16, F.lane);
    }
    { bf16_t* WTL = (bf16_t*)(ws + WS_WTL);
      for (int e = F.bid * NTHR + F.tid; e < NL * 56 * MIX; e += F.G * NTHR) { const int n = e % MIX, k8 = (e / MIX) % 56, l = e / (MIX * 56); const int k0 = k8 * 8;
          const float* src = k0 < 96 ? in[8] + ((size_t)l * 96 + k0) * MIX : (k0 < 192 ? in[10] + ((size_t)l * 96 + (k0 - 96)) * MIX : in[11] + ((size_t)l * 256 + (k0 - 192)) * MIX);
          u32x4 o; o.x = pk2(src[n], src[MIX + n]); o.y = pk2(src[2 * MIX + n], src[3 * MIX + n]); o.z = pk2(src[4 * MIX + n], src[5 * MIX + n]); o.w = pk2(src[6 * MIX + n], src[7 * MIX + n]);
          *(u32x4*)(WTL + ((size_t)l * MIX + n) * 448 + k0) = o; } }
    const int* pos = (const int*)in[1];
    float* rope = (float*)(ws + WS_ROPE);
    for (int e = F.bid * NTHR + F.tid; e < MTOK * 8; e += F.G * NTHR) { const int m = e >> 3, i = e & 7;
        const float inv = exp2f(-(float)i * 0.125f * 18.931568569324174f);
        const float ang = (float)pos[m] * inv; float sn, cs; sincosf(ang, &sn, &cs);
        rope[m * 16 + i] = cs; rope[m * 16 + 8 + i] = sn; }
    const float* x = in[0]; bf16_t* YB = (bf16_t*)(ws + WS_YB); float* pa = (float*)(ws + WS_PARTA);
    for (int m = gw; m < MTOK; m += NGW) { float s = 0.f;
#pragma unroll
        for (int j = 0; j < 8; ++j) { const f32x4 v = *(const f32x4*)(x + (size_t)m * DM + (j * 64 + F.lane) * 4); s += (v[0] * v[0] + v[1] * v[1]) + (v[2] * v[2] + v[3] * v[3]);
            u32x2 w; w.x = pk2(v[0], v[1]); w.y = pk2(v[2], v[3]); *(u32x2*)(YB + (size_t)m * DM + (j * 64 + F.lane) * 4) = w; }
        s = wave_sum(s);
        if (F.lane < 32) pa[(size_t)m * 32 + F.lane] = (F.lane == 0) ? s : 0.f; }
}

DI void dsa_prep_item(const Frame& F, unsigned char* ws, const float* idxg, int item) {
    const float* ZS = (const float*)(ws + WS_ZS); const float* rope = (const float*)(ws + WS_ROPE);
    bf16_t* Q = (bf16_t*)(ws + WS_Q); bf16_t* Kb = (bf16_t*)(ws + WS_K); bf16_t* VT = (bf16_t*)(ws + WS_VT); bf16_t* QI = (bf16_t*)(ws + WS_QI); bf16_t* KI = (bf16_t*)(ws + WS_KI); float* WI = (float*)(ws + WS_WI);
    const int m0 = item * 64;
#pragma unroll 4
    for (int e = F.tid; e < 64 * 640; e += NTHR) { const int t = e / 640, pc = e % 640; const int m = m0 + t;
        int zc, oc; bf16_t* dst; int ld; float sc = 1.f;
        if (pc < 256) { zc = ZO_Q + 2 * pc; oc = 2 * pc; dst = Q; ld = 512; sc = 0.125f; }
        else if (pc < 512) { zc = ZO_AK + 2 * (pc - 256); oc = 2 * (pc - 256); dst = Kb; ld = 512; }
        else { zc = ZO_QI + 2 * (pc - 512); oc = 2 * (pc - 512); dst = QI; ld = 256; }
        const f32x2 v = *(const f32x2*)(ZS + (size_t)m * ZS_COLS + zc); float a = v[0], b = v[1];
        const int p = oc & 63;
        if (p < 16) { const float cs = rope[m * 16 + (p >> 1)], sn = rope[m * 16 + 8 + (p >> 1)]; const float a2 = a * cs - b * sn, b2 = b * cs + a * sn; a = a2; b = b2; }
        *(unsigned*)(dst + (size_t)m * ld + oc) = pk2(a * sc, b * sc); }
    for (int tt = 0; tt < 8; ++tt) { const int m = m0 + F.wave * 8 + tt;
        const float xv = ZS[(size_t)m * ZS_COLS + ZO_KI + F.lane];
        const float ss = wave_sum(xv * xv);
        const int dim = F.lane < 16 ? ((F.lane >> 1) + 8 * (F.lane & 1)) : F.lane;
        float y = xv * (1.0f / sqrtf(ss * (1.0f / 64.f) + RMS_EPS)) * idxg[dim];
        const float pr = __shfl_xor(y, 1);
        if (F.lane < 16) { const float cs = rope[m * 16 + (F.lane >> 1)], sn = rope[m * 16 + 8 + (F.lane >> 1)]; y = (F.lane & 1) ? (y * cs + pr * sn) : (y * cs - pr * sn); }
        KI[(size_t)m * 64 + F.lane] = (bf16_t)f2bf(y);
        if (F.lane < 4) WI[(size_t)m * 4 + F.lane] = ZS[(size_t)m * ZS_COLS + ZO_WI + F.lane]; }
    LAS unsigned char* L = F.lds;
    for (int e = F.tid; e < 64 * 128; e += NTHR) { const int t = e >> 7, c4 = (e & 127) * 4;
        const f32x4 v = *(const f32x4*)(ZS + (size_t)(m0 + t) * ZS_COLS + ZO_AV + c4);
        u32x2 w; w.x = pk2(v[0], v[1]); w.y = pk2(v[2], v[3]); *(LAS u32x2*)(L + t * 1040 + c4 * 2) = w; }
    __syncthreads();
    { const int b = m0 / SEQ, s0 = m0 % SEQ;
      for (int e = F.tid; e < 512 * 8; e += NTHR) { const int c = e >> 3, oct = e & 7;
          unsigned short vals[8];
#pragma unroll
          for (int j = 0; j < 8; ++j) vals[j] = *(const LAS unsigned short*)(L + (oct * 8 + j) * 1040 + c * 2);
          u32x4 o; o.x = vals[0] | ((unsigned)vals[1] << 16); o.y = vals[2] | ((unsigned)vals[3] << 16); o.z = vals[4] | ((unsigned)vals[5] << 16); o.w = vals[6] | ((unsigned)vals[7] << 16);
          *(u32x4*)(VT + ((size_t)(b * 512 + c)) * SEQ + s0 + oct * 8) = o; } }
    __syncthreads();
}

DI float softplusf_(float x) { return fmaxf(x, 0.f) + __logf(1.0f + __expf(-fabsf(x))); }
DI float tanhf_(float x) { return 1.0f - 2.0f * __builtin_amdgcn_rcpf(1.0f + __expf(2.0f * x)); }
DI float half32_sum(float x) { x = row16_sum(x); return x + __shfl_xor(x, 16); }
DI void rwkv_prep_item(const Frame& F, unsigned char* ws, const In& in, int l, int item) {
    const float* ZS = (const float*)(ws + WS_ZS);
    const float* mu = in[6] + l * B_COLS; const float* w0 = in[7] + l * MIX; const float* a0 = in[9] + l * MIX; const float* k_k = in[12] + l * MIX; const float* k_a = in[13] + l * MIX;
    const bf16_t* WTL = (const bf16_t*)(ws + WS_WTL) + (size_t)l * MIX * 448;
    float* RW = (float*)(ws + WS_RW); constexpr size_t RS = RW_STRIDE / 4;
    const int m0 = item * 32; const bool first = (m0 % SEQ) == 0;
    constexpr int XP = 456;
    LAS bf16_t* X = (LAS bf16_t*)F.lds;
    for (int e = F.tid; e < 32 * 448; e += NTHR) { const int t = e / 448, c = e % 448; const int m = m0 + t, zc = ZO_LW + c;
        const float z = ZS[(size_t)m * ZS_COLS + zc]; const float zp = (first && t == 0) ? 0.f : ZS[(size_t)(m - 1) * ZS_COLS + zc];
        const float xs = z + (zp - z) * mu[zc];
        X[t * XP + c] = (bf16_t)f2bf(c < 96 ? tanhf_(xs) : (c < 192 ? xs : sigmoidf_(xs))); }
    __syncthreads();
    const int r = F.lane & 31, hh = F.lane >> 5, h = F.wave;
    float inv[16];
#pragma unroll
    for (int i = 0; i < 16; ++i) inv[i] = 0.f;
#pragma unroll
    for (int nt = 0; nt < 2; ++nt) { const int n = h * 64 + nt * 32 + r; const float muK = mu[ZO_K + n], kkn = k_k[n];
#pragma unroll
        for (int g = 0; g < 4; ++g) { const int tb = 8 * g + 4 * hh;
            float pk = (first && tb == 0) ? 0.f : ZS[(size_t)(m0 + tb - 1) * ZS_COLS + ZO_K + n];
#pragma unroll
            for (int j = 0; j < 4; ++j) { const float zk_ = ZS[(size_t)(m0 + tb + j) * ZS_COLS + ZO_K + n]; const float k = (zk_ + (pk - zk_) * muK) * kkn; pk = zk_; inv[4 * g + j] += k * k; } } }
#pragma unroll
    for (int i = 0; i < 16; ++i) inv[i] = 1.0f / fmaxf(sqrtf(half32_sum(inv[i])), 1e-12f);
    const LAS bf16_t* xa = X + r * XP + 8 * hh;
#pragma unroll 1
    for (int nt = 0; nt < 2; ++nt) { const int n = h * 64 + nt * 32 + r; const bf16_t* wrow = WTL + (size_t)n * 448 + 8 * hh;
        f32x16 aw, aa, ag;
#pragma unroll
        for (int i = 0; i < 16; ++i) { aw[i] = 0.f; aa[i] = 0.f; ag[i] = 0.f; }
#pragma unroll
        for (int s2 = 0; s2 < 6; ++s2) { aw = MFMA32(*(const LAS bf16x8*)(xa + 16 * s2), *(const bf16x8*)(wrow + 16 * s2), aw);
                                         aa = MFMA32(*(const LAS bf16x8*)(xa + 96 + 16 * s2), *(const bf16x8*)(wrow + 96 + 16 * s2), aa); }
#pragma unroll
        for (int s2 = 0; s2 < 16; ++s2) ag = MFMA32(*(const LAS bf16x8*)(xa + 192 + 16 * s2), *(const bf16x8*)(wrow + 192 + 16 * s2), ag);
        const float muR = mu[ZO_R + n], muK = mu[ZO_K + n], muV = mu[ZO_V + n], w0n = w0[n], a0n = a0[n], kkn = k_k[n], kan = k_a[n];
#pragma unroll
        for (int g = 0; g < 4; ++g) { const int tb = 8 * g + 4 * hh;
            float pr, pk, pv;
            if (first && tb == 0) { pr = 0.f; pk = 0.f; pv = 0.f; }
            else { const float* zp = ZS + (size_t)(m0 + tb - 1) * ZS_COLS; pr = zp[ZO_R + n]; pk = zp[ZO_K + n]; pv = zp[ZO_V + n]; }
#pragma unroll
            for (int j = 0; j < 4; ++j) { const int i = 4 * g + j, m = m0 + tb + j; const float* zr = ZS + (size_t)m * ZS_COLS;
                const float zr_ = zr[ZO_R + n], zk_ = zr[ZO_K + n], zv_ = zr[ZO_V + n];
                const float rr = zr_ + (pr - zr_) * muR, k = zk_ + (pk - zk_) * muK, v = zv_ + (pv - zv_) * muV;
                pr = zr_; pk = zk_; pv = zv_;
                const float wlog = -softplusf_(-(w0n + aw[i])) - 0.5f;
                const float decay = __expf(-__expf(wlog));
                const float a = sigmoidf_(a0n + aa[i]);
                const float kk = k * kkn * inv[i];
                const size_t o = (size_t)m * MIX + n;
                RW[0 * RS + o] = rr; RW[1 * RS + o] = decay; RW[2 * RS + o] = k * (1.0f + (a - 1.0f) * kan); RW[3 * RS + o] = v; RW[4 * RS + o] = -kk; RW[5 * RS + o] = kk * a; RW[6 * RS + o] = ag[i]; } } }
    __syncthreads();
}

DI void pool_item(const Frame& F, unsigned char* ws, const In& in, int l, int item) {
    const float* ZS = (const float*)(ws + WS_ZS); bf16_t* MIXp = (bf16_t*)(ws + WS_MIX);
    const float* pw = in[17] + (size_t)l * 4 * 128 * 128; const float* psc = in[18] + l * MIX;
    const int m0 = item * 16, t0 = m0 % SEQ;
    LAS float* Z = (LAS float*)F.lds;
    LAS float* DT = Z + 31 * 512;
    for (int e = F.tid; e < 31 * 128; e += NTHR) { const int r = e >> 7, c4 = (e & 127) * 4; const int ta = t0 - 15 + r;
        f32x4 v = (f32x4){0.f, 0.f, 0.f, 0.f};
        if (ta >= 0) v = *(const f32x4*)(ZS + (size_t)(m0 - 15 + r) * ZS_COLS + ZO_C + c4);
        *(LAS f32x4*)(Z + r * 512 + c4) = v; }
    __syncthreads();
    const int j = F.tid, gi = j >> 7, win = 2 << gi;
    for (int t = 0; t < 16; ++t) { float s = 0.f;
        for (int i = 0; i < win; ++i) s += Z[(15 + t - i) * 512 + j];
        const int cnt = (t0 + t + 1) < win ? (t0 + t + 1) : win;
        DT[j * 16 + t] = s / (float)cnt - Z[(15 + t) * 512 + j]; }
    __syncthreads();
    float acc[16];
#pragma unroll
    for (int t = 0; t < 16; ++t) acc[t] = 0.f;
    const int dcol = j & 127;
#pragma unroll 8
    for (int k = 0; k < 128; ++k) { const float wv = pw[((size_t)gi * 128 + k) * 128 + dcol];
#pragma unroll
        for (int q = 0; q < 4; ++q) { const f32x4 x = *(const LAS f32x4*)(DT + (gi * 128 + k) * 16 + 4 * q);
#pragma unroll
            for (int i = 0; i < 4; ++i) acc[4 * q + i] += x[i] * wv; } }
    const float sc = psc[j];
#pragma unroll
    for (int t = 0; t < 16; ++t) MIXp[(size_t)(m0 + t) * (4 * MIX) + 2 * MIX + j] = (bf16_t)f2bf(acc[t] * sc);
    __syncthreads();
}

struct SsmCoef { float lr, li; float br[16], bi[16]; };
DI void ssm_coef(const In& in, int l, int g, int p, SsmCoef& c) {
    const float are = in[19][((size_t)l * 32 + g) * 64 + p], aim = in[20][((size_t)l * 32 + g) * 64 + p];
    const float dt = expf(in[21][l * 32 + g]);
    const float er = expf(are * dt); float sn, cs; sincosf(aim * dt, &sn, &cs);
    c.lr = er * cs; c.li = er * sn;
    const float nr = c.lr - 1.0f, ni = c.li, den = are * are + aim * aim;
    const float cr = (nr * are + ni * aim) / den, ci = (ni * are - nr * aim) / den;
    const float* bre = in[22] + (((size_t)l * 32 + g) * 64 + p) * 16; const float* bim = in[23] + (((size_t)l * 32 + g) * 64 + p) * 16;
#pragma unroll
    for (int k = 0; k < 16; ++k) { const float x = bre[k], y = bim[k]; c.br[k] = cr * x - ci * y; c.bi[k] = cr * y + ci * x; }
}
DI void ssm_pass1_item(const Frame& F, unsigned char* ws, const In& in, int l, int item) {
    const float* ZS = (const float*)(ws + WS_ZS); float* SST = (float*)(ws + WS_SSTATE);
    const int wt = item * 8 + F.wave, b = wt >> 9, g = (wt >> 4) & 31, ch = wt & 15, p = F.lane;
    SsmCoef c; ssm_coef(in, l, g, p, c);
    LAS float* UL = (LAS float*)(F.lds + F.wave * 8192);
    const int mb = b * SEQ + ch * 128;
#pragma unroll
    for (int i = 0; i < 8; ++i) { const int e = i * 64 + F.lane, t = e >> 2, q = e & 3;
        *(LAS f32x4*)(UL + t * 16 + q * 4) = *(const f32x4*)(ZS + (size_t)(mb + t) * ZS_COLS + ZO_D + g * 16 + q * 4); }
    LDS_WAIT(); asm volatile("" ::: "memory");
    float xr = 0.f, xi = 0.f;
#pragma unroll 2
    for (int t = 0; t < 128; ++t) { float bur = 0.f, bui = 0.f;
#pragma unroll
        for (int q = 0; q < 4; ++q) { const f32x4 u = *(const LAS f32x4*)(UL + t * 16 + q * 4);
#pragma unroll
            for (int i = 0; i < 4; ++i) { bur += c.br[4 * q + i] * u[i]; bui += c.bi[4 * q + i] * u[i]; } }
        const float nr = c.lr * xr - c.li * xi + bur, ni = c.lr * xi + c.li * xr + bui; xr = nr; xi = ni; }
    *(f32x2*)(SST + ((size_t)wt * 64 + p) * 2) = (f32x2){xr, xi};
    LDS_WAIT(); asm volatile("" ::: "memory");
}
DI float gelu_tanh(float y) { const float u = 0.7978845608028654f * (y + 0.044715f * y * y * y); return 0.5f * y * (1.0f + tanhf(u)); }
DI void ssm_pass3_item(const Frame& F, unsigned char* ws, const In& in, int l, int item) {
    const float* ZS = (const float*)(ws + WS_ZS); const float* SST = (const float*)(ws + WS_SSTATE);
    float* YS = (float*)(ws + WS_YS); bf16_t* YSB = (bf16_t*)(ws + WS_YSB);
    const int wt = item * 8 + F.wave, b = wt >> 9, g = (wt >> 4) & 31, ch = wt & 15, p = F.lane;
    SsmCoef c; ssm_coef(in, l, g, p, c);
    LAS float* CL = (LAS float*)(F.lds + 98304);
    { const float* cre = in[24] + ((size_t)l * 32 + g) * 16 * 64; const float* cim = in[25] + ((size_t)l * 32 + g) * 16 * 64;
      for (int e = F.tid; e < 1024; e += NTHR) { const int cc = e >> 6, pp = e & 63; *(LAS f32x2*)(CL + cc * 132 + pp * 2) = (f32x2){cre[e], cim[e]}; } }
    __syncthreads();
    float l128r = c.lr, l128i = c.li;
#pragma unroll
    for (int i = 0; i < 7; ++i) { const float nr = l128r * l128r - l128i * l128i, ni = 2.f * l128r * l128i; l128r = nr; l128i = ni; }
    float xr = 0.f, xi = 0.f;
    for (int cc = 0; cc < ch; ++cc) { const f32x2 e = *(const f32x2*)(SST + ((size_t)(wt - ch + cc) * 64 + p) * 2);
        const float nr = l128r * xr - l128i * xi + e[0], ni = l128r * xi + l128i * xr + e[1]; xr = nr; xi = ni; }
    LAS float* UL = (LAS float*)(F.lds + F.wave * 12288);
    LAS float* XS = UL + 256;
    const int mb = b * SEQ + ch * 128;
    const float dsk = in[26][l * MIX + g * 16 + (F.lane & 15)];
    for (int sc = 0; sc < 8; ++sc) {
        { const int t = F.lane >> 2, q = F.lane & 3;
          *(LAS f32x4*)(UL + t * 16 + q * 4) = *(const f32x4*)(ZS + (size_t)(mb + sc * 16 + t) * ZS_COLS + ZO_D + g * 16 + q * 4); }
        LDS_WAIT(); asm volatile("" ::: "memory");
#pragma unroll 2
        for (int t = 0; t < 16; ++t) { float bur = 0.f, bui = 0.f;
#pragma unroll
            for (int q = 0; q < 4; ++q) { const f32x4 u = *(const LAS f32x4*)(UL + t * 16 + q * 4);
#pragma unroll
                for (int i = 0; i < 4; ++i) { bur += c.br[4 * q + i] * u[i]; bui += c.bi[4 * q + i] * u[i]; } }
            const float nr = c.lr * xr - c.li * xi + bur, ni = c.lr * xi + c.li * xr + bui; xr = nr; xi = ni;
            *(LAS f32x2*)(XS + (t * 64 + p) * 2) = (f32x2){xr, xi}; }
        LDS_WAIT(); asm volatile("" ::: "memory");
        const int cc = F.lane & 15, tq = F.lane >> 4;
        float y[4] = {0.f, 0.f, 0.f, 0.f};
#pragma unroll 4
        for (int pp = 0; pp < 64; pp += 2) { const f32x4 cv = *(const LAS f32x4*)(CL + cc * 132 + pp * 2);
#pragma unroll
            for (int jj = 0; jj < 4; ++jj) { const f32x4 xv = *(const LAS f32x4*)(XS + ((tq * 4 + jj) * 64 + pp) * 2);
                y[jj] += cv[0] * xv[0] - cv[1] * xv[1] + cv[2] * xv[2] - cv[3] * xv[3]; } }
#pragma unroll
        for (int jj = 0; jj < 4; ++jj) { const int t = tq * 4 + jj; const int m = mb + sc * 16 + t;
            const float yy = gelu_tanh(y[jj] + dsk * UL[t * 16 + cc]);
            YS[(size_t)m * MIX + g * 16 + cc] = yy; YSB[(size_t)m * MIX + g * 16 + cc] = (bf16_t)f2bf(yy); }
        LDS_WAIT(); asm volatile("" ::: "memory");
    }
    __syncthreads();
}

DI float vmul_(float a, float b) { float d; asm("v_mul_f32 %0, %1, %2" : "=v"(d) : "v"(a), "v"(b)); return d; }
DI float vfma_(float a, float b, float c) { float d; asm("v_fma_f32 %0, %1, %2, %3" : "=v"(d) : "v"(a), "v"(b), "v"(c)); return d; }
DI void row16_sum2(float& x0, float& x1) {
    asm("s_nop 1\n\t"
        "v_add_f32_dpp %0, %0, %0 quad_perm:[1,0,3,2] row_mask:0xf bank_mask:0xf bound_ctrl:1\n\tv_add_f32_dpp %1, %1, %1 quad_perm:[1,0,3,2] row_mask:0xf bank_mask:0xf bound_ctrl:1\n\ts_nop 0\n\t"
        "v_add_f32_dpp %0, %0, %0 quad_perm:[2,3,0,1] row_mask:0xf bank_mask:0xf bound_ctrl:1\n\tv_add_f32_dpp %1, %1, %1 quad_perm:[2,3,0,1] row_mask:0xf bank_mask:0xf bound_ctrl:1\n\ts_nop 0\n\t"
        "v_add_f32_dpp %0, %0, %0 row_half_mirror row_mask:0xf bank_mask:0xf bound_ctrl:1\n\tv_add_f32_dpp %1, %1, %1 row_half_mirror row_mask:0xf bank_mask:0xf bound_ctrl:1\n\ts_nop 0\n\t"
        "v_add_f32_dpp %0, %0, %0 row_mirror row_mask:0xf bank_mask:0xf bound_ctrl:1\n\tv_add_f32_dpp %1, %1, %1 row_mirror row_mask:0xf bank_mask:0xf bound_ctrl:1\n\ts_nop 1"
        : "+v"(x0), "+v"(x1));
}
DI void rwkv_scan_item(const Frame& F, unsigned char* ws, int item) {
    const float* RW = (const float*)(ws + WS_RW); constexpr size_t RS = RW_STRIDE / 4;
    float* YRAW = (float*)(ws + WS_YRAW);
    constexpr int TC = 32, NCH = SEQ / TC;
    const int b = item >> 3, h = item & 7;
    const int rg = F.lane >> 4, jq = F.lane & 15, row0 = F.wave * 8 + rg * 2;
    LAS float* BUF = (LAS float*)F.lds;
    constexpr int BUFSZ = 6 * TC * 64;
    const int st = F.tid >> 4, sq = F.tid & 15;
    const float* gsrc = RW + (size_t)(b * SEQ + st) * MIX + h * 64 + 4 * sq;
    f32x4 pre[6];
#pragma unroll
    for (int a = 0; a < 6; ++a) pre[a] = *(const f32x4*)(gsrc + a * RS);
#pragma unroll
    for (int a = 0; a < 6; ++a) *(LAS f32x4*)(BUF + (a * TC + st) * 64 + 4 * sq) = pre[a];
    __syncthreads();
    float S0[4] = {0.f, 0.f, 0.f, 0.f}, S1[4] = {0.f, 0.f, 0.f, 0.f};
    float* yout = YRAW + (size_t)(b * SEQ) * MIX + h * 64 + row0;
#pragma unroll 1
    for (int c = 0; c < NCH; ++c) {
        if (c + 1 < NCH) {
#pragma unroll
            for (int a = 0; a < 6; ++a) pre[a] = *(const f32x4*)(gsrc + a * RS + (size_t)(c + 1) * TC * MIX);
        }
        const LAS float* P = BUF + (c & 1) * BUFSZ;
#pragma unroll 1
        for (int t16 = 0; t16 < TC; t16 += 16) {
            float yk0 = 0.f, yk1 = 0.f;
#pragma unroll 4
            for (int tt = 0; tt < 16; ++tt) { const int t = t16 + tt;
                const f32x4 a4 = *(const LAS f32x4*)(P + (4 * TC + t) * 64 + 4 * jq);
                const f32x4 k4 = *(const LAS f32x4*)(P + (2 * TC + t) * 64 + 4 * jq);
                const f32x2 v2 = *(const LAS f32x2*)(P + (3 * TC + t) * 64 + row0);
                const f32x4 b4 = *(const LAS f32x4*)(P + (5 * TC + t) * 64 + 4 * jq);
                const f32x4 w4 = *(const LAS f32x4*)(P + (1 * TC + t) * 64 + 4 * jq);
                const f32x4 r4 = *(const LAS f32x4*)(P + (0 * TC + t) * 64 + 4 * jq);
                float sa0 = vfma_(S0[3], a4[3], vfma_(S0[2], a4[2], vfma_(S0[1], a4[1], vmul_(S0[0], a4[0]))));
                float sa1 = vfma_(S1[3], a4[3], vfma_(S1[2], a4[2], vfma_(S1[1], a4[1], vmul_(S1[0], a4[0]))));
                row16_sum2(sa0, sa1);
#pragma unroll
                for (int i = 0; i < 4; ++i) { S0[i] = vfma_(S0[i], w4[i], vfma_(sa0, b4[i], vmul_(v2[0], k4[i]))); S1[i] = vfma_(S1[i], w4[i], vfma_(sa1, b4[i], vmul_(v2[1], k4[i]))); }
                float y0 = vfma_(S0[3], r4[3], vfma_(S0[2], r4[2], vfma_(S0[1], r4[1], vmul_(S0[0], r4[0]))));
                float y1 = vfma_(S1[3], r4[3], vfma_(S1[2], r4[2], vfma_(S1[1], r4[1], vmul_(S1[0], r4[0]))));
                row16_sum2(y0, y1);
                const bool mine = (tt & 15) == jq;
                yk0 = mine ? y0 : yk0; yk1 = mine ? y1 : yk1; }
            *(f32x2*)(yout + (size_t)(c * TC + t16 + jq) * MIX) = (f32x2){yk0, yk1};
        }
        if (c + 1 < NCH) {
            LAS float* Q = BUF + ((c + 1) & 1) * BUFSZ;
#pragma unroll
            for (int a = 0; a < 6; ++a) *(LAS f32x4*)(Q + (a * TC + st) * 64 + 4 * sq) = pre[a];
        }
        __syncthreads();
    }
}
DI void rwkv_post_rows(const Frame& F, unsigned char* ws, const In& in, int l, int w0, int nw) {
    const float* RW = (const float*)(ws + WS_RW); constexpr size_t RS = RW_STRIDE / 4;
    const float* YRAW = (const float*)(ws + WS_YRAW); bf16_t* MIXp = (bf16_t*)(ws + WS_MIX);
    const float* r_k = in[14] + l * MIX; const float* lng = in[15] + l * MIX; const float* lnb = in[16] + l * MIX;
    for (int e = w0; e < MTOK * 8; e += nw) { const int m = e >> 3, h = e & 7, ch = h * 64 + F.lane; const size_t o = (size_t)m * MIX + ch;
        const float y = YRAW[o];
        const float mean = wave_sum(y) * (1.f / 64.f); const float d = y - mean; const float var = wave_sum(d * d) * (1.f / 64.f);
        const float yn = d * (1.0f / sqrtf(var + GN_EPS)) * lng[ch] + lnb[ch];
        const float bon = wave_sum(RW[0 * RS + o] * RW[2 * RS + o] * r_k[ch]) * RW[3 * RS + o];
        MIXp[(size_t)m * (4 * MIX) + MIX + ch] = (bf16_t)f2bf((yn + bon) * RW[6 * RS + o]); }
}

DI unsigned wave_sum_u32(unsigned x) {
    float f = __builtin_bit_cast(float, x); (void)f;
    int v = (int)x;
    v += __builtin_amdgcn_update_dpp(0, v, 0xB1, 0xF, 0xF, true); v += __builtin_amdgcn_update_dpp(0, v, 0x4E, 0xF, 0xF, true);
    v += __builtin_amdgcn_update_dpp(0, v, 0x141, 0xF, 0xF, true); v += __builtin_amdgcn_update_dpp(0, v, 0x140, 0xF, 0xF, true);
    return (unsigned)(__builtin_amdgcn_readlane(v, 0) + __builtin_amdgcn_readlane(v, 16) + __builtin_amdgcn_readlane(v, 32) + __builtin_amdgcn_readlane(v, 48));
}
DI unsigned fkey(float v) { unsigned u = __builtin_bit_cast(unsigned, v); if (u == 0x80000000u) u = 0u; return (u & 0x80000000u) ? ~u : (u | 0x80000000u); }
DI bf16x8 pack8(float a0, float a1, float a2, float a3, float a4, float a5, float a6, float a7) {
    u32x4 p; p.x = pk2(a0, a1); p.y = pk2(a2, a3); p.z = pk2(a4, a5); p.w = pk2(a6, a7); return __builtin_bit_cast(bf16x8, p); }
struct AttTile { bf16x8 kf[4]; s16x4 vf[8]; unsigned mw; };
DI void att_load(AttTile& T, const bf16_t* kp, const bf16_t* vp, const unsigned* mp, int kt) {
#pragma unroll
    for (int s = 0; s < 4; ++s) T.kf[s] = *(const bf16x8*)(kp + (size_t)kt * 32 * 512 + 16 * s);
#pragma unroll
    for (int s2 = 0; s2 < 2; ++s2) { const bf16_t* v = vp + kt * 32 + 16 * s2;
        T.vf[4 * s2 + 0] = *(const s16x4*)(v); T.vf[4 * s2 + 1] = *(const s16x4*)(v + 8);
        T.vf[4 * s2 + 2] = *(const s16x4*)(v + (size_t)32 * SEQ); T.vf[4 * s2 + 3] = *(const s16x4*)(v + (size_t)32 * SEQ + 8); }
    T.mw = mp[kt];
}
DI void att_tile(const AttTile& T, const bf16x8 (&qf)[4], f32x16& o0, f32x16& o1, float& mrun, float& lrun, int hh) {
    f32x16 sa;
#pragma unroll
    for (int i = 0; i < 16; ++i) sa[i] = 0.f;
#pragma unroll
    for (int s = 0; s < 4; ++s) sa = MFMA32(T.kf[s], qf[s], sa);
    float mx = -1e30f;
#pragma unroll
    for (int i = 0; i < 16; ++i) { const int kr = (i & 3) + 8 * (i >> 2) + 4 * hh; const bool on = (T.mw >> kr) & 1u; sa[i] = on ? sa[i] : -1e30f; mx = fmaxf(mx, sa[i]); }
    mx = fmaxf(mx, __shfl_xor(mx, 32));
    const float mnew = fmaxf(mrun, mx);
    if (__any(mnew > mrun)) {
        const float alpha = __expf(mrun - mnew); lrun *= alpha;
#pragma unroll
        for (int i = 0; i < 16; ++i) { o0[i] *= alpha; o1[i] *= alpha; }
        mrun = mnew; }
    float p[16], ps = 0.f;
#pragma unroll
    for (int i = 0; i < 16; ++i) { p[i] = (sa[i] > -1e29f) ? __expf(sa[i] - mrun) : 0.f; ps += p[i]; }
    lrun += ps;
#pragma unroll
    for (int s2 = 0; s2 < 2; ++s2) {
        const bf16x8 pb = pack8(p[8 * s2], p[8 * s2 + 1], p[8 * s2 + 2], p[8 * s2 + 3], p[8 * s2 + 4], p[8 * s2 + 5], p[8 * s2 + 6], p[8 * s2 + 7]);
        const bf16x8 vf0 = __builtin_shufflevector(T.vf[4 * s2], T.vf[4 * s2 + 1], 0, 1, 2, 3, 4, 5, 6, 7), vf1 = __builtin_shufflevector(T.vf[4 * s2 + 2], T.vf[4 * s2 + 3], 0, 1, 2, 3, 4, 5, 6, 7);
        o0 = MFMA32(vf0, pb, o0); o1 = MFMA32(vf1, pb, o1); }
}
DI void dsa_item(const Frame& F, unsigned char* ws, int item) {
    const bf16_t* Q = (const bf16_t*)(ws + WS_Q); const bf16_t* Kb = (const bf16_t*)(ws + WS_K); const bf16_t* VT = (const bf16_t*)(ws + WS_VT);
    const bf16_t* QI = (const bf16_t*)(ws + WS_QI); const bf16_t* KI = (const bf16_t*)(ws + WS_KI); const float* WI = (const float*)(ws + WS_WI);
    float* SC = (float*)(ws + WS_SC); unsigned* MASK = (unsigned*)(ws + WS_MASK); bf16_t* MIXp = (bf16_t*)(ws + WS_MIX);
    const int b = item >> 6, qb = item & 63, q0 = qb * 32, m0 = b * SEQ + q0;
    const int r = F.lane & 31, hh = F.lane >> 5;
    {
        float wv[4];
#pragma unroll
        for (int hd = 0; hd < 4; ++hd) wv[hd] = WI[(size_t)(m0 + r) * 4 + hd];
        const bf16_t* qip = QI + (size_t)(m0 + r) * 256 + 8 * hh;
        const bf16_t* kip = KI + (size_t)(b * SEQ + r) * 64 + 8 * hh;
        bf16x8 kf[4], kn[4];
        if (F.wave <= qb) {
#pragma unroll
            for (int s = 0; s < 4; ++s) kf[s] = *(const bf16x8*)(kip + (size_t)F.wave * 32 * 64 + 16 * s); }
        for (int kt = F.wave; kt <= qb; kt += 8) {
            if (kt + 8 <= qb) {
#pragma unroll
                for (int s = 0; s < 4; ++s) kn[s] = *(const bf16x8*)(kip + (size_t)(kt + 8) * 32 * 64 + 16 * s); }
            f32x16 sc;
#pragma unroll
            for (int i = 0; i < 16; ++i) sc[i] = 0.f;
#pragma unroll
            for (int hd = 0; hd < 4; ++hd) { f32x16 a; bf16x8 qf[4];
#pragma unroll
                for (int s = 0; s < 4; ++s) qf[s] = *(const bf16x8*)(qip + hd * 64 + 16 * s);
#pragma unroll
                for (int i = 0; i < 16; ++i) a[i] = 0.f;
#pragma unroll
                for (int s = 0; s < 4; ++s) a = MFMA32(kf[s], qf[s], a);
#pragma unroll
                for (int i = 0; i < 16; ++i) sc[i] += wv[hd] * fmaxf(a[i], 0.f); }
#pragma unroll
            for (int g = 0; g < 4; ++g) *(f32x4*)(SC + (size_t)(m0 + r) * SEQ + kt * 32 + 8 * g + 4 * hh) = (f32x4){sc[4 * g], sc[4 * g + 1], sc[4 * g + 2], sc[4 * g + 3]};
#pragma unroll
            for (int s = 0; s < 4; ++s) kf[s] = kn[s];
        }
    }
    VM_WAIT(); __syncthreads();
    for (int qq = 0; qq < 4; ++qq) {
        const int rq = F.wave * 4 + qq, t = q0 + rq, m = m0 + rq;
        unsigned* mrow = MASK + (size_t)m * 64;
        if (t + 1 <= 256) {
            for (int j = 0; j < 32; ++j) { const unsigned long long bm = __ballot(F.lane + 64 * j <= t); if (F.lane == 0) { mrow[2 * j] = (unsigned)bm; mrow[2 * j + 1] = (unsigned)(bm >> 32); } }
        } else {
            unsigned key[32];
#pragma unroll
            for (int j = 0; j < 32; ++j) { const int s = F.lane + 64 * j; key[j] = (s <= t) ? fkey(SC[(size_t)m * SEQ + (s <= t ? s : 0)]) : 0u; }
            unsigned T = 0u;
#pragma unroll 1
            for (int bit = 31; bit >= 0; --bit) { const unsigned cand = T | (1u << bit); unsigned cnt = 0u;
#pragma unroll
                for (int j = 0; j < 32; ++j) cnt += (key[j] >= cand) ? 1u : 0u;
                if (wave_sum_u32(cnt) >= 256u) T = cand; }
            unsigned cg = 0u;
#pragma unroll
            for (int j = 0; j < 32; ++j) cg += (key[j] > T) ? 1u : 0u;
            const int cgt = (int)wave_sum_u32(cg);
            const int need = 256 - cgt; int run = 0;
            const unsigned long long lt = (1ull << F.lane) - 1ull;
#pragma unroll
            for (int j = 0; j < 32; ++j) {
                const unsigned long long eq = __ballot(key[j] == T), gt = __ballot(key[j] > T);
                const int pre = run + __popcll(eq & lt);
                const unsigned long long se = __ballot(key[j] == T && pre < need);
                const unsigned long long bm = gt | se; run += __popcll(eq);
                if (F.lane == 0) { mrow[2 * j] = (unsigned)bm; mrow[2 * j + 1] = (unsigned)(bm >> 32); }
                if ((j & 3) == 3) __builtin_amdgcn_sched_barrier(0); }
        }
    }
    VM_WAIT(); __syncthreads();
    {
        const int hd = F.wave;
        bf16x8 qf[4];
#pragma unroll
        for (int s = 0; s < 4; ++s) qf[s] = *(const bf16x8*)(Q + (size_t)(m0 + r) * 512 + hd * 64 + 16 * s + 8 * hh);
        f32x16 o0, o1;
#pragma unroll
        for (int i = 0; i < 16; ++i) { o0[i] = 0.f; o1[i] = 0.f; }
        float mrun = -1e30f, lrun = 0.f;
        const bf16_t* kp = Kb + (size_t)(b * SEQ + r) * 512 + hd * 64 + 8 * hh;
        const bf16_t* vp = VT + ((size_t)(b * 8 + hd) * 64 + r) * SEQ + 4 * hh;
        const unsigned* mp = MASK + (size_t)(m0 + r) * 64;
        AttTile A, B;
        att_load(A, kp, vp, mp, 0);
        for (int kt = 0; kt <= qb; kt += 2) {
            if (kt + 1 <= qb) att_load(B, kp, vp, mp, kt + 1);
            att_tile(A, qf, o0, o1, mrun, lrun, hh);
            if (kt + 1 <= qb) {
                if (kt + 2 <= qb) att_load(A, kp, vp, mp, kt + 2);
                att_tile(B, qf, o0, o1, mrun, lrun, hh); }
        }
        const float inv = 1.0f / (lrun + __shfl_xor(lrun, 32));
        bf16_t* orow = MIXp + (size_t)(m0 + r) * (4 * MIX) + hd * 64;
#pragma unroll
        for (int g = 0; g < 4; ++g) {
            u32x2 w0; w0.x = pk2(o0[4 * g] * inv, o0[4 * g + 1] * inv); w0.y = pk2(o0[4 * g + 2] * inv, o0[4 * g + 3] * inv);
            u32x2 w1; w1.x = pk2(o1[4 * g] * inv, o1[4 * g + 1] * inv); w1.y = pk2(o1[4 * g + 2] * inv, o1[4 * g + 3] * inv);
            *(u32x2*)(orow + 8 * g + 4 * hh) = w0; *(u32x2*)(orow + 32 + 8 * g + 4 * hh) = w1; }
    }
    __syncthreads();
}

DI float siluf_(float x) { return x * sigmoidf_(x); }
DI void conv_phase(const Frame& F, unsigned char* ws, const In& in, int l) {
    const bf16_t* U = (const bf16_t*)(ws + WS_U); bf16_t* ACT = (bf16_t*)(ws + WS_ACT);
    const float* cw = in[33] + (size_t)l * 3 * DFF2; const float* cb = in[34] + (size_t)l * DFF2;
    constexpr int NCG = DFF / 8;
    const long total = (long)NCG * (MTOK / 32);
    for (long e = (long)F.bid * NTHR + F.tid; e < total; e += (long)F.G * NTHR) {
        const int cg = (int)(e % NCG), tg = (int)(e / NCG); const int f0 = cg * 8, m0 = tg * 32; const bool first = (m0 % SEQ) == 0;
        float wg[3][8], wv[3][8], bg[8], bv[8];
#pragma unroll
        for (int j = 0; j < 3; ++j)
#pragma unroll
            for (int i = 0; i < 8; ++i) { wg[j][i] = cw[(size_t)j * DFF2 + f0 + i]; wv[j][i] = cw[(size_t)j * DFF2 + DFF + f0 + i]; }
#pragma unroll
        for (int i = 0; i < 8; ++i) { bg[i] = cb[f0 + i]; bv[i] = cb[DFF + f0 + i]; }
        float g1[8], g2[8], v1[8], v2[8];
#pragma unroll
        for (int i = 0; i < 8; ++i) { g1[i] = 0.f; g2[i] = 0.f; v1[i] = 0.f; v2[i] = 0.f; }
        if (!first) {
            const u32x4 a = *(const u32x4*)(U + (size_t)(m0 - 1) * DFF2 + f0), b = *(const u32x4*)(U + (size_t)(m0 - 2) * DFF2 + f0);
            const u32x4 c = *(const u32x4*)(U + (size_t)(m0 - 1) * DFF2 + DFF + f0), d = *(const u32x4*)(U + (size_t)(m0 - 2) * DFF2 + DFF + f0);
#pragma unroll
            for (int i = 0; i < 4; ++i) { g1[2 * i] = bf2f(a[i] & 0xffffu); g1[2 * i + 1] = bf2f(a[i] >> 16); g2[2 * i] = bf2f(b[i] & 0xffffu); g2[2 * i + 1] = bf2f(b[i] >> 16);
                v1[2 * i] = bf2f(c[i] & 0xffffu); v1[2 * i + 1] = bf2f(c[i] >> 16); v2[2 * i] = bf2f(d[i] & 0xffffu); v2[2 * i + 1] = bf2f(d[i] >> 16); }
        }
#pragma unroll 2
        for (int t = 0; t < 32; ++t) {
            const u32x4 a = *(const u32x4*)(U + (size_t)(m0 + t) * DFF2 + f0), c = *(const u32x4*)(U + (size_t)(m0 + t) * DFF2 + DFF + f0);
            float g0[8], v0[8], o[8];
#pragma unroll
            for (int i = 0; i < 4; ++i) { g0[2 * i] = bf2f(a[i] & 0xffffu); g0[2 * i + 1] = bf2f(a[i] >> 16); v0[2 * i] = bf2f(c[i] & 0xffffu); v0[2 * i + 1] = bf2f(c[i] >> 16); }
#pragma unroll
            for (int i = 0; i < 8; ++i) { const float gc = bg[i] + wg[0][i] * g2[i] + wg[1][i] * g1[i] + wg[2][i] * g0[i]; const float vc = bv[i] + wv[0][i] * v2[i] + wv[1][i] * v1[i] + wv[2][i] * v0[i];
                o[i] = siluf_(gc) * vc; g2[i] = g1[i]; g1[i] = g0[i]; v2[i] = v1[i]; v1[i] = v0[i]; }
            u32x4 w; w.x = pk2(o[0], o[1]); w.y = pk2(o[2], o[3]); w.z = pk2(o[4], o[5]); w.w = pk2(o[6], o[7]);
            *(u32x4*)(ACT + (size_t)(m0 + t) * DFF + f0) = w;
        }
    }
}

DI void final_phase(const Frame& F, unsigned char* ws, const float* gfin, float* out) {
    const float* Y = (const float*)(ws + WS_Y); const float* part = (const float*)(ws + WS_PARTA);
    const int gw = F.bid * NWAVES + F.wave, NGW = F.G * NWAVES;
    for (int m = gw; m < MTOK; m += NGW) {
        float s = (F.lane < 32) ? part[(size_t)m * 32 + F.lane] : 0.f; s = wave_sum(s);
        const float rs = 1.0f / sqrtf(s * (1.0f / DM) + RMS_EPS);
#pragma unroll
        for (int j = 0; j < 8; ++j) { const int c = (j * 64 + F.lane) * 4; const f32x4 v = *(const f32x4*)(Y + (size_t)m * DM + c), g = *(const f32x4*)(gfin + c);
            *(f32x4*)(out + (size_t)m * DM + c) = v * rs * g; }
    }
}

struct Args { InTab in; float* out; unsigned char* ws; int ph_lo, ph_hi; };
constexpr int ZG1_UNITS = 24 * 32, ZG2_UNITS = 28 * 32;
constexpr int PH_PER_LAYER = 9, N_PHASES = 1 + NL * PH_PER_LAYER + 1;

__global__ void __launch_bounds__(NTHR, 2) hybrid_fwd(Args args) {
    extern __shared__ __attribute__((aligned(16))) unsigned char lds_raw[];
    Frame F0; F0.lds = (LAS unsigned char*)lds_raw; F0.tid = threadIdx.x; F0.lane = F0.tid & 63; F0.wave = __builtin_amdgcn_readfirstlane(F0.tid >> 6); F0.bid = blockIdx.x; F0.G = gridDim.x;
    unsigned char* ws0 = args.ws; In in0; in0.t = (CAS const gfptr_t*)__builtin_amdgcn_kernarg_segment_ptr();
    const int lo = args.ph_lo, hi = args.ph_hi;
    volatile LAS unsigned* MISC = (volatile LAS unsigned*)(F0.lds + MISC_OFF);
    if (F0.tid < 16) MISC[F0.tid] = 0u;
    __syncthreads();
    XcdBarrier bar; bar.bar = (unsigned*)(ws0 + WS_CTL) + CW_BAR; bar.x = 0; bar.st = nullptr;
    const bool multi = (hi - lo) > 1;
    if (multi) bar = xcd_barrier_post((unsigned*)(ws0 + WS_CTL) + CW_BAR, MISC + 8);
#ifndef SUBMASK
#define SUBMASK 7
#endif
#ifndef DUPSUB
#define DUPSUB 0
#endif
#ifndef DUPMASK
#define DUPMASK 0u
#endif
#define NREP(j) (((DUPMASK >> (j)) & 1u) ? 2 : 1)
#ifndef PHMASK
#define PHMASK 0xFFFFFFFFu
#endif
#define IN_PH(k) (lo <= (k) && (k) < hi)
#define ON(j) ((PHMASK >> (j)) & 1u)
#define LAYER_PTRS unsigned char* wt = ws + WS_WT + (size_t)l * WT_LAYER; float* Y = (float*)(ws + WS_Y); bf16_t* YB = (bf16_t*)(ws + WS_YB); float* PA = (float*)(ws + WS_PARTA); float* PB = (float*)(ws + WS_PARTB); const LAS float* rsT = (const LAS float*)(F.lds + RST_OFF); (void)wt; (void)Y; (void)YB; (void)PA; (void)PB; (void)rsT;
#define SEAM(k) do { if (IN_PH(k) && IN_PH((k) + 1)) xcd_barrier(bar); } while (0)

    if (ON(0) && IN_PH(0)) for (int rep = 0; rep < NREP(0); ++rep) { if (rep) xcd_barrier(bar); const In in = in_fresh(in0); const Frame F = fresh(F0); unsigned char* ws = fresh_ptr(ws0); p0_prologue(F, in, ws); }
    SEAM(0);

    for (int l = 0; l < NL; ++l) {
        const int pb = 1 + l * PH_PER_LAYER;
        if (ON(1) && IN_PH(pb + 0)) for (int rep = 0; rep < NREP(1); ++rep) { if (rep) xcd_barrier(bar); const In in = in_fresh(in0); const Frame F = fresh(F0); unsigned char* ws = fresh_ptr(ws0); LAYER_PTRS
            pg8::Gemm g{YB, (const bf16_t*)(wt + WT_IN), DM, DM, DM}; const pg8::OrderLin S{F.bid, F.G, ZG1_UNITS, 0, DM, DM};
            pg8::Unit u0; int pm0 = -1; if (S.next(0, u0)) pm0 = u0.pm;
            if (pm0 >= 0) rs_table(F, PA, pm0); else __syncthreads();
            pg8::EpiZ E{(float*)(ws + WS_ZS), (bf16_t*)(ws + WS_G), in[4] + (size_t)l * GCOLS, PA, rsT, pm0};
            pg8::gemm_phase<pg8::EpiZ, pg8::OrderLin, true>(F.lds, F.tid, g, S, E);
        }
        SEAM(pb + 0);
        if (ON(2) && IN_PH(pb + 1)) for (int rep = 0; rep < NREP(2); ++rep) { if (rep) xcd_barrier(bar); const In in = in_fresh(in0); const Frame F = fresh(F0); unsigned char* ws = fresh_ptr(ws0); LAYER_PTRS
            for (int it = F.bid; it < 1152; it += F.G) {
                if (it < 128) { dsa_prep_item(F, ws, in[5] + l * 64, it); if (DUPSUB & 64) dsa_prep_item(F, ws, in[5] + l * 64, it); }
                else if (it < 384) { rwkv_prep_item(F, ws, in, l, it - 128); if (DUPSUB & 16) rwkv_prep_item(F, ws, in, l, it - 128); }
                else if (it < 896) { pool_item(F, ws, in, l, it - 384); if (DUPSUB & 32) pool_item(F, ws, in, l, it - 384); }
                else { ssm_pass1_item(F, ws, in, l, it - 896); if (DUPSUB & 128) ssm_pass1_item(F, ws, in, l, it - 896); }
            }
        }
        SEAM(pb + 1);
        if (ON(3) && IN_PH(pb + 2)) for (int rep = 0; rep < NREP(3); ++rep) { if (rep) xcd_barrier(bar); const In in = in_fresh(in0); const Frame F = fresh(F0); unsigned char* ws = fresh_ptr(ws0); LAYER_PTRS
            const bool split = F.G >= 128; const int nrw = split ? 32 : 0;
            if (SUBMASK & 1) { const Frame Fa = fresh(F0);
                if (split) { if (Fa.bid < 32) { rwkv_scan_item(Fa, ws, Fa.bid); if (DUPSUB & 1) rwkv_scan_item(Fa, ws, Fa.bid); } }
                else for (int it = Fa.bid; it < 32; it += Fa.G) rwkv_scan_item(Fa, ws, it); }
            if (F.bid >= nrw) {
                if (SUBMASK & 2) { const Frame Fb = fresh(F0); const int nb = Fb.G - nrw, b0 = Fb.bid - nrw;
                    for (int it = b0; it < 256; it += nb) { const int b = it & 3, qb = 63 - (it >> 2); dsa_item(Fb, ws, b * 64 + qb); if (DUPSUB & 2) dsa_item(Fb, ws, b * 64 + qb); } }
                if (SUBMASK & 4) { const Frame Fc = fresh(F0); const int nb = Fc.G - nrw, b0 = Fc.bid - nrw;
                    for (int it = nb - 1 - b0; it < 256; it += nb) { ssm_pass3_item(Fc, fresh_ptr(ws0), in_fresh(in0), l, it); if (DUPSUB & 4) ssm_pass3_item(Fc, fresh_ptr(ws0), in_fresh(in0), l, it); } }
                { const Frame Fd = fresh(F0); unsigned char* wsd = fresh_ptr(ws0); const In ind = in_fresh(in0);
                    unsigned char* wtd = wsd + WS_WT + (size_t)l * WT_LAYER; float* PAd = (float*)(wsd + WS_PARTA);
                    pg8::Gemm g{(const bf16_t*)(wsd + WS_YB), (const bf16_t*)(wtd + WT_IN), DM, DM, DM}; const bool tri = (Fd.G == 256 && nrw == 32);
                    const pg8::OrderLin SL{Fd.bid - nrw, Fd.G - nrw, ZG2_UNITS, 24, DM, DM}; const pg8::OrderTri ST{(Fd.bid - nrw) & 31, (Fd.bid - nrw) >> 5, 24, DM, DM};
                    pg8::Unit u0; int pm0 = -1; if (tri ? ST.next(0, u0) : SL.next(0, u0)) pm0 = u0.pm;
                    if (pm0 >= 0) rs_table(Fd, PAd, pm0); else __syncthreads();
                    pg8::EpiZ E{(float*)(wsd + WS_ZS), (bf16_t*)(wsd + WS_G), ind[4] + (size_t)l * GCOLS, PAd, (const LAS float*)(Fd.lds + RST_OFF), pm0};
                    if (tri) pg8::gemm_phase<pg8::EpiZ, pg8::OrderTri, true>(Fd.lds, Fd.tid, g, ST, E);
                    else pg8::gemm_phase<pg8::EpiZ, pg8::OrderLin, true>(Fd.lds, Fd.tid, g, SL, E); }
            }
        }
        SEAM(pb + 2);
        if (ON(4) && IN_PH(pb + 3)) for (int rep = 0; rep < NREP(4); ++rep) { if (rep) xcd_barrier(bar); const In in = in_fresh(in0); const Frame F = fresh(F0); unsigned char* ws = fresh_ptr(ws0); LAYER_PTRS
            pg8::Gemm g{(const bf16_t*)(ws + WS_YSB), (const bf16_t*)(wt + WT_GLU), MIX, MIX, MIX}; pg8::Order S; S.init(MTOK / 256, MIX / 256, F.G, F.bid, MIX, MIX);
            pg8::EpiGlu E{(const float*)(ws + WS_YS), in[28] + l * MIX, (bf16_t*)(ws + WS_MIX)};
            pg8::gemm_phase<pg8::EpiGlu, pg8::Order, true>(F.lds, F.tid, g, S, E);
            { const Frame Fp = fresh(F0); const int ng = (Fp.G > 64) ? 64 : 0;
              if (Fp.bid >= ng) rwkv_post_rows(Fp, fresh_ptr(ws0), in_fresh(in0), l, (Fp.bid - ng) * NWAVES + Fp.wave, (Fp.G - ng) * NWAVES); }
        }
        SEAM(pb + 3);
        if (ON(5) && IN_PH(pb + 4)) for (int rep = 0; rep < NREP(5); ++rep) { if (rep) xcd_barrier(bar); const In in = in_fresh(in0); const Frame F = fresh(F0); unsigned char* ws = fresh_ptr(ws0); LAYER_PTRS
            pg8::Gemm g{(const bf16_t*)(ws + WS_MIX), (const bf16_t*)(wt + WT_BR), 4 * MIX, MIX, MIX}; pg8::Order S; S.init(MTOK / 256, DM / 256, F.G, F.bid, 4 * MIX, MIX, 4, MIX, DM);
            pg8::EpiMerge E{(const bf16_t*)(ws + WS_G), (float*)(ws + WS_MF), (bf16_t*)(ws + WS_MERGED)};
            pg8::gemm_phase<pg8::EpiMerge, pg8::Order, true>(F.lds, F.tid, g, S, E);
        }
        SEAM(pb + 4);
        if (ON(6) && IN_PH(pb + 5)) for (int rep = 0; rep < NREP(6); ++rep) { if (rep) xcd_barrier(bar); const In in = in_fresh(in0); const Frame F = fresh(F0); unsigned char* ws = fresh_ptr(ws0); LAYER_PTRS
            pg8::Gemm g{(const bf16_t*)(ws + WS_MERGED), (const bf16_t*)(wt + WT_OUT), DM, DM, DM}; pg8::Order S; S.init(MTOK / 256, DM / 256, F.G, F.bid, DM, DM);
            pg8::EpiRes E{l == 0 ? in[0] : Y, Y, YB, PB};
            pg8::gemm_phase<pg8::EpiRes, pg8::Order, true>(F.lds, F.tid, g, S, E);
        }
        SEAM(pb + 5);
        if (ON(7) && IN_PH(pb + 6)) for (int rep = 0; rep < NREP(7); ++rep) { if (rep) xcd_barrier(bar); const In in = in_fresh(in0); const Frame F = fresh(F0); unsigned char* ws = fresh_ptr(ws0); LAYER_PTRS
            pg8::Gemm g{YB, (const bf16_t*)(wt + WT_UP), DM, DM, DM}; pg8::Order S; S.init(MTOK / 256, DFF2 / 256, F.G, F.bid, DM, DM);
            pg8::Unit u0; int pm0 = -1; if (S.next(0, u0)) pm0 = u0.pm;
            if (pm0 >= 0) rs_table(F, PB, pm0); else __syncthreads();
            pg8::EpiU E{(bf16_t*)(ws + WS_U), DFF2, PB, rsT, pm0};
            pg8::gemm_phase<pg8::EpiU, pg8::Order, true>(F.lds, F.tid, g, S, E);
        }
        SEAM(pb + 6);
        if (ON(8) && IN_PH(pb + 7)) for (int rep = 0; rep < NREP(8); ++rep) { if (rep) xcd_barrier(bar); const In in = in_fresh(in0); const Frame F = fresh(F0); unsigned char* ws = fresh_ptr(ws0); LAYER_PTRS conv_phase(F, ws, in, l); }
        SEAM(pb + 7);
        if (ON(9) && IN_PH(pb + 8)) for (int rep = 0; rep < NREP(9); ++rep) { if (rep) xcd_barrier(bar); const In in = in_fresh(in0); const Frame F = fresh(F0); unsigned char* ws = fresh_ptr(ws0); LAYER_PTRS
            pg8::Gemm g{(const bf16_t*)(ws + WS_ACT), (const bf16_t*)(wt + WT_DOWN), DFF, DFF, DFF}; pg8::Order S; S.init(MTOK / 256, DM / 256, F.G, F.bid, DFF, DFF);
            pg8::EpiRes E{Y, Y, YB, PA};
            pg8::gemm_phase<pg8::EpiRes, pg8::Order, true>(F.lds, F.tid, g, S, E);
        }
        SEAM(pb + 8);
    }
    if (ON(10) && IN_PH(N_PHASES - 1)) { const In in = in_fresh(in0); const Frame F = fresh(F0); unsigned char* ws = fresh_ptr(ws0); final_phase(F, ws, in[36], args.out); }
#ifdef DBG_STOP
    if (lo == 100) { const Frame F = fresh(F0); unsigned char* ws = fresh_ptr(ws0);
        for (size_t e = (size_t)F.bid * NTHR + F.tid; e < (size_t)MTOK * DM; e += (size_t)F.G * NTHR) {
            const int m = (int)(e / DM), c = (int)(e % DM); float v;
            if (DBG_BUF == 0) v = bf2f(((const bf16_t*)(ws + WS_MIX))[e]);
            else if (DBG_BUF == 1) v = ((const float*)(ws + WS_ZS))[(size_t)m * ZS_COLS + c];
            else if (DBG_BUF == 2) v = ((const float*)(ws + WS_ZS))[(size_t)m * ZS_COLS + 2048 + c];
            else if (DBG_BUF == 3) v = bf2f(((const bf16_t*)(ws + WS_G))[(size_t)m * GCOLS + c]);
            else if (DBG_BUF == 4) v = ((const float*)(ws + WS_Y))[e];
            else v = bf2f(((const bf16_t*)(ws + WS_MERGED))[e]);
            args.out[e] = v; } }
#endif
#undef IN_PH
#undef SEAM
}

extern "C" void kernel_launch(void* const* d_in, const int* in_sizes, int n_in, void* d_out, int out_size, void* d_ws, size_t ws_size, hipStream_t stream) {
    static int grid = 0;
    if (grid == 0) {
        if (n_in != 37 || out_size != MTOK * DM || ws_size < WS_END) { fprintf(stderr, "kernel_launch: unexpected problem (n_in %d, out %d, ws %zu < %zu)\n", n_in, out_size, ws_size, (size_t)WS_END); grid = -1; return; }
        int dev = 0, cus = 0, per_cu = 0;
        if (hipGetDevice(&dev) != hipSuccess || hipDeviceGetAttribute(&cus, hipDeviceAttributeMultiprocessorCount, dev) != hipSuccess) { grid = -1; return; }
        if (hipFuncSetAttribute((const void*)hybrid_fwd, hipFuncAttributeMaxDynamicSharedMemorySize, LDS_BYTES) != hipSuccess) { fprintf(stderr, "kernel_launch: hipFuncSetAttribute failed\n"); grid = -1; return; }
        if (hipOccupancyMaxActiveBlocksPerMultiprocessor(&per_cu, (const void*)hybrid_fwd, NTHR, LDS_BYTES) != hipSuccess || per_cu < 1) fprintf(stderr, "kernel_launch: occupancy query says %d\n", per_cu);
        (void)hipGetLastError();
        grid = cus;
    }
    if (grid < 0) return;
    (void)hipMemsetAsync((char*)d_ws + WS_CTL, 0, CTL_ZERO_BYTES, stream);
    Args a{};
    for (int i = 0; i < 37; ++i) a.in.p[i] = (const float*)d_in[i];
    a.out = (float*)d_out; a.ws = (unsigned char*)d_ws;
#ifdef DBG_STOP
    for (int k = 0; k < DBG_STOP; ++k) { a.ph_lo = k; a.ph_hi = k + 1; hipLaunchKernelGGL(hybrid_fwd, dim3(grid), dim3(NTHR), LDS_BYTES, stream, a); }
    a.ph_lo = 100; a.ph_hi = 101; hipLaunchKernelGGL(hybrid_fwd, dim3(grid), dim3(NTHR), LDS_BYTES, stream, a);
#elif MK_N_LAUNCHES == 1
    a.ph_lo = 0; a.ph_hi = N_PHASES;
    hipLaunchKernelGGL(hybrid_fwd, dim3(grid), dim3(NTHR), LDS_BYTES, stream, a);
#else
    for (int k = 0; k < N_PHASES; ++k) { a.ph_lo = k; a.ph_hi = k + 1; hipLaunchKernelGGL(hybrid_fwd, dim3(grid), dim3(NTHR), LDS_BYTES, stream, a); }
#endif
}
```

```cpp
#include <hip/hip_runtime.h>
#include <cstdio>
#include <cstdint>

#ifndef MK_N_LAUNCHES
#define MK_N_LAUNCHES 1
#endif

#define LAS __attribute__((address_space(3)))
#define GAS __attribute__((address_space(1)))
typedef unsigned short bf16_t;
typedef short bf16x8 __attribute__((ext_vector_type(8)));
typedef short s16x4 __attribute__((ext_vector_type(4)));
typedef float f32x4 __attribute__((ext_vector_type(4)));
typedef float f32x2 __attribute__((ext_vector_type(2)));
typedef float f32x16 __attribute__((ext_vector_type(16)));
typedef unsigned u32x4 __attribute__((ext_vector_type(4)));
typedef unsigned u32x2 __attribute__((ext_vector_type(2)));
#define DI __device__ __forceinline__

constexpr int NB = 4, SEQ = 2048, DM = 2048, MTOK = NB * SEQ, NL = 4, MIX = 512, DFF = 5504, DFF2 = 2 * DFF;
constexpr int IN_COLS = 13060, NZ = 13312, ZS_COLS = 5120, GCOLS = 8192;
constexpr int B_COLS = 1984;
constexpr int ZO_R = 0, ZO_K = 512, ZO_V = 1024, ZO_LW = 1536, ZO_LA = 1632, ZO_LG = 1728;
constexpr int ZO_Q = 2048, ZO_AK = 2560, ZO_AV = 3072, ZO_QI = 3584, ZO_KI = 3840, ZO_WI = 3904, ZO_C = 4096, ZO_D = 4608;
constexpr float RMS_EPS = 1e-6f, GN_EPS = 64e-5f;

constexpr size_t MiB = 1u << 20;
constexpr size_t WS_CTL = 0, CTL_ZERO_BYTES = 1 * MiB;
constexpr size_t WS_ROPE = 1 * MiB;
constexpr size_t WS_PARTA = 2 * MiB;
constexpr size_t WS_PARTB = 3 * MiB;
constexpr size_t WS_SSTATE = 4 * MiB;
constexpr size_t WS_WI = 5 * MiB;
constexpr size_t WS_KI = 6 * MiB;
constexpr size_t WS_MASK = 7 * MiB;
constexpr size_t WS_QI = 9 * MiB;
constexpr size_t WS_Q = 13 * MiB;
constexpr size_t WS_K = 21 * MiB;
constexpr size_t WS_VT = 29 * MiB;
constexpr size_t WS_Y = 37 * MiB;
constexpr size_t WS_YB = 101 * MiB;
constexpr size_t WS_MIX = 133 * MiB;
constexpr size_t WS_MERGED = 165 * MiB;
constexpr size_t WS_YS = 197 * MiB;
constexpr size_t WS_YSB = 213 * MiB;
constexpr size_t WS_RW = 221 * MiB;
constexpr size_t RW_STRIDE = 16 * MiB;
constexpr size_t WS_SC = 333 * MiB;
constexpr size_t WS_MF = 1368 * MiB;
constexpr size_t WS_ZS = 461 * MiB;
constexpr size_t WS_G = 621 * MiB;
constexpr size_t WS_U = 461 * MiB;
constexpr size_t WS_ACT = 749 * MiB;
constexpr size_t WS_WT = 836 * MiB;
constexpr size_t WT_IN = 0, WT_BR = 52 * MiB, WT_OUT = 60 * MiB, WT_UP = 68 * MiB, WT_DOWN = 111 * MiB, WT_GLU = 111 * MiB + 22544384, WT_LAYER = 133 * MiB;
constexpr size_t WS_YRAW = WS_MF + 192 * MiB;
constexpr size_t WS_WTL = WS_YRAW + 16 * MiB;
constexpr size_t WS_END = WS_WTL + 2 * MiB;
static_assert(WS_WT + 4 * WT_LAYER == WS_MF, "ws map");
static_assert(WT_GLU + 524288 <= WT_LAYER, "wt map");
static_assert(WS_U + (size_t)MTOK * DFF2 * 2 <= WS_ACT && WS_ACT + (size_t)MTOK * DFF * 2 <= WS_WT, "ws map");

constexpr int CW_BAR = 4096;

constexpr int RING_BYTES = 131072;
constexpr int MISC_OFF = RING_BYTES;
constexpr int RST_OFF = RING_BYTES + 1024;
constexpr int LDS_BYTES = 147456;
constexpr int NWAVES = 8, NTHR = 512;

DI unsigned f2bf(float f) { unsigned u = __builtin_bit_cast(unsigned, f); return (u + 0x7fffu + ((u >> 16) & 1u)) >> 16; }
DI unsigned cvt_pk_bf16(float lo, float hi);
DI unsigned pk2(float lo, float hi) { return cvt_pk_bf16(lo, hi); }
DI float bf2f(unsigned b) { return __builtin_bit_cast(float, b << 16); }
typedef __bf16 bf16x2v __attribute__((ext_vector_type(2)));
DI unsigned cvt_pk_bf16(float lo, float hi) { const f32x2 v = {lo, hi}; const bf16x2v b = __builtin_convertvector(v, bf16x2v); return __builtin_bit_cast(unsigned, b); }
DI float wave_sum(float v) {
#pragma unroll
    for (int o = 1; o < 64; o <<= 1) v += __shfl_xor(v, o);
    return v;
}
template <int CTRL> DI float dpp_xadd(float x) { const int r = __builtin_amdgcn_update_dpp(0, __builtin_bit_cast(int, x), CTRL, 0xF, 0xF, true); return x + __builtin_bit_cast(float, r); }
DI float row16_sum(float x) { x = dpp_xadd<0xB1>(x); x = dpp_xadd<0x4E>(x); x = dpp_xadd<0x141>(x); x = dpp_xadd<0x140>(x); return x; }
DI float sigmoidf_(float x) { return __builtin_amdgcn_rcpf(1.0f + __expf(-x)); }
#define LDS_WAIT() asm volatile("s_waitcnt lgkmcnt(0)" ::: "memory")
#define VM_WAIT() asm volatile("s_waitcnt vmcnt(0)" ::: "memory")
#define MFMA32(a, b, c) __builtin_amdgcn_mfma_f32_32x32x16_bf16((a), (b), (c), 0, 0, 0)

#define XB_TMO      128
#define XB_XCNT(j)  (256  + 64 * (j))
#define XB_XSUB(j)  (1280 + 64 * (j))
#define XB_XGEN(j)  (2304 + 64 * (j))
#define XB_TOP      3328
#define XB_TOPGEN   3392
#define XCD_BAR_WORDS 3456
#define XB_SPIN_CAP (1u << 21)
DI unsigned xb_ld(unsigned* p)              { return __hip_atomic_load(p, __ATOMIC_RELAXED, __HIP_MEMORY_SCOPE_AGENT); }
DI unsigned xb_add(unsigned* p, unsigned v) { return __hip_atomic_fetch_add(p, v, __ATOMIC_RELAXED, __HIP_MEMORY_SCOPE_AGENT); }
DI unsigned xb_xcc_id() { return (unsigned)__builtin_amdgcn_s_getreg((3 << 11) | 20) & 0xFu; }
#define XB_SPIN(cond, bar) do { unsigned _sp = 0; while (cond) { __builtin_amdgcn_s_sleep(1); \
    if ((++_sp & 255u) == 0u) { if (xb_ld(&(bar)[XB_TMO])) break; if (_sp > XB_SPIN_CAP) { atomicAdd(&(bar)[XB_TMO], 1u); break; } } } } while (0)
struct XcdBarrier { unsigned* bar; unsigned x; volatile LAS unsigned* st; };
DI XcdBarrier xcd_barrier_post(unsigned* bar, volatile LAS unsigned* st) {
    XcdBarrier b; b.bar = bar; b.x = xb_xcc_id(); b.st = st;
    if (threadIdx.x == 0) (void)xb_add(&bar[XB_XCNT(b.x)], 1u);
    return b;
}
DI void xcd_barrier_complete(unsigned* bar, unsigned x, unsigned& nloc, unsigned& nx) {
    const unsigned G = gridDim.x * gridDim.y * gridDim.z;
    unsigned sum, cnt, mine, sp = 0u;
    for (;;) {
        sum = 0u; cnt = 0u; mine = 0u;
#pragma unroll
        for (unsigned j = 0; j < 16; ++j) { const unsigned c = xb_ld(&bar[XB_XCNT(j)]); sum += c; cnt += (c > 0u) ? 1u : 0u; mine = (j == x) ? c : mine; }
        if (sum == G) break;
        __builtin_amdgcn_s_sleep(1);
        if ((++sp & 255u) == 0u) { if (xb_ld(&bar[XB_TMO])) break; if (sp > XB_SPIN_CAP) { atomicAdd(&bar[XB_TMO], 1u); break; } }
    }
    nloc = mine > 0u ? mine : 1u; nx = cnt > 0u ? cnt : 1u;
}
DI void xcd_barrier(const XcdBarrier& b) {
    asm volatile("s_waitcnt vmcnt(0)" ::: "memory");
    __syncthreads();
    if (threadIdx.x == 0) {
        unsigned* bar = b.bar;
        __builtin_amdgcn_s_waitcnt(0);
        unsigned nloc = b.st[0], nx = b.st[1];
        if (nloc == 0u) { xcd_barrier_complete(bar, b.x, nloc, nx); b.st[0] = nloc; b.st[1] = nx; }
        const unsigned old = xb_add(&bar[XB_XSUB(b.x)], 1u);
        const unsigned gen = old / nloc;
        if (old + 1u == (gen + 1u) * nloc) {
            __builtin_amdgcn_fence(__ATOMIC_RELEASE, "agent");
            asm volatile("s_waitcnt vmcnt(0)" ::: "memory");
            const unsigned og = xb_add(&bar[XB_TOP], 1u);
            const unsigned tg = og / nx;
            if (og + 1u == (tg + 1u) * nx) xb_add(&bar[XB_TOPGEN], 1u);
            else XB_SPIN(xb_ld(&bar[XB_TOPGEN]) == tg, bar);
            __builtin_amdgcn_fence(__ATOMIC_ACQUIRE, "agent");
            xb_add(&bar[XB_XGEN(b.x)], 1u);
            asm volatile("s_waitcnt vmcnt(0)" ::: "memory");
        } else {
            XB_SPIN(xb_ld(&bar[XB_XGEN(b.x)]) == gen, bar);
            __builtin_amdgcn_fence(__ATOMIC_ACQUIRE, "agent");
            asm volatile("s_waitcnt vmcnt(0)" ::: "memory");
        }
    }
    __syncthreads();
}

namespace pg8 {
constexpr int BM = 256, BK = 64, HALF = 128, HTB = HALF * BK * 2, STAGE_BYTES = 8 * HTB, NXCD = 8, WGM = 8;
DI int lds_byte(int r, int c) { const int st = (r >> 4) * 2 + (c >> 5), rr = r & 15, cc = c & 31, ob = rr * 64 + cc * 2; return st * 1024 + (ob ^ (((ob >> 9) & 1) << 5)); }
DI void stage_rc(int b, int& R, int& C) { const int st = b / 1024, sb = b % 1024, swz = sb ^ (((sb >> 9) & 1) << 5); R = (st >> 1) * 16 + swz / 64; C = (st & 1) * 32 + (swz % 64) / 2; }
DI int perm32(int rho) { const int n = rho >> 4, i = rho & 15; return 8 * (i >> 2) + 4 * n + (i & 3); }

struct Unit { int pm, pn, sub; long offA, offB; };
struct Gemm { const bf16_t* A; const bf16_t* Bt; int lda, ldb, K; };

struct Order {
    int nM, nN, nwg, G, c, lda, ldb, nsub, subA, subB;
    DI void init(int nM_, int nN_, int G_, int c_, int lda_, int ldb_, int nsub_ = 1, int subA_ = 0, int subB_ = 0) { nM = nM_; nN = nN_; nwg = nM * nN; G = G_; c = c_; lda = lda_; ldb = ldb_; nsub = nsub_; subA = subA_; subB = subB_; }
    DI bool next(int i, Unit& u) const {
        const int ti = i / nsub, sub = i - ti * nsub;
        const long L = (long)ti * G + c; if (L >= nwg) return false;
        int wgid = (int)L; { const int q = nwg / NXCD, r = nwg % NXCD, xcd = wgid % NXCD, off = wgid / NXCD; wgid = (xcd < r ? xcd * (q + 1) : r * (q + 1) + (xcd - r) * q) + off; }
        const int nig = WGM * nN, gid = wgid / nig, fm = gid * WGM, gsz = (nM - fm) < WGM ? (nM - fm) : WGM;
        u.pm = fm + ((wgid % nig) % gsz); u.pn = (wgid % nig) / gsz; u.sub = sub;
        u.offA = ((long)u.pm * BM * lda + (long)sub * subA) * 2; u.offB = ((long)u.pn * BM + (long)sub * subB) * (long)ldb * 2;
        return true;
    }
};

struct OrderLin {
    int c, G, nu, pnbase, lda, ldb;
    DI bool next(int i, Unit& u) const { const int v = c + i * G; if (v >= nu) return false; u.pm = v & 31; u.pn = pnbase + (v >> 5); u.sub = 0;
        u.offA = (long)u.pm * BM * lda * 2; u.offB = (long)u.pn * BM * (long)ldb * 2; return true; }
};
struct OrderTri {
    int pm, k, pnbase, lda, ldb;
    DI bool next(int i, Unit& u) const { const int cnt = k < 5 ? k + 1 : (k == 5 ? 7 : 6), st = k <= 5 ? (k * (k + 1)) / 2 : 22;
        if (i >= cnt) return false; u.pm = pm; u.pn = pnbase + st + i; u.sub = 0;
        u.offA = (long)u.pm * BM * lda * 2; u.offB = (long)u.pn * BM * (long)ldb * 2; return true; }
};
template <class Epi, class Sched, bool ALIGN_EPI>
DI void gemm_phase(LAS unsigned char* lds, const int tid, const Gemm g, const Sched& S, const Epi& E) {
    const int wid = __builtin_amdgcn_readfirstlane(tid >> 6), lane = tid & 63, wr = wid >> 2, wc = wid & 3, fr = lane & 15, fq = lane >> 4;
    const int K = g.K, nt = K / BK;
    unsigned voffA[2], voffB[2];
#pragma unroll
    for (int i = 0; i < 2; ++i) { int R, C; stage_rc(tid * 16 + i * 8192, R, C); const int Rb = Epi::PERM ? ((R & ~31) + perm32(R & 31)) : R;
        voffA[i] = (unsigned)(R * g.lda + C) * 2u; voffB[i] = (unsigned)(Rb * g.ldb + C) * 2u; }
    const size_t kstep = (size_t)(BK * 2);
    const size_t hstepA = (size_t)HALF * g.lda * 2, hstepB = (size_t)HALF * g.ldb * 2;
    const unsigned ldsw = (unsigned)wid * 1024u;
    const int aoff = lds_byte(wr * 64 + fr, fq * 8), boff = lds_byte(wc * 32 + fr, fq * 8);
#define PG8_SA(b, h) (((b) * 2 + (h)) * HTB)
#define PG8_SB(b, h) ((4 + (b) * 2 + (h)) * HTB)
#define PG8_STAGE(bufoff, gbase, voff) do { _Pragma("unroll") for (int _i = 0; _i < 2; ++_i) \
        __builtin_amdgcn_global_load_lds((const unsigned*)((const char*)(gbase) + (voff)[_i]), (LAS unsigned*)(lds + (bufoff) + ldsw + _i * 8192), 16, 0, 0); } while (0)
#define PG8_LDA(dst, b, h) do { _Pragma("unroll") for (int m = 0; m < 4; ++m) _Pragma("unroll") for (int k = 0; k < 2; ++k) dst[m][k] = *(const LAS bf16x8*)(lds + PG8_SA(b, h) + aoff + m * 2048 + k * 1024); } while (0)
#define PG8_LDB(dst, b, h) do { _Pragma("unroll") for (int n = 0; n < 2; ++n) _Pragma("unroll") for (int k = 0; k < 2; ++k) dst[n][k] = *(const LAS bf16x8*)(lds + PG8_SB(b, h) + boff + n * 2048 + k * 1024); } while (0)
#define PG8_MMA(ai, bj, At, Bt) do { __builtin_amdgcn_s_setprio(1); _Pragma("unroll") for (int m = 0; m < 4; ++m) _Pragma("unroll") for (int n = 0; n < 2; ++n) _Pragma("unroll") for (int k = 0; k < 2; ++k) \
        acc[ai][bj][m][n] = __builtin_amdgcn_mfma_f32_16x16x32_bf16(Bt[n][k], At[m][k], acc[ai][bj][m][n], 0, 0, 0); __builtin_amdgcn_s_setprio(0); } while (0)
#define PG8_WAIT_V(n) asm volatile("s_waitcnt vmcnt(" #n ")" ::: "memory")
#define PG8_WAIT_L(n) asm volatile("s_waitcnt lgkmcnt(" #n ")" ::: "memory")
#define PG8_BAR __builtin_amdgcn_s_barrier()
#define PG8_SCHED __builtin_amdgcn_sched_barrier(0)
    Unit cur, nxt; int ui = 0;
    if (!S.next(0, cur)) return;
    f32x4 acc[2][2][4][2];
#pragma unroll
    for (int a = 0; a < 2; ++a)
#pragma unroll
        for (int b = 0; b < 2; ++b)
#pragma unroll
            for (int m = 0; m < 4; ++m)
#pragma unroll
                for (int n = 0; n < 2; ++n) acc[a][b][m][n] = (f32x4){0.f, 0.f, 0.f, 0.f};
    bf16x8 At[4][2], B0[2][2], B1[2][2];
    const char* cA = (const char*)g.A + cur.offA; const char* cB = (const char*)g.Bt + cur.offB;
    PG8_STAGE(PG8_SB(0, 0), cB, voffB); PG8_STAGE(PG8_SB(0, 1), cB + hstepB, voffB); PG8_STAGE(PG8_SA(0, 0), cA, voffA); PG8_STAGE(PG8_SA(0, 1), cA + hstepA, voffA);
    if (wr == 1) PG8_BAR;
    PG8_WAIT_V(2); PG8_BAR;
    PG8_STAGE(PG8_SB(1, 0), cB + kstep, voffB); PG8_STAGE(PG8_SA(1, 0), cA + kstep, voffA); PG8_STAGE(PG8_SB(1, 1), cB + hstepB + kstep, voffB);
    PG8_WAIT_V(6); PG8_BAR;
    for (;;) {
        const bool has_next = S.next(ui + 1, nxt);
        const char* nA = has_next ? (const char*)g.A + nxt.offA : cA; const char* nB = has_next ? (const char*)g.Bt + nxt.offB : cB;
        for (int t = 0; t < nt; t += 2) {
            const bool last = (t == nt - 2);
            const char* a1 = cA + (size_t)(t + 1) * kstep;
            const char* a2 = last ? nA : cA + (size_t)(t + 2) * kstep; const char* b2 = last ? nB : cB + (size_t)(t + 2) * kstep;
            const char* a3 = a2 + kstep; const char* b3 = b2 + kstep;
            PG8_LDB(B0, 0, 0); PG8_LDB(B1, 0, 1); PG8_SCHED; PG8_LDA(At, 0, 0); PG8_STAGE(PG8_SA(1, 1), a1 + hstepA, voffA);
            PG8_WAIT_V(8); PG8_WAIT_L(0); PG8_BAR; PG8_MMA(0, 0, At, B0); PG8_MMA(0, 1, At, B1); PG8_BAR; PG8_SCHED;
            PG8_LDA(At, 0, 1); PG8_STAGE(PG8_SB(0, 0), b2, voffB); PG8_STAGE(PG8_SB(0, 1), b2 + hstepB, voffB); PG8_STAGE(PG8_SA(0, 0), a2, voffA);
            PG8_WAIT_V(8); PG8_WAIT_L(0); PG8_BAR; PG8_MMA(1, 0, At, B0); PG8_MMA(1, 1, At, B1); PG8_BAR; PG8_SCHED;
            PG8_LDB(B0, 1, 0); PG8_LDB(B1, 1, 1); PG8_SCHED; PG8_LDA(At, 1, 0); PG8_STAGE(PG8_SA(0, 1), a2 + hstepA, voffA);
            PG8_WAIT_V(8); PG8_WAIT_L(0); PG8_BAR; PG8_MMA(0, 0, At, B0); PG8_MMA(0, 1, At, B1); PG8_BAR; PG8_SCHED;
            PG8_LDA(At, 1, 1); PG8_STAGE(PG8_SB(1, 0), b3, voffB); PG8_STAGE(PG8_SB(1, 1), b3 + hstepB, voffB); PG8_STAGE(PG8_SA(1, 0), a3, voffA);
            PG8_WAIT_V(8); PG8_WAIT_L(0); PG8_BAR; PG8_MMA(1, 0, At, B0); PG8_MMA(1, 1, At, B1); PG8_BAR; PG8_SCHED;
        }
        if constexpr (ALIGN_EPI) { if (wr == 0) PG8_BAR; }
        E(acc, cur, wr, wc, fr, fq);
        if (!has_next) break;
#pragma unroll
        for (int a = 0; a < 2; ++a)
#pragma unroll
            for (int b = 0; b < 2; ++b)
#pragma unroll
                for (int m = 0; m < 4; ++m)
#pragma unroll
                    for (int n = 0; n < 2; ++n) acc[a][b][m][n] = (f32x4){0.f, 0.f, 0.f, 0.f};
        cur = nxt; cA = nA; cB = nB; ++ui;
        if constexpr (ALIGN_EPI) { if (wr == 1) PG8_BAR; }
    }
    PG8_WAIT_V(0);
    if constexpr (!ALIGN_EPI) { if (wr == 0) PG8_BAR; }
    PG8_BAR;
#undef PG8_SA
#undef PG8_SB
#undef PG8_STAGE
#undef PG8_LDA
#undef PG8_LDB
#undef PG8_MMA
#undef PG8_WAIT_V
#undef PG8_WAIT_L
#undef PG8_BAR
#undef PG8_SCHED
}

typedef const f32x4 (&AccRef)[2][2][4][2];
DI float row_scale_slow(const float* part, int row) { float s = 0.f; for (int i = 0; i < 32; ++i) s += part[(size_t)row * 32 + i]; return 1.0f / sqrtf(s * (1.0f / DM) + RMS_EPS); }

struct EpiZ {
    static constexpr bool PERM = true;
    float* ZS; bf16_t* G; const float* bgate; const float* part; const LAS float* rsT; int pm0;
    DI void operator()(AccRef acc, const Unit& u, int wr, int wc, int fr, int fq) const {
#pragma unroll
        for (int ai = 0; ai < 2; ++ai)
#pragma unroll
            for (int m = 0; m < 4; ++m) {
                const int lr = ai * HALF + wr * 64 + m * 16 + fr, row = u.pm * BM + lr;
                const float s = (u.pm == pm0) ? rsT[lr] : row_scale_slow(part, row);
#pragma unroll
                for (int bj = 0; bj < 2; ++bj) {
                    const int col0 = u.pn * BM + bj * HALF + wc * 32 + 8 * fq;
                    f32x4 v0 = acc[ai][bj][m][0] * s, v1 = acc[ai][bj][m][1] * s;
                    if (u.pn < 20) { float* p = ZS + (size_t)row * ZS_COLS + col0; *(f32x4*)p = v0; *(f32x4*)(p + 4) = v1; }
                    else { const int gc = col0 - ZS_COLS; const f32x4 b0 = *(const f32x4*)(bgate + gc), b1 = *(const f32x4*)(bgate + gc + 4);
                        v0 += b0; v1 += b1;
                        u32x4 w; w.x = cvt_pk_bf16(sigmoidf_(v0[0]), sigmoidf_(v0[1])); w.y = cvt_pk_bf16(sigmoidf_(v0[2]), sigmoidf_(v0[3]));
                        w.z = cvt_pk_bf16(sigmoidf_(v1[0]), sigmoidf_(v1[1])); w.w = cvt_pk_bf16(sigmoidf_(v1[2]), sigmoidf_(v1[3]));
                        *(u32x4*)(G + (size_t)row * GCOLS + gc) = w; }
                }
            }
    }
};
struct EpiU {
    static constexpr bool PERM = true;
    bf16_t* U; int ldc; const float* part; const LAS float* rsT; int pm0;
    DI void operator()(AccRef acc, const Unit& u, int wr, int wc, int fr, int fq) const {
#pragma unroll
        for (int ai = 0; ai < 2; ++ai)
#pragma unroll
            for (int m = 0; m < 4; ++m) {
                const int lr = ai * HALF + wr * 64 + m * 16 + fr, row = u.pm * BM + lr;
                const float s = (u.pm == pm0) ? rsT[lr] : row_scale_slow(part, row);
#pragma unroll
                for (int bj = 0; bj < 2; ++bj) {
                    const int col0 = u.pn * BM + bj * HALF + wc * 32 + 8 * fq;
                    const f32x4 v0 = acc[ai][bj][m][0] * s, v1 = acc[ai][bj][m][1] * s;
                    u32x4 w; w.x = cvt_pk_bf16(v0[0], v0[1]); w.y = cvt_pk_bf16(v0[2], v0[3]); w.z = cvt_pk_bf16(v1[0], v1[1]); w.w = cvt_pk_bf16(v1[2], v1[3]);
                    *(u32x4*)(U + (size_t)row * ldc + col0) = w;
                }
            }
    }
};
struct EpiRes {
    static constexpr bool PERM = false;
    const float* Yin; float* Y; bf16_t* YB; float* part;
    DI void operator()(AccRef acc, const Unit& u, int wr, int wc, int fr, int fq) const {
#pragma unroll
        for (int ai = 0; ai < 2; ++ai)
#pragma unroll
            for (int m = 0; m < 4; ++m) {
                const int row = u.pm * BM + ai * HALF + wr * 64 + m * 16 + fr;
                float ss = 0.f;
#pragma unroll
                for (int bj = 0; bj < 2; ++bj)
#pragma unroll
                    for (int n = 0; n < 2; ++n) {
                        const int col = u.pn * BM + bj * HALF + wc * 32 + 16 * n + 4 * fq;
                        const size_t o = (size_t)row * DM + col;
                        const f32x4 y = *(const f32x4*)(Yin + o) + acc[ai][bj][m][n];
                        *(f32x4*)(Y + o) = y;
                        u32x2 w; w.x = cvt_pk_bf16(y[0], y[1]); w.y = cvt_pk_bf16(y[2], y[3]);
                        *(u32x2*)(YB + o) = w;
                        ss += (y[0] * y[0] + y[1] * y[1]) + (y[2] * y[2] + y[3] * y[3]);
                    }
                ss += __shfl_xor(ss, 16); ss += __shfl_xor(ss, 32);
                if (fq == 0) part[(size_t)row * 32 + u.pn * 4 + wc] = ss;
            }
    }
};
struct EpiGlu {
    static constexpr bool PERM = true;
    const float* YS; const float* bias; bf16_t* MIXp;
    DI void operator()(AccRef acc, const Unit& u, int wr, int wc, int fr, int fq) const {
#pragma unroll
        for (int ai = 0; ai < 2; ++ai)
#pragma unroll
            for (int m = 0; m < 4; ++m) {
                const int row = u.pm * BM + ai * HALF + wr * 64 + m * 16 + fr;
#pragma unroll
                for (int bj = 0; bj < 2; ++bj) {
                    const int col0 = u.pn * BM + bj * HALF + wc * 32 + 8 * fq;
                    const f32x4 b0 = *(const f32x4*)(bias + col0), b1 = *(const f32x4*)(bias + col0 + 4);
                    const f32x4 y0 = *(const f32x4*)(YS + (size_t)row * MIX + col0), y1 = *(const f32x4*)(YS + (size_t)row * MIX + col0 + 4);
                    const f32x4 v0 = acc[ai][bj][m][0] + b0, v1 = acc[ai][bj][m][1] + b1;
                    u32x4 w; w.x = cvt_pk_bf16(y0[0] * sigmoidf_(v0[0]), y0[1] * sigmoidf_(v0[1])); w.y = cvt_pk_bf16(y0[2] * sigmoidf_(v0[2]), y0[3] * sigmoidf_(v0[3]));
                    w.z = cvt_pk_bf16(y1[0] * sigmoidf_(v1[0]), y1[1] * sigmoidf_(v1[1])); w.w = cvt_pk_bf16(y1[2] * sigmoidf_(v1[2]), y1[3] * sigmoidf_(v1[3]));
                    *(u32x4*)(MIXp + (size_t)row * (4 * MIX) + 3 * MIX + col0) = w;
                }
            }
    }
};
struct EpiMerge {
    static constexpr bool PERM = true;
    const bf16_t* G; bf16_t* MFh; bf16_t* MERGED;
    DI void operator()(AccRef acc, const Unit& u, int wr, int wc, int fr, int fq) const {
#pragma unroll
        for (int ai = 0; ai < 2; ++ai)
#pragma unroll
            for (int m = 0; m < 4; ++m) {
                const int row = u.pm * BM + ai * HALF + wr * 64 + m * 16 + fr;
#pragma unroll
                for (int bj = 0; bj < 2; ++bj) {
                    const int col0 = u.pn * BM + bj * HALF + wc * 32 + 8 * fq;
                    const u32x4 gw = *(const u32x4*)(G + (size_t)row * GCOLS + u.sub * DM + col0);
                    f32x4 v0 = acc[ai][bj][m][0], v1 = acc[ai][bj][m][1];
                    v0[0] *= bf2f(gw.x & 0xffffu); v0[1] *= bf2f(gw.x >> 16); v0[2] *= bf2f(gw.y & 0xffffu); v0[3] *= bf2f(gw.y >> 16);
                    v1[0] *= bf2f(gw.z & 0xffffu); v1[1] *= bf2f(gw.z >> 16); v1[2] *= bf2f(gw.w & 0xffffu); v1[3] *= bf2f(gw.w >> 16);
                    bf16_t* p = MFh + (size_t)row * DM + col0;
                    constexpr size_t SL = (size_t)MTOK * DM;
                    if (u.sub < 3) { u32x4 w; w.x = cvt_pk_bf16(v0[0], v0[1]); w.y = cvt_pk_bf16(v0[2], v0[3]); w.z = cvt_pk_bf16(v1[0], v1[1]); w.w = cvt_pk_bf16(v1[2], v1[3]); *(u32x4*)(p + u.sub * SL) = w; }
                    else {
#pragma unroll
                        for (int q = 0; q < 3; ++q) { const u32x4 t = *(const u32x4*)(p + q * SL);
                            v0[0] += bf2f(t.x & 0xffffu); v0[1] += bf2f(t.x >> 16); v0[2] += bf2f(t.y & 0xffffu); v0[3] += bf2f(t.y >> 16);
                            v1[0] += bf2f(t.z & 0xffffu); v1[1] += bf2f(t.z >> 16); v1[2] += bf2f(t.w & 0xffffu); v1[3] += bf2f(t.w >> 16); }
                        u32x4 w; w.x = cvt_pk_bf16(v0[0], v0[1]); w.y = cvt_pk_bf16(v0[2], v0[3]); w.z = cvt_pk_bf16(v1[0], v1[1]); w.w = cvt_pk_bf16(v1[2], v1[3]);
                        *(u32x4*)(MERGED + (size_t)row * DM + col0) = w; }
                }
            }
    }
};
}

struct Frame { LAS unsigned char* lds; int tid, lane, wave, bid, G; };

DI Frame fresh(const Frame& F0) { Frame F = F0; int tid = F0.tid, bid = F0.bid, G = F0.G, wave = F0.wave; unsigned lo = (unsigned)(size_t)F0.lds;
    asm volatile("" : "+v"(tid)); asm volatile("" : "+s"(bid), "+s"(G), "+s"(wave), "+s"(lo));
    F.tid = tid; F.lane = tid & 63; F.wave = wave; F.bid = bid; F.G = G; F.lds = (LAS unsigned char*)(size_t)lo; return F; }
DI unsigned char* fresh_ptr(unsigned char* p) { size_t z = 0; asm volatile("" : "+s"(z)); return p + z; }
DI void rs_table(const Frame& F, const float* part, int pm) {
    LAS float* rsT = (LAS float*)(F.lds + RST_OFF);
    if (F.tid < 256) { const int row = pm * 256 + F.tid; float s = 0.f;
#pragma unroll
        for (int i = 0; i < 8; ++i) { const f32x4 v = *(const f32x4*)(part + (size_t)row * 32 + 4 * i); s += (v[0] + v[1]) + (v[2] + v[3]); }
        rsT[F.tid] = 1.0f / sqrtf(s * (1.0f / DM) + RMS_EPS); }
    __syncthreads();
}

DI int head_perm(int c) { const int h = c >> 6, p = c & 63; const int dim = p < 16 ? ((p >> 1) + 8 * (p & 1)) : p; return (h << 6) + dim; }
DI int zin_colmap(int n) {
    if (n < B_COLS) return 1860 + n;
    if (n < 2048) return -1;
    if (n < 2560) return head_perm(n - 2048);
    if (n < 3072) return 512 + head_perm(n - 2560);
    if (n < 3584) return 1024 + (n - 3072);
    if (n < 3840) return 1536 + head_perm(n - 3584);
    if (n < 3904) return 1792 + head_perm(n - 3840);
    if (n < 3908) return 1856 + (n - 3904);
    if (n < 4096) return -1;
    if (n < 4608) return 3844 + (n - 4096);
    if (n < 5120) return 4356 + (n - 4608);
    return 4868 + (n - 5120);
}
template <int MODE>
DI void tr_item(const float* W, int ldw, const float* ksc, bf16_t* WT, int K, LAS float* scr, int kb, int nb, int lane) {
    const int k0 = 64 * kb, n0 = 32 * nb, nn = n0 + (lane & 31);
    const int col = MODE == 1 ? zin_colmap(nn) : nn;
    float tv[32];
    if (col >= 0) {
#pragma unroll
        for (int i = 0; i < 32; ++i) tv[i] = W[(size_t)(k0 + 2 * i + (lane >> 5)) * ldw + col];
        if (ksc) {
#pragma unroll
            for (int i = 0; i < 32; ++i) tv[i] *= ksc[k0 + 2 * i + (lane >> 5)]; }
    } else {
#pragma unroll
        for (int i = 0; i < 32; ++i) tv[i] = 0.f; }
#pragma unroll
    for (int i = 0; i < 32; ++i) scr[(2 * i + (lane >> 5)) * 33 + (lane & 31)] = tv[i];
    LDS_WAIT(); asm volatile("" ::: "memory");
    const int c = lane & 7;
#pragma unroll
    for (int j = 0; j < 4; ++j) { const int n = (lane >> 3) + 8 * j; const LAS float* s = scr + (8 * c) * 33 + n;
        u32x4 o; o.x = pk2(s[0 * 33], s[1 * 33]); o.y = pk2(s[2 * 33], s[3 * 33]); o.z = pk2(s[4 * 33], s[5 * 33]); o.w = pk2(s[6 * 33], s[7 * 33]);
        *(u32x4*)(WT + (size_t)(n0 + n) * K + k0 + 8 * c) = o; }
    LDS_WAIT(); asm volatile("" ::: "memory");
}
struct InTab { const float* p[37]; };
#define CAS __attribute__((address_space(4)))
typedef const float* fptr_t;
typedef GAS const float* gfptr_t;
struct In { CAS const gfptr_t* t; DI fptr_t operator[](int i) const { return (fptr_t)t[i]; } };
DI In in_fresh(In in) { CAS const gfptr_t* t = in.t; asm volatile("" : "+s"(t)); In r; r.t = t; return r; }
DI void p0_prologue(const Frame& F, const In& in, unsigned char* ws) {
    LAS float* scr = (LAS float*)(F.lds + F.wave * 16384);
    const int gw = F.bid * NWAVES + F.wave, NGW = F.G * NWAVES;
    constexpr int I_IN = 32 * (NZ / 32), I_BR = 4 * 8 * 64, I_OUT = 32 * 64, I_UP = 32 * (DFF2 / 32), I_DN = 86 * 64, I_GLU = 8 * 16;
    constexpr int I_LAYER = I_IN + I_BR + I_OUT + I_UP + I_DN + I_GLU;
    for (int it = gw; it < NL * I_LAYER; it += NGW) {
        const int l = it / I_LAYER; int r = it - l * I_LAYER;
        unsigned char* wt = ws + WS_WT + (size_t)l * WT_LAYER;
        if (r < I_IN) { const int nbk = NZ / 32; tr_item<1>(in[3] + (size_t)l * DM * IN_COLS, IN_COLS, in[2] + l * DM, (bf16_t*)(wt + WT_IN), DM, scr, r / nbk, r % nbk, F.lane); continue; } r -= I_IN;
        if (r < I_BR) { const int n = r / 512, rr = r % 512; tr_item<0>(in[29] + ((size_t)l * 4 + n) * MIX * DM, DM, nullptr, (bf16_t*)(wt + WT_BR) + (size_t)n * DM * MIX, MIX, scr, rr / 64, rr % 64, F.lane); continue; } r -= I_BR;
        if (r < I_OUT) { tr_item<0>(in[30] + (size_t)l * DM * DM, DM, nullptr, (bf16_t*)(wt + WT_OUT), DM, scr, r / 64, r % 64, F.lane); continue; } r -= I_OUT;
        if (r < I_UP) { const int nbk = DFF2 / 32; tr_item<0>(in[32] + (size_t)l * DM * DFF2, DFF2, in[31] + l * DM, (bf16_t*)(wt + WT_UP), DM, scr, r / nbk, r % nbk, F.lane); continue; } r -= I_UP;
        if (r < I_DN) { tr_item<0>(in[35] + (size_t)l * DFF * DM, DM, nullptr, (bf16_t*)(wt + WT_DOWN), DFF, scr, r / 64, r % 64, F.lane); continue; } r -= I_DN;
        tr_item<0>(in[27] + (size_t)l * MIX * MIX, MIX, nullptr, (bf16_t*)(wt + WT_GLU), MIX, scr, r / 16, r % 16, F.lane);
    }
    { bf16_t* WTL = (bf16_t*)(ws + WS_WTL);
      for (int e = F.bid * NTHR + F.tid; e < NL * 56 * MIX; e += F.G * NTHR) { const int n = e % MIX, k8 = (e / MIX) % 56, l = e / (MIX * 56); const int k0 = k8 * 8;
          const float* src = k0 < 96 ? in[8] + ((size_t)l * 96 + k0) * MIX : (k0 < 192 ? in[10] + ((size_t)l * 96 + (k0 - 96)) * MIX : in[11] + ((size_t)l * 256 + (k0 - 192)) * MIX);
          u32x4 o; o.x = pk2(src[n], src[MIX + n]); o.y = pk2(src[2 * MIX + n], src[3 * MIX + n]); o.z = pk2(src[4 * MIX + n], src[5 * MIX + n]); o.w = pk2(src[6 * MIX + n], src[7 * MIX + n]);
          *(u32x4*)(WTL + ((size_t)l * MIX + n) * 448 + k0) = o; } }
    const int* pos = (const int*)in[1];
    float* rope = (float*)(ws + WS_ROPE);
    for (int e = F.bid * NTHR + F.tid; e < MTOK * 8; e += F.G * NTHR) { const int m = e >> 3, i = e & 7;
        const float inv = exp2f(-(float)i * 0.125f * 18.931568569324174f);
        const float ang = (float)pos[m] * inv; float sn, cs; sincosf(ang, &sn, &cs);
        rope[m * 16 + i] = cs; rope[m * 16 + 8 + i] = sn; }
    const float* x = in[0]; bf16_t* YB = (bf16_t*)(ws + WS_YB); float* pa = (float*)(ws + WS_PARTA);
    for (int m = gw; m < MTOK; m += NGW) { float s = 0.f;
#pragma unroll
        for (int j = 0; j < 8; ++j) { const f32x4 v = *(const f32x4*)(x + (size_t)m * DM + (j * 64 + F.lane) * 4); s += (v[0] * v[0] + v[1] * v[1]) + (v[2] * v[2] + v[3] * v[3]);
            u32x2 w; w.x = pk2(v[0], v[1]); w.y = pk2(v[2], v[3]); *(u32x2*)(YB + (size_t)m * DM + (j * 64 + F.lane) * 4) = w; }
        s = wave_sum(s);
        if (F.lane < 32) pa[(size_t)m * 32 + F.lane] = (F.lane == 0) ? s : 0.f; }
}

DI void dsa_prep_item(const Frame& F, unsigned char* ws, const float* idxg, int item) {
    const float* ZS = (const float*)(ws + WS_ZS); const float* rope = (const float*)(ws + WS_ROPE);
    bf16_t* Q = (bf16_t*)(ws + WS_Q); bf16_t* Kb = (bf16_t*)(ws + WS_K); bf16_t* VT = (bf16_t*)(ws + WS_VT); bf16_t* QI = (bf16_t*)(ws + WS_QI); bf16_t* KI = (bf16_t*)(ws + WS_KI); float* WI = (float*)(ws + WS_WI);
    const int m0 = item * 64;
#pragma unroll 8
    for (int e = F.tid; e < 64 * 640; e += NTHR) { const int t = e / 640, pc = e % 640; const int m = m0 + t;
        int zc, oc; bf16_t* dst; int ld; float sc = 1.f;
        if (pc < 256) { zc = ZO_Q + 2 * pc; oc = 2 * pc; dst = Q; ld = 512; sc = 0.125f; }
        else if (pc < 512) { zc = ZO_AK + 2 * (pc - 256); oc = 2 * (pc - 256); dst = Kb; ld = 512; }
        else { zc = ZO_QI + 2 * (pc - 512); oc = 2 * (pc - 512); dst = QI; ld = 256; }
        const f32x2 v = *(const f32x2*)(ZS + (size_t)m * ZS_COLS + zc); float a = v[0], b = v[1];
        const int p = oc & 63;
        { const float cs = rope[m * 16 + ((p >> 1) & 7)], sn = rope[m * 16 + 8 + ((p >> 1) & 7)]; const float a2 = a * cs - b * sn, b2 = b * cs + a * sn; a = (p < 16) ? a2 : a; b = (p < 16) ? b2 : b; }
        *(unsigned*)(dst + (size_t)m * ld + oc) = pk2(a * sc, b * sc); }
    for (int tt = 0; tt < 8; ++tt) { const int m = m0 + F.wave * 8 + tt;
        const float xv = ZS[(size_t)m * ZS_COLS + ZO_KI + F.lane];
        const float ss = wave_sum(xv * xv);
        const int dim = F.lane < 16 ? ((F.lane >> 1) + 8 * (F.lane & 1)) : F.lane;
        float y = xv * (1.0f / sqrtf(ss * (1.0f / 64.f) + RMS_EPS)) * idxg[dim];
        const float pr = __shfl_xor(y, 1);
        if (F.lane < 16) { const float cs = rope[m * 16 + (F.lane >> 1)], sn = rope[m * 16 + 8 + (F.lane >> 1)]; y = (F.lane & 1) ? (y * cs + pr * sn) : (y * cs - pr * sn); }
        KI[(size_t)m * 64 + F.lane] = (bf16_t)f2bf(y);
        if (F.lane < 4) WI[(size_t)m * 4 + F.lane] = ZS[(size_t)m * ZS_COLS + ZO_WI + F.lane]; }
    LAS unsigned char* L = F.lds;
    for (int e = F.tid; e < 64 * 128; e += NTHR) { const int t = e >> 7, c4 = (e & 127) * 4;
        const f32x4 v = *(const f32x4*)(ZS + (size_t)(m0 + t) * ZS_COLS + ZO_AV + c4);
        u32x2 w; w.x = pk2(v[0], v[1]); w.y = pk2(v[2], v[3]); *(LAS u32x2*)(L + t * 1040 + c4 * 2) = w; }
    __syncthreads();
    { const int b = m0 / SEQ, s0 = m0 % SEQ;
      for (int e = F.tid; e < 512 * 8; e += NTHR) { const int c = e >> 3, oct = e & 7;
          unsigned short vals[8];
#pragma unroll
          for (int j = 0; j < 8; ++j) vals[j] = *(const LAS unsigned short*)(L + (oct * 8 + j) * 1040 + c * 2);
          u32x4 o; o.x = vals[0] | ((unsigned)vals[1] << 16); o.y = vals[2] | ((unsigned)vals[3] << 16); o.z = vals[4] | ((unsigned)vals[5] << 16); o.w = vals[6] | ((unsigned)vals[7] << 16);
          *(u32x4*)(VT + ((size_t)(b * 512 + c)) * SEQ + s0 + oct * 8) = o; } }
    __syncthreads();
}

DI float softplusf_(float x) { return fmaxf(x, 0.f) + __logf(1.0f + __expf(-fabsf(x))); }
DI float tanhf_(float x) { return 1.0f - 2.0f * __builtin_amdgcn_rcpf(1.0f + __expf(2.0f * x)); }
DI float half32_sum(float x) { x = row16_sum(x); return x + __shfl_xor(x, 16); }
DI void rwkv_prep_item(const Frame& F, unsigned char* ws, const In& in, int l, int item) {
    const float* ZS = (const float*)(ws + WS_ZS);
    const float* mu = in[6] + l * B_COLS; const float* w0 = in[7] + l * MIX; const float* a0 = in[9] + l * MIX; const float* k_k = in[12] + l * MIX; const float* k_a = in[13] + l * MIX;
    const bf16_t* WTL = (const bf16_t*)(ws + WS_WTL) + (size_t)l * MIX * 448;
    float* RW = (float*)(ws + WS_RW); constexpr size_t RS = RW_STRIDE / 4;
    const int m0 = item * 32; const bool first = (m0 % SEQ) == 0;
    constexpr int XP = 456;
    LAS bf16_t* X = (LAS bf16_t*)F.lds;
#pragma unroll 7
    for (int e = F.tid; e < 32 * 448; e += NTHR) { const int t = e / 448, c = e % 448; const int m = m0 + t, zc = ZO_LW + c;
        const bool nop = first && t == 0; const float z = ZS[(size_t)m * ZS_COLS + zc]; const float zq = ZS[(size_t)(nop ? m : m - 1) * ZS_COLS + zc]; const float zp = nop ? 0.f : zq;
        const float xs = z + (zp - z) * mu[zc];
        X[t * XP + c] = (bf16_t)f2bf(c < 96 ? tanhf_(xs) : (c < 192 ? xs : sigmoidf_(xs))); }
    __syncthreads();
    const int r = F.lane & 31, hh = F.lane >> 5, h = F.wave;
    float inv[16];
#pragma unroll
    for (int i = 0; i < 16; ++i) inv[i] = 0.f;
#pragma unroll
    for (int nt = 0; nt < 2; ++nt) { const int n = h * 64 + nt * 32 + r; const float muK = mu[ZO_K + n], kkn = k_k[n];
#pragma unroll
        for (int g = 0; g < 4; ++g) { const int tb = 8 * g + 4 * hh;
            float pk = (first && tb == 0) ? 0.f : ZS[(size_t)(m0 + tb - 1) * ZS_COLS + ZO_K + n];
#pragma unroll
            for (int j = 0; j < 4; ++j) { const float zk_ = ZS[(size_t)(m0 + tb + j) * ZS_COLS + ZO_K + n]; const float k = (zk_ + (pk - zk_) * muK) * kkn; pk = zk_; inv[4 * g + j] += k * k; } } }
#pragma unroll
    for (int i = 0; i < 16; ++i) inv[i] = 1.0f / fmaxf(sqrtf(half32_sum(inv[i])), 1e-12f);
    const LAS bf16_t* xa = X + r * XP + 8 * hh;
#pragma unroll 1
    for (int nt = 0; nt < 2; ++nt) { const int n = h * 64 + nt * 32 + r; const bf16_t* wrow = WTL + (size_t)n * 448 + 8 * hh;
        f32x16 aw, aa, ag;
#pragma unroll
        for (int i = 0; i < 16; ++i) { aw[i] = 0.f; aa[i] = 0.f; ag[i] = 0.f; }
#pragma unroll
        for (int s2 = 0; s2 < 6; ++s2) { aw = MFMA32(*(const LAS bf16x8*)(xa + 16 * s2), *(const bf16x8*)(wrow + 16 * s2), aw);
                                         aa = MFMA32(*(const LAS bf16x8*)(xa + 96 + 16 * s2), *(const bf16x8*)(wrow + 96 + 16 * s2), aa); }
#pragma unroll
        for (int s2 = 0; s2 < 16; ++s2) ag = MFMA32(*(const LAS bf16x8*)(xa + 192 + 16 * s2), *(const bf16x8*)(wrow + 192 + 16 * s2), ag);
        const float muR = mu[ZO_R + n], muK = mu[ZO_K + n], muV = mu[ZO_V + n], w0n = w0[n], a0n = a0[n], kkn = k_k[n], kan = k_a[n];
#pragma unroll
        for (int g = 0; g < 4; ++g) { const int tb = 8 * g + 4 * hh;
            float pr, pk, pv;
            if (first && tb == 0) { pr = 0.f; pk = 0.f; pv = 0.f; }
            else { const float* zp = ZS + (size_t)(m0 + tb - 1) * ZS_COLS; pr = zp[ZO_R + n]; pk = zp[ZO_K + n]; pv = zp[ZO_V + n]; }
#pragma unroll
            for (int j = 0; j < 4; ++j) { const int i = 4 * g + j, m = m0 + tb + j; const float* zr = ZS + (size_t)m * ZS_COLS;
                const float zr_ = zr[ZO_R + n], zk_ = zr[ZO_K + n], zv_ = zr[ZO_V + n];
                const float rr = zr_ + (pr - zr_) * muR, k = zk_ + (pk - zk_) * muK, v = zv_ + (pv - zv_) * muV;
                pr = zr_; pk = zk_; pv = zv_;
                const float wlog = -softplusf_(-(w0n + aw[i])) - 0.5f;
                const float decay = __expf(-__expf(wlog));
                const float a = sigmoidf_(a0n + aa[i]);
                const float kk = k * kkn * inv[i];
                const size_t o = (size_t)m * MIX + n;
                RW[0 * RS + o] = rr; RW[1 * RS + o] = decay; RW[2 * RS + o] = k * (1.0f + (a - 1.0f) * kan); RW[3 * RS + o] = v; RW[4 * RS + o] = -kk; RW[5 * RS + o] = kk * a; RW[6 * RS + o] = ag[i]; } } }
    __syncthreads();
}

DI void pool_item(const Frame& F, unsigned char* ws, const In& in, int l, int item) {
    const float* ZS = (const float*)(ws + WS_ZS); bf16_t* MIXp = (bf16_t*)(ws + WS_MIX);
    const float* pw = in[17] + (size_t)l * 4 * 128 * 128; const float* psc = in[18] + l * MIX;
    const int m0 = item * 16, t0 = m0 % SEQ;
    LAS float* Z = (LAS float*)F.lds;
    LAS float* DT = Z + 31 * 512;
    for (int e = F.tid; e < 31 * 128; e += NTHR) { const int r = e >> 7, c4 = (e & 127) * 4; const int ta = t0 - 15 + r;
        f32x4 v = (f32x4){0.f, 0.f, 0.f, 0.f};
        if (ta >= 0) v = *(const f32x4*)(ZS + (size_t)(m0 - 15 + r) * ZS_COLS + ZO_C + c4);
        *(LAS f32x4*)(Z + r * 512 + c4) = v; }
    __syncthreads();
    const int j = F.tid, gi = j >> 7, win = 2 << gi;
    for (int t = 0; t < 16; ++t) { float s = 0.f;
        for (int i = 0; i < win; ++i) s += Z[(15 + t - i) * 512 + j];
        const int cnt = (t0 + t + 1) < win ? (t0 + t + 1) : win;
        DT[j * 16 + t] = s / (float)cnt - Z[(15 + t) * 512 + j]; }
    __syncthreads();
    float acc[16];
#pragma unroll
    for (int t = 0; t < 16; ++t) acc[t] = 0.f;
    const int dcol = j & 127;
#pragma unroll 8
    for (int k = 0; k < 128; ++k) { const float wv = pw[((size_t)gi * 128 + k) * 128 + dcol];
#pragma unroll
        for (int q = 0; q < 4; ++q) { const f32x4 x = *(const LAS f32x4*)(DT + (gi * 128 + k) * 16 + 4 * q);
#pragma unroll
            for (int i = 0; i < 4; ++i) acc[4 * q + i] += x[i] * wv; } }
    const float sc = psc[j];
#pragma unroll
    for (int t = 0; t < 16; ++t) MIXp[(size_t)(m0 + t) * (4 * MIX) + 2 * MIX + j] = (bf16_t)f2bf(acc[t] * sc);
    __syncthreads();
}

struct SsmCoef { float lr, li; float br[16], bi[16]; };
DI void ssm_coef(const In& in, int l, int g, int p, SsmCoef& c) {
    const float are = in[19][((size_t)l * 32 + g) * 64 + p], aim = in[20][((size_t)l * 32 + g) * 64 + p];
    const float dt = expf(in[21][l * 32 + g]);
    const float er = expf(are * dt); float sn, cs; sincosf(aim * dt, &sn, &cs);
    c.lr = er * cs; c.li = er * sn;
    const float nr = c.lr - 1.0f, ni = c.li, den = are * are + aim * aim;
    const float cr = (nr * are + ni * aim) / den, ci = (ni * are - nr * aim) / den;
    const float* bre = in[22] + (((size_t)l * 32 + g) * 64 + p) * 16; const float* bim = in[23] + (((size_t)l * 32 + g) * 64 + p) * 16;
#pragma unroll
    for (int k = 0; k < 16; ++k) { const float x = bre[k], y = bim[k]; c.br[k] = cr * x - ci * y; c.bi[k] = cr * y + ci * x; }
}
DI void ssm_pass1_item(const Frame& F, unsigned char* ws, const In& in, int l, int item) {
    const float* ZS = (const float*)(ws + WS_ZS); float* SST = (float*)(ws + WS_SSTATE);
    const int wt = item * 8 + F.wave, b = wt >> 9, g = (wt >> 4) & 31, ch = wt & 15, p = F.lane;
    SsmCoef c; ssm_coef(in, l, g, p, c);
    LAS float* UL = (LAS float*)(F.lds + F.wave * 8192);
    const int mb = b * SEQ + ch * 128;
#pragma unroll
    for (int i = 0; i < 8; ++i) { const int e = i * 64 + F.lane, t = e >> 2, q = e & 3;
        *(LAS f32x4*)(UL + t * 16 + q * 4) = *(const f32x4*)(ZS + (size_t)(mb + t) * ZS_COLS + ZO_D + g * 16 + q * 4); }
    LDS_WAIT(); asm volatile("" ::: "memory");
    float xr = 0.f, xi = 0.f;
#pragma unroll 2
    for (int t = 0; t < 128; ++t) { float bur = 0.f, bui = 0.f;
#pragma unroll
        for (int q = 0; q < 4; ++q) { const f32x4 u = *(const LAS f32x4*)(UL + t * 16 + q * 4);
#pragma unroll
            for (int i = 0; i < 4; ++i) { bur += c.br[4 * q + i] * u[i]; bui += c.bi[4 * q + i] * u[i]; } }
        const float nr = c.lr * xr - c.li * xi + bur, ni = c.lr * xi + c.li * xr + bui; xr = nr; xi = ni; }
    *(f32x2*)(SST + ((size_t)wt * 64 + p) * 2) = (f32x2){xr, xi};
    LDS_WAIT(); asm volatile("" ::: "memory");
}
DI float gelu_tanh(float y) { const float u = 0.7978845608028654f * (y + 0.044715f * y * y * y); return y * (1.0f - __builtin_amdgcn_rcpf(1.0f + __expf(2.0f * u))); }
DI void ssm_pass3_item(const Frame& F, unsigned char* ws, const In& in, int l, int item) {
    const float* ZS = (const float*)(ws + WS_ZS); const float* SST = (const float*)(ws + WS_SSTATE);
    float* YS = (float*)(ws + WS_YS); bf16_t* YSB = (bf16_t*)(ws + WS_YSB);
    const int wt = item * 8 + F.wave, b = wt >> 9, g = (wt >> 4) & 31, ch = wt & 15, p = F.lane;
    SsmCoef c; ssm_coef(in, l, g, p, c);
    LAS float* CL = (LAS float*)(F.lds + 98304);
    { const float* cre = in[24] + ((size_t)l * 32 + g) * 16 * 64; const float* cim = in[25] + ((size_t)l * 32 + g) * 16 * 64;
      for (int e = F.tid; e < 1024; e += NTHR) { const int cc = e >> 6, pp = e & 63; *(LAS f32x2*)(CL + cc * 132 + pp * 2) = (f32x2){cre[e], cim[e]}; } }
    __syncthreads();
    float l128r = c.lr, l128i = c.li;
#pragma unroll
    for (int i = 0; i < 7; ++i) { const float nr = l128r * l128r - l128i * l128i, ni = 2.f * l128r * l128i; l128r = nr; l128i = ni; }
    float xr = 0.f, xi = 0.f;
    { f32x2 ev[15];
#pragma unroll
      for (int cc = 0; cc < 15; ++cc) { const int c2 = cc < ch ? cc : 0; ev[cc] = *(const f32x2*)(SST + ((size_t)(wt - ch + c2) * 64 + p) * 2); }
#pragma unroll
      for (int cc = 0; cc < 15; ++cc) if (cc < ch) { const float nr = l128r * xr - l128i * xi + ev[cc][0], ni = l128r * xi + l128i * xr + ev[cc][1]; xr = nr; xi = ni; } }
    LAS float* UL = (LAS float*)(F.lds + F.wave * 12288);
    LAS float* XS = UL + 256;
    const int mb = b * SEQ + ch * 128;
    const float dsk = in[26][l * MIX + g * 16 + (F.lane & 15)];
    const float* usrc = ZS + (size_t)(mb + (F.lane >> 2)) * ZS_COLS + ZO_D + g * 16 + (F.lane & 3) * 4;
    f32x4 unext = *(const f32x4*)usrc;
    for (int sc = 0; sc < 8; ++sc) {
        *(LAS f32x4*)(UL + (F.lane >> 2) * 16 + (F.lane & 3) * 4) = unext;
        if (sc < 7) unext = *(const f32x4*)(usrc + (size_t)(sc + 1) * 16 * ZS_COLS);
        LDS_WAIT(); asm volatile("" ::: "memory");
#pragma unroll 2
        for (int t = 0; t < 16; ++t) { float bur = 0.f, bui = 0.f;
#pragma unroll
            for (int q = 0; q < 4; ++q) { const f32x4 u = *(const LAS f32x4*)(UL + t * 16 + q * 4);
#pragma unroll
                for (int i = 0; i < 4; ++i) { bur += c.br[4 * q + i] * u[i]; bui += c.bi[4 * q + i] * u[i]; } }
            const float nr = c.lr * xr - c.li * xi + bur, ni = c.lr * xi + c.li * xr + bui; xr = nr; xi = ni;
            *(LAS f32x2*)(XS + (t * 64 + p) * 2) = (f32x2){xr, xi}; }
        LDS_WAIT(); asm volatile("" ::: "memory");
        const int cc = F.lane & 15, tq = F.lane >> 4;
        float y[4] = {0.f, 0.f, 0.f, 0.f};
#pragma unroll 4
        for (int pp = 0; pp < 64; pp += 2) { const f32x4 cv = *(const LAS f32x4*)(CL + cc * 132 + pp * 2);
#pragma unroll
            for (int jj = 0; jj < 4; ++jj) { const f32x4 xv = *(const LAS f32x4*)(XS + ((tq * 4 + jj) * 64 + pp) * 2);
                y[jj] += cv[0] * xv[0] - cv[1] * xv[1] + cv[2] * xv[2] - cv[3] * xv[3]; } }
#pragma unroll
        for (int jj = 0; jj < 4; ++jj) { const int t = tq * 4 + jj; const int m = mb + sc * 16 + t;
            const float yy = gelu_tanh(y[jj] + dsk * UL[t * 16 + cc]);
            YS[(size_t)m * MIX + g * 16 + cc] = yy; YSB[(size_t)m * MIX + g * 16 + cc] = (bf16_t)f2bf(yy); }
        LDS_WAIT(); asm volatile("" ::: "memory");
    }
    __syncthreads();
}

DI float vmul_(float a, float b) { float d; asm("v_mul_f32 %0, %1, %2" : "=v"(d) : "v"(a), "v"(b)); return d; }
DI float vfma_(float a, float b, float c) { float d; asm("v_fma_f32 %0, %1, %2, %3" : "=v"(d) : "v"(a), "v"(b), "v"(c)); return d; }
DI void row16_sum2(float& x0, float& x1) {
    asm("s_nop 1\n\t"
        "v_add_f32_dpp %0, %0, %0 quad_perm:[1,0,3,2] row_mask:0xf bank_mask:0xf bound_ctrl:1\n\tv_add_f32_dpp %1, %1, %1 quad_perm:[1,0,3,2] row_mask:0xf bank_mask:0xf bound_ctrl:1\n\ts_nop 0\n\t"
        "v_add_f32_dpp %0, %0, %0 quad_perm:[2,3,0,1] row_mask:0xf bank_mask:0xf bound_ctrl:1\n\tv_add_f32_dpp %1, %1, %1 quad_perm:[2,3,0,1] row_mask:0xf bank_mask:0xf bound_ctrl:1\n\ts_nop 0\n\t"
        "v_add_f32_dpp %0, %0, %0 row_half_mirror row_mask:0xf bank_mask:0xf bound_ctrl:1\n\tv_add_f32_dpp %1, %1, %1 row_half_mirror row_mask:0xf bank_mask:0xf bound_ctrl:1\n\ts_nop 0\n\t"
        "v_add_f32_dpp %0, %0, %0 row_mirror row_mask:0xf bank_mask:0xf bound_ctrl:1\n\tv_add_f32_dpp %1, %1, %1 row_mirror row_mask:0xf bank_mask:0xf bound_ctrl:1\n\ts_nop 1"
        : "+v"(x0), "+v"(x1));
}
DI void rwkv_scan_item(const Frame& F, unsigned char* ws, int item) {
    const float* RW = (const float*)(ws + WS_RW); constexpr size_t RS = RW_STRIDE / 4;
    float* YRAW = (float*)(ws + WS_YRAW);
    constexpr int TC = 32, NCH = SEQ / TC;
    const int b = item >> 3, h = item & 7;
    const int rg = F.lane >> 4, jq = F.lane & 15, row0 = F.wave * 8 + rg * 2;
    LAS float* BUF = (LAS float*)F.lds;
    constexpr int BUFSZ = 6 * TC * 64;
    const int st = F.tid >> 4, sq = F.tid & 15;
    const float* gsrc = RW + (size_t)(b * SEQ + st) * MIX + h * 64 + 4 * sq;
    f32x4 pre[6];
#pragma unroll
    for (int a = 0; a < 6; ++a) pre[a] = *(const f32x4*)(gsrc + a * RS);
#pragma unroll
    for (int a = 0; a < 6; ++a) *(LAS f32x4*)(BUF + (a * TC + st) * 64 + 4 * sq) = pre[a];
    __syncthreads();
    float S0[4] = {0.f, 0.f, 0.f, 0.f}, S1[4] = {0.f, 0.f, 0.f, 0.f};
    float* yout = YRAW + (size_t)(b * SEQ) * MIX + h * 64 + row0;
#pragma unroll 1
    for (int c = 0; c < NCH; ++c) {
        if (c + 1 < NCH) {
#pragma unroll
            for (int a = 0; a < 6; ++a) pre[a] = *(const f32x4*)(gsrc + a * RS + (size_t)(c + 1) * TC * MIX);
        }
        const LAS float* P = BUF + (c & 1) * BUFSZ;
#pragma unroll 1
        for (int t16 = 0; t16 < TC; t16 += 16) {
            float yk0 = 0.f, yk1 = 0.f;
#pragma unroll 4
            for (int tt = 0; tt < 16; ++tt) { const int t = t16 + tt;
                const f32x4 a4 = *(const LAS f32x4*)(P + (4 * TC + t) * 64 + 4 * jq);
                const f32x4 k4 = *(const LAS f32x4*)(P + (2 * TC + t) * 64 + 4 * jq);
                const f32x2 v2 = *(const LAS f32x2*)(P + (3 * TC + t) * 64 + row0);
                const f32x4 b4 = *(const LAS f32x4*)(P + (5 * TC + t) * 64 + 4 * jq);
                const f32x4 w4 = *(const LAS f32x4*)(P + (1 * TC + t) * 64 + 4 * jq);
                const f32x4 r4 = *(const LAS f32x4*)(P + (0 * TC + t) * 64 + 4 * jq);
                float sa0 = vfma_(S0[3], a4[3], vfma_(S0[2], a4[2], vfma_(S0[1], a4[1], vmul_(S0[0], a4[0]))));
                float sa1 = vfma_(S1[3], a4[3], vfma_(S1[2], a4[2], vfma_(S1[1], a4[1], vmul_(S1[0], a4[0]))));
                row16_sum2(sa0, sa1);
#pragma unroll
                for (int i = 0; i < 4; ++i) { S0[i] = vfma_(S0[i], w4[i], vfma_(sa0, b4[i], vmul_(v2[0], k4[i]))); S1[i] = vfma_(S1[i], w4[i], vfma_(sa1, b4[i], vmul_(v2[1], k4[i]))); }
                float y0 = vfma_(S0[3], r4[3], vfma_(S0[2], r4[2], vfma_(S0[1], r4[1], vmul_(S0[0], r4[0]))));
                float y1 = vfma_(S1[3], r4[3], vfma_(S1[2], r4[2], vfma_(S1[1], r4[1], vmul_(S1[0], r4[0]))));
                row16_sum2(y0, y1);
                const bool mine = (tt & 15) == jq;
                yk0 = mine ? y0 : yk0; yk1 = mine ? y1 : yk1; }
            *(f32x2*)(yout + (size_t)(c * TC + t16 + jq) * MIX) = (f32x2){yk0, yk1};
        }
        if (c + 1 < NCH) {
            LAS float* Q = BUF + ((c + 1) & 1) * BUFSZ;
#pragma unroll
            for (int a = 0; a < 6; ++a) *(LAS f32x4*)(Q + (a * TC + st) * 64 + 4 * sq) = pre[a];
        }
        __syncthreads();
    }
}
DI void rwkv_post_rows(const Frame& F, unsigned char* ws, const In& in, int l, int w0, int nw) {
    const float* RW = (const float*)(ws + WS_RW); constexpr size_t RS = RW_STRIDE / 4;
    const float* YRAW = (const float*)(ws + WS_YRAW); bf16_t* MIXp = (bf16_t*)(ws + WS_MIX);
    const float* r_k = in[14] + l * MIX; const float* lng = in[15] + l * MIX; const float* lnb = in[16] + l * MIX;
    for (int e = w0; e < MTOK * 8; e += nw) { const int m = e >> 3, h = e & 7, ch = h * 64 + F.lane; const size_t o = (size_t)m * MIX + ch;
        const float y = YRAW[o];
        const float mean = wave_sum(y) * (1.f / 64.f); const float d = y - mean; const float var = wave_sum(d * d) * (1.f / 64.f);
        const float yn = d * (1.0f / sqrtf(var + GN_EPS)) * lng[ch] + lnb[ch];
        const float bon = wave_sum(RW[0 * RS + o] * RW[2 * RS + o] * r_k[ch]) * RW[3 * RS + o];
        MIXp[(size_t)m * (4 * MIX) + MIX + ch] = (bf16_t)f2bf((yn + bon) * RW[6 * RS + o]); }
}

DI unsigned wave_sum_u32(unsigned x) {
    float f = __builtin_bit_cast(float, x); (void)f;
    int v = (int)x;
    v += __builtin_amdgcn_update_dpp(0, v, 0xB1, 0xF, 0xF, true); v += __builtin_amdgcn_update_dpp(0, v, 0x4E, 0xF, 0xF, true);
    v += __builtin_amdgcn_update_dpp(0, v, 0x141, 0xF, 0xF, true); v += __builtin_amdgcn_update_dpp(0, v, 0x140, 0xF, 0xF, true);
    return (unsigned)(__builtin_amdgcn_readlane(v, 0) + __builtin_amdgcn_readlane(v, 16) + __builtin_amdgcn_readlane(v, 32) + __builtin_amdgcn_readlane(v, 48));
}
DI unsigned fkey(float v) { unsigned u = __builtin_bit_cast(unsigned, v); if (u == 0x80000000u) u = 0u; return (u & 0x80000000u) ? ~u : (u | 0x80000000u); }
DI bf16x8 pack8(float a0, float a1, float a2, float a3, float a4, float a5, float a6, float a7) {
    u32x4 p; p.x = pk2(a0, a1); p.y = pk2(a2, a3); p.z = pk2(a4, a5); p.w = pk2(a6, a7); return __builtin_bit_cast(bf16x8, p); }
struct AttTile { bf16x8 kf[4]; s16x4 vf[8]; unsigned mw; };
DI void att_load(AttTile& T, const bf16_t* kp, const bf16_t* vp, const unsigned* mp, int kt) {
#pragma unroll
    for (int s = 0; s < 4; ++s) T.kf[s] = *(const bf16x8*)(kp + (size_t)kt * 32 * 512 + 16 * s);
#pragma unroll
    for (int s2 = 0; s2 < 2; ++s2) { const bf16_t* v = vp + kt * 32 + 16 * s2;
        T.vf[4 * s2 + 0] = *(const s16x4*)(v); T.vf[4 * s2 + 1] = *(const s16x4*)(v + 8);
        T.vf[4 * s2 + 2] = *(const s16x4*)(v + (size_t)32 * SEQ); T.vf[4 * s2 + 3] = *(const s16x4*)(v + (size_t)32 * SEQ + 8); }
    T.mw = mp[kt];
}
DI void att_tile(const AttTile& T, const bf16x8 (&qf)[4], f32x16& o0, f32x16& o1, float& mrun, float& lrun, int hh) {
    f32x16 sa;
#pragma unroll
    for (int i = 0; i < 16; ++i) sa[i] = 0.f;
#pragma unroll
    for (int s = 0; s < 4; ++s) sa = MFMA32(T.kf[s], qf[s], sa);
    float mx = -1e30f;
#pragma unroll
    for (int i = 0; i < 16; ++i) { const int kr = (i & 3) + 8 * (i >> 2) + 4 * hh; const bool on = (T.mw >> kr) & 1u; sa[i] = on ? sa[i] : -1e30f; mx = fmaxf(mx, sa[i]); }
    mx = fmaxf(mx, __shfl_xor(mx, 32));
    const float mnew = fmaxf(mrun, mx);
    if (__any(mnew > mrun)) {
        const float alpha = __expf(mrun - mnew); lrun *= alpha;
#pragma unroll
        for (int i = 0; i < 16; ++i) { o0[i] *= alpha; o1[i] *= alpha; }
        mrun = mnew; }
    float p[16], ps = 0.f;
#pragma unroll
    for (int i = 0; i < 16; ++i) { p[i] = (sa[i] > -1e29f) ? __expf(sa[i] - mrun) : 0.f; ps += p[i]; }
    lrun += ps;
#pragma unroll
    for (int s2 = 0; s2 < 2; ++s2) {
        const bf16x8 pb = pack8(p[8 * s2], p[8 * s2 + 1], p[8 * s2 + 2], p[8 * s2 + 3], p[8 * s2 + 4], p[8 * s2 + 5], p[8 * s2 + 6], p[8 * s2 + 7]);
        const bf16x8 vf0 = __builtin_shufflevector(T.vf[4 * s2], T.vf[4 * s2 + 1], 0, 1, 2, 3, 4, 5, 6, 7), vf1 = __builtin_shufflevector(T.vf[4 * s2 + 2], T.vf[4 * s2 + 3], 0, 1, 2, 3, 4, 5, 6, 7);
        o0 = MFMA32(vf0, pb, o0); o1 = MFMA32(vf1, pb, o1); }
}
DI void dsa_item(const Frame& F, unsigned char* ws, int item) {
    const bf16_t* Q = (const bf16_t*)(ws + WS_Q); const bf16_t* Kb = (const bf16_t*)(ws + WS_K); const bf16_t* VT = (const bf16_t*)(ws + WS_VT);
    const bf16_t* QI = (const bf16_t*)(ws + WS_QI); const bf16_t* KI = (const bf16_t*)(ws + WS_KI); const float* WI = (const float*)(ws + WS_WI);
    float* SC = (float*)(ws + WS_SC); unsigned* MASK = (unsigned*)(ws + WS_MASK); bf16_t* MIXp = (bf16_t*)(ws + WS_MIX);
    const int b = item >> 6, qb = item & 63, q0 = qb * 32, m0 = b * SEQ + q0;
    const int r = F.lane & 31, hh = F.lane >> 5;
    {
        float wv[4];
#pragma unroll
        for (int hd = 0; hd < 4; ++hd) wv[hd] = WI[(size_t)(m0 + r) * 4 + hd];
        const bf16_t* qip = QI + (size_t)(m0 + r) * 256 + 8 * hh;
        const bf16_t* kip = KI + (size_t)(b * SEQ + r) * 64 + 8 * hh;
        bf16x8 kf[4], kn[4];
        if (F.wave <= qb) {
#pragma unroll
            for (int s = 0; s < 4; ++s) kf[s] = *(const bf16x8*)(kip + (size_t)F.wave * 32 * 64 + 16 * s); }
        for (int kt = F.wave; kt <= qb; kt += 8) {
            if (kt + 8 <= qb) {
#pragma unroll
                for (int s = 0; s < 4; ++s) kn[s] = *(const bf16x8*)(kip + (size_t)(kt + 8) * 32 * 64 + 16 * s); }
            f32x16 sc;
#pragma unroll
            for (int i = 0; i < 16; ++i) sc[i] = 0.f;
#pragma unroll
            for (int hd = 0; hd < 4; ++hd) { f32x16 a; bf16x8 qf[4];
#pragma unroll
                for (int s = 0; s < 4; ++s) qf[s] = *(const bf16x8*)(qip + hd * 64 + 16 * s);
#pragma unroll
                for (int i = 0; i < 16; ++i) a[i] = 0.f;
#pragma unroll
                for (int s = 0; s < 4; ++s) a = MFMA32(kf[s], qf[s], a);
#pragma unroll
                for (int i = 0; i < 16; ++i) sc[i] += wv[hd] * fmaxf(a[i], 0.f); }
#pragma unroll
            for (int g = 0; g < 4; ++g) *(f32x4*)(SC + (size_t)(m0 + r) * SEQ + kt * 32 + 8 * g + 4 * hh) = (f32x4){sc[4 * g], sc[4 * g + 1], sc[4 * g + 2], sc[4 * g + 3]};
#pragma unroll
            for (int s = 0; s < 4; ++s) kf[s] = kn[s];
        }
    }
    VM_WAIT(); __syncthreads();
    for (int qq = 0; qq < 4; ++qq) {
        const int rq = F.wave * 4 + qq, t = q0 + rq, m = m0 + rq;
        unsigned* mrow = MASK + (size_t)m * 64;
        if (t + 1 <= 256) {
            for (int j = 0; j < 32; ++j) { const unsigned long long bm = __ballot(F.lane + 64 * j <= t); if (F.lane == 0) { mrow[2 * j] = (unsigned)bm; mrow[2 * j + 1] = (unsigned)(bm >> 32); } }
        } else {
            unsigned key[32];
#pragma unroll
            for (int j = 0; j < 32; ++j) { const int s = F.lane + 64 * j; key[j] = (s <= t) ? fkey(SC[(size_t)m * SEQ + (s <= t ? s : 0)]) : 0u; }
            unsigned T = 0u;
#pragma unroll 1
            for (int bit = 31; bit >= 0; --bit) { const unsigned cand = T | (1u << bit); unsigned cnt = 0u;
#pragma unroll
                for (int j = 0; j < 32; ++j) cnt += (key[j] >= cand) ? 1u : 0u;
                if (wave_sum_u32(cnt) >= 256u) T = cand; }
            unsigned cg = 0u;
#pragma unroll
            for (int j = 0; j < 32; ++j) cg += (key[j] > T) ? 1u : 0u;
            const int cgt = (int)wave_sum_u32(cg);
            const int need = 256 - cgt; int run = 0;
            const unsigned long long lt = (1ull << F.lane) - 1ull;
#pragma unroll
            for (int j = 0; j < 32; ++j) {
                const unsigned long long eq = __ballot(key[j] == T), gt = __ballot(key[j] > T);
                const int pre = run + __popcll(eq & lt);
                const unsigned long long se = __ballot(key[j] == T && pre < need);
                const unsigned long long bm = gt | se; run += __popcll(eq);
                if (F.lane == 0) { mrow[2 * j] = (unsigned)bm; mrow[2 * j + 1] = (unsigned)(bm >> 32); }
                if ((j & 3) == 3) __builtin_amdgcn_sched_barrier(0); }
        }
    }
    VM_WAIT(); __syncthreads();
    {
        const int hd = F.wave;
        bf16x8 qf[4];
#pragma unroll
        for (int s = 0; s < 4; ++s) qf[s] = *(const bf16x8*)(Q + (size_t)(m0 + r) * 512 + hd * 64 + 16 * s + 8 * hh);
        f32x16 o0, o1;
#pragma unroll
        for (int i = 0; i < 16; ++i) { o0[i] = 0.f; o1[i] = 0.f; }
        float mrun = -1e30f, lrun = 0.f;
        const bf16_t* kp = Kb + (size_t)(b * SEQ + r) * 512 + hd * 64 + 8 * hh;
        const bf16_t* vp = VT + ((size_t)(b * 8 + hd) * 64 + r) * SEQ + 4 * hh;
        const unsigned* mp = MASK + (size_t)(m0 + r) * 64;
        AttTile A, B;
        att_load(A, kp, vp, mp, 0);
        for (int kt = 0; kt <= qb; kt += 2) {
            if (kt + 1 <= qb) att_load(B, kp, vp, mp, kt + 1);
            att_tile(A, qf, o0, o1, mrun, lrun, hh);
            if (kt + 1 <= qb) {
                if (kt + 2 <= qb) att_load(A, kp, vp, mp, kt + 2);
                att_tile(B, qf, o0, o1, mrun, lrun, hh); }
        }
        const float inv = 1.0f / (lrun + __shfl_xor(lrun, 32));
        bf16_t* orow = MIXp + (size_t)(m0 + r) * (4 * MIX) + hd * 64;
#pragma unroll
        for (int g = 0; g < 4; ++g) {
            u32x2 w0; w0.x = pk2(o0[4 * g] * inv, o0[4 * g + 1] * inv); w0.y = pk2(o0[4 * g + 2] * inv, o0[4 * g + 3] * inv);
            u32x2 w1; w1.x = pk2(o1[4 * g] * inv, o1[4 * g + 1] * inv); w1.y = pk2(o1[4 * g + 2] * inv, o1[4 * g + 3] * inv);
            *(u32x2*)(orow + 8 * g + 4 * hh) = w0; *(u32x2*)(orow + 32 + 8 * g + 4 * hh) = w1; }
    }
    __syncthreads();
}

DI float siluf_(float x) { return x * sigmoidf_(x); }
DI void conv_phase(const Frame& F, unsigned char* ws, const In& in, int l) {
    const bf16_t* U = (const bf16_t*)(ws + WS_U); bf16_t* ACT = (bf16_t*)(ws + WS_ACT);
    const float* cw = in[33] + (size_t)l * 3 * DFF2; const float* cb = in[34] + (size_t)l * DFF2;
    constexpr int NCG = DFF / 8;
    const long total = (long)NCG * (MTOK / 32);
    for (long e = (long)F.bid * NTHR + F.tid; e < total; e += (long)F.G * NTHR) {
        const int cg = (int)(e % NCG), tg = (int)(e / NCG); const int f0 = cg * 8, m0 = tg * 32; const bool first = (m0 % SEQ) == 0;
        float wg[3][8], wv[3][8], bg[8], bv[8];
#pragma unroll
        for (int j = 0; j < 3; ++j)
#pragma unroll
            for (int i = 0; i < 8; ++i) { wg[j][i] = cw[(size_t)j * DFF2 + f0 + i]; wv[j][i] = cw[(size_t)j * DFF2 + DFF + f0 + i]; }
#pragma unroll
        for (int i = 0; i < 8; ++i) { bg[i] = cb[f0 + i]; bv[i] = cb[DFF + f0 + i]; }
        float g1[8], g2[8], v1[8], v2[8];
#pragma unroll
        for (int i = 0; i < 8; ++i) { g1[i] = 0.f; g2[i] = 0.f; v1[i] = 0.f; v2[i] = 0.f; }
        if (!first) {
            const u32x4 a = *(const u32x4*)(U + (size_t)(m0 - 1) * DFF2 + f0), b = *(const u32x4*)(U + (size_t)(m0 - 2) * DFF2 + f0);
            const u32x4 c = *(const u32x4*)(U + (size_t)(m0 - 1) * DFF2 + DFF + f0), d = *(const u32x4*)(U + (size_t)(m0 - 2) * DFF2 + DFF + f0);
#pragma unroll
            for (int i = 0; i < 4; ++i) { g1[2 * i] = bf2f(a[i] & 0xffffu); g1[2 * i + 1] = bf2f(a[i] >> 16); g2[2 * i] = bf2f(b[i] & 0xffffu); g2[2 * i + 1] = bf2f(b[i] >> 16);
                v1[2 * i] = bf2f(c[i] & 0xffffu); v1[2 * i + 1] = bf2f(c[i] >> 16); v2[2 * i] = bf2f(d[i] & 0xffffu); v2[2 * i + 1] = bf2f(d[i] >> 16); }
        }
#pragma unroll 2
        for (int t = 0; t < 32; ++t) {
            const u32x4 a = *(const u32x4*)(U + (size_t)(m0 + t) * DFF2 + f0), c = *(const u32x4*)(U + (size_t)(m0 + t) * DFF2 + DFF + f0);
            float g0[8], v0[8], o[8];
#pragma unroll
            for (int i = 0; i < 4; ++i) { g0[2 * i] = bf2f(a[i] & 0xffffu); g0[2 * i + 1] = bf2f(a[i] >> 16); v0[2 * i] = bf2f(c[i] & 0xffffu); v0[2 * i + 1] = bf2f(c[i] >> 16); }
#pragma unroll
            for (int i = 0; i < 8; ++i) { const float gc = bg[i] + wg[0][i] * g2[i] + wg[1][i] * g1[i] + wg[2][i] * g0[i]; const float vc = bv[i] + wv[0][i] * v2[i] + wv[1][i] * v1[i] + wv[2][i] * v0[i];
                o[i] = siluf_(gc) * vc; g2[i] = g1[i]; g1[i] = g0[i]; v2[i] = v1[i]; v1[i] = v0[i]; }
            u32x4 w; w.x = pk2(o[0], o[1]); w.y = pk2(o[2], o[3]); w.z = pk2(o[4], o[5]); w.w = pk2(o[6], o[7]);
            *(u32x4*)(ACT + (size_t)(m0 + t) * DFF + f0) = w;
        }
    }
}

DI void final_phase(const Frame& F, unsigned char* ws, const float* gfin, float* out) {
    const float* Y = (const float*)(ws + WS_Y); const float* part = (const float*)(ws + WS_PARTA);
    const int gw = F.bid * NWAVES + F.wave, NGW = F.G * NWAVES;
    for (int m = gw; m < MTOK; m += NGW) {
        float s = (F.lane < 32) ? part[(size_t)m * 32 + F.lane] : 0.f; s = wave_sum(s);
        const float rs = 1.0f / sqrtf(s * (1.0f / DM) + RMS_EPS);
#pragma unroll
        for (int j = 0; j < 8; ++j) { const int c = (j * 64 + F.lane) * 4; const f32x4 v = *(const f32x4*)(Y + (size_t)m * DM + c), g = *(const f32x4*)(gfin + c);
            *(f32x4*)(out + (size_t)m * DM + c) = v * rs * g; }
    }
}

struct Args { InTab in; float* out; unsigned char* ws; int ph_lo, ph_hi; };
constexpr int ZG1_UNITS = 24 * 32, ZG2_UNITS = 28 * 32;
constexpr int PH_PER_LAYER = 9, N_PHASES = 1 + NL * PH_PER_LAYER + 1;

__global__ void __launch_bounds__(NTHR, 2) hybrid_fwd(Args args) {
    extern __shared__ __attribute__((aligned(16))) unsigned char lds_raw[];
    Frame F0; F0.lds = (LAS unsigned char*)lds_raw; F0.tid = threadIdx.x; F0.lane = F0.tid & 63; F0.wave = __builtin_amdgcn_readfirstlane(F0.tid >> 6); F0.bid = blockIdx.x; F0.G = gridDim.x;
    unsigned char* ws0 = args.ws; In in0; in0.t = (CAS const gfptr_t*)__builtin_amdgcn_kernarg_segment_ptr();
    const int lo = args.ph_lo, hi = args.ph_hi;
    volatile LAS unsigned* MISC = (volatile LAS unsigned*)(F0.lds + MISC_OFF);
    if (F0.tid < 16) MISC[F0.tid] = 0u;
    __syncthreads();
    XcdBarrier bar; bar.bar = (unsigned*)(ws0 + WS_CTL) + CW_BAR; bar.x = 0; bar.st = nullptr;
    const bool multi = (hi - lo) > 1;
    if (multi) bar = xcd_barrier_post((unsigned*)(ws0 + WS_CTL) + CW_BAR, MISC + 8);
#ifndef SUBMASK
#define SUBMASK 7
#endif
#ifndef DUPSUB
#define DUPSUB 0
#endif
#ifndef DUPMASK
#define DUPMASK 0u
#endif
#define NREP(j) (((DUPMASK >> (j)) & 1u) ? 2 : 1)
#ifndef PHMASK
#define PHMASK 0xFFFFFFFFu
#endif
#define IN_PH(k) (lo <= (k) && (k) < hi)
#define ON(j) ((PHMASK >> (j)) & 1u)
#define LAYER_PTRS unsigned char* wt = ws + WS_WT + (size_t)l * WT_LAYER; float* Y = (float*)(ws + WS_Y); bf16_t* YB = (bf16_t*)(ws + WS_YB); float* PA = (float*)(ws + WS_PARTA); float* PB = (float*)(ws + WS_PARTB); const LAS float* rsT = (const LAS float*)(F.lds + RST_OFF); (void)wt; (void)Y; (void)YB; (void)PA; (void)PB; (void)rsT;
#define SEAM(k) do { if (IN_PH(k) && IN_PH((k) + 1)) xcd_barrier(bar); } while (0)

    if (ON(0) && IN_PH(0)) for (int rep = 0; rep < NREP(0); ++rep) { if (rep) xcd_barrier(bar); const In in = in_fresh(in0); const Frame F = fresh(F0); unsigned char* ws = fresh_ptr(ws0); p0_prologue(F, in, ws); }
    SEAM(0);

    for (int l = 0; l < NL; ++l) {
        const int pb = 1 + l * PH_PER_LAYER;
        if (ON(1) && IN_PH(pb + 0)) for (int rep = 0; rep < NREP(1); ++rep) { if (rep) xcd_barrier(bar); const In in = in_fresh(in0); const Frame F = fresh(F0); unsigned char* ws = fresh_ptr(ws0); LAYER_PTRS
            pg8::Gemm g{YB, (const bf16_t*)(wt + WT_IN), DM, DM, DM}; const pg8::OrderLin S{F.bid, F.G, ZG1_UNITS, 0, DM, DM};
            pg8::Unit u0; int pm0 = -1; if (S.next(0, u0)) pm0 = u0.pm;
            if (pm0 >= 0) rs_table(F, PA, pm0); else __syncthreads();
            pg8::EpiZ E{(float*)(ws + WS_ZS), (bf16_t*)(ws + WS_G), in[4] + (size_t)l * GCOLS, PA, rsT, pm0};
            pg8::gemm_phase<pg8::EpiZ, pg8::OrderLin, true>(F.lds, F.tid, g, S, E);
        }
        SEAM(pb + 0);
        if (ON(2) && IN_PH(pb + 1)) for (int rep = 0; rep < NREP(2); ++rep) { if (rep) xcd_barrier(bar); const In in = in_fresh(in0); const Frame F = fresh(F0); unsigned char* ws = fresh_ptr(ws0); LAYER_PTRS
            for (int it = F.bid; it < 1152; it += F.G) {
                if (it < 128) { dsa_prep_item(F, ws, in[5] + l * 64, it); if (DUPSUB & 64) dsa_prep_item(F, ws, in[5] + l * 64, it); }
                else if (it < 384) { rwkv_prep_item(F, ws, in, l, it - 128); if (DUPSUB & 16) rwkv_prep_item(F, ws, in, l, it - 128); }
                else if (it < 896) { pool_item(F, ws, in, l, it - 384); if (DUPSUB & 32) pool_item(F, ws, in, l, it - 384); }
                else { ssm_pass1_item(F, ws, in, l, it - 896); if (DUPSUB & 128) ssm_pass1_item(F, ws, in, l, it - 896); }
            }
        }
        SEAM(pb + 1);
        if (ON(3) && IN_PH(pb + 2)) for (int rep = 0; rep < NREP(3); ++rep) { if (rep) xcd_barrier(bar); const In in = in_fresh(in0); const Frame F = fresh(F0); unsigned char* ws = fresh_ptr(ws0); LAYER_PTRS
            const bool split = F.G >= 128; const int nrw = split ? 32 : 0;
            if (SUBMASK & 1) { const Frame Fa = fresh(F0);
                if (split) { if (Fa.bid < 32) { rwkv_scan_item(Fa, ws, Fa.bid); if (DUPSUB & 1) rwkv_scan_item(Fa, ws, Fa.bid); } }
                else for (int it = Fa.bid; it < 32; it += Fa.G) rwkv_scan_item(Fa, ws, it); }
            if (F.bid >= nrw) {
                if (SUBMASK & 2) { const Frame Fb = fresh(F0); const int nb = Fb.G - nrw, b0 = Fb.bid - nrw;
                    for (int it = b0; it < 256; it += nb) { const int b = it & 3, qb = 63 - (it >> 2); dsa_item(Fb, ws, b * 64 + qb); if (DUPSUB & 2) dsa_item(Fb, ws, b * 64 + qb); } }
                if (SUBMASK & 4) { const Frame Fc = fresh(F0); const int nb = Fc.G - nrw, b0 = Fc.bid - nrw;
                    for (int it = nb - 1 - b0; it < 256; it += nb) { ssm_pass3_item(Fc, fresh_ptr(ws0), in_fresh(in0), l, it); if (DUPSUB & 4) ssm_pass3_item(Fc, fresh_ptr(ws0), in_fresh(in0), l, it); } }
                { const Frame Fd = fresh(F0); unsigned char* wsd = fresh_ptr(ws0); const In ind = in_fresh(in0);
                    unsigned char* wtd = wsd + WS_WT + (size_t)l * WT_LAYER; float* PAd = (float*)(wsd + WS_PARTA);
                    pg8::Gemm g{(const bf16_t*)(wsd + WS_YB), (const bf16_t*)(wtd + WT_IN), DM, DM, DM}; const bool tri = (Fd.G == 256 && nrw == 32);
                    const pg8::OrderLin SL{Fd.bid - nrw, Fd.G - nrw, ZG2_UNITS, 24, DM, DM}; const pg8::OrderTri ST{(Fd.bid - nrw) & 31, (Fd.bid - nrw) >> 5, 24, DM, DM};
                    pg8::Unit u0; int pm0 = -1; if (tri ? ST.next(0, u0) : SL.next(0, u0)) pm0 = u0.pm;
                    if (pm0 >= 0) rs_table(Fd, PAd, pm0); else __syncthreads();
                    pg8::EpiZ E{(float*)(wsd + WS_ZS), (bf16_t*)(wsd + WS_G), ind[4] + (size_t)l * GCOLS, PAd, (const LAS float*)(Fd.lds + RST_OFF), pm0};
                    if (tri) pg8::gemm_phase<pg8::EpiZ, pg8::OrderTri, true>(Fd.lds, Fd.tid, g, ST, E);
                    else pg8::gemm_phase<pg8::EpiZ, pg8::OrderLin, true>(Fd.lds, Fd.tid, g, SL, E); }
            }
        }
        SEAM(pb + 2);
        if (ON(4) && IN_PH(pb + 3)) for (int rep = 0; rep < NREP(4); ++rep) { if (rep) xcd_barrier(bar); const In in = in_fresh(in0); const Frame F = fresh(F0); unsigned char* ws = fresh_ptr(ws0); LAYER_PTRS
            pg8::Gemm g{(const bf16_t*)(ws + WS_YSB), (const bf16_t*)(wt + WT_GLU), MIX, MIX, MIX}; pg8::Order S; S.init(MTOK / 256, MIX / 256, F.G, F.bid, MIX, MIX);
            pg8::EpiGlu E{(const float*)(ws + WS_YS), in[28] + l * MIX, (bf16_t*)(ws + WS_MIX)};
            pg8::gemm_phase<pg8::EpiGlu, pg8::Order, true>(F.lds, F.tid, g, S, E);
            { const Frame Fp = fresh(F0); const int ng = (Fp.G > 64) ? 64 : 0;
              if (Fp.bid >= ng) rwkv_post_rows(Fp, fresh_ptr(ws0), in_fresh(in0), l, (Fp.bid - ng) * NWAVES + Fp.wave, (Fp.G - ng) * NWAVES); }
        }
        SEAM(pb + 3);
        if (ON(5) && IN_PH(pb + 4)) for (int rep = 0; rep < NREP(5); ++rep) { if (rep) xcd_barrier(bar); const In in = in_fresh(in0); const Frame F = fresh(F0); unsigned char* ws = fresh_ptr(ws0); LAYER_PTRS
            pg8::Gemm g{(const bf16_t*)(ws + WS_MIX), (const bf16_t*)(wt + WT_BR), 4 * MIX, MIX, MIX}; pg8::Order S; S.init(MTOK / 256, DM / 256, F.G, F.bid, 4 * MIX, MIX, 4, MIX, DM);
            pg8::EpiMerge E{(const bf16_t*)(ws + WS_G), (bf16_t*)(ws + WS_MF), (bf16_t*)(ws + WS_MERGED)};
            pg8::gemm_phase<pg8::EpiMerge, pg8::Order, true>(F.lds, F.tid, g, S, E);
        }
        SEAM(pb + 4);
        if (ON(6) && IN_PH(pb + 5)) for (int rep = 0; rep < NREP(6); ++rep) { if (rep) xcd_barrier(bar); const In in = in_fresh(in0); const Frame F = fresh(F0); unsigned char* ws = fresh_ptr(ws0); LAYER_PTRS
            pg8::Gemm g{(const bf16_t*)(ws + WS_MERGED), (const bf16_t*)(wt + WT_OUT), DM, DM, DM}; pg8::Order S; S.init(MTOK / 256, DM / 256, F.G, F.bid, DM, DM);
            pg8::EpiRes E{l == 0 ? in[0] : Y, Y, YB, PB};
            pg8::gemm_phase<pg8::EpiRes, pg8::Order, true>(F.lds, F.tid, g, S, E);
        }
        SEAM(pb + 5);
        if (ON(7) && IN_PH(pb + 6)) for (int rep = 0; rep < NREP(7); ++rep) { if (rep) xcd_barrier(bar); const In in = in_fresh(in0); const Frame F = fresh(F0); unsigned char* ws = fresh_ptr(ws0); LAYER_PTRS
            pg8::Gemm g{YB, (const bf16_t*)(wt + WT_UP), DM, DM, DM}; pg8::Order S; S.init(MTOK / 256, DFF2 / 256, F.G, F.bid, DM, DM);
            pg8::Unit u0; int pm0 = -1; if (S.next(0, u0)) pm0 = u0.pm;
            if (pm0 >= 0) rs_table(F, PB, pm0); else __syncthreads();
            pg8::EpiU E{(bf16_t*)(ws + WS_U), DFF2, PB, rsT, pm0};
            pg8::gemm_phase<pg8::EpiU, pg8::Order, true>(F.lds, F.tid, g, S, E);
        }
        SEAM(pb + 6);
        if (ON(8) && IN_PH(pb + 7)) for (int rep = 0; rep < NREP(8); ++rep) { if (rep) xcd_barrier(bar); const In in = in_fresh(in0); const Frame F = fresh(F0); unsigned char* ws = fresh_ptr(ws0); LAYER_PTRS conv_phase(F, ws, in, l); }
        SEAM(pb + 7);
        if (ON(9) && IN_PH(pb + 8)) for (int rep = 0; rep < NREP(9); ++rep) { if (rep) xcd_barrier(bar); const In in = in_fresh(in0); const Frame F = fresh(F0); unsigned char* ws = fresh_ptr(ws0); LAYER_PTRS
            pg8::Gemm g{(const bf16_t*)(ws + WS_ACT), (const bf16_t*)(wt + WT_DOWN), DFF, DFF, DFF}; pg8::Order S; S.init(MTOK / 256, DM / 256, F.G, F.bid, DFF, DFF);
            pg8::EpiRes E{Y, Y, YB, PA};
            pg8::gemm_phase<pg8::EpiRes, pg8::Order, true>(F.lds, F.tid, g, S, E);
        }
        SEAM(pb + 8);
    }
    if (ON(10) && IN_PH(N_PHASES - 1)) { const In in = in_fresh(in0); const Frame F = fresh(F0); unsigned char* ws = fresh_ptr(ws0); final_phase(F, ws, in[36], args.out); }
#ifdef DBG_STOP
    if (lo == 100) { const Frame F = fresh(F0); unsigned char* ws = fresh_ptr(ws0);
        for (size_t e = (size_t)F.bid * NTHR + F.tid; e < (size_t)MTOK * DM; e += (size_t)F.G * NTHR) {
            const int m = (int)(e / DM), c = (int)(e % DM); float v;
            if (DBG_BUF == 0) v = bf2f(((const bf16_t*)(ws + WS_MIX))[e]);
            else if (DBG_BUF == 1) v = ((const float*)(ws + WS_ZS))[(size_t)m * ZS_COLS + c];
            else if (DBG_BUF == 2) v = ((const float*)(ws + WS_ZS))[(size_t)m * ZS_COLS + 2048 + c];
            else if (DBG_BUF == 3) v = bf2f(((const bf16_t*)(ws + WS_G))[(size_t)m * GCOLS + c]);
            else if (DBG_BUF == 4) v = ((const float*)(ws + WS_Y))[e];
            else v = bf2f(((const bf16_t*)(ws + WS_MERGED))[e]);
            args.out[e] = v; } }
#endif
#undef IN_PH
#undef SEAM
}

extern "C" void kernel_launch(void* const* d_in, const int* in_sizes, int n_in, void* d_out, int out_size, void* d_ws, size_t ws_size, hipStream_t stream) {
    static int grid = 0;
    if (grid == 0) {
        if (n_in != 37 || out_size != MTOK * DM || ws_size < WS_END) { fprintf(stderr, "kernel_launch: unexpected problem (n_in %d, out %d, ws %zu < %zu)\n", n_in, out_size, ws_size, (size_t)WS_END); grid = -1; return; }
        int dev = 0, cus = 0, per_cu = 0;
        if (hipGetDevice(&dev) != hipSuccess || hipDeviceGetAttribute(&cus, hipDeviceAttributeMultiprocessorCount, dev) != hipSuccess) { grid = -1; return; }
        if (hipFuncSetAttribute((const void*)hybrid_fwd, hipFuncAttributeMaxDynamicSharedMemorySize, LDS_BYTES) != hipSuccess) { fprintf(stderr, "kernel_launch: hipFuncSetAttribute failed\n"); grid = -1; return; }
        if (hipOccupancyMaxActiveBlocksPerMultiprocessor(&per_cu, (const void*)hybrid_fwd, NTHR, LDS_BYTES) != hipSuccess || per_cu < 1) fprintf(stderr, "kernel_launch: occupancy query says %d\n", per_cu);
        (void)hipGetLastError();
        grid = cus;
    }
    if (grid < 0) return;
    (void)hipMemsetAsync((char*)d_ws + WS_CTL, 0, CTL_ZERO_BYTES, stream);
    Args a{};
    for (int i = 0; i < 37; ++i) a.in.p[i] = (const float*)d_in[i];
    a.out = (float*)d_out; a.ws = (unsigned char*)d_ws;
#ifdef DBG_STOP
    for (int k = 0; k < DBG_STOP; ++k) { a.ph_lo = k; a.ph_hi = k + 1; hipLaunchKernelGGL(hybrid_fwd, dim3(grid), dim3(NTHR), LDS_BYTES, stream, a); }
    a.ph_lo = 100; a.ph_hi = 101; hipLaunchKernelGGL(hybrid_fwd, dim3(grid), dim3(NTHR), LDS_BYTES, stream, a);
#elif MK_N_LAUNCHES == 1
    a.ph_lo = 0; a.ph_hi = N_PHASES;
    hipLaunchKernelGGL(hybrid_fwd, dim3(grid), dim3(NTHR), LDS_BYTES, stream, a);
#else
    for (int k = 0; k < N_PHASES; ++k) { a.ph_lo = k; a.ph_hi = k + 1; hipLaunchKernelGGL(hybrid_fwd, dim3(grid), dim3(NTHR), LDS_BYTES, stream, a); }
#endif
}
```

```cpp
#include <hip/hip_runtime.h>
#include <cstdio>
#include <cstdint>

#ifndef MK_N_LAUNCHES
#define MK_N_LAUNCHES 1
#endif

#define LAS __attribute__((address_space(3)))
#define GAS __attribute__((address_space(1)))
typedef unsigned short bf16_t;
typedef short bf16x8 __attribute__((ext_vector_type(8)));
typedef short s16x4 __attribute__((ext_vector_type(4)));
typedef float f32x4 __attribute__((ext_vector_type(4)));
typedef float f32x2 __attribute__((ext_vector_type(2)));
typedef float f32x16 __attribute__((ext_vector_type(16)));
typedef unsigned u32x4 __attribute__((ext_vector_type(4)));
typedef unsigned u32x2 __attribute__((ext_vector_type(2)));
#define DI __device__ __forceinline__

constexpr int NB = 4, SEQ = 2048, DM = 2048, MTOK = NB * SEQ, NL = 4, MIX = 512, DFF = 5504, DFF2 = 2 * DFF;
constexpr int IN_COLS = 13060, NZ = 13312, ZS_COLS = 5120, GCOLS = 8192;
constexpr int B_COLS = 1984;
constexpr int ZO_R = 0, ZO_K = 512, ZO_V = 1024, ZO_LW = 1536, ZO_LA = 1632, ZO_LG = 1728;
constexpr int ZO_Q = 2048, ZO_AK = 2560, ZO_AV = 3072, ZO_QI = 3584, ZO_KI = 3840, ZO_WI = 3904, ZO_C = 4096, ZO_D = 4608;
constexpr float RMS_EPS = 1e-6f, GN_EPS = 64e-5f;

constexpr size_t MiB = 1u << 20;
constexpr size_t WS_CTL = 0, CTL_ZERO_BYTES = 1 * MiB;
constexpr size_t WS_ROPE = 1 * MiB;
constexpr size_t WS_PARTA = 2 * MiB;
constexpr size_t WS_PARTB = 3 * MiB;
constexpr size_t WS_SSTATE = 4 * MiB;
constexpr size_t WS_WI = 5 * MiB;
constexpr size_t WS_KI = 6 * MiB;
constexpr size_t WS_MASK = 7 * MiB;
constexpr size_t WS_QI = 9 * MiB;
constexpr size_t WS_Q = 13 * MiB;
constexpr size_t WS_K = 21 * MiB;
constexpr size_t WS_VT = 29 * MiB;
constexpr size_t WS_Y = 37 * MiB;
constexpr size_t WS_YB = 101 * MiB;
constexpr size_t WS_MIX = 133 * MiB;
constexpr size_t WS_MERGED = 165 * MiB;
constexpr size_t WS_YS = 197 * MiB;
constexpr size_t WS_YSB = 213 * MiB;
constexpr size_t WS_RW = 221 * MiB;
constexpr size_t RW_STRIDE = 16 * MiB;
constexpr size_t WS_SC = 333 * MiB;
constexpr size_t WS_MF = 1368 * MiB;
constexpr size_t WS_ZS = 461 * MiB;
constexpr size_t WS_G = 621 * MiB;
constexpr size_t WS_U = 461 * MiB;
constexpr size_t WS_ACT = 749 * MiB;
constexpr size_t WS_WT = 836 * MiB;
constexpr size_t WT_IN = 0, WT_BR = 52 * MiB, WT_OUT = 60 * MiB, WT_UP = 68 * MiB, WT_DOWN = 111 * MiB, WT_GLU = 111 * MiB + 22544384, WT_LAYER = 133 * MiB;
constexpr size_t WS_YRAW = WS_MF + 192 * MiB;
constexpr size_t WS_WTL = WS_YRAW + 16 * MiB;
constexpr size_t WS_END = WS_WTL + 2 * MiB;
static_assert(WS_WT + 4 * WT_LAYER == WS_MF, "ws map");
static_assert(WT_GLU + 524288 <= WT_LAYER, "wt map");
static_assert(WS_U + (size_t)MTOK * DFF2 * 2 <= WS_ACT && WS_ACT + (size_t)MTOK * DFF * 2 <= WS_WT, "ws map");

constexpr int CW_BAR = 4096;

constexpr int RING_BYTES = 131072;
constexpr int MISC_OFF = RING_BYTES;
constexpr int RST_OFF = RING_BYTES + 1024;
constexpr int LDS_BYTES = 147456;
constexpr int NWAVES = 8, NTHR = 512;

DI unsigned f2bf(float f) { unsigned u = __builtin_bit_cast(unsigned, f); return (u + 0x7fffu + ((u >> 16) & 1u)) >> 16; }
DI unsigned cvt_pk_bf16(float lo, float hi);
DI unsigned pk2(float lo, float hi) { return cvt_pk_bf16(lo, hi); }
DI float bf2f(unsigned b) { return __builtin_bit_cast(float, b << 16); }
typedef __bf16 bf16x2v __attribute__((ext_vector_type(2)));
DI unsigned cvt_pk_bf16(float lo, float hi) { const f32x2 v = {lo, hi}; const bf16x2v b = __builtin_convertvector(v, bf16x2v); return __builtin_bit_cast(unsigned, b); }
DI float wave_sum(float v) {
#pragma unroll
    for (int o = 1; o < 64; o <<= 1) v += __shfl_xor(v, o);
    return v;
}
template <int CTRL> DI float dpp_xadd(float x) { const int r = __builtin_amdgcn_update_dpp(0, __builtin_bit_cast(int, x), CTRL, 0xF, 0xF, true); return x + __builtin_bit_cast(float, r); }
DI float row16_sum(float x) { x = dpp_xadd<0xB1>(x); x = dpp_xadd<0x4E>(x); x = dpp_xadd<0x141>(x); x = dpp_xadd<0x140>(x); return x; }
DI bf16x8 pack8(float a0, float a1, float a2, float a3, float a4, float a5, float a6, float a7) {
    u32x4 p; p.x = pk2(a0, a1); p.y = pk2(a2, a3); p.z = pk2(a4, a5); p.w = pk2(a6, a7); return __builtin_bit_cast(bf16x8, p); }
DI float sigmoidf_(float x) { return __builtin_amdgcn_rcpf(1.0f + __expf(-x)); }
#define LDS_WAIT() asm volatile("s_waitcnt lgkmcnt(0)" ::: "memory")
#define VM_WAIT() asm volatile("s_waitcnt vmcnt(0)" ::: "memory")
#define MFMA32(a, b, c) __builtin_amdgcn_mfma_f32_32x32x16_bf16((a), (b), (c), 0, 0, 0)

#define XB_TMO      128
#define XB_XCNT(j)  (256  + 64 * (j))
#define XB_XSUB(j)  (1280 + 64 * (j))
#define XB_XGEN(j)  (2304 + 64 * (j))
#define XB_TOP      3328
#define XB_TOPGEN   3392
#define XCD_BAR_WORDS 3456
#define XB_SPIN_CAP (1u << 21)
DI unsigned xb_ld(unsigned* p)              { return __hip_atomic_load(p, __ATOMIC_RELAXED, __HIP_MEMORY_SCOPE_AGENT); }
DI unsigned xb_add(unsigned* p, unsigned v) { return __hip_atomic_fetch_add(p, v, __ATOMIC_RELAXED, __HIP_MEMORY_SCOPE_AGENT); }
DI unsigned xb_xcc_id() { return (unsigned)__builtin_amdgcn_s_getreg((3 << 11) | 20) & 0xFu; }
#define XB_SPIN(cond, bar) do { unsigned _sp = 0; while (cond) { __builtin_amdgcn_s_sleep(1); \
    if ((++_sp & 255u) == 0u) { if (xb_ld(&(bar)[XB_TMO])) break; if (_sp > XB_SPIN_CAP) { atomicAdd(&(bar)[XB_TMO], 1u); break; } } } } while (0)
struct XcdBarrier { unsigned* bar; unsigned x; volatile LAS unsigned* st; };
DI XcdBarrier xcd_barrier_post(unsigned* bar, volatile LAS unsigned* st) {
    XcdBarrier b; b.bar = bar; b.x = xb_xcc_id(); b.st = st;
    if (threadIdx.x == 0) (void)xb_add(&bar[XB_XCNT(b.x)], 1u);
    return b;
}
DI void xcd_barrier_complete(unsigned* bar, unsigned x, unsigned& nloc, unsigned& nx) {
    const unsigned G = gridDim.x * gridDim.y * gridDim.z;
    unsigned sum, cnt, mine, sp = 0u;
    for (;;) {
        sum = 0u; cnt = 0u; mine = 0u;
#pragma unroll
        for (unsigned j = 0; j < 16; ++j) { const unsigned c = xb_ld(&bar[XB_XCNT(j)]); sum += c; cnt += (c > 0u) ? 1u : 0u; mine = (j == x) ? c : mine; }
        if (sum == G) break;
        __builtin_amdgcn_s_sleep(1);
        if ((++sp & 255u) == 0u) { if (xb_ld(&bar[XB_TMO])) break; if (sp > XB_SPIN_CAP) { atomicAdd(&bar[XB_TMO], 1u); break; } }
    }
    nloc = mine > 0u ? mine : 1u; nx = cnt > 0u ? cnt : 1u;
}
DI void xcd_barrier(const XcdBarrier& b) {
    asm volatile("s_waitcnt vmcnt(0)" ::: "memory");
    __syncthreads();
    if (threadIdx.x == 0) {
        unsigned* bar = b.bar;
        __builtin_amdgcn_s_waitcnt(0);
        unsigned nloc = b.st[0], nx = b.st[1];
        if (nloc == 0u) { xcd_barrier_complete(bar, b.x, nloc, nx); b.st[0] = nloc; b.st[1] = nx; }
        const unsigned old = xb_add(&bar[XB_XSUB(b.x)], 1u);
        const unsigned gen = old / nloc;
        if (old + 1u == (gen + 1u) * nloc) {
            __builtin_amdgcn_fence(__ATOMIC_RELEASE, "agent");
            asm volatile("s_waitcnt vmcnt(0)" ::: "memory");
            const unsigned og = xb_add(&bar[XB_TOP], 1u);
            const unsigned tg = og / nx;
            if (og + 1u == (tg + 1u) * nx) xb_add(&bar[XB_TOPGEN], 1u);
            else XB_SPIN(xb_ld(&bar[XB_TOPGEN]) == tg, bar);
            __builtin_amdgcn_fence(__ATOMIC_ACQUIRE, "agent");
            xb_add(&bar[XB_XGEN(b.x)], 1u);
            asm volatile("s_waitcnt vmcnt(0)" ::: "memory");
        } else {
            XB_SPIN(xb_ld(&bar[XB_XGEN(b.x)]) == gen, bar);
            __builtin_amdgcn_fence(__ATOMIC_ACQUIRE, "agent");
            asm volatile("s_waitcnt vmcnt(0)" ::: "memory");
        }
    }
    __syncthreads();
}

namespace pg8 {
constexpr int BM = 256, BK = 64, HALF = 128, HTB = HALF * BK * 2, STAGE_BYTES = 8 * HTB, NXCD = 8, WGM = 8;
DI int lds_byte(int r, int c) { const int st = (r >> 4) * 2 + (c >> 5), rr = r & 15, cc = c & 31, ob = rr * 64 + cc * 2; return st * 1024 + (ob ^ (((ob >> 9) & 1) << 5)); }
DI void stage_rc(int b, int& R, int& C) { const int st = b / 1024, sb = b % 1024, swz = sb ^ (((sb >> 9) & 1) << 5); R = (st >> 1) * 16 + swz / 64; C = (st & 1) * 32 + (swz % 64) / 2; }
DI int perm32(int rho) { const int n = rho >> 4, i = rho & 15; return 8 * (i >> 2) + 4 * n + (i & 3); }

struct Unit { int pm, pn, sub; long offA, offB; };
struct Gemm { const bf16_t* A; const bf16_t* Bt; int lda, ldb, K; };

struct Order {
    int nM, nN, nwg, G, c, lda, ldb, nsub, subA, subB;
    DI void init(int nM_, int nN_, int G_, int c_, int lda_, int ldb_, int nsub_ = 1, int subA_ = 0, int subB_ = 0) { nM = nM_; nN = nN_; nwg = nM * nN; G = G_; c = c_; lda = lda_; ldb = ldb_; nsub = nsub_; subA = subA_; subB = subB_; }
    DI bool next(int i, Unit& u) const {
        const int ti = i / nsub, sub = i - ti * nsub;
        const long L = (long)ti * G + c; if (L >= nwg) return false;
        int wgid = (int)L; { const int q = nwg / NXCD, r = nwg % NXCD, xcd = wgid % NXCD, off = wgid / NXCD; wgid = (xcd < r ? xcd * (q + 1) : r * (q + 1) + (xcd - r) * q) + off; }
        const int nig = WGM * nN, gid = wgid / nig, fm = gid * WGM, gsz = (nM - fm) < WGM ? (nM - fm) : WGM;
        u.pm = fm + ((wgid % nig) % gsz); u.pn = (wgid % nig) / gsz; u.sub = sub;
        u.offA = ((long)u.pm * BM * lda + (long)sub * subA) * 2; u.offB = ((long)u.pn * BM + (long)sub * subB) * (long)ldb * 2;
        return true;
    }
};

struct OrderLin {
    int c, G, nu, pnbase, lda, ldb;
    DI bool next(int i, Unit& u) const { const int v = c + i * G; if (v >= nu) return false; u.pm = v & 31; u.pn = pnbase + (v >> 5); u.sub = 0;
        u.offA = (long)u.pm * BM * lda * 2; u.offB = (long)u.pn * BM * (long)ldb * 2; return true; }
};
struct OrderTri {
    int pm, k, pnbase, lda, ldb;
    DI bool next(int i, Unit& u) const { int cnt, st;
        if (pm < 24) { cnt = k < 5 ? k + 1 : (k == 5 ? 7 : 6); st = k <= 5 ? (k * (k + 1)) / 2 : 22; }
        else { cnt = k < 5 ? k + 2 : (k == 5 ? 8 : 0); st = k <= 5 ? (k * (k + 3)) / 2 : 28; }
        if (i >= cnt) return false; u.pm = pm; u.pn = pnbase + st + i; u.sub = 0;
        u.offA = (long)u.pm * BM * lda * 2; u.offB = (long)u.pn * BM * (long)ldb * 2; return true; }
};
template <class Epi, class Sched, bool ALIGN_EPI>
DI void gemm_phase(LAS unsigned char* lds, const int tid, const Gemm g, const Sched& S, const Epi& E) {
    const int wid = __builtin_amdgcn_readfirstlane(tid >> 6), lane = tid & 63, wr = wid >> 2, wc = wid & 3, fr = lane & 15, fq = lane >> 4;
    const int K = g.K, nt = K / BK;
    unsigned voffA[2], voffB[2];
#pragma unroll
    for (int i = 0; i < 2; ++i) { int R, C; stage_rc(tid * 16 + i * 8192, R, C); const int Rb = Epi::PERM ? ((R & ~31) + perm32(R & 31)) : R;
        voffA[i] = (unsigned)(R * g.lda + C) * 2u; voffB[i] = (unsigned)(Rb * g.ldb + C) * 2u; }
    const size_t kstep = (size_t)(BK * 2);
    const size_t hstepA = (size_t)HALF * g.lda * 2, hstepB = (size_t)HALF * g.ldb * 2;
    const unsigned ldsw = (unsigned)wid * 1024u;
    const int aoff = lds_byte(wr * 64 + fr, fq * 8), boff = lds_byte(wc * 32 + fr, fq * 8);
#define PG8_SA(b, h) (((b) * 2 + (h)) * HTB)
#define PG8_SB(b, h) ((4 + (b) * 2 + (h)) * HTB)
#define PG8_STAGE(bufoff, gbase, voff) do { _Pragma("unroll") for (int _i = 0; _i < 2; ++_i) \
        __builtin_amdgcn_global_load_lds((const unsigned*)((const char*)(gbase) + (voff)[_i]), (LAS unsigned*)(lds + (bufoff) + ldsw + _i * 8192), 16, 0, 0); } while (0)
#define PG8_LDA(dst, b, h) do { _Pragma("unroll") for (int m = 0; m < 4; ++m) _Pragma("unroll") for (int k = 0; k < 2; ++k) dst[m][k] = *(const LAS bf16x8*)(lds + PG8_SA(b, h) + aoff + m * 2048 + k * 1024); } while (0)
#define PG8_LDB(dst, b, h) do { _Pragma("unroll") for (int n = 0; n < 2; ++n) _Pragma("unroll") for (int k = 0; k < 2; ++k) dst[n][k] = *(const LAS bf16x8*)(lds + PG8_SB(b, h) + boff + n * 2048 + k * 1024); } while (0)
#define PG8_MMA(ai, bj, At, Bt) do { __builtin_amdgcn_s_setprio(1); _Pragma("unroll") for (int m = 0; m < 4; ++m) _Pragma("unroll") for (int n = 0; n < 2; ++n) _Pragma("unroll") for (int k = 0; k < 2; ++k) \
        acc[ai][bj][m][n] = __builtin_amdgcn_mfma_f32_16x16x32_bf16(Bt[n][k], At[m][k], acc[ai][bj][m][n], 0, 0, 0); __builtin_amdgcn_s_setprio(0); } while (0)
#define PG8_WAIT_V(n) asm volatile("s_waitcnt vmcnt(" #n ")" ::: "memory")
#define PG8_WAIT_L(n) asm volatile("s_waitcnt lgkmcnt(" #n ")" ::: "memory")
#define PG8_BAR __builtin_amdgcn_s_barrier()
#define PG8_SCHED __builtin_amdgcn_sched_barrier(0)
    Unit cur, nxt; int ui = 0;
    if (!S.next(0, cur)) return;
    f32x4 acc[2][2][4][2];
#pragma unroll
    for (int a = 0; a < 2; ++a)
#pragma unroll
        for (int b = 0; b < 2; ++b)
#pragma unroll
            for (int m = 0; m < 4; ++m)
#pragma unroll
                for (int n = 0; n < 2; ++n) acc[a][b][m][n] = (f32x4){0.f, 0.f, 0.f, 0.f};
    bf16x8 At[4][2], B0[2][2], B1[2][2];
    const char* cA = (const char*)g.A + cur.offA; const char* cB = (const char*)g.Bt + cur.offB;
    PG8_STAGE(PG8_SB(0, 0), cB, voffB); PG8_STAGE(PG8_SB(0, 1), cB + hstepB, voffB); PG8_STAGE(PG8_SA(0, 0), cA, voffA); PG8_STAGE(PG8_SA(0, 1), cA + hstepA, voffA);
    if (wr == 1) PG8_BAR;
    PG8_WAIT_V(2); PG8_BAR;
    PG8_STAGE(PG8_SB(1, 0), cB + kstep, voffB); PG8_STAGE(PG8_SA(1, 0), cA + kstep, voffA); PG8_STAGE(PG8_SB(1, 1), cB + hstepB + kstep, voffB);
    PG8_WAIT_V(6); PG8_BAR;
    for (;;) {
        const bool has_next = S.next(ui + 1, nxt);
        const char* nA = has_next ? (const char*)g.A + nxt.offA : cA; const char* nB = has_next ? (const char*)g.Bt + nxt.offB : cB;
        for (int t = 0; t < nt; t += 2) {
            const bool last = (t == nt - 2);
            const char* a1 = cA + (size_t)(t + 1) * kstep;
            const char* a2 = last ? nA : cA + (size_t)(t + 2) * kstep; const char* b2 = last ? nB : cB + (size_t)(t + 2) * kstep;
            const char* a3 = a2 + kstep; const char* b3 = b2 + kstep;
            PG8_LDB(B0, 0, 0); PG8_LDB(B1, 0, 1); PG8_SCHED; PG8_LDA(At, 0, 0); PG8_STAGE(PG8_SA(1, 1), a1 + hstepA, voffA);
            PG8_WAIT_V(8); PG8_WAIT_L(0); PG8_BAR; PG8_MMA(0, 0, At, B0); PG8_MMA(0, 1, At, B1); PG8_BAR; PG8_SCHED;
            PG8_LDA(At, 0, 1); PG8_STAGE(PG8_SB(0, 0), b2, voffB); PG8_STAGE(PG8_SB(0, 1), b2 + hstepB, voffB); PG8_STAGE(PG8_SA(0, 0), a2, voffA);
            PG8_WAIT_V(8); PG8_WAIT_L(0); PG8_BAR; PG8_MMA(1, 0, At, B0); PG8_MMA(1, 1, At, B1); PG8_BAR; PG8_SCHED;
            PG8_LDB(B0, 1, 0); PG8_LDB(B1, 1, 1); PG8_SCHED; PG8_LDA(At, 1, 0); PG8_STAGE(PG8_SA(0, 1), a2 + hstepA, voffA);
            PG8_WAIT_V(8); PG8_WAIT_L(0); PG8_BAR; PG8_MMA(0, 0, At, B0); PG8_MMA(0, 1, At, B1); PG8_BAR; PG8_SCHED;
            PG8_LDA(At, 1, 1); PG8_STAGE(PG8_SB(1, 0), b3, voffB); PG8_STAGE(PG8_SB(1, 1), b3 + hstepB, voffB); PG8_STAGE(PG8_SA(1, 0), a3, voffA);
            PG8_WAIT_V(8); PG8_WAIT_L(0); PG8_BAR; PG8_MMA(1, 0, At, B0); PG8_MMA(1, 1, At, B1); PG8_BAR; PG8_SCHED;
        }
        if constexpr (ALIGN_EPI) { if (wr == 0) PG8_BAR; }
        E(acc, cur, wr, wc, fr, fq);
        if (!has_next) break;
#pragma unroll
        for (int a = 0; a < 2; ++a)
#pragma unroll
            for (int b = 0; b < 2; ++b)
#pragma unroll
                for (int m = 0; m < 4; ++m)
#pragma unroll
                    for (int n = 0; n < 2; ++n) acc[a][b][m][n] = (f32x4){0.f, 0.f, 0.f, 0.f};
        cur = nxt; cA = nA; cB = nB; ++ui;
        if constexpr (ALIGN_EPI) { if (wr == 1) PG8_BAR; }
    }
    PG8_WAIT_V(0);
    if constexpr (!ALIGN_EPI) { if (wr == 0) PG8_BAR; }
    PG8_BAR;
#undef PG8_SA
#undef PG8_SB
#undef PG8_STAGE
#undef PG8_LDA
#undef PG8_LDB
#undef PG8_MMA
#undef PG8_WAIT_V
#undef PG8_WAIT_L
#undef PG8_BAR
#undef PG8_SCHED
}

typedef const f32x4 (&AccRef)[2][2][4][2];
DI float row_scale_slow(const float* part, int row) { float s = 0.f; for (int i = 0; i < 32; ++i) s += part[(size_t)row * 32 + i]; return 1.0f / sqrtf(s * (1.0f / DM) + RMS_EPS); }

struct EpiZ {
    static constexpr bool PERM = true;
    float* ZS; bf16_t* G; const float* bgate; const float* part; const LAS float* rsT; int pm0;
    DI void operator()(AccRef acc, const Unit& u, int wr, int wc, int fr, int fq) const {
#pragma unroll
        for (int ai = 0; ai < 2; ++ai)
#pragma unroll
            for (int m = 0; m < 4; ++m) {
                const int lr = ai * HALF + wr * 64 + m * 16 + fr, row = u.pm * BM + lr;
                const float s = (u.pm == pm0) ? rsT[lr] : row_scale_slow(part, row);
#pragma unroll
                for (int bj = 0; bj < 2; ++bj) {
                    const int col0 = u.pn * BM + bj * HALF + wc * 32 + 8 * fq;
                    f32x4 v0 = acc[ai][bj][m][0] * s, v1 = acc[ai][bj][m][1] * s;
                    if (u.pn < 20) { float* p = ZS + (size_t)row * ZS_COLS + col0; *(f32x4*)p = v0; *(f32x4*)(p + 4) = v1; }
                    else { const int gc = col0 - ZS_COLS; const f32x4 b0 = *(const f32x4*)(bgate + gc), b1 = *(const f32x4*)(bgate + gc + 4);
                        v0 += b0; v1 += b1;
                        u32x4 w; w.x = cvt_pk_bf16(sigmoidf_(v0[0]), sigmoidf_(v0[1])); w.y = cvt_pk_bf16(sigmoidf_(v0[2]), sigmoidf_(v0[3]));
                        w.z = cvt_pk_bf16(sigmoidf_(v1[0]), sigmoidf_(v1[1])); w.w = cvt_pk_bf16(sigmoidf_(v1[2]), sigmoidf_(v1[3]));
                        *(u32x4*)(G + (size_t)row * GCOLS + gc) = w; }
                }
            }
    }
};
struct EpiU {
    static constexpr bool PERM = true;
    bf16_t* U; int ldc; const float* part; const LAS float* rsT; int pm0;
    DI void operator()(AccRef acc, const Unit& u, int wr, int wc, int fr, int fq) const {
#pragma unroll
        for (int ai = 0; ai < 2; ++ai)
#pragma unroll
            for (int m = 0; m < 4; ++m) {
                const int lr = ai * HALF + wr * 64 + m * 16 + fr, row = u.pm * BM + lr;
                const float s = (u.pm == pm0) ? rsT[lr] : row_scale_slow(part, row);
#pragma unroll
                for (int bj = 0; bj < 2; ++bj) {
                    const int col0 = u.pn * BM + bj * HALF + wc * 32 + 8 * fq;
                    const f32x4 v0 = acc[ai][bj][m][0] * s, v1 = acc[ai][bj][m][1] * s;
                    u32x4 w; w.x = cvt_pk_bf16(v0[0], v0[1]); w.y = cvt_pk_bf16(v0[2], v0[3]); w.z = cvt_pk_bf16(v1[0], v1[1]); w.w = cvt_pk_bf16(v1[2], v1[3]);
                    *(u32x4*)(U + (size_t)row * ldc + col0) = w;
                }
            }
    }
};
struct EpiRes {
    static constexpr bool PERM = false;
    const float* Yin; float* Y; bf16_t* YB; float* part;
    DI void operator()(AccRef acc, const Unit& u, int wr, int wc, int fr, int fq) const {
#pragma unroll
        for (int ai = 0; ai < 2; ++ai)
#pragma unroll
            for (int m = 0; m < 4; ++m) {
                const int row = u.pm * BM + ai * HALF + wr * 64 + m * 16 + fr;
                float ss = 0.f;
#pragma unroll
                for (int bj = 0; bj < 2; ++bj)
#pragma unroll
                    for (int n = 0; n < 2; ++n) {
                        const int col = u.pn * BM + bj * HALF + wc * 32 + 16 * n + 4 * fq;
                        const size_t o = (size_t)row * DM + col;
                        const f32x4 y = *(const f32x4*)(Yin + o) + acc[ai][bj][m][n];
                        *(f32x4*)(Y + o) = y;
                        u32x2 w; w.x = cvt_pk_bf16(y[0], y[1]); w.y = cvt_pk_bf16(y[2], y[3]);
                        *(u32x2*)(YB + o) = w;
                        ss += (y[0] * y[0] + y[1] * y[1]) + (y[2] * y[2] + y[3] * y[3]);
                    }
                ss += __shfl_xor(ss, 16); ss += __shfl_xor(ss, 32);
                if (fq == 0) part[(size_t)row * 32 + u.pn * 4 + wc] = ss;
            }
    }
};
struct EpiGlu {
    static constexpr bool PERM = true;
    const bf16_t* YB16; const float* bias; bf16_t* MIXp;
    DI void operator()(AccRef acc, const Unit& u, int wr, int wc, int fr, int fq) const {
#pragma unroll
        for (int ai = 0; ai < 2; ++ai)
#pragma unroll
            for (int m = 0; m < 4; ++m) {
                const int row = u.pm * BM + ai * HALF + wr * 64 + m * 16 + fr;
#pragma unroll
                for (int bj = 0; bj < 2; ++bj) {
                    const int col0 = u.pn * BM + bj * HALF + wc * 32 + 8 * fq;
                    const f32x4 b0 = *(const f32x4*)(bias + col0), b1 = *(const f32x4*)(bias + col0 + 4);
                    const u32x4 yw = *(const u32x4*)(YB16 + (size_t)row * MIX + col0);
                    const f32x4 y0 = (f32x4){bf2f(yw.x & 0xffffu), bf2f(yw.x >> 16), bf2f(yw.y & 0xffffu), bf2f(yw.y >> 16)}, y1 = (f32x4){bf2f(yw.z & 0xffffu), bf2f(yw.z >> 16), bf2f(yw.w & 0xffffu), bf2f(yw.w >> 16)};
                    const f32x4 v0 = acc[ai][bj][m][0] + b0, v1 = acc[ai][bj][m][1] + b1;
                    u32x4 w; w.x = cvt_pk_bf16(y0[0] * sigmoidf_(v0[0]), y0[1] * sigmoidf_(v0[1])); w.y = cvt_pk_bf16(y0[2] * sigmoidf_(v0[2]), y0[3] * sigmoidf_(v0[3]));
                    w.z = cvt_pk_bf16(y1[0] * sigmoidf_(v1[0]), y1[1] * sigmoidf_(v1[1])); w.w = cvt_pk_bf16(y1[2] * sigmoidf_(v1[2]), y1[3] * sigmoidf_(v1[3]));
                    *(u32x4*)(MIXp + (size_t)row * (4 * MIX) + 3 * MIX + col0) = w;
                }
            }
    }
};
struct EpiMerge {
    static constexpr bool PERM = true;
    const bf16_t* G; bf16_t* MFh; bf16_t* MERGED;
    DI void operator()(AccRef acc, const Unit& u, int wr, int wc, int fr, int fq) const {
#pragma unroll
        for (int ai = 0; ai < 2; ++ai)
#pragma unroll
            for (int m = 0; m < 4; ++m) {
                const int row = u.pm * BM + ai * HALF + wr * 64 + m * 16 + fr;
#pragma unroll
                for (int bj = 0; bj < 2; ++bj) {
                    const int col0 = u.pn * BM + bj * HALF + wc * 32 + 8 * fq;
                    const u32x4 gw = *(const u32x4*)(G + (size_t)row * GCOLS + u.sub * DM + col0);
                    f32x4 v0 = acc[ai][bj][m][0], v1 = acc[ai][bj][m][1];
                    v0[0] *= bf2f(gw.x & 0xffffu); v0[1] *= bf2f(gw.x >> 16); v0[2] *= bf2f(gw.y & 0xffffu); v0[3] *= bf2f(gw.y >> 16);
                    v1[0] *= bf2f(gw.z & 0xffffu); v1[1] *= bf2f(gw.z >> 16); v1[2] *= bf2f(gw.w & 0xffffu); v1[3] *= bf2f(gw.w >> 16);
                    bf16_t* p = MFh + (size_t)row * DM + col0;
                    constexpr size_t SL = (size_t)MTOK * DM;
                    if (u.sub < 3) { u32x4 w; w.x = cvt_pk_bf16(v0[0], v0[1]); w.y = cvt_pk_bf16(v0[2], v0[3]); w.z = cvt_pk_bf16(v1[0], v1[1]); w.w = cvt_pk_bf16(v1[2], v1[3]); *(u32x4*)(p + u.sub * SL) = w; }
                    else {
#pragma unroll
                        for (int q = 0; q < 3; ++q) { const u32x4 t = *(const u32x4*)(p + q * SL);
                            v0[0] += bf2f(t.x & 0xffffu); v0[1] += bf2f(t.x >> 16); v0[2] += bf2f(t.y & 0xffffu); v0[3] += bf2f(t.y >> 16);
                            v1[0] += bf2f(t.z & 0xffffu); v1[1] += bf2f(t.z >> 16); v1[2] += bf2f(t.w & 0xffffu); v1[3] += bf2f(t.w >> 16); }
                        u32x4 w; w.x = cvt_pk_bf16(v0[0], v0[1]); w.y = cvt_pk_bf16(v0[2], v0[3]); w.z = cvt_pk_bf16(v1[0], v1[1]); w.w = cvt_pk_bf16(v1[2], v1[3]);
                        *(u32x4*)(MERGED + (size_t)row * DM + col0) = w; }
                }
            }
    }
};
}

struct Frame { LAS unsigned char* lds; int tid, lane, wave, bid, G; };

DI Frame fresh(const Frame& F0) { Frame F = F0; int tid = F0.tid, bid = F0.bid, G = F0.G, wave = F0.wave; unsigned lo = (unsigned)(size_t)F0.lds;
    asm volatile("" : "+v"(tid)); asm volatile("" : "+s"(bid), "+s"(G), "+s"(wave), "+s"(lo));
    F.tid = tid; F.lane = tid & 63; F.wave = wave; F.bid = bid; F.G = G; F.lds = (LAS unsigned char*)(size_t)lo; return F; }
DI unsigned char* fresh_ptr(unsigned char* p) { size_t z = 0; asm volatile("" : "+s"(z)); return p + z; }
DI void rs_table(const Frame& F, const float* part, int pm) {
    LAS float* rsT = (LAS float*)(F.lds + RST_OFF);
    if (F.tid < 256) { const int row = pm * 256 + F.tid; float s = 0.f;
#pragma unroll
        for (int i = 0; i < 8; ++i) { const f32x4 v = *(const f32x4*)(part + (size_t)row * 32 + 4 * i); s += (v[0] + v[1]) + (v[2] + v[3]); }
        rsT[F.tid] = 1.0f / sqrtf(s * (1.0f / DM) + RMS_EPS); }
    __syncthreads();
}

DI int head_perm(int c) { const int h = c >> 6, p = c & 63; const int dim = p < 16 ? ((p >> 1) + 8 * (p & 1)) : p; return (h << 6) + dim; }
DI int zin_colmap(int n) {
    if (n < B_COLS) return 1860 + n;
    if (n < 2048) return -1;
    if (n < 2560) return head_perm(n - 2048);
    if (n < 3072) return 512 + head_perm(n - 2560);
    if (n < 3584) return 1024 + (n - 3072);
    if (n < 3840) return 1536 + head_perm(n - 3584);
    if (n < 3904) return 1792 + head_perm(n - 3840);
    if (n < 3908) return 1856 + (n - 3904);
    if (n < 4096) return -1;
    if (n < 4608) return 3844 + (n - 4096);
    if (n < 5120) return 4356 + (n - 4608);
    return 4868 + (n - 5120);
}
template <int MODE>
DI void tr_item(const float* W, int ldw, const float* ksc, bf16_t* WT, int K, LAS float* scr, int kb, int nb, int lane) {
    const int k0 = 64 * kb, n0 = 32 * nb, nn = n0 + (lane & 31);
    const int col = MODE == 1 ? zin_colmap(nn) : nn;
    float tv[32];
    if (col >= 0) {
#pragma unroll
        for (int i = 0; i < 32; ++i) tv[i] = W[(size_t)(k0 + 2 * i + (lane >> 5)) * ldw + col];
        if (ksc) {
#pragma unroll
            for (int i = 0; i < 32; ++i) tv[i] *= ksc[k0 + 2 * i + (lane >> 5)]; }
    } else {
#pragma unroll
        for (int i = 0; i < 32; ++i) tv[i] = 0.f; }
#pragma unroll
    for (int i = 0; i < 32; ++i) scr[(2 * i + (lane >> 5)) * 33 + (lane & 31)] = tv[i];
    LDS_WAIT(); asm volatile("" ::: "memory");
    const int c = lane & 7;
#pragma unroll
    for (int j = 0; j < 4; ++j) { const int n = (lane >> 3) + 8 * j; const LAS float* s = scr + (8 * c) * 33 + n;
        u32x4 o; o.x = pk2(s[0 * 33], s[1 * 33]); o.y = pk2(s[2 * 33], s[3 * 33]); o.z = pk2(s[4 * 33], s[5 * 33]); o.w = pk2(s[6 * 33], s[7 * 33]);
        *(u32x4*)(WT + (size_t)(n0 + n) * K + k0 + 8 * c) = o; }
    LDS_WAIT(); asm volatile("" ::: "memory");
}
struct InTab { const float* p[37]; };
#define CAS __attribute__((address_space(4)))
typedef const float* fptr_t;
typedef GAS const float* gfptr_t;
struct In { CAS const gfptr_t* t; DI fptr_t operator[](int i) const { return (fptr_t)t[i]; } };
DI In in_fresh(In in) { CAS const gfptr_t* t = in.t; asm volatile("" : "+s"(t)); In r; r.t = t; return r; }
DI void p0_prologue(const Frame& F, const In& in, unsigned char* ws) {
    LAS float* scr = (LAS float*)(F.lds + F.wave * 16384);
    const int gw = F.bid * NWAVES + F.wave, NGW = F.G * NWAVES;
    constexpr int I_IN = 32 * (NZ / 32), I_BR = 4 * 8 * 64, I_OUT = 32 * 64, I_UP = 32 * (DFF2 / 32), I_DN = 86 * 64, I_GLU = 8 * 16;
    constexpr int I_LAYER = I_IN + I_BR + I_OUT + I_UP + I_DN + I_GLU;
    for (int it = gw; it < NL * I_LAYER; it += NGW) {
        const int l = it / I_LAYER; int r = it - l * I_LAYER;
        unsigned char* wt = ws + WS_WT + (size_t)l * WT_LAYER;
        if (r < I_IN) { const int nbk = NZ / 32; tr_item<1>(in[3] + (size_t)l * DM * IN_COLS, IN_COLS, in[2] + l * DM, (bf16_t*)(wt + WT_IN), DM, scr, r / nbk, r % nbk, F.lane); continue; } r -= I_IN;
        if (r < I_BR) { const int n = r / 512, rr = r % 512; tr_item<0>(in[29] + ((size_t)l * 4 + n) * MIX * DM, DM, nullptr, (bf16_t*)(wt + WT_BR) + (size_t)n * DM * MIX, MIX, scr, rr / 64, rr % 64, F.lane); continue; } r -= I_BR;
        if (r < I_OUT) { tr_item<0>(in[30] + (size_t)l * DM * DM, DM, nullptr, (bf16_t*)(wt + WT_OUT), DM, scr, r / 64, r % 64, F.lane); continue; } r -= I_OUT;
        if (r < I_UP) { const int nbk = DFF2 / 32; tr_item<0>(in[32] + (size_t)l * DM * DFF2, DFF2, in[31] + l * DM, (bf16_t*)(wt + WT_UP), DM, scr, r / nbk, r % nbk, F.lane); continue; } r -= I_UP;
        if (r < I_DN) { tr_item<0>(in[35] + (size_t)l * DFF * DM, DM, nullptr, (bf16_t*)(wt + WT_DOWN), DFF, scr, r / 64, r % 64, F.lane); continue; } r -= I_DN;
        tr_item<0>(in[27] + (size_t)l * MIX * MIX, MIX, nullptr, (bf16_t*)(wt + WT_GLU), MIX, scr, r / 16, r % 16, F.lane);
    }
    { bf16_t* WTL = (bf16_t*)(ws + WS_WTL);
      for (int e = F.bid * NTHR + F.tid; e < NL * 56 * MIX; e += F.G * NTHR) { const int n = e % MIX, k8 = (e / MIX) % 56, l = e / (MIX * 56); const int k0 = k8 * 8;
          const float* src = k0 < 96 ? in[8] + ((size_t)l * 96 + k0) * MIX : (k0 < 192 ? in[10] + ((size_t)l * 96 + (k0 - 96)) * MIX : in[11] + ((size_t)l * 256 + (k0 - 192)) * MIX);
          u32x4 o; o.x = pk2(src[n], src[MIX + n]); o.y = pk2(src[2 * MIX + n], src[3 * MIX + n]); o.z = pk2(src[4 * MIX + n], src[5 * MIX + n]); o.w = pk2(src[6 * MIX + n], src[7 * MIX + n]);
          *(u32x4*)(WTL + ((size_t)l * MIX + n) * 448 + k0) = o; } }
    const int* pos = (const int*)in[1];
    float* rope = (float*)(ws + WS_ROPE);
    for (int e = F.bid * NTHR + F.tid; e < MTOK * 8; e += F.G * NTHR) { const int m = e >> 3, i = e & 7;
        const float inv = exp2f(-(float)i * 0.125f * 18.931568569324174f);
        const float ang = (float)pos[m] * inv; float sn, cs; sincosf(ang, &sn, &cs);
        rope[m * 16 + i] = cs; rope[m * 16 + 8 + i] = sn; }
    const float* x = in[0]; bf16_t* YB = (bf16_t*)(ws + WS_YB); float* pa = (float*)(ws + WS_PARTA);
    for (int m = gw; m < MTOK; m += NGW) { float s = 0.f;
#pragma unroll
        for (int j = 0; j < 8; ++j) { const f32x4 v = *(const f32x4*)(x + (size_t)m * DM + (j * 64 + F.lane) * 4); s += (v[0] * v[0] + v[1] * v[1]) + (v[2] * v[2] + v[3] * v[3]);
            u32x2 w; w.x = pk2(v[0], v[1]); w.y = pk2(v[2], v[3]); *(u32x2*)(YB + (size_t)m * DM + (j * 64 + F.lane) * 4) = w; }
        s = wave_sum(s);
        if (F.lane < 32) pa[(size_t)m * 32 + F.lane] = (F.lane == 0) ? s : 0.f; }
}

DI void dsa_prep_item(const Frame& F, unsigned char* ws, const float* idxg, int item) {
    const float* ZS = (const float*)(ws + WS_ZS); const float* rope = (const float*)(ws + WS_ROPE);
    bf16_t* Q = (bf16_t*)(ws + WS_Q); bf16_t* Kb = (bf16_t*)(ws + WS_K); bf16_t* VT = (bf16_t*)(ws + WS_VT); bf16_t* QI = (bf16_t*)(ws + WS_QI); bf16_t* KI = (bf16_t*)(ws + WS_KI); float* WI = (float*)(ws + WS_WI);
    const int m0 = item * 64;
#pragma unroll 8
    for (int e = F.tid; e < 64 * 640; e += NTHR) { const int t = e / 640, pc = e % 640; const int m = m0 + t;
        int zc, oc; bf16_t* dst; int ld; float sc = 1.f;
        if (pc < 256) { zc = ZO_Q + 2 * pc; oc = 2 * pc; dst = Q; ld = 512; sc = 0.125f; }
        else if (pc < 512) { zc = ZO_AK + 2 * (pc - 256); oc = 2 * (pc - 256); dst = Kb; ld = 512; }
        else { zc = ZO_QI + 2 * (pc - 512); oc = 2 * (pc - 512); dst = QI; ld = 256; }
        const f32x2 v = *(const f32x2*)(ZS + (size_t)m * ZS_COLS + zc); float a = v[0], b = v[1];
        const int p = oc & 63;
        { const float cs = rope[m * 16 + ((p >> 1) & 7)], sn = rope[m * 16 + 8 + ((p >> 1) & 7)]; const float a2 = a * cs - b * sn, b2 = b * cs + a * sn; a = (p < 16) ? a2 : a; b = (p < 16) ? b2 : b; }
        *(unsigned*)(dst + (size_t)m * ld + oc) = pk2(a * sc, b * sc); }
    for (int tt = 0; tt < 8; ++tt) { const int m = m0 + F.wave * 8 + tt;
        const float xv = ZS[(size_t)m * ZS_COLS + ZO_KI + F.lane];
        const float ss = wave_sum(xv * xv);
        const int dim = F.lane < 16 ? ((F.lane >> 1) + 8 * (F.lane & 1)) : F.lane;
        float y = xv * (1.0f / sqrtf(ss * (1.0f / 64.f) + RMS_EPS)) * idxg[dim];
        const float pr = __shfl_xor(y, 1);
        if (F.lane < 16) { const float cs = rope[m * 16 + (F.lane >> 1)], sn = rope[m * 16 + 8 + (F.lane >> 1)]; y = (F.lane & 1) ? (y * cs + pr * sn) : (y * cs - pr * sn); }
        KI[(size_t)m * 64 + F.lane] = (bf16_t)f2bf(y);
        if (F.lane < 4) WI[(size_t)m * 4 + F.lane] = ZS[(size_t)m * ZS_COLS + ZO_WI + F.lane]; }
    LAS unsigned char* L = F.lds;
    for (int e = F.tid; e < 64 * 128; e += NTHR) { const int t = e >> 7, c4 = (e & 127) * 4;
        const f32x4 v = *(const f32x4*)(ZS + (size_t)(m0 + t) * ZS_COLS + ZO_AV + c4);
        u32x2 w; w.x = pk2(v[0], v[1]); w.y = pk2(v[2], v[3]); *(LAS u32x2*)(L + t * 1040 + c4 * 2) = w; }
    __syncthreads();
    { const int b = m0 / SEQ, s0 = m0 % SEQ;
      for (int e = F.tid; e < 512 * 8; e += NTHR) { const int c = e >> 3, oct = e & 7;
          unsigned short vals[8];
#pragma unroll
          for (int j = 0; j < 8; ++j) vals[j] = *(const LAS unsigned short*)(L + (oct * 8 + j) * 1040 + c * 2);
          u32x4 o; o.x = vals[0] | ((unsigned)vals[1] << 16); o.y = vals[2] | ((unsigned)vals[3] << 16); o.z = vals[4] | ((unsigned)vals[5] << 16); o.w = vals[6] | ((unsigned)vals[7] << 16);
          *(u32x4*)(VT + ((size_t)(b * 512 + c)) * SEQ + s0 + oct * 8) = o; } }
    __syncthreads();
}

DI float softplusf_(float x) { return fmaxf(x, 0.f) + __logf(1.0f + __expf(-fabsf(x))); }
DI float tanhf_(float x) { return 1.0f - 2.0f * __builtin_amdgcn_rcpf(1.0f + __expf(2.0f * x)); }
DI float half32_sum(float x) { x = row16_sum(x); return x + __shfl_xor(x, 16); }
DI void rwkv_prep_item(const Frame& F, unsigned char* ws, const In& in, int l, int item) {
    const float* ZS = (const float*)(ws + WS_ZS);
    const float* mu = in[6] + l * B_COLS; const float* w0 = in[7] + l * MIX; const float* a0 = in[9] + l * MIX; const float* k_k = in[12] + l * MIX; const float* k_a = in[13] + l * MIX;
    const bf16_t* WTL = (const bf16_t*)(ws + WS_WTL) + (size_t)l * MIX * 448;
    float* RW = (float*)(ws + WS_RW); constexpr size_t RS = RW_STRIDE / 4;
    const int m0 = item * 32; const bool first = (m0 % SEQ) == 0;
    constexpr int XP = 456;
    LAS bf16_t* X = (LAS bf16_t*)F.lds;
#pragma unroll 7
    for (int e = F.tid; e < 32 * 448; e += NTHR) { const int t = e / 448, c = e % 448; const int m = m0 + t, zc = ZO_LW + c;
        const bool nop = first && t == 0; const float z = ZS[(size_t)m * ZS_COLS + zc]; const float zq = ZS[(size_t)(nop ? m : m - 1) * ZS_COLS + zc]; const float zp = nop ? 0.f : zq;
        const float xs = z + (zp - z) * mu[zc];
        X[t * XP + c] = (bf16_t)f2bf(c < 96 ? tanhf_(xs) : (c < 192 ? xs : sigmoidf_(xs))); }
    __syncthreads();
    const int r = F.lane & 31, hh = F.lane >> 5, h = F.wave;
    float inv[16];
#pragma unroll
    for (int i = 0; i < 16; ++i) inv[i] = 0.f;
#pragma unroll
    for (int nt = 0; nt < 2; ++nt) { const int n = h * 64 + nt * 32 + r; const float muK = mu[ZO_K + n], kkn = k_k[n];
#pragma unroll
        for (int g = 0; g < 4; ++g) { const int tb = 8 * g + 4 * hh;
            float pk = (first && tb == 0) ? 0.f : ZS[(size_t)(m0 + tb - 1) * ZS_COLS + ZO_K + n];
#pragma unroll
            for (int j = 0; j < 4; ++j) { const float zk_ = ZS[(size_t)(m0 + tb + j) * ZS_COLS + ZO_K + n]; const float k = (zk_ + (pk - zk_) * muK) * kkn; pk = zk_; inv[4 * g + j] += k * k; } } }
#pragma unroll
    for (int i = 0; i < 16; ++i) inv[i] = 1.0f / fmaxf(sqrtf(half32_sum(inv[i])), 1e-12f);
    const LAS bf16_t* xa = X + r * XP + 8 * hh;
#pragma unroll 1
    for (int nt = 0; nt < 2; ++nt) { const int n = h * 64 + nt * 32 + r; const bf16_t* wrow = WTL + (size_t)n * 448 + 8 * hh;
        f32x16 aw, aa, ag;
#pragma unroll
        for (int i = 0; i < 16; ++i) { aw[i] = 0.f; aa[i] = 0.f; ag[i] = 0.f; }
#pragma unroll
        for (int s2 = 0; s2 < 6; ++s2) { aw = MFMA32(*(const LAS bf16x8*)(xa + 16 * s2), *(const bf16x8*)(wrow + 16 * s2), aw);
                                         aa = MFMA32(*(const LAS bf16x8*)(xa + 96 + 16 * s2), *(const bf16x8*)(wrow + 96 + 16 * s2), aa); }
#pragma unroll
        for (int s2 = 0; s2 < 16; ++s2) ag = MFMA32(*(const LAS bf16x8*)(xa + 192 + 16 * s2), *(const bf16x8*)(wrow + 192 + 16 * s2), ag);
        const float muR = mu[ZO_R + n], muK = mu[ZO_K + n], muV = mu[ZO_V + n], w0n = w0[n], a0n = a0[n], kkn = k_k[n], kan = k_a[n];
#pragma unroll
        for (int g = 0; g < 4; ++g) { const int tb = 8 * g + 4 * hh;
            float pr, pk, pv;
            if (first && tb == 0) { pr = 0.f; pk = 0.f; pv = 0.f; }
            else { const float* zp = ZS + (size_t)(m0 + tb - 1) * ZS_COLS; pr = zp[ZO_R + n]; pk = zp[ZO_K + n]; pv = zp[ZO_V + n]; }
#pragma unroll
            for (int j = 0; j < 4; ++j) { const int i = 4 * g + j, m = m0 + tb + j; const float* zr = ZS + (size_t)m * ZS_COLS;
                const float zr_ = zr[ZO_R + n], zk_ = zr[ZO_K + n], zv_ = zr[ZO_V + n];
                const float rr = zr_ + (pr - zr_) * muR, k = zk_ + (pk - zk_) * muK, v = zv_ + (pv - zv_) * muV;
                pr = zr_; pk = zk_; pv = zv_;
                const float wlog = -softplusf_(-(w0n + aw[i])) - 0.5f;
                const float decay = __expf(-__expf(wlog));
                const float a = sigmoidf_(a0n + aa[i]);
                const float kk = k * kkn * inv[i];
                const size_t o = (size_t)m * MIX + n;
                RW[0 * RS + o] = rr; RW[1 * RS + o] = decay; RW[2 * RS + o] = k * (1.0f + (a - 1.0f) * kan); RW[3 * RS + o] = v; RW[4 * RS + o] = -kk; RW[5 * RS + o] = kk * a; RW[6 * RS + o] = ag[i]; } } }
    __syncthreads();
}

DI void pool_item(const Frame& F, unsigned char* ws, const In& in, int l, int item) {
    const float* ZS = (const float*)(ws + WS_ZS); bf16_t* MIXp = (bf16_t*)(ws + WS_MIX);
    const float* pw = in[17] + (size_t)l * 4 * 128 * 128; const float* psc = in[18] + l * MIX;
    const int m0 = item * 16, t0 = m0 % SEQ;
    LAS float* Z = (LAS float*)F.lds;
    LAS float* DT = Z + 31 * 512;
    for (int e = F.tid; e < 31 * 128; e += NTHR) { const int r = e >> 7, c4 = (e & 127) * 4; const int ta = t0 - 15 + r;
        f32x4 v = (f32x4){0.f, 0.f, 0.f, 0.f};
        if (ta >= 0) v = *(const f32x4*)(ZS + (size_t)(m0 - 15 + r) * ZS_COLS + ZO_C + c4);
        *(LAS f32x4*)(Z + r * 512 + c4) = v; }
    __syncthreads();
    const int j = F.tid, gi = j >> 7, win = 2 << gi;
    for (int t = 0; t < 16; ++t) { float s = 0.f;
        for (int i = 0; i < win; ++i) s += Z[(15 + t - i) * 512 + j];
        const int cnt = (t0 + t + 1) < win ? (t0 + t + 1) : win;
        DT[j * 16 + t] = s / (float)cnt - Z[(15 + t) * 512 + j]; }
    __syncthreads();
    float acc[16];
#pragma unroll
    for (int t = 0; t < 16; ++t) acc[t] = 0.f;
    const int dcol = j & 127;
#pragma unroll 8
    for (int k = 0; k < 128; ++k) { const float wv = pw[((size_t)gi * 128 + k) * 128 + dcol];
#pragma unroll
        for (int q = 0; q < 4; ++q) { const f32x4 x = *(const LAS f32x4*)(DT + (gi * 128 + k) * 16 + 4 * q);
#pragma unroll
            for (int i = 0; i < 4; ++i) acc[4 * q + i] += x[i] * wv; } }
    const float sc = psc[j];
#pragma unroll
    for (int t = 0; t < 16; ++t) MIXp[(size_t)(m0 + t) * (4 * MIX) + 2 * MIX + j] = (bf16_t)f2bf(acc[t] * sc);
    __syncthreads();
}

struct SsmCoef { float lr, li; float br[16], bi[16]; };
DI void ssm_coef(const In& in, int l, int g, int p, SsmCoef& c) {
    const float are = in[19][((size_t)l * 32 + g) * 64 + p], aim = in[20][((size_t)l * 32 + g) * 64 + p];
    const float dt = expf(in[21][l * 32 + g]);
    const float er = expf(are * dt); float sn, cs; sincosf(aim * dt, &sn, &cs);
    c.lr = er * cs; c.li = er * sn;
    const float nr = c.lr - 1.0f, ni = c.li, den = are * are + aim * aim;
    const float cr = (nr * are + ni * aim) / den, ci = (ni * are - nr * aim) / den;
    const float* bre = in[22] + (((size_t)l * 32 + g) * 64 + p) * 16; const float* bim = in[23] + (((size_t)l * 32 + g) * 64 + p) * 16;
#pragma unroll
    for (int k = 0; k < 16; ++k) { const float x = bre[k], y = bim[k]; c.br[k] = cr * x - ci * y; c.bi[k] = cr * y + ci * x; }
}
DI void ssm_pass1_item(const Frame& F, unsigned char* ws, const In& in, int l, int item) {
    const float* ZS = (const float*)(ws + WS_ZS); float* SST = (float*)(ws + WS_SSTATE);
    const int wt = item * 8 + F.wave, b = wt >> 9, g = (wt >> 4) & 31, ch = wt & 15, p = F.lane;
    SsmCoef c; ssm_coef(in, l, g, p, c);
    LAS float* UL = (LAS float*)(F.lds + F.wave * 8192);
    const int mb = b * SEQ + ch * 128;
#pragma unroll
    for (int i = 0; i < 8; ++i) { const int e = i * 64 + F.lane, t = e >> 2, q = e & 3;
        *(LAS f32x4*)(UL + t * 16 + q * 4) = *(const f32x4*)(ZS + (size_t)(mb + t) * ZS_COLS + ZO_D + g * 16 + q * 4); }
    LDS_WAIT(); asm volatile("" ::: "memory");
    float xr = 0.f, xi = 0.f;
#pragma unroll 2
    for (int t = 0; t < 128; ++t) { float bur = 0.f, bui = 0.f;
#pragma unroll
        for (int q = 0; q < 4; ++q) { const f32x4 u = *(const LAS f32x4*)(UL + t * 16 + q * 4);
#pragma unroll
            for (int i = 0; i < 4; ++i) { bur += c.br[4 * q + i] * u[i]; bui += c.bi[4 * q + i] * u[i]; } }
        const float nr = c.lr * xr - c.li * xi + bur, ni = c.lr * xi + c.li * xr + bui; xr = nr; xi = ni; }
    *(f32x2*)(SST + ((size_t)wt * 64 + p) * 2) = (f32x2){xr, xi};
    LDS_WAIT(); asm volatile("" ::: "memory");
}
DI float gelu_tanh(float y) { const float u = 0.7978845608028654f * (y + 0.044715f * y * y * y); return y * (1.0f - __builtin_amdgcn_rcpf(1.0f + __expf(2.0f * u))); }
DI void ssm_pass3_item(const Frame& F, unsigned char* ws, const In& in, int l, int item) {
    const float* ZS = (const float*)(ws + WS_ZS); const float* SST = (const float*)(ws + WS_SSTATE);
    float* YS = (float*)(ws + WS_YS); bf16_t* YSB = (bf16_t*)(ws + WS_YSB);
    const int wt = item * 8 + F.wave, b = wt >> 9, g = (wt >> 4) & 31, ch = wt & 15, p = F.lane;
    SsmCoef c; ssm_coef(in, l, g, p, c);
    LAS float* CL = (LAS float*)(F.lds + 98304);
    { const float* cre = in[24] + ((size_t)l * 32 + g) * 16 * 64; const float* cim = in[25] + ((size_t)l * 32 + g) * 16 * 64;
      for (int e = F.tid; e < 1024; e += NTHR) { const int cc = e >> 6, pp = e & 63; *(LAS f32x2*)(CL + cc * 132 + pp * 2) = (f32x2){cre[e], cim[e]}; } }
    __syncthreads();
    float l128r = c.lr, l128i = c.li;
#pragma unroll
    for (int i = 0; i < 7; ++i) { const float nr = l128r * l128r - l128i * l128i, ni = 2.f * l128r * l128i; l128r = nr; l128i = ni; }
    float xr = 0.f, xi = 0.f;
    { f32x2 ev[15];
#pragma unroll
      for (int cc = 0; cc < 15; ++cc) { const int c2 = cc < ch ? cc : 0; ev[cc] = *(const f32x2*)(SST + ((size_t)(wt - ch + c2) * 64 + p) * 2); }
#pragma unroll
      for (int cc = 0; cc < 15; ++cc) if (cc < ch) { const float nr = l128r * xr - l128i * xi + ev[cc][0], ni = l128r * xi + l128i * xr + ev[cc][1]; xr = nr; xi = ni; } }
    LAS float* UL = (LAS float*)(F.lds + F.wave * 12288);
    LAS float* XS = UL + 256;
    const int mb = b * SEQ + ch * 128;
    const float dsk = in[26][l * MIX + g * 16 + (F.lane & 15)];
    const float* usrc = ZS + (size_t)(mb + (F.lane >> 2)) * ZS_COLS + ZO_D + g * 16 + (F.lane & 3) * 4;
    f32x4 unext = *(const f32x4*)usrc;
    for (int sc = 0; sc < 8; ++sc) {
        *(LAS f32x4*)(UL + (F.lane >> 2) * 16 + (F.lane & 3) * 4) = unext;
        if (sc < 7) unext = *(const f32x4*)(usrc + (size_t)(sc + 1) * 16 * ZS_COLS);
        LDS_WAIT(); asm volatile("" ::: "memory");
#pragma unroll 2
        for (int t = 0; t < 16; ++t) { float bur = 0.f, bui = 0.f;
#pragma unroll
            for (int q = 0; q < 4; ++q) { const f32x4 u = *(const LAS f32x4*)(UL + t * 16 + q * 4);
#pragma unroll
                for (int i = 0; i < 4; ++i) { bur += c.br[4 * q + i] * u[i]; bui += c.bi[4 * q + i] * u[i]; } }
            const float nr = c.lr * xr - c.li * xi + bur, ni = c.lr * xi + c.li * xr + bui; xr = nr; xi = ni;
            *(LAS f32x2*)(XS + (t * 64 + p) * 2) = (f32x2){xr, xi}; }
        LDS_WAIT(); asm volatile("" ::: "memory");
        const int cc = F.lane & 15, tq = F.lane >> 4;
        float y[4] = {0.f, 0.f, 0.f, 0.f};
#pragma unroll 4
        for (int pp = 0; pp < 64; pp += 2) { const f32x4 cv = *(const LAS f32x4*)(CL + cc * 132 + pp * 2);
#pragma unroll
            for (int jj = 0; jj < 4; ++jj) { const f32x4 xv = *(const LAS f32x4*)(XS + ((tq * 4 + jj) * 64 + pp) * 2);
                y[jj] += cv[0] * xv[0] - cv[1] * xv[1] + cv[2] * xv[2] - cv[3] * xv[3]; } }
#pragma unroll
        for (int jj = 0; jj < 4; ++jj) { const int t = tq * 4 + jj; const int m = mb + sc * 16 + t;
            const float yy = gelu_tanh(y[jj] + dsk * UL[t * 16 + cc]);
            YS[(size_t)m * MIX + g * 16 + cc] = yy; YSB[(size_t)m * MIX + g * 16 + cc] = (bf16_t)f2bf(yy); }
        LDS_WAIT(); asm volatile("" ::: "memory");
    }
    __syncthreads();
}

DI void ssm_seq_item(const Frame& F, unsigned char* ws, const In& in, int l, int item) {
    const float* ZS = (const float*)(ws + WS_ZS); bf16_t* YSB = (bf16_t*)(ws + WS_YSB);
    const int task = item * 8 + F.wave, g = task >> 1, bp = task & 1;
    const int r = F.lane & 31, hh = F.lane >> 5;
    constexpr int XP = 136;
    LAS bf16_t* Xl = (LAS bf16_t*)(F.lds + F.wave * 8704);
    float lr[2], li[2]; bf16x8 Bf[4];
#pragma unroll
    for (int ps = 0; ps < 2; ++ps) { const int p = r + 32 * ps;
        const float are = in[19][((size_t)l * 32 + g) * 64 + p], aim = in[20][((size_t)l * 32 + g) * 64 + p];
        const float dt = __expf(in[21][l * 32 + g]);
        const float er = __expf(are * dt); float sn, cs; sincosf(aim * dt, &sn, &cs);
        lr[ps] = er * cs; li[ps] = er * sn;
        const float nr = lr[ps] - 1.0f, ni = li[ps], den = are * are + aim * aim;
        const float cr = (nr * are + ni * aim) / den, ci = (ni * are - nr * aim) / den;
        const float* bre = in[22] + (((size_t)l * 32 + g) * 64 + p) * 16 + 8 * hh; const float* bim = in[23] + (((size_t)l * 32 + g) * 64 + p) * 16 + 8 * hh;
        float vr[8], vi[8];
#pragma unroll
        for (int j = 0; j < 8; ++j) { const float x = bre[j], y = bim[j]; vr[j] = cr * x - ci * y; vi[j] = cr * y + ci * x; }
        Bf[2 * ps] = pack8(vr[0], vr[1], vr[2], vr[3], vr[4], vr[5], vr[6], vr[7]); Bf[2 * ps + 1] = pack8(vi[0], vi[1], vi[2], vi[3], vi[4], vi[5], vi[6], vi[7]); }
    bf16x8 Cf[8];
    { const float* cre = in[24] + (((size_t)l * 32 + g) * 16 + (r & 15)) * 64; const float* cim = in[25] + (((size_t)l * 32 + g) * 16 + (r & 15)) * 64;
#pragma unroll
      for (int s2 = 0; s2 < 8; ++s2) { const int q = s2 >> 1, n0 = 16 * (s2 & 1) + 8 * hh + 32 * (q >> 1); float v[8];
#pragma unroll
          for (int j = 0; j < 8; ++j) { const float x = (q & 1) ? -cim[n0 + j] : cre[n0 + j]; v[j] = (r < 16) ? x : 0.f; }
          Cf[s2] = pack8(v[0], v[1], v[2], v[3], v[4], v[5], v[6], v[7]); } }
    const float dsk = in[26][l * MIX + g * 16 + (r & 15)];
    bf16x8 Dg;
    { float v[8];
#pragma unroll
      for (int j = 0; j < 8; ++j) v[j] = (r < 16 && 8 * hh + j == r) ? dsk : 0.f;
      Dg = pack8(v[0], v[1], v[2], v[3], v[4], v[5], v[6], v[7]); }
    float xr0 = 0.f, xi0 = 0.f, xr1 = 0.f, xi1 = 0.f;
    const int hr = (r >> 2) & 1, ir = 4 * (r >> 3) + (r & 3);
    const float* usrc = ZS + (size_t)((bp + 2 * hr) * SEQ + ir) * ZS_COLS + ZO_D + g * 16 + 8 * hh;
    f32x4 ua = *(const f32x4*)usrc, ub = *(const f32x4*)(usrc + 4);
    const size_t ebase = (size_t)((bp + 2 * hh) * SEQ) ;
    bf16_t* yout = YSB + ebase * MIX + g * 16 + (r & 15);
#pragma unroll 1
    for (int tile = 0; tile < SEQ / 16; ++tile) {
        const bf16x8 Au = pack8(ua[0], ua[1], ua[2], ua[3], ub[0], ub[1], ub[2], ub[3]);
        if (tile + 1 < SEQ / 16) { ua = *(const f32x4*)(usrc + (size_t)(tile + 1) * 16 * ZS_COLS); ub = *(const f32x4*)(usrc + (size_t)(tile + 1) * 16 * ZS_COLS + 4); }
        f32x16 z16;
#pragma unroll
        for (int i = 0; i < 16; ++i) z16[i] = 0.f;
        f32x16 a0 = MFMA32(Au, Bf[0], z16), a1 = MFMA32(Au, Bf[1], z16), a2 = MFMA32(Au, Bf[2], z16), a3 = MFMA32(Au, Bf[3], z16);
#pragma unroll
        for (int i = 0; i < 16; ++i) {
            const float n0r = lr[0] * xr0 - li[0] * xi0 + a0[i], n0i = lr[0] * xi0 + li[0] * xr0 + a1[i]; xr0 = n0r; xi0 = n0i; a0[i] = n0r; a1[i] = n0i;
            const float n1r = lr[1] * xr1 - li[1] * xi1 + a2[i], n1i = lr[1] * xi1 + li[1] * xr1 + a3[i]; xr1 = n1r; xi1 = n1i; a2[i] = n1r; a3[i] = n1i; }
#pragma unroll
        for (int i = 0; i < 16; ++i) { const int rho = (i & 3) + 8 * (i >> 2) + 4 * hh; LAS bf16_t* row = Xl + rho * XP + r;
            row[0] = (bf16_t)f2bf(a0[i]); row[32] = (bf16_t)f2bf(a1[i]); row[64] = (bf16_t)f2bf(a2[i]); row[96] = (bf16_t)f2bf(a3[i]); }
        LDS_WAIT(); asm volatile("" ::: "memory");
        f32x16 ay = MFMA32(Au, Dg, z16);
#pragma unroll
        for (int s2 = 0; s2 < 8; ++s2) ay = MFMA32(*(const LAS bf16x8*)(Xl + r * XP + 16 * s2 + 8 * hh), Cf[s2], ay);
        if (r < 16) {
#pragma unroll
            for (int i = 0; i < 16; ++i) yout[(size_t)(tile * 16 + i) * MIX] = (bf16_t)f2bf(gelu_tanh(ay[i])); }
        LDS_WAIT(); asm volatile("" ::: "memory");
    }
}

DI float vmul_(float a, float b) { float d; asm("v_mul_f32 %0, %1, %2" : "=v"(d) : "v"(a), "v"(b)); return d; }
DI float vfma_(float a, float b, float c) { float d; asm("v_fma_f32 %0, %1, %2, %3" : "=v"(d) : "v"(a), "v"(b), "v"(c)); return d; }
DI void row16_sum2(float& x0, float& x1) {
    asm("s_nop 1\n\t"
        "v_add_f32_dpp %0, %0, %0 quad_perm:[1,0,3,2] row_mask:0xf bank_mask:0xf bound_ctrl:1\n\tv_add_f32_dpp %1, %1, %1 quad_perm:[1,0,3,2] row_mask:0xf bank_mask:0xf bound_ctrl:1\n\ts_nop 0\n\t"
        "v_add_f32_dpp %0, %0, %0 quad_perm:[2,3,0,1] row_mask:0xf bank_mask:0xf bound_ctrl:1\n\tv_add_f32_dpp %1, %1, %1 quad_perm:[2,3,0,1] row_mask:0xf bank_mask:0xf bound_ctrl:1\n\ts_nop 0\n\t"
        "v_add_f32_dpp %0, %0, %0 row_half_mirror row_mask:0xf bank_mask:0xf bound_ctrl:1\n\tv_add_f32_dpp %1, %1, %1 row_half_mirror row_mask:0xf bank_mask:0xf bound_ctrl:1\n\ts_nop 0\n\t"
        "v_add_f32_dpp %0, %0, %0 row_mirror row_mask:0xf bank_mask:0xf bound_ctrl:1\n\tv_add_f32_dpp %1, %1, %1 row_mirror row_mask:0xf bank_mask:0xf bound_ctrl:1\n\ts_nop 1"
        : "+v"(x0), "+v"(x1));
}
DI void rwkv_scan_item(const Frame& F, unsigned char* ws, int item) {
    const float* RW = (const float*)(ws + WS_RW); constexpr size_t RS = RW_STRIDE / 4;
    float* YRAW = (float*)(ws + WS_YRAW);
    constexpr int TC = 32, NCH = SEQ / TC;
    const int b = item >> 3, h = item & 7;
    const int rg = F.lane >> 4, jq = F.lane & 15, row0 = F.wave * 8 + rg * 2;
    LAS float* BUF = (LAS float*)F.lds;
    constexpr int BUFSZ = 6 * TC * 64;
    const int st = F.tid >> 4, sq = F.tid & 15;
    const float* gsrc = RW + (size_t)(b * SEQ + st) * MIX + h * 64 + 4 * sq;
    f32x4 pre[6];
#pragma unroll
    for (int a = 0; a < 6; ++a) pre[a] = *(const f32x4*)(gsrc + a * RS);
#pragma unroll
    for (int a = 0; a < 6; ++a) *(LAS f32x4*)(BUF + (a * TC + st) * 64 + 4 * sq) = pre[a];
    __syncthreads();
    float S0[4] = {0.f, 0.f, 0.f, 0.f}, S1[4] = {0.f, 0.f, 0.f, 0.f};
    float* yout = YRAW + (size_t)(b * SEQ) * MIX + h * 64 + row0;
#pragma unroll 1
    for (int c = 0; c < NCH; ++c) {
        if (c + 1 < NCH) {
#pragma unroll
            for (int a = 0; a < 6; ++a) pre[a] = *(const f32x4*)(gsrc + a * RS + (size_t)(c + 1) * TC * MIX);
        }
        const LAS float* P = BUF + (c & 1) * BUFSZ;
#pragma unroll 1
        for (int t16 = 0; t16 < TC; t16 += 16) {
            float yk0 = 0.f, yk1 = 0.f;
#pragma unroll 4
            for (int tt = 0; tt < 16; ++tt) { const int t = t16 + tt;
                const f32x4 a4 = *(const LAS f32x4*)(P + (4 * TC + t) * 64 + 4 * jq);
                const f32x4 k4 = *(const LAS f32x4*)(P + (2 * TC + t) * 64 + 4 * jq);
                const f32x2 v2 = *(const LAS f32x2*)(P + (3 * TC + t) * 64 + row0);
                const f32x4 b4 = *(const LAS f32x4*)(P + (5 * TC + t) * 64 + 4 * jq);
                const f32x4 w4 = *(const LAS f32x4*)(P + (1 * TC + t) * 64 + 4 * jq);
                const f32x4 r4 = *(const LAS f32x4*)(P + (0 * TC + t) * 64 + 4 * jq);
                float sa0 = vfma_(S0[3], a4[3], vfma_(S0[2], a4[2], vfma_(S0[1], a4[1], vmul_(S0[0], a4[0]))));
                float sa1 = vfma_(S1[3], a4[3], vfma_(S1[2], a4[2], vfma_(S1[1], a4[1], vmul_(S1[0], a4[0]))));
                row16_sum2(sa0, sa1);
#pragma unroll
                for (int i = 0; i < 4; ++i) { S0[i] = vfma_(S0[i], w4[i], vfma_(sa0, b4[i], vmul_(v2[0], k4[i]))); S1[i] = vfma_(S1[i], w4[i], vfma_(sa1, b4[i], vmul_(v2[1], k4[i]))); }
                float y0 = vfma_(S0[3], r4[3], vfma_(S0[2], r4[2], vfma_(S0[1], r4[1], vmul_(S0[0], r4[0]))));
                float y1 = vfma_(S1[3], r4[3], vfma_(S1[2], r4[2], vfma_(S1[1], r4[1], vmul_(S1[0], r4[0]))));
                row16_sum2(y0, y1);
                const bool mine = (tt & 15) == jq;
                yk0 = mine ? y0 : yk0; yk1 = mine ? y1 : yk1; }
            *(f32x2*)(yout + (size_t)(c * TC + t16 + jq) * MIX) = (f32x2){yk0, yk1};
        }
        if (c + 1 < NCH) {
            LAS float* Q = BUF + ((c + 1) & 1) * BUFSZ;
#pragma unroll
            for (int a = 0; a < 6; ++a) *(LAS f32x4*)(Q + (a * TC + st) * 64 + 4 * sq) = pre[a];
        }
        __syncthreads();
    }
}
DI void rwkv_post_rows(const Frame& F, unsigned char* ws, const In& in, int l, int w0, int nw) {
    const float* RW = (const float*)(ws + WS_RW); constexpr size_t RS = RW_STRIDE / 4;
    const float* YRAW = (const float*)(ws + WS_YRAW); bf16_t* MIXp = (bf16_t*)(ws + WS_MIX);
    const float* r_k = in[14] + l * MIX; const float* lng = in[15] + l * MIX; const float* lnb = in[16] + l * MIX;
    for (int e = w0; e < MTOK * 8; e += nw) { const int m = e >> 3, h = e & 7, ch = h * 64 + F.lane; const size_t o = (size_t)m * MIX + ch;
        const float y = YRAW[o];
        const float mean = wave_sum(y) * (1.f / 64.f); const float d = y - mean; const float var = wave_sum(d * d) * (1.f / 64.f);
        const float yn = d * (1.0f / sqrtf(var + GN_EPS)) * lng[ch] + lnb[ch];
        const float bon = wave_sum(RW[0 * RS + o] * RW[2 * RS + o] * r_k[ch]) * RW[3 * RS + o];
        MIXp[(size_t)m * (4 * MIX) + MIX + ch] = (bf16_t)f2bf((yn + bon) * RW[6 * RS + o]); }
}

DI unsigned wave_sum_u32(unsigned x) {
    float f = __builtin_bit_cast(float, x); (void)f;
    int v = (int)x;
    v += __builtin_amdgcn_update_dpp(0, v, 0xB1, 0xF, 0xF, true); v += __builtin_amdgcn_update_dpp(0, v, 0x4E, 0xF, 0xF, true);
    v += __builtin_amdgcn_update_dpp(0, v, 0x141, 0xF, 0xF, true); v += __builtin_amdgcn_update_dpp(0, v, 0x140, 0xF, 0xF, true);
    return (unsigned)(__builtin_amdgcn_readlane(v, 0) + __builtin_amdgcn_readlane(v, 16) + __builtin_amdgcn_readlane(v, 32) + __builtin_amdgcn_readlane(v, 48));
}
DI unsigned fkey(float v) { unsigned u = __builtin_bit_cast(unsigned, v); if (u == 0x80000000u) u = 0u; return (u & 0x80000000u) ? ~u : (u | 0x80000000u); }
struct AttTile { bf16x8 kf[4]; s16x4 vf[8]; unsigned mw; };
DI void att_load(AttTile& T, const bf16_t* kp, const bf16_t* vp, const unsigned* mp, int kt) {
#pragma unroll
    for (int s = 0; s < 4; ++s) T.kf[s] = *(const bf16x8*)(kp + (size_t)kt * 32 * 512 + 16 * s);
#pragma unroll
    for (int s2 = 0; s2 < 2; ++s2) { const bf16_t* v = vp + kt * 32 + 16 * s2;
        T.vf[4 * s2 + 0] = *(const s16x4*)(v); T.vf[4 * s2 + 1] = *(const s16x4*)(v + 8);
        T.vf[4 * s2 + 2] = *(const s16x4*)(v + (size_t)32 * SEQ); T.vf[4 * s2 + 3] = *(const s16x4*)(v + (size_t)32 * SEQ + 8); }
    T.mw = mp[kt];
}
DI void att_tile(const AttTile& T, const bf16x8 (&qf)[4], f32x16& o0, f32x16& o1, float& mrun, float& lrun, int hh) {
    f32x16 sa;
#pragma unroll
    for (int i = 0; i < 16; ++i) sa[i] = 0.f;
#pragma unroll
    for (int s = 0; s < 4; ++s) sa = MFMA32(T.kf[s], qf[s], sa);
    float mx = -1e30f;
#pragma unroll
    for (int i = 0; i < 16; ++i) { const int kr = (i & 3) + 8 * (i >> 2) + 4 * hh; const bool on = (T.mw >> kr) & 1u; sa[i] = on ? sa[i] : -1e30f; mx = fmaxf(mx, sa[i]); }
    mx = fmaxf(mx, __shfl_xor(mx, 32));
    const float mnew = fmaxf(mrun, mx);
    if (__any(mnew > mrun)) {
        const float alpha = __expf(mrun - mnew); lrun *= alpha;
#pragma unroll
        for (int i = 0; i < 16; ++i) { o0[i] *= alpha; o1[i] *= alpha; }
        mrun = mnew; }
    float p[16], ps = 0.f;
#pragma unroll
    for (int i = 0; i < 16; ++i) { p[i] = (sa[i] > -1e29f) ? __expf(sa[i] - mrun) : 0.f; ps += p[i]; }
    lrun += ps;
#pragma unroll
    for (int s2 = 0; s2 < 2; ++s2) {
        const bf16x8 pb = pack8(p[8 * s2], p[8 * s2 + 1], p[8 * s2 + 2], p[8 * s2 + 3], p[8 * s2 + 4], p[8 * s2 + 5], p[8 * s2 + 6], p[8 * s2 + 7]);
        const bf16x8 vf0 = __builtin_shufflevector(T.vf[4 * s2], T.vf[4 * s2 + 1], 0, 1, 2, 3, 4, 5, 6, 7), vf1 = __builtin_shufflevector(T.vf[4 * s2 + 2], T.vf[4 * s2 + 3], 0, 1, 2, 3, 4, 5, 6, 7);
        o0 = MFMA32(vf0, pb, o0); o1 = MFMA32(vf1, pb, o1); }
}
DI void dsa_item(const Frame& F, unsigned char* ws, int item) {
    const bf16_t* Q = (const bf16_t*)(ws + WS_Q); const bf16_t* Kb = (const bf16_t*)(ws + WS_K); const bf16_t* VT = (const bf16_t*)(ws + WS_VT);
    const bf16_t* QI = (const bf16_t*)(ws + WS_QI); const bf16_t* KI = (const bf16_t*)(ws + WS_KI); const float* WI = (const float*)(ws + WS_WI);
    float* SC = (float*)(ws + WS_SC); unsigned* MASK = (unsigned*)(ws + WS_MASK); bf16_t* MIXp = (bf16_t*)(ws + WS_MIX);
    const int b = item >> 6, qb = item & 63, q0 = qb * 32, m0 = b * SEQ + q0;
    const int r = F.lane & 31, hh = F.lane >> 5;
    {
        float wv[4];
#pragma unroll
        for (int hd = 0; hd < 4; ++hd) wv[hd] = WI[(size_t)(m0 + r) * 4 + hd];
        const bf16_t* qip = QI + (size_t)(m0 + r) * 256 + 8 * hh;
        const bf16_t* kip = KI + (size_t)(b * SEQ + r) * 64 + 8 * hh;
        bf16x8 kf[4], kn[4];
        if (F.wave <= qb) {
#pragma unroll
            for (int s = 0; s < 4; ++s) kf[s] = *(const bf16x8*)(kip + (size_t)F.wave * 32 * 64 + 16 * s); }
        for (int kt = F.wave; kt <= qb; kt += 8) {
            if (kt + 8 <= qb) {
#pragma unroll
                for (int s = 0; s < 4; ++s) kn[s] = *(const bf16x8*)(kip + (size_t)(kt + 8) * 32 * 64 + 16 * s); }
            f32x16 sc;
#pragma unroll
            for (int i = 0; i < 16; ++i) sc[i] = 0.f;
#pragma unroll
            for (int hd = 0; hd < 4; ++hd) { f32x16 a; bf16x8 qf[4];
#pragma unroll
                for (int s = 0; s < 4; ++s) qf[s] = *(const bf16x8*)(qip + hd * 64 + 16 * s);
#pragma unroll
                for (int i = 0; i < 16; ++i) a[i] = 0.f;
#pragma unroll
                for (int s = 0; s < 4; ++s) a = MFMA32(kf[s], qf[s], a);
#pragma unroll
                for (int i = 0; i < 16; ++i) sc[i] += wv[hd] * fmaxf(a[i], 0.f); }
#pragma unroll
            for (int g = 0; g < 4; ++g) *(f32x4*)(SC + (size_t)(m0 + r) * SEQ + kt * 32 + 8 * g + 4 * hh) = (f32x4){sc[4 * g], sc[4 * g + 1], sc[4 * g + 2], sc[4 * g + 3]};
#pragma unroll
            for (int s = 0; s < 4; ++s) kf[s] = kn[s];
        }
    }
    VM_WAIT(); __syncthreads();
    for (int qq = 0; qq < 4; ++qq) {
        const int rq = F.wave * 4 + qq, t = q0 + rq, m = m0 + rq;
        unsigned* mrow = MASK + (size_t)m * 64;
        if (t + 1 <= 256) {
            for (int j = 0; j < 32; ++j) { const unsigned long long bm = __ballot(F.lane + 64 * j <= t); if (F.lane == 0) { mrow[2 * j] = (unsigned)bm; mrow[2 * j + 1] = (unsigned)(bm >> 32); } }
        } else {
            unsigned key[32];
#pragma unroll
            for (int j = 0; j < 32; ++j) { const int s = F.lane + 64 * j; key[j] = (s <= t) ? fkey(SC[(size_t)m * SEQ + (s <= t ? s : 0)]) : 0u; }
            unsigned T = 0u;
#pragma unroll 1
            for (int bit = 31; bit >= 0; --bit) { const unsigned cand = T | (1u << bit); unsigned cnt = 0u;
#pragma unroll
                for (int j = 0; j < 32; ++j) cnt += (key[j] >= cand) ? 1u : 0u;
                if (wave_sum_u32(cnt) >= 256u) T = cand; }
            unsigned cg = 0u;
#pragma unroll
            for (int j = 0; j < 32; ++j) cg += (key[j] > T) ? 1u : 0u;
            const int cgt = (int)wave_sum_u32(cg);
            const int need = 256 - cgt; int run = 0;
            const unsigned long long lt = (1ull << F.lane) - 1ull;
#pragma unroll
            for (int j = 0; j < 32; ++j) {
                const unsigned long long eq = __ballot(key[j] == T), gt = __ballot(key[j] > T);
                const int pre = run + __popcll(eq & lt);
                const unsigned long long se = __ballot(key[j] == T && pre < need);
                const unsigned long long bm = gt | se; run += __popcll(eq);
                if (F.lane == 0) { mrow[2 * j] = (unsigned)bm; mrow[2 * j + 1] = (unsigned)(bm >> 32); }
                if ((j & 3) == 3) __builtin_amdgcn_sched_barrier(0); }
        }
    }
    VM_WAIT(); __syncthreads();
    {
        const int hd = F.wave;
        bf16x8 qf[4];
#pragma unroll
        for (int s = 0; s < 4; ++s) qf[s] = *(const bf16x8*)(Q + (size_t)(m0 + r) * 512 + hd * 64 + 16 * s + 8 * hh);
        f32x16 o0, o1;
#pragma unroll
        for (int i = 0; i < 16; ++i) { o0[i] = 0.f; o1[i] = 0.f; }
        float mrun = -1e30f, lrun = 0.f;
        const bf16_t* kp = Kb + (size_t)(b * SEQ + r) * 512 + hd * 64 + 8 * hh;
        const bf16_t* vp = VT + ((size_t)(b * 8 + hd) * 64 + r) * SEQ + 4 * hh;
        const unsigned* mp = MASK + (size_t)(m0 + r) * 64;
        AttTile A, B;
        att_load(A, kp, vp, mp, 0);
        for (int kt = 0; kt <= qb; kt += 2) {
            if (kt + 1 <= qb) att_load(B, kp, vp, mp, kt + 1);
            att_tile(A, qf, o0, o1, mrun, lrun, hh);
            if (kt + 1 <= qb) {
                if (kt + 2 <= qb) att_load(A, kp, vp, mp, kt + 2);
                att_tile(B, qf, o0, o1, mrun, lrun, hh); }
        }
        const float inv = 1.0f / (lrun + __shfl_xor(lrun, 32));
        bf16_t* orow = MIXp + (size_t)(m0 + r) * (4 * MIX) + hd * 64;
#pragma unroll
        for (int g = 0; g < 4; ++g) {
            u32x2 w0; w0.x = pk2(o0[4 * g] * inv, o0[4 * g + 1] * inv); w0.y = pk2(o0[4 * g + 2] * inv, o0[4 * g + 3] * inv);
            u32x2 w1; w1.x = pk2(o1[4 * g] * inv, o1[4 * g + 1] * inv); w1.y = pk2(o1[4 * g + 2] * inv, o1[4 * g + 3] * inv);
            *(u32x2*)(orow + 8 * g + 4 * hh) = w0; *(u32x2*)(orow + 32 + 8 * g + 4 * hh) = w1; }
    }
    __syncthreads();
}

DI float siluf_(float x) { return x * sigmoidf_(x); }
DI void conv_phase(const Frame& F, unsigned char* ws, const In& in, int l) {
    const bf16_t* U = (const bf16_t*)(ws + WS_U); bf16_t* ACT = (bf16_t*)(ws + WS_ACT);
    const float* cw = in[33] + (size_t)l * 3 * DFF2; const float* cb = in[34] + (size_t)l * DFF2;
    constexpr int NCG = DFF / 8;
    const long total = (long)NCG * (MTOK / 32);
    for (long e = (long)F.bid * NTHR + F.tid; e < total; e += (long)F.G * NTHR) {
        const int cg = (int)(e % NCG), tg = (int)(e / NCG); const int f0 = cg * 8, m0 = tg * 32; const bool first = (m0 % SEQ) == 0;
        float wg[3][8], wv[3][8], bg[8], bv[8];
#pragma unroll
        for (int j = 0; j < 3; ++j)
#pragma unroll
            for (int i = 0; i < 8; ++i) { wg[j][i] = cw[(size_t)j * DFF2 + f0 + i]; wv[j][i] = cw[(size_t)j * DFF2 + DFF + f0 + i]; }
#pragma unroll
        for (int i = 0; i < 8; ++i) { bg[i] = cb[f0 + i]; bv[i] = cb[DFF + f0 + i]; }
        float g1[8], g2[8], v1[8], v2[8];
#pragma unroll
        for (int i = 0; i < 8; ++i) { g1[i] = 0.f; g2[i] = 0.f; v1[i] = 0.f; v2[i] = 0.f; }
        if (!first) {
            const u32x4 a = *(const u32x4*)(U + (size_t)(m0 - 1) * DFF2 + f0), b = *(const u32x4*)(U + (size_t)(m0 - 2) * DFF2 + f0);
            const u32x4 c = *(const u32x4*)(U + (size_t)(m0 - 1) * DFF2 + DFF + f0), d = *(const u32x4*)(U + (size_t)(m0 - 2) * DFF2 + DFF + f0);
#pragma unroll
            for (int i = 0; i < 4; ++i) { g1[2 * i] = bf2f(a[i] & 0xffffu); g1[2 * i + 1] = bf2f(a[i] >> 16); g2[2 * i] = bf2f(b[i] & 0xffffu); g2[2 * i + 1] = bf2f(b[i] >> 16);
                v1[2 * i] = bf2f(c[i] & 0xffffu); v1[2 * i + 1] = bf2f(c[i] >> 16); v2[2 * i] = bf2f(d[i] & 0xffffu); v2[2 * i + 1] = bf2f(d[i] >> 16); }
        }
#pragma unroll 2
        for (int t = 0; t < 32; ++t) {
            const u32x4 a = *(const u32x4*)(U + (size_t)(m0 + t) * DFF2 + f0), c = *(const u32x4*)(U + (size_t)(m0 + t) * DFF2 + DFF + f0);
            float g0[8], v0[8], o[8];
#pragma unroll
            for (int i = 0; i < 4; ++i) { g0[2 * i] = bf2f(a[i] & 0xffffu); g0[2 * i + 1] = bf2f(a[i] >> 16); v0[2 * i] = bf2f(c[i] & 0xffffu); v0[2 * i + 1] = bf2f(c[i] >> 16); }
#pragma unroll
            for (int i = 0; i < 8; ++i) { const float gc = bg[i] + wg[0][i] * g2[i] + wg[1][i] * g1[i] + wg[2][i] * g0[i]; const float vc = bv[i] + wv[0][i] * v2[i] + wv[1][i] * v1[i] + wv[2][i] * v0[i];
                o[i] = siluf_(gc) * vc; g2[i] = g1[i]; g1[i] = g0[i]; v2[i] = v1[i]; v1[i] = v0[i]; }
            u32x4 w; w.x = pk2(o[0], o[1]); w.y = pk2(o[2], o[3]); w.z = pk2(o[4], o[5]); w.w = pk2(o[6], o[7]);
            *(u32x4*)(ACT + (size_t)(m0 + t) * DFF + f0) = w;
        }
    }
}

DI void final_phase(const Frame& F, unsigned char* ws, const float* gfin, float* out) {
    const float* Y = (const float*)(ws + WS_Y); const float* part = (const float*)(ws + WS_PARTA);
    const int gw = F.bid * NWAVES + F.wave, NGW = F.G * NWAVES;
    for (int m = gw; m < MTOK; m += NGW) {
        float s = (F.lane < 32) ? part[(size_t)m * 32 + F.lane] : 0.f; s = wave_sum(s);
        const float rs = 1.0f / sqrtf(s * (1.0f / DM) + RMS_EPS);
#pragma unroll
        for (int j = 0; j < 8; ++j) { const int c = (j * 64 + F.lane) * 4; const f32x4 v = *(const f32x4*)(Y + (size_t)m * DM + c), g = *(const f32x4*)(gfin + c);
            *(f32x4*)(out + (size_t)m * DM + c) = v * rs * g; }
    }
}

struct Args { InTab in; float* out; unsigned char* ws; int ph_lo, ph_hi; };
constexpr int ZG1_UNITS = 24 * 32, ZG2_UNITS = 28 * 32;
constexpr int PH_PER_LAYER = 9, N_PHASES = 1 + NL * PH_PER_LAYER + 1;

__global__ void __launch_bounds__(NTHR, 2) hybrid_fwd(Args args) {
    extern __shared__ __attribute__((aligned(16))) unsigned char lds_raw[];
    Frame F0; F0.lds = (LAS unsigned char*)lds_raw; F0.tid = threadIdx.x; F0.lane = F0.tid & 63; F0.wave = __builtin_amdgcn_readfirstlane(F0.tid >> 6); F0.bid = blockIdx.x; F0.G = gridDim.x;
    unsigned char* ws0 = args.ws; In in0; in0.t = (CAS const gfptr_t*)__builtin_amdgcn_kernarg_segment_ptr();
    const int lo = args.ph_lo, hi = args.ph_hi;
    volatile LAS unsigned* MISC = (volatile LAS unsigned*)(F0.lds + MISC_OFF);
    if (F0.tid < 16) MISC[F0.tid] = 0u;
    __syncthreads();
    XcdBarrier bar; bar.bar = (unsigned*)(ws0 + WS_CTL) + CW_BAR; bar.x = 0; bar.st = nullptr;
    const bool multi = (hi - lo) > 1;
    if (multi) bar = xcd_barrier_post((unsigned*)(ws0 + WS_CTL) + CW_BAR, MISC + 8);
#ifndef SUBMASK
#define SUBMASK 7
#endif
#ifndef DUPSUB
#define DUPSUB 0
#endif
#ifndef DUPMASK
#define DUPMASK 0u
#endif
#define NREP(j) (((DUPMASK >> (j)) & 1u) ? 2 : 1)
#ifndef PHMASK
#define PHMASK 0xFFFFFFFFu
#endif
#define IN_PH(k) (lo <= (k) && (k) < hi)
#define ON(j) ((PHMASK >> (j)) & 1u)
#define LAYER_PTRS unsigned char* wt = ws + WS_WT + (size_t)l * WT_LAYER; float* Y = (float*)(ws + WS_Y); bf16_t* YB = (bf16_t*)(ws + WS_YB); float* PA = (float*)(ws + WS_PARTA); float* PB = (float*)(ws + WS_PARTB); const LAS float* rsT = (const LAS float*)(F.lds + RST_OFF); (void)wt; (void)Y; (void)YB; (void)PA; (void)PB; (void)rsT;
#define SEAM(k) do { if (IN_PH(k) && IN_PH((k) + 1)) xcd_barrier(bar); } while (0)

    if (ON(0) && IN_PH(0)) for (int rep = 0; rep < NREP(0); ++rep) { if (rep) xcd_barrier(bar); const In in = in_fresh(in0); const Frame F = fresh(F0); unsigned char* ws = fresh_ptr(ws0); p0_prologue(F, in, ws); }
    SEAM(0);

    for (int l = 0; l < NL; ++l) {
        const int pb = 1 + l * PH_PER_LAYER;
        if (ON(1) && IN_PH(pb + 0)) for (int rep = 0; rep < NREP(1); ++rep) { if (rep) xcd_barrier(bar); const In in = in_fresh(in0); const Frame F = fresh(F0); unsigned char* ws = fresh_ptr(ws0); LAYER_PTRS
            pg8::Gemm g{YB, (const bf16_t*)(wt + WT_IN), DM, DM, DM}; const pg8::OrderLin S{F.bid, F.G, ZG1_UNITS, 0, DM, DM};
            pg8::Unit u0; int pm0 = -1; if (S.next(0, u0)) pm0 = u0.pm;
            if (pm0 >= 0) rs_table(F, PA, pm0); else __syncthreads();
            pg8::EpiZ E{(float*)(ws + WS_ZS), (bf16_t*)(ws + WS_G), in[4] + (size_t)l * GCOLS, PA, rsT, pm0};
            pg8::gemm_phase<pg8::EpiZ, pg8::OrderLin, true>(F.lds, F.tid, g, S, E);
        }
        SEAM(pb + 0);
        if (ON(2) && IN_PH(pb + 1)) for (int rep = 0; rep < NREP(2); ++rep) { if (rep) xcd_barrier(bar); const In in = in_fresh(in0); const Frame F = fresh(F0); unsigned char* ws = fresh_ptr(ws0); LAYER_PTRS
            for (int it = F.bid; it < 896; it += F.G) {
                if (it < 128) { dsa_prep_item(F, ws, in[5] + l * 64, it); if (DUPSUB & 64) dsa_prep_item(F, ws, in[5] + l * 64, it); }
                else if (it < 384) { rwkv_prep_item(F, ws, in, l, it - 128); if (DUPSUB & 16) rwkv_prep_item(F, ws, in, l, it - 128); }
                else if (it < 896) { pool_item(F, ws, in, l, it - 384); if (DUPSUB & 32) pool_item(F, ws, in, l, it - 384); }
                else { ssm_pass1_item(F, ws, in, l, it - 896); if (DUPSUB & 128) ssm_pass1_item(F, ws, in, l, it - 896); }
            }
        }
        SEAM(pb + 1);
        if (ON(3) && IN_PH(pb + 2)) for (int rep = 0; rep < NREP(3); ++rep) { if (rep) xcd_barrier(bar); const In in = in_fresh(in0); const Frame F = fresh(F0); unsigned char* ws = fresh_ptr(ws0); LAYER_PTRS
            const bool split = F.G >= 128; const int nrw = split ? 32 : 0;
            if (SUBMASK & 1) { const Frame Fa = fresh(F0);
                if (split) { if (Fa.bid < 32) { rwkv_scan_item(Fa, ws, Fa.bid); if (DUPSUB & 1) rwkv_scan_item(Fa, ws, Fa.bid); } }
                else for (int it = Fa.bid; it < 32; it += Fa.G) rwkv_scan_item(Fa, ws, it); }
            if (F.bid >= nrw) {
                if (SUBMASK & 2) { const Frame Fb = fresh(F0); const int nb = Fb.G - nrw - 8, b0 = Fb.bid - nrw;
                    if (b0 < nb) for (int it = b0; it < 256; it += nb) { const int b = it & 3, qb = 63 - (it >> 2); dsa_item(Fb, ws, b * 64 + qb); if (DUPSUB & 2) dsa_item(Fb, ws, b * 64 + qb); } }
                if (SUBMASK & 4) { const Frame Fc = fresh(F0); const int nb = Fc.G - nrw, b0 = Fc.bid - nrw;
                    for (int it = b0 - (nb - 8); it >= 0 && it < 8; it += nb) { ssm_seq_item(Fc, fresh_ptr(ws0), in_fresh(in0), l, it); if (DUPSUB & 4) ssm_seq_item(Fc, fresh_ptr(ws0), in_fresh(in0), l, it); }
                    if (nb < 8) for (int it = b0; it < 8; it += nb) ssm_seq_item(Fc, fresh_ptr(ws0), in_fresh(in0), l, it);
                    __syncthreads(); }
                { const Frame Fd = fresh(F0); unsigned char* wsd = fresh_ptr(ws0); const In ind = in_fresh(in0);
                    unsigned char* wtd = wsd + WS_WT + (size_t)l * WT_LAYER; float* PAd = (float*)(wsd + WS_PARTA);
                    pg8::Gemm g{(const bf16_t*)(wsd + WS_YB), (const bf16_t*)(wtd + WT_IN), DM, DM, DM}; const bool tri = (Fd.G == 256 && nrw == 32);
                    const pg8::OrderLin SL{Fd.bid - nrw, Fd.G - nrw, ZG2_UNITS, 24, DM, DM}; const pg8::OrderTri ST{(Fd.bid - nrw) & 31, (Fd.bid - nrw) >> 5, 24, DM, DM};
                    pg8::Unit u0; int pm0 = -1; if (tri ? ST.next(0, u0) : SL.next(0, u0)) pm0 = u0.pm;
                    if (pm0 >= 0) rs_table(Fd, PAd, pm0); else __syncthreads();
                    pg8::EpiZ E{(float*)(wsd + WS_ZS), (bf16_t*)(wsd + WS_G), ind[4] + (size_t)l * GCOLS, PAd, (const LAS float*)(Fd.lds + RST_OFF), pm0};
                    if (tri) pg8::gemm_phase<pg8::EpiZ, pg8::OrderTri, true>(Fd.lds, Fd.tid, g, ST, E); }
            }
        }
        SEAM(pb + 2);
        if (ON(4) && IN_PH(pb + 3)) for (int rep = 0; rep < NREP(4); ++rep) { if (rep) xcd_barrier(bar); const In in = in_fresh(in0); const Frame F = fresh(F0); unsigned char* ws = fresh_ptr(ws0); LAYER_PTRS
            pg8::Gemm g{(const bf16_t*)(ws + WS_YSB), (const bf16_t*)(wt + WT_GLU), MIX, MIX, MIX}; pg8::Order S; S.init(MTOK / 256, MIX / 256, F.G, F.bid, MIX, MIX);
            pg8::EpiGlu E{(const bf16_t*)(ws + WS_YSB), in[28] + l * MIX, (bf16_t*)(ws + WS_MIX)};
            pg8::gemm_phase<pg8::EpiGlu, pg8::Order, true>(F.lds, F.tid, g, S, E);
            { const Frame Fp = fresh(F0); const int ng = (Fp.G > 64) ? 64 : 0;
              if (Fp.bid >= ng) rwkv_post_rows(Fp, fresh_ptr(ws0), in_fresh(in0), l, (Fp.bid - ng) * NWAVES + Fp.wave, (Fp.G - ng) * NWAVES); }
        }
        SEAM(pb + 3);
        if (ON(5) && IN_PH(pb + 4)) for (int rep = 0; rep < NREP(5); ++rep) { if (rep) xcd_barrier(bar); const In in = in_fresh(in0); const Frame F = fresh(F0); unsigned char* ws = fresh_ptr(ws0); LAYER_PTRS
            pg8::Gemm g{(const bf16_t*)(ws + WS_MIX), (const bf16_t*)(wt + WT_BR), 4 * MIX, MIX, MIX}; pg8::Order S; S.init(MTOK / 256, DM / 256, F.G, F.bid, 4 * MIX, MIX, 4, MIX, DM);
            pg8::EpiMerge E{(const bf16_t*)(ws + WS_G), (bf16_t*)(ws + WS_MF), (bf16_t*)(ws + WS_MERGED)};
            pg8::gemm_phase<pg8::EpiMerge, pg8::Order, true>(F.lds, F.tid, g, S, E);
        }
        SEAM(pb + 4);
        if (ON(6) && IN_PH(pb + 5)) for (int rep = 0; rep < NREP(6); ++rep) { if (rep) xcd_barrier(bar); const In in = in_fresh(in0); const Frame F = fresh(F0); unsigned char* ws = fresh_ptr(ws0); LAYER_PTRS
            pg8::Gemm g{(const bf16_t*)(ws + WS_MERGED), (const bf16_t*)(wt + WT_OUT), DM, DM, DM}; pg8::Order S; S.init(MTOK / 256, DM / 256, F.G, F.bid, DM, DM);
            pg8::EpiRes E{l == 0 ? in[0] : Y, Y, YB, PB};
            pg8::gemm_phase<pg8::EpiRes, pg8::Order, true>(F.lds, F.tid, g, S, E);
        }
        SEAM(pb + 5);
        if (ON(7) && IN_PH(pb + 6)) for (int rep = 0; rep < NREP(7); ++rep) { if (rep) xcd_barrier(bar); const In in = in_fresh(in0); const Frame F = fresh(F0); unsigned char* ws = fresh_ptr(ws0); LAYER_PTRS
            pg8::Gemm g{YB, (const bf16_t*)(wt + WT_UP), DM, DM, DM}; pg8::Order S; S.init(MTOK / 256, DFF2 / 256, F.G, F.bid, DM, DM);
            pg8::Unit u0; int pm0 = -1; if (S.next(0, u0)) pm0 = u0.pm;
            if (pm0 >= 0) rs_table(F, PB, pm0); else __syncthreads();
            pg8::EpiU E{(bf16_t*)(ws + WS_U), DFF2, PB, rsT, pm0};
            pg8::gemm_phase<pg8::EpiU, pg8::Order, true>(F.lds, F.tid, g, S, E);
        }
        SEAM(pb + 6);
        if (ON(8) && IN_PH(pb + 7)) for (int rep = 0; rep < NREP(8); ++rep) { if (rep) xcd_barrier(bar); const In in = in_fresh(in0); const Frame F = fresh(F0); unsigned char* ws = fresh_ptr(ws0); LAYER_PTRS conv_phase(F, ws, in, l); }
        SEAM(pb + 7);
        if (ON(9) && IN_PH(pb + 8)) for (int rep = 0; rep < NREP(9); ++rep) { if (rep) xcd_barrier(bar); const In in = in_fresh(in0); const Frame F = fresh(F0); unsigned char* ws = fresh_ptr(ws0); LAYER_PTRS
            pg8::Gemm g{(const bf16_t*)(ws + WS_ACT), (const bf16_t*)(wt + WT_DOWN), DFF, DFF, DFF}; pg8::Order S; S.init(MTOK / 256, DM / 256, F.G, F.bid, DFF, DFF);
            pg8::EpiRes E{Y, Y, YB, PA};
            pg8::gemm_phase<pg8::EpiRes, pg8::Order, true>(F.lds, F.tid, g, S, E);
        }
        SEAM(pb + 8);
    }
    if (ON(10) && IN_PH(N_PHASES - 1)) { const In in = in_fresh(in0); const Frame F = fresh(F0); unsigned char* ws = fresh_ptr(ws0); final_phase(F, ws, in[36], args.out); }
#ifdef DBG_STOP
    if (lo == 100) { const Frame F = fresh(F0); unsigned char* ws = fresh_ptr(ws0);
        for (size_t e = (size_t)F.bid * NTHR + F.tid; e < (size_t)MTOK * DM; e += (size_t)F.G * NTHR) {
            const int m = (int)(e / DM), c = (int)(e % DM); float v;
            if (DBG_BUF == 0) v = bf2f(((const bf16_t*)(ws + WS_MIX))[e]);
            else if (DBG_BUF == 1) v = ((const float*)(ws + WS_ZS))[(size_t)m * ZS_COLS + c];
            else if (DBG_BUF == 2) v = ((const float*)(ws + WS_ZS))[(size_t)m * ZS_COLS + 2048 + c];
            else if (DBG_BUF == 3) v = bf2f(((const bf16_t*)(ws + WS_G))[(size_t)m * GCOLS + c]);
            else if (DBG_BUF == 4) v = ((const float*)(ws + WS_Y))[e];
            else v = bf2f(((const bf16_t*)(ws + WS_MERGED))[e]);
            args.out[e] = v; } }
#endif
#undef IN_PH
#undef SEAM
}

extern "C" void kernel_launch(void* const* d_in, const int* in_sizes, int n_in, void* d_out, int out_size, void* d_ws, size_t ws_size, hipStream_t stream) {
    static int grid = 0;
    if (grid == 0) {
        if (n_in != 37 || out_size != MTOK * DM || ws_size < WS_END) { fprintf(stderr, "kernel_launch: unexpected problem (n_in %d, out %d, ws %zu < %zu)\n", n_in, out_size, ws_size, (size_t)WS_END); grid = -1; return; }
        int dev = 0, cus = 0, per_cu = 0;
        if (hipGetDevice(&dev) != hipSuccess || hipDeviceGetAttribute(&cus, hipDeviceAttributeMultiprocessorCount, dev) != hipSuccess) { grid = -1; return; }
        if (hipFuncSetAttribute((const void*)hybrid_fwd, hipFuncAttributeMaxDynamicSharedMemorySize, LDS_BYTES) != hipSuccess) { fprintf(stderr, "kernel_launch: hipFuncSetAttribute failed\n"); grid = -1; return; }
        if (hipOccupancyMaxActiveBlocksPerMultiprocessor(&per_cu, (const void*)hybrid_fwd, NTHR, LDS_BYTES) != hipSuccess || per_cu < 1) fprintf(stderr, "kernel_launch: occupancy query says %d\n", per_cu);
        (void)hipGetLastError();
        grid = cus >= 256 ? 256 : cus;
    }
    if (grid < 0) return;
    (void)hipMemsetAsync((char*)d_ws + WS_CTL, 0, CTL_ZERO_BYTES, stream);
    Args a{};
    for (int i = 0; i < 37; ++i) a.in.p[i] = (const float*)d_in[i];
    a.out = (float*)d_out; a.ws = (unsigned char*)d_ws;
#ifdef DBG_STOP
    for (int k = 0; k < DBG_STOP; ++k) { a.ph_lo = k; a.ph_hi = k + 1; hipLaunchKernelGGL(hybrid_fwd, dim3(grid), dim3(NTHR), LDS_BYTES, stream, a); }
    a.ph_lo = 100; a.ph_hi = 101; hipLaunchKernelGGL(hybrid_fwd, dim3(grid), dim3(NTHR), LDS_BYTES, stream, a);
#elif MK_N_LAUNCHES == 1
    a.ph_lo = 0; a.ph_hi = N_PHASES;
    hipLaunchKernelGGL(hybrid_fwd, dim3(grid), dim3(NTHR), LDS_BYTES, stream, a);
#else
    for (int k = 0; k < N_PHASES; ++k) { a.ph_lo = k; a.ph_hi = k + 1; hipLaunchKernelGGL(hybrid_fwd, dim3(grid), dim3(NTHR), LDS_BYTES, stream, a); }
#endif
}
```

```cpp
#include <hip/hip_runtime.h>
#include <cstdio>
#include <cstdint>

#ifndef MK_N_LAUNCHES
#define MK_N_LAUNCHES 1
#endif

#define LAS __attribute__((address_space(3)))
#define GAS __attribute__((address_space(1)))
typedef unsigned short bf16_t;
typedef short bf16x8 __attribute__((ext_vector_type(8)));
typedef short s16x4 __attribute__((ext_vector_type(4)));
typedef float f32x4 __attribute__((ext_vector_type(4)));
typedef float f32x2 __attribute__((ext_vector_type(2)));
typedef float f32x16 __attribute__((ext_vector_type(16)));
typedef unsigned u32x4 __attribute__((ext_vector_type(4)));
typedef unsigned u32x2 __attribute__((ext_vector_type(2)));
#define DI __device__ __forceinline__

constexpr int NB = 4, SEQ = 2048, DM = 2048, MTOK = NB * SEQ, NL = 4, MIX = 512, DFF = 5504, DFF2 = 2 * DFF;
constexpr int IN_COLS = 13060, NZ = 13312, ZS_COLS = 5120, GCOLS = 8192;
constexpr int B_COLS = 1984;
constexpr int ZO_R = 0, ZO_K = 512, ZO_V = 1024, ZO_LW = 1536, ZO_LA = 1632, ZO_LG = 1728;
constexpr int ZO_Q = 2048, ZO_AK = 2560, ZO_AV = 3072, ZO_QI = 3584, ZO_KI = 3840, ZO_WI = 3904, ZO_C = 4096, ZO_D = 4608;
constexpr float RMS_EPS = 1e-6f, GN_EPS = 64e-5f;

constexpr size_t MiB = 1u << 20;
constexpr size_t WS_CTL = 0, CTL_ZERO_BYTES = 1 * MiB;
constexpr size_t WS_ROPE = 1 * MiB;
constexpr size_t WS_PARTA = 2 * MiB;
constexpr size_t WS_PARTB = 3 * MiB;
constexpr size_t WS_SSTATE = 4 * MiB;
constexpr size_t WS_WI = 5 * MiB;
constexpr size_t WS_RS = 5 * MiB + 256 * 1024;
constexpr size_t WS_KI = 6 * MiB;
constexpr size_t WS_MASK = 7 * MiB;
constexpr size_t WS_QI = 9 * MiB;
constexpr size_t WS_Q = 13 * MiB;
constexpr size_t WS_K = 21 * MiB;
constexpr size_t WS_VT = 29 * MiB;
constexpr size_t WS_Y = 37 * MiB;
constexpr size_t WS_YB = 101 * MiB;
constexpr size_t WS_MIX = 133 * MiB;
constexpr size_t WS_MERGED = 165 * MiB;
constexpr size_t WS_YS = 197 * MiB;
constexpr size_t WS_YSB = 213 * MiB;
constexpr size_t WS_RW = 221 * MiB;
constexpr size_t RW_STRIDE = 16 * MiB;
constexpr size_t WS_SC = 333 * MiB;
constexpr size_t WS_MF = 1368 * MiB;
constexpr size_t WS_ZS = 461 * MiB;
constexpr size_t WS_G = 621 * MiB;
constexpr size_t WS_U = 461 * MiB;
constexpr size_t WS_ACT = 749 * MiB;
constexpr size_t WS_WT = 836 * MiB;
constexpr size_t WT_IN = 0, WT_BR = 52 * MiB, WT_OUT = 60 * MiB, WT_UP = 68 * MiB, WT_DOWN = 111 * MiB, WT_GLU = 111 * MiB + 22544384, WT_LAYER = 133 * MiB;
constexpr size_t WS_YRAW = WS_MF + 192 * MiB;
constexpr size_t WS_WTL = WS_YRAW + 16 * MiB;
constexpr size_t WS_WTP = WS_WTL + 2 * MiB;
constexpr size_t WS_END = WS_WTP + 1 * MiB;
static_assert(WS_WT + 4 * WT_LAYER == WS_MF, "ws map");
static_assert(WT_GLU + 524288 <= WT_LAYER, "wt map");
static_assert(WS_U + (size_t)MTOK * DFF2 * 2 <= WS_ACT && WS_ACT + (size_t)MTOK * DFF * 2 <= WS_WT, "ws map");

constexpr int CW_BAR = 4096;
constexpr int CW_CONV = 12288;
constexpr int CW_QUEUE = 8192;

constexpr int RING_BYTES = 131072;
constexpr int MISC_OFF = RING_BYTES;
constexpr int RST_OFF = RING_BYTES + 1024;
constexpr int LDS_BYTES = 147456;
constexpr int NWAVES = 8, NTHR = 512;

DI unsigned f2bf(float f) { unsigned u = __builtin_bit_cast(unsigned, f); return (u + 0x7fffu + ((u >> 16) & 1u)) >> 16; }
DI unsigned cvt_pk_bf16(float lo, float hi);
DI unsigned pk2(float lo, float hi) { return cvt_pk_bf16(lo, hi); }
DI float bf2f(unsigned b) { return __builtin_bit_cast(float, b << 16); }
typedef __bf16 bf16x2v __attribute__((ext_vector_type(2)));
DI unsigned cvt_pk_bf16(float lo, float hi) { const f32x2 v = {lo, hi}; const bf16x2v b = __builtin_convertvector(v, bf16x2v); return __builtin_bit_cast(unsigned, b); }
DI float wave_sum(float v) {
#pragma unroll
    for (int o = 1; o < 64; o <<= 1) v += __shfl_xor(v, o);
    return v;
}
template <int CTRL> DI float dpp_xadd(float x) { const int r = __builtin_amdgcn_update_dpp(0, __builtin_bit_cast(int, x), CTRL, 0xF, 0xF, true); return x + __builtin_bit_cast(float, r); }
DI float row16_sum(float x) { x = dpp_xadd<0xB1>(x); x = dpp_xadd<0x4E>(x); x = dpp_xadd<0x141>(x); x = dpp_xadd<0x140>(x); return x; }
DI bf16x8 pack8(float a0, float a1, float a2, float a3, float a4, float a5, float a6, float a7) {
    u32x4 p; p.x = pk2(a0, a1); p.y = pk2(a2, a3); p.z = pk2(a4, a5); p.w = pk2(a6, a7); return __builtin_bit_cast(bf16x8, p); }
DI f32x4 ld4bf(const bf16_t* p) { const u32x2 w = *(const u32x2*)p; return (f32x4){bf2f(w.x & 0xffffu), bf2f(w.x >> 16), bf2f(w.y & 0xffffu), bf2f(w.y >> 16)}; }
DI float sigmoidf_(float x) { return __builtin_amdgcn_rcpf(1.0f + __expf(-x)); }
#define LDS_WAIT() asm volatile("s_waitcnt lgkmcnt(0)" ::: "memory")
#define VM_WAIT() asm volatile("s_waitcnt vmcnt(0)" ::: "memory")
#define MFMA32(a, b, c) __builtin_amdgcn_mfma_f32_32x32x16_bf16((a), (b), (c), 0, 0, 0)

#define XB_TMO      128
#define XB_XCNT(j)  (256  + 64 * (j))
#define XB_XSUB(j)  (1280 + 64 * (j))
#define XB_XGEN(j)  (2304 + 64 * (j))
#define XB_TOP      3328
#define XB_TOPGEN   3392
#define XCD_BAR_WORDS 3456
#define XB_SPIN_CAP (1u << 21)
DI unsigned xb_ld(unsigned* p)              { return __hip_atomic_load(p, __ATOMIC_RELAXED, __HIP_MEMORY_SCOPE_AGENT); }
DI unsigned xb_add(unsigned* p, unsigned v) { return __hip_atomic_fetch_add(p, v, __ATOMIC_RELAXED, __HIP_MEMORY_SCOPE_AGENT); }
DI unsigned xb_xcc_id() { return (unsigned)__builtin_amdgcn_s_getreg((3 << 11) | 20) & 0xFu; }
#define XB_SPIN(cond, bar) do { unsigned _sp = 0; while (cond) { __builtin_amdgcn_s_sleep(1); \
    if ((++_sp & 255u) == 0u) { if (xb_ld(&(bar)[XB_TMO])) break; if (_sp > XB_SPIN_CAP) { atomicAdd(&(bar)[XB_TMO], 1u); break; } } } } while (0)
struct XcdBarrier { unsigned* bar; unsigned x; volatile LAS unsigned* st; };
DI XcdBarrier xcd_barrier_post(unsigned* bar, volatile LAS unsigned* st) {
    XcdBarrier b; b.bar = bar; b.x = xb_xcc_id(); b.st = st;
    if (threadIdx.x == 0) (void)xb_add(&bar[XB_XCNT(b.x)], 1u);
    return b;
}
DI void xcd_barrier_complete(unsigned* bar, unsigned x, unsigned& nloc, unsigned& nx) {
    const unsigned G = gridDim.x * gridDim.y * gridDim.z;
    unsigned sum, cnt, mine, sp = 0u;
    for (;;) {
        sum = 0u; cnt = 0u; mine = 0u;
#pragma unroll
        for (unsigned j = 0; j < 16; ++j) { const unsigned c = xb_ld(&bar[XB_XCNT(j)]); sum += c; cnt += (c > 0u) ? 1u : 0u; mine = (j == x) ? c : mine; }
        if (sum == G) break;
        __builtin_amdgcn_s_sleep(1);
        if ((++sp & 255u) == 0u) { if (xb_ld(&bar[XB_TMO])) break; if (sp > XB_SPIN_CAP) { atomicAdd(&bar[XB_TMO], 1u); break; } }
    }
    nloc = mine > 0u ? mine : 1u; nx = cnt > 0u ? cnt : 1u;
}
DI void xcd_barrier(const XcdBarrier& b) {
    asm volatile("s_waitcnt vmcnt(0)" ::: "memory");
    __syncthreads();
    if (threadIdx.x == 0) {
        unsigned* bar = b.bar;
        __builtin_amdgcn_s_waitcnt(0);
        unsigned nloc = b.st[0], nx = b.st[1];
        if (nloc == 0u) { xcd_barrier_complete(bar, b.x, nloc, nx); b.st[0] = nloc; b.st[1] = nx; }
        const unsigned old = xb_add(&bar[XB_XSUB(b.x)], 1u);
        const unsigned gen = old / nloc;
        if (old + 1u == (gen + 1u) * nloc) {
            __builtin_amdgcn_fence(__ATOMIC_RELEASE, "agent");
            asm volatile("s_waitcnt vmcnt(0)" ::: "memory");
            const unsigned og = xb_add(&bar[XB_TOP], 1u);
            const unsigned tg = og / nx;
            if (og + 1u == (tg + 1u) * nx) xb_add(&bar[XB_TOPGEN], 1u);
            else XB_SPIN(xb_ld(&bar[XB_TOPGEN]) == tg, bar);
            __builtin_amdgcn_fence(__ATOMIC_ACQUIRE, "agent");
            xb_add(&bar[XB_XGEN(b.x)], 1u);
            asm volatile("s_waitcnt vmcnt(0)" ::: "memory");
        } else {
            XB_SPIN(xb_ld(&bar[XB_XGEN(b.x)]) == gen, bar);
            __builtin_amdgcn_fence(__ATOMIC_ACQUIRE, "agent");
            asm volatile("s_waitcnt vmcnt(0)" ::: "memory");
        }
    }
    __syncthreads();
}

namespace pg8 {
constexpr int BM = 256, BK = 64, HALF = 128, HTB = HALF * BK * 2, STAGE_BYTES = 8 * HTB, NXCD = 8, WGM = 8;
DI int lds_byte(int r, int c) { const int st = (r >> 4) * 2 + (c >> 5), rr = r & 15, cc = c & 31, ob = rr * 64 + cc * 2; return st * 1024 + (ob ^ (((ob >> 9) & 1) << 5)); }
DI void stage_rc(int b, int& R, int& C) { const int st = b / 1024, sb = b % 1024, swz = sb ^ (((sb >> 9) & 1) << 5); R = (st >> 1) * 16 + swz / 64; C = (st & 1) * 32 + (swz % 64) / 2; }
DI int perm32(int rho) { const int n = rho >> 4, i = rho & 15; return 8 * (i >> 2) + 4 * n + (i & 3); }

struct Unit { int pm, pn, sub; long offA, offB; };
struct Gemm { const bf16_t* A; const bf16_t* Bt; int lda, ldb, K; };

struct Order {
    int nM, nN, nwg, G, c, lda, ldb, nsub, subA, subB;
    DI void init(int nM_, int nN_, int G_, int c_, int lda_, int ldb_, int nsub_ = 1, int subA_ = 0, int subB_ = 0) { nM = nM_; nN = nN_; nwg = nM * nN; G = G_; c = c_; lda = lda_; ldb = ldb_; nsub = nsub_; subA = subA_; subB = subB_; }
    DI bool next(int i, Unit& u) const {
        const int ti = i / nsub, sub = i - ti * nsub;
        const long L = (long)ti * G + c; if (L >= nwg) return false;
        int wgid = (int)L; { const int q = nwg / NXCD, r = nwg % NXCD, xcd = wgid % NXCD, off = wgid / NXCD; wgid = (xcd < r ? xcd * (q + 1) : r * (q + 1) + (xcd - r) * q) + off; }
        const int nig = WGM * nN, gid = wgid / nig, fm = gid * WGM, gsz = (nM - fm) < WGM ? (nM - fm) : WGM;
        u.pm = fm + ((wgid % nig) % gsz); u.pn = (wgid % nig) / gsz; u.sub = sub;
        u.offA = ((long)u.pm * BM * lda + (long)sub * subA) * 2; u.offB = ((long)u.pn * BM + (long)sub * subB) * (long)ldb * 2;
        return true;
    }
};

struct OrderLin {
    int c, G, nu, pnbase, lda, ldb;
    DI bool next(int i, Unit& u) const { const int v = c + i * G; if (v >= nu) return false; u.pm = v & 31; u.pn = pnbase + (v >> 5); u.sub = 0;
        u.offA = (long)u.pm * BM * lda * 2; u.offB = (long)u.pn * BM * (long)ldb * 2; return true; }
};
struct OrderTri {
    int pm, k, pnbase, lda, ldb;
    DI bool next(int i, Unit& u) const { int cnt, st;
        if (pm < 24) { cnt = k + 1; st = (k * (k + 1)) / 2; }
        else { cnt = k == 0 ? 3 : (k < 6 ? k + 2 : 0); st = k == 0 ? 0 : (k < 6 ? 3 + ((k - 1) * (k + 4)) / 2 : 28); }
        if (i >= cnt) return false; u.pm = pm; u.pn = pnbase + st + i; u.sub = 0;
        u.offA = (long)u.pm * BM * lda * 2; u.offB = (long)u.pn * BM * (long)ldb * 2; return true; }
};
struct OrderQueue {
    unsigned* head; volatile LAS unsigned* slot; int tid, nu, pnbase, lda, ldb, xg;
    DI void setup() const { if (tid == 0) { slot[0] = __hip_atomic_fetch_add(head, 1u, __ATOMIC_RELAXED, __HIP_MEMORY_SCOPE_AGENT); } asm volatile("s_waitcnt lgkmcnt(0)" ::: "memory"); __syncthreads(); }
    DI bool next(int i, Unit& u) const {
        const unsigned v = slot[i & 1];
        if (tid == 0) { slot[(i + 1) & 1] = __hip_atomic_fetch_add(head, 1u, __ATOMIC_RELAXED, __HIP_MEMORY_SCOPE_AGENT); }
        asm volatile("s_waitcnt lgkmcnt(0)" ::: "memory");
        if (v >= (unsigned)nu) return false;
        u.pm = xg + 8 * (int)(v & 3u); u.pn = pnbase + (int)(v >> 2); u.sub = 0;
        u.offA = (long)u.pm * BM * lda * 2; u.offB = (long)u.pn * BM * (long)ldb * 2; return true; }
};
template <class Epi, class Sched, bool ALIGN_EPI>
DI void gemm_phase(LAS unsigned char* lds, const int tid, const Gemm g, const Sched& S, const Epi& E) {
    const int wid = __builtin_amdgcn_readfirstlane(tid >> 6), lane = tid & 63, wr = wid >> 2, wc = wid & 3, fr = lane & 15, fq = lane >> 4;
    const int K = g.K, nt = K / BK;
    unsigned voffA[2], voffB[2];
#pragma unroll
    for (int i = 0; i < 2; ++i) { int R, C; stage_rc(tid * 16 + i * 8192, R, C); const int Rb = Epi::PERM ? ((R & ~31) + perm32(R & 31)) : R;
        voffA[i] = (unsigned)(R * g.lda + C) * 2u; voffB[i] = (unsigned)(Rb * g.ldb + C) * 2u; }
    const size_t kstep = (size_t)(BK * 2);
    const size_t hstepA = (size_t)HALF * g.lda * 2, hstepB = (size_t)HALF * g.ldb * 2;
    const unsigned ldsw = (unsigned)wid * 1024u;
    const int aoff = lds_byte(wr * 64 + fr, fq * 8), boff = lds_byte(wc * 32 + fr, fq * 8);
#define PG8_SA(b, h) (((b) * 2 + (h)) * HTB)
#define PG8_SB(b, h) ((4 + (b) * 2 + (h)) * HTB)
#define PG8_STAGE(bufoff, gbase, voff) do { _Pragma("unroll") for (int _i = 0; _i < 2; ++_i) \
        __builtin_amdgcn_global_load_lds((const unsigned*)((const char*)(gbase) + (voff)[_i]), (LAS unsigned*)(lds + (bufoff) + ldsw + _i * 8192), 16, 0, 0); } while (0)
#define PG8_LDA(dst, b, h) do { _Pragma("unroll") for (int m = 0; m < 4; ++m) _Pragma("unroll") for (int k = 0; k < 2; ++k) dst[m][k] = *(const LAS bf16x8*)(lds + PG8_SA(b, h) + aoff + m * 2048 + k * 1024); } while (0)
#define PG8_LDB(dst, b, h) do { _Pragma("unroll") for (int n = 0; n < 2; ++n) _Pragma("unroll") for (int k = 0; k < 2; ++k) dst[n][k] = *(const LAS bf16x8*)(lds + PG8_SB(b, h) + boff + n * 2048 + k * 1024); } while (0)
#define PG8_MMA(ai, bj, At, Bt) do { __builtin_amdgcn_s_setprio(1); _Pragma("unroll") for (int m = 0; m < 4; ++m) _Pragma("unroll") for (int n = 0; n < 2; ++n) _Pragma("unroll") for (int k = 0; k < 2; ++k) \
        acc[ai][bj][m][n] = __builtin_amdgcn_mfma_f32_16x16x32_bf16(Bt[n][k], At[m][k], acc[ai][bj][m][n], 0, 0, 0); __builtin_amdgcn_s_setprio(0); } while (0)
#define PG8_WAIT_V(n) asm volatile("s_waitcnt vmcnt(" #n ")" ::: "memory")
#define PG8_WAIT_L(n) asm volatile("s_waitcnt lgkmcnt(" #n ")" ::: "memory")
#define PG8_BAR __builtin_amdgcn_s_barrier()
#define PG8_SCHED __builtin_amdgcn_sched_barrier(0)
    Unit cur, nxt; int ui = 0;
    if (!S.next(0, cur)) return;
    f32x4 acc[2][2][4][2];
#pragma unroll
    for (int a = 0; a < 2; ++a)
#pragma unroll
        for (int b = 0; b < 2; ++b)
#pragma unroll
            for (int m = 0; m < 4; ++m)
#pragma unroll
                for (int n = 0; n < 2; ++n) acc[a][b][m][n] = (f32x4){0.f, 0.f, 0.f, 0.f};
    bf16x8 At[4][2], B0[2][2], B1[2][2];
    const char* cA = (const char*)g.A + cur.offA; const char* cB = (const char*)g.Bt + cur.offB;
    PG8_STAGE(PG8_SB(0, 0), cB, voffB); PG8_STAGE(PG8_SB(0, 1), cB + hstepB, voffB); PG8_STAGE(PG8_SA(0, 0), cA, voffA); PG8_STAGE(PG8_SA(0, 1), cA + hstepA, voffA);
    if (wr == 1) PG8_BAR;
    PG8_WAIT_V(2); PG8_BAR;
    PG8_STAGE(PG8_SB(1, 0), cB + kstep, voffB); PG8_STAGE(PG8_SA(1, 0), cA + kstep, voffA); PG8_STAGE(PG8_SB(1, 1), cB + hstepB + kstep, voffB);
    PG8_WAIT_V(6); PG8_BAR;
    for (;;) {
        const bool has_next = S.next(ui + 1, nxt);
        const char* nA = has_next ? (const char*)g.A + nxt.offA : cA; const char* nB = has_next ? (const char*)g.Bt + nxt.offB : cB;
        for (int t = 0; t < nt; t += 2) {
            const bool last = (t == nt - 2);
            const char* a1 = cA + (size_t)(t + 1) * kstep;
            const char* a2 = last ? nA : cA + (size_t)(t + 2) * kstep; const char* b2 = last ? nB : cB + (size_t)(t + 2) * kstep;
            const char* a3 = a2 + kstep; const char* b3 = b2 + kstep;
            PG8_LDB(B0, 0, 0); PG8_LDB(B1, 0, 1); PG8_SCHED; PG8_LDA(At, 0, 0); PG8_STAGE(PG8_SA(1, 1), a1 + hstepA, voffA);
            PG8_WAIT_V(8); PG8_WAIT_L(0); PG8_BAR; PG8_MMA(0, 0, At, B0); PG8_MMA(0, 1, At, B1); PG8_BAR; PG8_SCHED;
            PG8_LDA(At, 0, 1); PG8_STAGE(PG8_SB(0, 0), b2, voffB); PG8_STAGE(PG8_SB(0, 1), b2 + hstepB, voffB); PG8_STAGE(PG8_SA(0, 0), a2, voffA);
            PG8_WAIT_V(8); PG8_WAIT_L(0); PG8_BAR; PG8_MMA(1, 0, At, B0); PG8_MMA(1, 1, At, B1); PG8_BAR; PG8_SCHED;
            PG8_LDB(B0, 1, 0); PG8_LDB(B1, 1, 1); PG8_SCHED; PG8_LDA(At, 1, 0); PG8_STAGE(PG8_SA(0, 1), a2 + hstepA, voffA);
            PG8_WAIT_V(8); PG8_WAIT_L(0); PG8_BAR; PG8_MMA(0, 0, At, B0); PG8_MMA(0, 1, At, B1); PG8_BAR; PG8_SCHED;
            PG8_LDA(At, 1, 1); PG8_STAGE(PG8_SB(1, 0), b3, voffB); PG8_STAGE(PG8_SB(1, 1), b3 + hstepB, voffB); PG8_STAGE(PG8_SA(1, 0), a3, voffA);
            PG8_WAIT_V(8); PG8_WAIT_L(0); PG8_BAR; PG8_MMA(1, 0, At, B0); PG8_MMA(1, 1, At, B1); PG8_BAR; PG8_SCHED;
        }
        if constexpr (ALIGN_EPI) { if (wr == 0) PG8_BAR; }
        E(acc, cur, wr, wc, fr, fq);
        if (!has_next) break;
#pragma unroll
        for (int a = 0; a < 2; ++a)
#pragma unroll
            for (int b = 0; b < 2; ++b)
#pragma unroll
                for (int m = 0; m < 4; ++m)
#pragma unroll
                    for (int n = 0; n < 2; ++n) acc[a][b][m][n] = (f32x4){0.f, 0.f, 0.f, 0.f};
        cur = nxt; cA = nA; cB = nB; ++ui;
        if constexpr (ALIGN_EPI) { if (wr == 1) PG8_BAR; }
    }
    PG8_WAIT_V(0);
    if constexpr (!ALIGN_EPI) { if (wr == 0) PG8_BAR; }
    PG8_BAR;
#undef PG8_SA
#undef PG8_SB
#undef PG8_STAGE
#undef PG8_LDA
#undef PG8_LDB
#undef PG8_MMA
#undef PG8_WAIT_V
#undef PG8_WAIT_L
#undef PG8_BAR
#undef PG8_SCHED
}

typedef const f32x4 (&AccRef)[2][2][4][2];
DI float row_scale_slow(const float* part, int row) { float s = 0.f; for (int i = 0; i < 32; ++i) s += part[(size_t)row * 32 + i]; return 1.0f / sqrtf(s * (1.0f / DM) + RMS_EPS); }

#define EPI_SB() __builtin_amdgcn_sched_barrier(0)
DI void epi_z_store(AccRef acc, const Unit& u, int wr, int wc, int fr, int fq, bf16_t* ZS, bf16_t* G, const f32x4 (&bb)[2][2], const float (&sv)[2][4]) {
#pragma unroll
    for (int ai = 0; ai < 2; ++ai)
#pragma unroll
        for (int m = 0; m < 4; ++m) {
            const int row = u.pm * BM + ai * HALF + wr * 64 + m * 16 + fr; const float s = sv[ai][m];
#pragma unroll
            for (int bj = 0; bj < 2; ++bj) {
                const int col0 = u.pn * BM + bj * HALF + wc * 32 + 8 * fq;
                f32x4 v0 = acc[ai][bj][m][0] * s, v1 = acc[ai][bj][m][1] * s;
                if (u.pn < 20) { u32x4 w; w.x = cvt_pk_bf16(v0[0], v0[1]); w.y = cvt_pk_bf16(v0[2], v0[3]); w.z = cvt_pk_bf16(v1[0], v1[1]); w.w = cvt_pk_bf16(v1[2], v1[3]); *(u32x4*)(ZS + (size_t)row * ZS_COLS + col0) = w; }
                else { const int gc = col0 - ZS_COLS;
                    v0 += bb[bj][0]; v1 += bb[bj][1];
                    u32x4 w; w.x = cvt_pk_bf16(sigmoidf_(v0[0]), sigmoidf_(v0[1])); w.y = cvt_pk_bf16(sigmoidf_(v0[2]), sigmoidf_(v0[3]));
                    w.z = cvt_pk_bf16(sigmoidf_(v1[0]), sigmoidf_(v1[1])); w.w = cvt_pk_bf16(sigmoidf_(v1[2]), sigmoidf_(v1[3]));
                    *(u32x4*)(G + (size_t)row * GCOLS + gc) = w; }
            }
        }
}
DI void epi_z_bias(f32x4 (&bb)[2][2], const float* bgate, const Unit& u, int wc, int fq) {
#pragma unroll
    for (int bj = 0; bj < 2; ++bj) { bb[bj][0] = (f32x4){0.f, 0.f, 0.f, 0.f}; bb[bj][1] = bb[bj][0]; }
    if (u.pn >= 20) {
#pragma unroll
        for (int bj = 0; bj < 2; ++bj) { const int gc = u.pn * BM + bj * HALF + wc * 32 + 8 * fq - ZS_COLS; bb[bj][0] = *(const f32x4*)(bgate + gc); bb[bj][1] = *(const f32x4*)(bgate + gc + 4); } }
}
struct EpiZ {
    static constexpr bool PERM = true;
    bf16_t* ZS; bf16_t* G; const float* bgate; const float* part; const LAS float* rsT; int pm0;
    DI void operator()(AccRef acc, const Unit& u, int wr, int wc, int fr, int fq) const {
        f32x4 bb[2][2]; float sv[2][4];
        epi_z_bias(bb, bgate, u, wc, fq);
#pragma unroll
        for (int ai = 0; ai < 2; ++ai)
#pragma unroll
            for (int m = 0; m < 4; ++m) { const int lr = ai * HALF + wr * 64 + m * 16 + fr; sv[ai][m] = (u.pm == pm0) ? rsT[lr] : row_scale_slow(part, u.pm * BM + lr); }
        EPI_SB();
        epi_z_store(acc, u, wr, wc, fr, fq, ZS, G, bb, sv);
    }
};
struct EpiZq {
    static constexpr bool PERM = true;
    bf16_t* ZS; bf16_t* G; const float* bgate; const float* rsg;
    DI void operator()(AccRef acc, const Unit& u, int wr, int wc, int fr, int fq) const {
        f32x4 bb[2][2]; float sv[2][4];
        epi_z_bias(bb, bgate, u, wc, fq);
#pragma unroll
        for (int ai = 0; ai < 2; ++ai)
#pragma unroll
            for (int m = 0; m < 4; ++m) sv[ai][m] = rsg[u.pm * BM + ai * HALF + wr * 64 + m * 16 + fr];
        EPI_SB();
        epi_z_store(acc, u, wr, wc, fr, fq, ZS, G, bb, sv);
    }
};
struct EpiU {
    static constexpr bool PERM = true;
    bf16_t* U; int ldc; const float* part; const LAS float* rsT; int pm0;
    DI void operator()(AccRef acc, const Unit& u, int wr, int wc, int fr, int fq) const {
#pragma unroll
        for (int ai = 0; ai < 2; ++ai)
#pragma unroll
            for (int m = 0; m < 4; ++m) {
                const int lr = ai * HALF + wr * 64 + m * 16 + fr, row = u.pm * BM + lr;
                const float s = (u.pm == pm0) ? rsT[lr] : row_scale_slow(part, row);
#pragma unroll
                for (int bj = 0; bj < 2; ++bj) {
                    const int col0 = u.pn * BM + bj * HALF + wc * 32 + 8 * fq;
                    const f32x4 v0 = acc[ai][bj][m][0] * s, v1 = acc[ai][bj][m][1] * s;
                    u32x4 w; w.x = cvt_pk_bf16(v0[0], v0[1]); w.y = cvt_pk_bf16(v0[2], v0[3]); w.z = cvt_pk_bf16(v1[0], v1[1]); w.w = cvt_pk_bf16(v1[2], v1[3]);
                    *(u32x4*)(U + (size_t)row * ldc + col0) = w;
                }
            }
    }
};
struct EpiRes {
    static constexpr bool PERM = false;
    const float* Yin; float* Y; bf16_t* YB; float* part;
    DI void operator()(AccRef acc, const Unit& u, int wr, int wc, int fr, int fq) const {
#pragma unroll
        for (int ai = 0; ai < 2; ++ai)
#pragma unroll
            for (int mp = 0; mp < 2; ++mp) {
                f32x4 yin[2][2][2];
#pragma unroll
                for (int mm = 0; mm < 2; ++mm) { const int row = u.pm * BM + ai * HALF + wr * 64 + (2 * mp + mm) * 16 + fr;
#pragma unroll
                    for (int bj = 0; bj < 2; ++bj)
#pragma unroll
                        for (int n = 0; n < 2; ++n) yin[mm][bj][n] = *(const f32x4*)(Yin + (size_t)row * DM + u.pn * BM + bj * HALF + wc * 32 + 16 * n + 4 * fq); }
                EPI_SB();
#pragma unroll
                for (int mm = 0; mm < 2; ++mm) { const int m = 2 * mp + mm; const int row = u.pm * BM + ai * HALF + wr * 64 + m * 16 + fr;
                    float ss = 0.f;
#pragma unroll
                    for (int bj = 0; bj < 2; ++bj)
#pragma unroll
                        for (int n = 0; n < 2; ++n) {
                            const int col = u.pn * BM + bj * HALF + wc * 32 + 16 * n + 4 * fq;
                            const size_t o = (size_t)row * DM + col;
                            const f32x4 y = yin[mm][bj][n] + acc[ai][bj][m][n];
                            *(f32x4*)(Y + o) = y;
                            u32x2 w; w.x = cvt_pk_bf16(y[0], y[1]); w.y = cvt_pk_bf16(y[2], y[3]);
                            *(u32x2*)(YB + o) = w;
                            ss += (y[0] * y[0] + y[1] * y[1]) + (y[2] * y[2] + y[3] * y[3]);
                        }
                    ss += __shfl_xor(ss, 16); ss += __shfl_xor(ss, 32);
                    if (fq == 0) part[(size_t)row * 32 + u.pn * 4 + wc] = ss; }
                EPI_SB();
            }
    }
};
struct EpiGlu {
    static constexpr bool PERM = true;
    const bf16_t* YB16; const float* bias; bf16_t* MIXp;
    DI void operator()(AccRef acc, const Unit& u, int wr, int wc, int fr, int fq) const {
        f32x4 bb[2][2];
#pragma unroll
        for (int bj = 0; bj < 2; ++bj) { const int col0 = u.pn * BM + bj * HALF + wc * 32 + 8 * fq; bb[bj][0] = *(const f32x4*)(bias + col0); bb[bj][1] = *(const f32x4*)(bias + col0 + 4); }
#pragma unroll
        for (int ai = 0; ai < 2; ++ai) {
            u32x4 yw[4][2];
#pragma unroll
            for (int m = 0; m < 4; ++m)
#pragma unroll
                for (int bj = 0; bj < 2; ++bj) yw[m][bj] = *(const u32x4*)(YB16 + (size_t)(u.pm * BM + ai * HALF + wr * 64 + m * 16 + fr) * MIX + u.pn * BM + bj * HALF + wc * 32 + 8 * fq);
            EPI_SB();
#pragma unroll
            for (int m = 0; m < 4; ++m) {
                const int row = u.pm * BM + ai * HALF + wr * 64 + m * 16 + fr;
#pragma unroll
                for (int bj = 0; bj < 2; ++bj) {
                    const int col0 = u.pn * BM + bj * HALF + wc * 32 + 8 * fq;
                    const u32x4 t = yw[m][bj];
                    const f32x4 y0 = (f32x4){bf2f(t.x & 0xffffu), bf2f(t.x >> 16), bf2f(t.y & 0xffffu), bf2f(t.y >> 16)}, y1 = (f32x4){bf2f(t.z & 0xffffu), bf2f(t.z >> 16), bf2f(t.w & 0xffffu), bf2f(t.w >> 16)};
                    const f32x4 v0 = acc[ai][bj][m][0] + bb[bj][0], v1 = acc[ai][bj][m][1] + bb[bj][1];
                    u32x4 w; w.x = cvt_pk_bf16(y0[0] * sigmoidf_(v0[0]), y0[1] * sigmoidf_(v0[1])); w.y = cvt_pk_bf16(y0[2] * sigmoidf_(v0[2]), y0[3] * sigmoidf_(v0[3]));
                    w.z = cvt_pk_bf16(y1[0] * sigmoidf_(v1[0]), y1[1] * sigmoidf_(v1[1])); w.w = cvt_pk_bf16(y1[2] * sigmoidf_(v1[2]), y1[3] * sigmoidf_(v1[3]));
                    *(u32x4*)(MIXp + (size_t)row * (4 * MIX) + 3 * MIX + col0) = w;
                }
            }
            EPI_SB();
        }
    }
};
struct EpiMerge {
    static constexpr bool PERM = true;
    const bf16_t* G; bf16_t* MFh; bf16_t* MERGED;
    DI void operator()(AccRef acc, const Unit& u, int wr, int wc, int fr, int fq) const {
        constexpr size_t SL = (size_t)MTOK * DM;
        if (u.sub < 3) {
#pragma unroll
            for (int ai = 0; ai < 2; ++ai) {
                u32x4 gw[4][2];
#pragma unroll
                for (int m = 0; m < 4; ++m)
#pragma unroll
                    for (int bj = 0; bj < 2; ++bj) gw[m][bj] = *(const u32x4*)(G + (size_t)(u.pm * BM + ai * HALF + wr * 64 + m * 16 + fr) * GCOLS + u.sub * DM + u.pn * BM + bj * HALF + wc * 32 + 8 * fq);
                EPI_SB();
#pragma unroll
                for (int m = 0; m < 4; ++m) { const int row = u.pm * BM + ai * HALF + wr * 64 + m * 16 + fr;
#pragma unroll
                    for (int bj = 0; bj < 2; ++bj) { const int col0 = u.pn * BM + bj * HALF + wc * 32 + 8 * fq; const u32x4 g = gw[m][bj];
                        f32x4 v0 = acc[ai][bj][m][0], v1 = acc[ai][bj][m][1];
                        v0[0] *= bf2f(g.x & 0xffffu); v0[1] *= bf2f(g.x >> 16); v0[2] *= bf2f(g.y & 0xffffu); v0[3] *= bf2f(g.y >> 16);
                        v1[0] *= bf2f(g.z & 0xffffu); v1[1] *= bf2f(g.z >> 16); v1[2] *= bf2f(g.w & 0xffffu); v1[3] *= bf2f(g.w >> 16);
                        u32x4 w; w.x = cvt_pk_bf16(v0[0], v0[1]); w.y = cvt_pk_bf16(v0[2], v0[3]); w.z = cvt_pk_bf16(v1[0], v1[1]); w.w = cvt_pk_bf16(v1[2], v1[3]);
                        *(u32x4*)(MFh + u.sub * SL + (size_t)row * DM + col0) = w; } }
                EPI_SB();
            }
        } else {
#pragma unroll
            for (int ai = 0; ai < 2; ++ai)
#pragma unroll
                for (int m = 0; m < 4; ++m) { const int row = u.pm * BM + ai * HALF + wr * 64 + m * 16 + fr;
                    u32x4 gw[2], t[2][3];
#pragma unroll
                    for (int bj = 0; bj < 2; ++bj) { const int col0 = u.pn * BM + bj * HALF + wc * 32 + 8 * fq;
                        gw[bj] = *(const u32x4*)(G + (size_t)row * GCOLS + 3 * DM + col0);
#pragma unroll
                        for (int q = 0; q < 3; ++q) t[bj][q] = *(const u32x4*)(MFh + q * SL + (size_t)row * DM + col0); }
                    EPI_SB();
#pragma unroll
                    for (int bj = 0; bj < 2; ++bj) { const int col0 = u.pn * BM + bj * HALF + wc * 32 + 8 * fq; const u32x4 g = gw[bj];
                        f32x4 v0 = acc[ai][bj][m][0], v1 = acc[ai][bj][m][1];
                        v0[0] *= bf2f(g.x & 0xffffu); v0[1] *= bf2f(g.x >> 16); v0[2] *= bf2f(g.y & 0xffffu); v0[3] *= bf2f(g.y >> 16);
                        v1[0] *= bf2f(g.z & 0xffffu); v1[1] *= bf2f(g.z >> 16); v1[2] *= bf2f(g.w & 0xffffu); v1[3] *= bf2f(g.w >> 16);
#pragma unroll
                        for (int q = 0; q < 3; ++q) { const u32x4 tt = t[bj][q];
                            v0[0] += bf2f(tt.x & 0xffffu); v0[1] += bf2f(tt.x >> 16); v0[2] += bf2f(tt.y & 0xffffu); v0[3] += bf2f(tt.y >> 16);
                            v1[0] += bf2f(tt.z & 0xffffu); v1[1] += bf2f(tt.z >> 16); v1[2] += bf2f(tt.w & 0xffffu); v1[3] += bf2f(tt.w >> 16); }
                        u32x4 w; w.x = cvt_pk_bf16(v0[0], v0[1]); w.y = cvt_pk_bf16(v0[2], v0[3]); w.z = cvt_pk_bf16(v1[0], v1[1]); w.w = cvt_pk_bf16(v1[2], v1[3]);
                        *(u32x4*)(MERGED + (size_t)row * DM + col0) = w; }
                    EPI_SB(); }
        }
    }
};
}

struct Frame { LAS unsigned char* lds; int tid, lane, wave, bid, G; };

DI Frame fresh(const Frame& F0) { Frame F = F0; int tid = F0.tid, bid = F0.bid, G = F0.G, wave = F0.wave; unsigned lo = (unsigned)(size_t)F0.lds;
    asm volatile("" : "+v"(tid)); asm volatile("" : "+s"(bid), "+s"(G), "+s"(wave), "+s"(lo));
    F.tid = tid; F.lane = tid & 63; F.wave = wave; F.bid = bid; F.G = G; F.lds = (LAS unsigned char*)(size_t)lo; return F; }
DI unsigned char* fresh_ptr(unsigned char* p) { size_t z = 0; asm volatile("" : "+s"(z)); return p + z; }
DI void rs_table(const Frame& F, const float* part, int pm) {
    LAS float* rsT = (LAS float*)(F.lds + RST_OFF);
    if (F.tid < 256) { const int row = pm * 256 + F.tid; float s = 0.f;
#pragma unroll
        for (int i = 0; i < 8; ++i) { const f32x4 v = *(const f32x4*)(part + (size_t)row * 32 + 4 * i); s += (v[0] + v[1]) + (v[2] + v[3]); }
        rsT[F.tid] = 1.0f / sqrtf(s * (1.0f / DM) + RMS_EPS); }
    __syncthreads();
}

DI int head_perm(int c) { const int h = c >> 6, p = c & 63; const int dim = p < 16 ? ((p >> 1) + 8 * (p & 1)) : p; return (h << 6) + dim; }
DI int zin_colmap(int n) {
    if (n < B_COLS) return 1860 + n;
    if (n < 2048) return -1;
    if (n < 2560) return head_perm(n - 2048);
    if (n < 3072) return 512 + head_perm(n - 2560);
    if (n < 3584) return 1024 + (n - 3072);
    if (n < 3840) return 1536 + head_perm(n - 3584);
    if (n < 3904) return 1792 + head_perm(n - 3840);
    if (n < 3908) return 1856 + (n - 3904);
    if (n < 4096) return -1;
    if (n < 4608) return 3844 + (n - 4096);
    if (n < 5120) return 4356 + (n - 4608);
    return 4868 + (n - 5120);
}
template <int MODE>
DI void tr_item(const float* W, int ldw, const float* ksc, bf16_t* WT, int K, LAS float* scr, int kb, int nb, int lane) {
    const int k0 = 64 * kb, n0 = 32 * nb, nn = n0 + (lane & 31);
    const int col = MODE == 1 ? zin_colmap(nn) : nn;
    float tv[32];
    if (col >= 0) {
#pragma unroll
        for (int i = 0; i < 32; ++i) tv[i] = W[(size_t)(k0 + 2 * i + (lane >> 5)) * ldw + col];
        if (ksc) {
#pragma unroll
            for (int i = 0; i < 32; ++i) tv[i] *= ksc[k0 + 2 * i + (lane >> 5)]; }
    } else {
#pragma unroll
        for (int i = 0; i < 32; ++i) tv[i] = 0.f; }
#pragma unroll
    for (int i = 0; i < 32; ++i) scr[(2 * i + (lane >> 5)) * 33 + (lane & 31)] = tv[i];
    LDS_WAIT(); asm volatile("" ::: "memory");
    const int c = lane & 7;
#pragma unroll
    for (int j = 0; j < 4; ++j) { const int n = (lane >> 3) + 8 * j; const LAS float* s = scr + (8 * c) * 33 + n;
        u32x4 o; o.x = pk2(s[0 * 33], s[1 * 33]); o.y = pk2(s[2 * 33], s[3 * 33]); o.z = pk2(s[4 * 33], s[5 * 33]); o.w = pk2(s[6 * 33], s[7 * 33]);
        *(u32x4*)(WT + (size_t)(n0 + n) * K + k0 + 8 * c) = o; }
    LDS_WAIT(); asm volatile("" ::: "memory");
}
struct InTab { const float* p[37]; };
#define CAS __attribute__((address_space(4)))
typedef const float* fptr_t;
typedef GAS const float* gfptr_t;
struct In { CAS const gfptr_t* t; DI fptr_t operator[](int i) const { return (fptr_t)t[i]; } };
DI In in_fresh(In in) { CAS const gfptr_t* t = in.t; asm volatile("" : "+s"(t)); In r; r.t = t; return r; }
constexpr int CV_IN = 32 * (NZ / 32), CV_BR = 4 * 8 * 64, CV_OUT = 32 * 64, CV_GLU = 8 * 16, CV_UP = 32 * (DFF2 / 32), CV_DN = 86 * 64;
constexpr int CV_S1 = 0, CV_S2 = CV_IN, CV_S3 = CV_S2 + CV_BR + CV_OUT + CV_GLU, CV_S4 = CV_S3 + CV_UP, CV_LAYER = CV_S4 + CV_DN;
DI void conv_w_item(const In& in, unsigned char* ws, LAS float* scr, int l, int r, int lane) {
    unsigned char* wt = ws + WS_WT + (size_t)l * WT_LAYER;
    if (r < CV_IN) { const int nbk = NZ / 32; tr_item<1>(in[3] + (size_t)l * DM * IN_COLS, IN_COLS, in[2] + l * DM, (bf16_t*)(wt + WT_IN), DM, scr, r / nbk, r % nbk, lane); return; } r -= CV_IN;
    if (r < CV_BR) { const int n = r / 512, rr = r % 512; tr_item<0>(in[29] + ((size_t)l * 4 + n) * MIX * DM, DM, nullptr, (bf16_t*)(wt + WT_BR) + (size_t)n * DM * MIX, MIX, scr, rr / 64, rr % 64, lane); return; } r -= CV_BR;
    if (r < CV_OUT) { tr_item<0>(in[30] + (size_t)l * DM * DM, DM, nullptr, (bf16_t*)(wt + WT_OUT), DM, scr, r / 64, r % 64, lane); return; } r -= CV_OUT;
    if (r < CV_GLU) { tr_item<0>(in[27] + (size_t)l * MIX * MIX, MIX, nullptr, (bf16_t*)(wt + WT_GLU), MIX, scr, r / 16, r % 16, lane); return; } r -= CV_GLU;
    if (r < CV_UP) { const int nbk = DFF2 / 32; tr_item<0>(in[32] + (size_t)l * DM * DFF2, DFF2, in[31] + l * DM, (bf16_t*)(wt + WT_UP), DM, scr, r / nbk, r % nbk, lane); return; } r -= CV_UP;
    tr_item<0>(in[35] + (size_t)l * DFF * DM, DM, nullptr, (bf16_t*)(wt + WT_DOWN), DFF, scr, r / 64, r % 64, lane);
}
DI void conv_w_drain(const Frame& F, const In& in, unsigned char* ws, int l, int lo, int hi, int sec) {
    if (l >= NL) return;
    unsigned* cnt = (unsigned*)(ws + WS_CTL) + CW_CONV + 64 * (l * 4 + sec);
    LAS float* scr = (LAS float*)(F.lds + F.wave * 16384);
    for (;;) { unsigned bt = 0u; if (F.lane == 0) bt = __hip_atomic_fetch_add(cnt, 1u, __ATOMIC_RELAXED, __HIP_MEMORY_SCOPE_AGENT);
        bt = (unsigned)__builtin_amdgcn_readfirstlane((int)bt);
        const int r0 = lo + (int)bt * 16; if (r0 >= hi) break;
        for (int r = r0; r < r0 + 16 && r < hi; ++r) conv_w_item(in, ws, scr, l, r, F.lane); }
}
DI void p0_prologue(const Frame& F, const In& in, unsigned char* ws) {
    LAS float* scr = (LAS float*)(F.lds + F.wave * 16384);
    const int gw = F.bid * NWAVES + F.wave, NGW = F.G * NWAVES;
    for (int it = gw; it < CV_LAYER; it += NGW) conv_w_item(in, ws, scr, 0, it, F.lane);
    { bf16_t* WTL = (bf16_t*)(ws + WS_WTL);
      for (int e = F.bid * NTHR + F.tid; e < NL * 56 * MIX; e += F.G * NTHR) { const int n = e % MIX, k8 = (e / MIX) % 56, l = e / (MIX * 56); const int k0 = k8 * 8;
          const float* src = k0 < 96 ? in[8] + ((size_t)l * 96 + k0) * MIX : (k0 < 192 ? in[10] + ((size_t)l * 96 + (k0 - 96)) * MIX : in[11] + ((size_t)l * 256 + (k0 - 192)) * MIX);
          u32x4 o; o.x = pk2(src[n], src[MIX + n]); o.y = pk2(src[2 * MIX + n], src[3 * MIX + n]); o.z = pk2(src[4 * MIX + n], src[5 * MIX + n]); o.w = pk2(src[6 * MIX + n], src[7 * MIX + n]);
          *(u32x4*)(WTL + ((size_t)l * MIX + n) * 448 + k0) = o; } }
    { bf16_t* WTP = (bf16_t*)(ws + WS_WTP);
      for (int e = F.bid * NTHR + F.tid; e < NL * 4 * 128 * 16; e += F.G * NTHR) { const int n = e & 127, k8 = (e >> 7) & 15, lg = e >> 11;
          const float* src = in[17] + ((size_t)lg * 128 + k8 * 8) * 128 + n;
          u32x4 o; o.x = pk2(src[0], src[128]); o.y = pk2(src[256], src[384]); o.z = pk2(src[512], src[640]); o.w = pk2(src[768], src[896]);
          *(u32x4*)(WTP + ((size_t)lg * 128 + n) * 128 + k8 * 8) = o; } }
    const int* pos = (const int*)in[1];
    float* rope = (float*)(ws + WS_ROPE);
    for (int e = F.bid * NTHR + F.tid; e < MTOK * 8; e += F.G * NTHR) { const int m = e >> 3, i = e & 7;
        const float inv = exp2f(-(float)i * 0.125f * 18.931568569324174f);
        const float ang = (float)pos[m] * inv; float sn, cs; sincosf(ang, &sn, &cs);
        rope[m * 16 + i] = cs; rope[m * 16 + 8 + i] = sn; }
    const float* x = in[0]; bf16_t* YB = (bf16_t*)(ws + WS_YB); float* pa = (float*)(ws + WS_PARTA);
    for (int m = gw; m < MTOK; m += NGW) { float s = 0.f;
        f32x4 xv[8];
#pragma unroll
        for (int j = 0; j < 8; ++j) xv[j] = *(const f32x4*)(x + (size_t)m * DM + (j * 64 + F.lane) * 4);
        __builtin_amdgcn_sched_barrier(0);
#pragma unroll
        for (int j = 0; j < 8; ++j) { const f32x4 v = xv[j]; s += (v[0] * v[0] + v[1] * v[1]) + (v[2] * v[2] + v[3] * v[3]);
            u32x2 w; w.x = pk2(v[0], v[1]); w.y = pk2(v[2], v[3]); *(u32x2*)(YB + (size_t)m * DM + (j * 64 + F.lane) * 4) = w; }
        s = wave_sum(s);
        if (F.lane < 32) pa[(size_t)m * 32 + F.lane] = (F.lane == 0) ? s : 0.f; }
}

DI void dsa_prep_item(const Frame& F, unsigned char* ws, const float* idxg, int item) {
    const bf16_t* ZS = (const bf16_t*)(ws + WS_ZS); const float* rope = (const float*)(ws + WS_ROPE);
    bf16_t* Q = (bf16_t*)(ws + WS_Q); bf16_t* Kb = (bf16_t*)(ws + WS_K); bf16_t* VT = (bf16_t*)(ws + WS_VT); bf16_t* QI = (bf16_t*)(ws + WS_QI); bf16_t* KI = (bf16_t*)(ws + WS_KI); float* WI = (float*)(ws + WS_WI);
    const int m0 = item * 32;
    int tid_ = F.tid; asm volatile("" : "+v"(tid_));
    const int wv4 = F.wave * 4;
    float kx[4], wx[4];
#pragma unroll
    for (int tt = 0; tt < 4; ++tt) { const int m = m0 + wv4 + tt; kx[tt] = bf2f(ZS[(size_t)m * ZS_COLS + ZO_KI + F.lane]); wx[tt] = bf2f(ZS[(size_t)m * ZS_COLS + ZO_WI + (F.lane & 3)]); }
#pragma unroll
    for (int hb = 0; hb < 2; ++hb) {
        u32x4 raw[5]; f32x4 cs[5], sn[5];
#pragma unroll
        for (int q = 0; q < 5; ++q) { const int e = tid_ + (5 * hb + q) * NTHR; const int t = e / 160, pc = e % 160; const int m = m0 + t;
            const int zc = pc < 64 ? ZO_Q + 8 * pc : (pc < 128 ? ZO_AK + 8 * (pc - 64) : ZO_QI + 8 * (pc - 128));
            raw[q] = *(const u32x4*)(ZS + (size_t)m * ZS_COLS + zc);
            cs[q] = *(const f32x4*)(rope + (size_t)m * 16 + 4 * (pc & 1)); sn[q] = *(const f32x4*)(rope + (size_t)m * 16 + 8 + 4 * (pc & 1)); }
        __builtin_amdgcn_sched_barrier(0);
#pragma unroll
        for (int q = 0; q < 5; ++q) { const int e = tid_ + (5 * hb + q) * NTHR; const int t = e / 160, pc = e % 160; const int m = m0 + t;
            const int c8 = pc & 7; const bool rot = c8 < 2; const float sc = pc < 64 ? 0.125f : 1.0f;
            float o[8];
#pragma unroll
            for (int i = 0; i < 4; ++i) { const unsigned wi = raw[q][i]; const float x1 = bf2f(wi & 0xffffu), x2 = bf2f(wi >> 16); const float r1 = x1 * cs[q][i] - x2 * sn[q][i], r2 = x2 * cs[q][i] + x1 * sn[q][i];
                o[2 * i] = (rot ? r1 : x1) * sc; o[2 * i + 1] = (rot ? r2 : x2) * sc; }
            u32x4 w; w.x = pk2(o[0], o[1]); w.y = pk2(o[2], o[3]); w.z = pk2(o[4], o[5]); w.w = pk2(o[6], o[7]);
            if (pc < 64) *(u32x4*)(Q + (size_t)m * 512 + 8 * pc) = w;
            else if (pc < 128) { const int oc = 8 * (pc - 64), tq = m % SEQ, hq = oc >> 6, pq = oc & 63;
                *(u32x4*)(Kb + (((((size_t)(m / SEQ) * 8 + hq) * 64 + (tq >> 5)) * 4 + (pq >> 4)) * 32 + (tq & 31)) * 16 + ((pq >> 3) & 1) * 8) = w; }
            else *(u32x4*)(QI + (size_t)m * 256 + 8 * (pc - 128)) = w; }
        __builtin_amdgcn_sched_barrier(0);
    }
    { const int dim = F.lane < 16 ? ((F.lane >> 1) + 8 * (F.lane & 1)) : F.lane; const float gn = idxg[dim];
      float csv[4], snv[4];
#pragma unroll
      for (int tt = 0; tt < 4; ++tt) { const int m = m0 + wv4 + tt; csv[tt] = rope[m * 16 + ((F.lane >> 1) & 7)]; snv[tt] = rope[m * 16 + 8 + ((F.lane >> 1) & 7)]; }
      __builtin_amdgcn_sched_barrier(0);
#pragma unroll
      for (int tt = 0; tt < 4; ++tt) { const int m = m0 + wv4 + tt;
        const float xv = kx[tt];
        const float ss = wave_sum(xv * xv);
        float y = xv * (1.0f / sqrtf(ss * (1.0f / 64.f) + RMS_EPS)) * gn;
        const float pr = __shfl_xor(y, 1);
        if (F.lane < 16) y = (F.lane & 1) ? (y * csv[tt] + pr * snv[tt]) : (y * csv[tt] - pr * snv[tt]);
        { const int tq = m % SEQ, pq = F.lane; KI[((((size_t)(m / SEQ) * 64 + (tq >> 5)) * 4 + (pq >> 4)) * 32 + (tq & 31)) * 16 + ((pq >> 3) & 1) * 8 + (pq & 7)] = (bf16_t)f2bf(y); }
        if (F.lane < 4) WI[(size_t)m * 4 + F.lane] = wx[tt]; } }
    LAS unsigned char* L = F.lds;
    for (int e = F.tid; e < 32 * 128; e += NTHR) { const int t = e >> 7, c4 = (e & 127) * 4;
        *(LAS u32x2*)(L + t * 1040 + c4 * 2) = *(const u32x2*)(ZS + (size_t)(m0 + t) * ZS_COLS + ZO_AV + c4); }
    __syncthreads();
    { const int b = m0 / SEQ, kt = (m0 % SEQ) >> 5;
      for (int e = F.tid; e < 512 * 4; e += NTHR) { const int c = e >> 2, s2 = (e >> 1) & 1, hq = e & 1;
          unsigned short vals[8];
#pragma unroll
          for (int j = 0; j < 8; ++j) vals[j] = *(const LAS unsigned short*)(L + (16 * s2 + 8 * (j >> 2) + 4 * hq + (j & 3)) * 1040 + c * 2);
          u32x4 o; o.x = vals[0] | ((unsigned)vals[1] << 16); o.y = vals[2] | ((unsigned)vals[3] << 16); o.z = vals[4] | ((unsigned)vals[5] << 16); o.w = vals[6] | ((unsigned)vals[7] << 16);
          const int hv = c >> 6, d = c & 63;
          *(u32x4*)(VT + ((((((size_t)b * 8 + hv) * 64 + kt) * 2 + s2) * 2 + (d >> 5)) * 32 + (d & 31)) * 16 + hq * 8) = o; } }
    __syncthreads();
}

DI float softplusf_(float x) { return fmaxf(x, 0.f) + __logf(1.0f + __expf(-fabsf(x))); }
DI float tanhf_(float x) { return 1.0f - 2.0f * __builtin_amdgcn_rcpf(1.0f + __expf(2.0f * x)); }
DI float half32_sum(float x) { x = row16_sum(x); return x + __shfl_xor(x, 16); }
DI f32x4 cv4bf(const u32x2 w) { return (f32x4){bf2f(w.x & 0xffffu), bf2f(w.x >> 16), bf2f(w.y & 0xffffu), bf2f(w.y >> 16)}; }
struct RwG { u32x2 zr, zk, zv, pr, pk, pv; };
DI void rwg_load(RwG& G, const bf16_t* zc_, const bf16_t* zp_, int n) {
    G.zr = *(const u32x2*)(zc_ + ZO_R + n); G.zk = *(const u32x2*)(zc_ + ZO_K + n); G.zv = *(const u32x2*)(zc_ + ZO_V + n);
    G.pr = *(const u32x2*)(zp_ + ZO_R + n); G.pk = *(const u32x2*)(zp_ + ZO_K + n); G.pv = *(const u32x2*)(zp_ + ZO_V + n);
}
DI void rwkv_prep_item(const Frame& F, unsigned char* ws, const In& in, int l, int item) {
    const bf16_t* ZS = (const bf16_t*)(ws + WS_ZS);
    const float* mu = in[6] + l * B_COLS; const float* w0 = in[7] + l * MIX; const float* a0 = in[9] + l * MIX; const float* k_k = in[12] + l * MIX; const float* k_a = in[13] + l * MIX;
    const bf16_t* WTL = (const bf16_t*)(ws + WS_WTL) + (size_t)l * MIX * 448;
    float* RW = (float*)(ws + WS_RW); constexpr size_t RS = RW_STRIDE / 4;
    const int m0 = item * 32; const bool first = (m0 % SEQ) == 0;
    constexpr int XP = 456;
    LAS bf16_t* X = (LAS bf16_t*)F.lds;
    LAS float* PT = (LAS float*)(F.lds + 32768);
    { u32x2 zc7[7], zp7[7]; f32x4 mv7[7]; float pt7[7];
#pragma unroll
      for (int it = 0; it < 7; ++it) { const int e = F.tid + it * NTHR; const int t = e / 112, c = (e % 112) * 4; const int m = m0 + t, zc = ZO_LW + c; const bool nop = first && t == 0;
          zc7[it] = *(const u32x2*)(ZS + (size_t)m * ZS_COLS + zc); zp7[it] = *(const u32x2*)(ZS + (size_t)(nop ? m : m - 1) * ZS_COLS + zc); mv7[it] = *(const f32x4*)(mu + zc); }
      pt7[0] = mu[ZO_R + F.tid]; pt7[1] = mu[ZO_K + F.tid]; pt7[2] = mu[ZO_V + F.tid]; pt7[3] = w0[F.tid]; pt7[4] = a0[F.tid]; pt7[5] = k_k[F.tid]; pt7[6] = k_a[F.tid];
      __builtin_amdgcn_sched_barrier(0);
#pragma unroll
      for (int a = 0; a < 7; ++a) PT[a * 512 + F.tid] = pt7[a];
#pragma unroll
      for (int it = 0; it < 7; ++it) { const int e = F.tid + it * NTHR; const int t = e / 112, c = (e % 112) * 4; const bool nop = first && t == 0;
          const f32x4 z = cv4bf(zc7[it]); f32x4 zp = cv4bf(zp7[it]);
          if (nop) zp = (f32x4){0.f, 0.f, 0.f, 0.f};
          const f32x4 xs = z + (zp - z) * mv7[it]; float o[4];
          const float ea = c < 96 ? 2.0f : -1.0f;
#pragma unroll
          for (int i = 0; i < 4; ++i) { const float rc = __builtin_amdgcn_rcpf(1.0f + __expf(ea * xs[i])); o[i] = c < 96 ? (1.0f - 2.0f * rc) : (c < 192 ? xs[i] : rc); }
          *(LAS u32x2*)(X + t * XP + c) = (u32x2){pk2(o[0], o[1]), pk2(o[2], o[3])}; } }
    __syncthreads();
    const int r = F.lane & 31, hh = F.lane >> 5, h = F.wave, m = m0 + r;
    const bool nop = first && r == 0;
    const bf16_t* zc_ = ZS + (size_t)m * ZS_COLS; const bf16_t* zp_ = ZS + (size_t)(nop ? m : m - 1) * ZS_COLS;
    float ss = 0.f;
    { u32x2 zk8[8], pk8[8];
#pragma unroll
      for (int q = 0; q < 8; ++q) { const int n = h * 64 + (q >> 2) * 32 + 8 * (q & 3) + 4 * hh; zk8[q] = *(const u32x2*)(zc_ + ZO_K + n); pk8[q] = *(const u32x2*)(zp_ + ZO_K + n); }
      __builtin_amdgcn_sched_barrier(0);
#pragma unroll
      for (int q = 0; q < 8; ++q) { const int n = h * 64 + (q >> 2) * 32 + 8 * (q & 3) + 4 * hh;
          const f32x4 zk = cv4bf(zk8[q]); f32x4 pk = cv4bf(pk8[q]); if (nop) pk = (f32x4){0.f, 0.f, 0.f, 0.f};
          const f32x4 kk = (zk + (pk - zk) * *(const LAS f32x4*)(PT + 512 + n)) * *(const LAS f32x4*)(PT + 5 * 512 + n);
          ss += (kk[0] * kk[0] + kk[1] * kk[1]) + (kk[2] * kk[2] + kk[3] * kk[3]); } }
    ss += __shfl_xor(ss, 32);
    const float inv = 1.0f / fmaxf(sqrtf(ss), 1e-12f);
    const LAS bf16_t* xb = X + r * XP + 8 * hh;
#pragma unroll 1
    for (int nt = 0; nt < 2; ++nt) { const bf16_t* wrow = WTL + (size_t)(h * 64 + nt * 32 + r) * 448 + 8 * hh;
        f32x16 aw, aa, ag;
#pragma unroll
        for (int i = 0; i < 16; ++i) { aw[i] = 0.f; aa[i] = 0.f; ag[i] = 0.f; }
        bf16x8 wA[7], wB[7];
#define RW_LOAD(dst, b) _Pragma("unroll") for (int q = 0; q < 7; ++q) dst[q] = *(const bf16x8*)(wrow + 16 * (7 * (b) + q))
#define RW_MMA(src, b) _Pragma("unroll") for (int q = 0; q < 7; ++q) { const int j = 7 * (b) + q; const bf16x8 xv = *(const LAS bf16x8*)(xb + 16 * j); \
            if (j < 6) aw = MFMA32(src[q], xv, aw); else if (j < 12) aa = MFMA32(src[q], xv, aa); else ag = MFMA32(src[q], xv, ag); }
        RW_LOAD(wA, 0); RW_LOAD(wB, 1); __builtin_amdgcn_sched_barrier(0);
        RW_MMA(wA, 0); __builtin_amdgcn_sched_barrier(0); RW_LOAD(wA, 2); __builtin_amdgcn_sched_barrier(0);
        RW_MMA(wB, 1); __builtin_amdgcn_sched_barrier(0); RW_LOAD(wB, 3); __builtin_amdgcn_sched_barrier(0);
        RW_MMA(wA, 2); __builtin_amdgcn_sched_barrier(0);
        RwG G0; rwg_load(G0, zc_, zp_, h * 64 + nt * 32 + 4 * hh); __builtin_amdgcn_sched_barrier(0);
        RW_MMA(wB, 3); __builtin_amdgcn_sched_barrier(0);
#undef RW_LOAD
#undef RW_MMA
#pragma unroll
        for (int g = 0; g < 4; ++g) { const int n = h * 64 + nt * 32 + 8 * g + 4 * hh;
            const RwG G = G0;
            if (g < 3) rwg_load(G0, zc_, zp_, n + 8);
            __builtin_amdgcn_sched_barrier(0);
            const f32x4 zr = cv4bf(G.zr), zk = cv4bf(G.zk), zv = cv4bf(G.zv);
            f32x4 pr = cv4bf(G.pr), pk = cv4bf(G.pk), pv = cv4bf(G.pv);
            if (nop) { pr = (f32x4){0.f, 0.f, 0.f, 0.f}; pk = pr; pv = pr; }
            const f32x4 rr = zr + (pr - zr) * *(const LAS f32x4*)(PT + n), k = zk + (pk - zk) * *(const LAS f32x4*)(PT + 512 + n), v = zv + (pv - zv) * *(const LAS f32x4*)(PT + 2 * 512 + n);
            const f32x4 w0v = *(const LAS f32x4*)(PT + 3 * 512 + n), a0v = *(const LAS f32x4*)(PT + 4 * 512 + n), kkv = *(const LAS f32x4*)(PT + 5 * 512 + n), kav = *(const LAS f32x4*)(PT + 6 * 512 + n);
            f32x4 dec, k2, nkk, kka, gg;
#pragma unroll
            for (int j = 0; j < 4; ++j) { const int i = 4 * g + j;
                const float wlog = -softplusf_(-(w0v[j] + aw[i])) - 0.5f; dec[j] = __expf(-__expf(wlog));
                const float a = sigmoidf_(a0v[j] + aa[i]); const float kk = k[j] * kkv[j] * inv;
                k2[j] = k[j] * (1.0f + (a - 1.0f) * kav[j]); nkk[j] = -kk; kka[j] = kk * a; gg[j] = ag[i]; }
            const size_t o = (size_t)m * MIX + n;
            *(f32x4*)(RW + 0 * RS + o) = rr; *(f32x4*)(RW + 1 * RS + o) = dec; *(f32x4*)(RW + 2 * RS + o) = k2; *(f32x4*)(RW + 3 * RS + o) = v;
            *(f32x4*)(RW + 4 * RS + o) = nkk; *(f32x4*)(RW + 5 * RS + o) = kka; *(f32x4*)(RW + 6 * RS + o) = gg;
            __builtin_amdgcn_sched_barrier(0); } }
    __syncthreads();
}

template <int LV> DI void pool_windows(const float (&z)[47], int t0, LAS bf16_t* D, int j) {
    float s[47];
#pragma unroll
    for (int i = 0; i < 47; ++i) s[i] = z[i];
#pragma unroll
    for (int lv = 0; lv < LV; ++lv) {
#pragma unroll
        for (int i = 46; i >= 0; --i) { const int o = i - (1 << lv); s[i] = s[i] + (o >= 0 ? s[o] : 0.f); } }
#pragma unroll
    for (int t = 0; t < 32; ++t) { const int ta = t0 + t; const int cnt = (ta + 1) < (1 << LV) ? (ta + 1) : (1 << LV);
        D[t * 520 + j] = (bf16_t)f2bf(s[15 + t] / (float)cnt - z[15 + t]); }
}
DI void pool_item(const Frame& F, unsigned char* ws, const In& in, int l, int item) {
    const bf16_t* ZS = (const bf16_t*)(ws + WS_ZS); bf16_t* MIXp = (bf16_t*)(ws + WS_MIX);
    const bf16_t* WTP = (const bf16_t*)(ws + WS_WTP) + (size_t)l * 4 * 128 * 128; const float* psc = in[18] + l * MIX;
    const int m0 = item * 32, t0 = m0 % SEQ;
    LAS bf16_t* D = (LAS bf16_t*)F.lds;
    { const int j = F.tid, gi = j >> 7;
      float z[47];
#pragma unroll
      for (int i = 0; i < 47; ++i) { const int ta = t0 - 15 + i; z[i] = bf2f(ZS[(size_t)(m0 - 15 + (ta >= 0 ? i : 15)) * ZS_COLS + ZO_C + j]); if (ta < 0) z[i] = 0.f; }
      if (gi == 0) pool_windows<1>(z, t0, D, j); else if (gi == 1) pool_windows<2>(z, t0, D, j); else if (gi == 2) pool_windows<3>(z, t0, D, j); else pool_windows<4>(z, t0, D, j); }
    __syncthreads();
    const int r = F.lane & 31, hh = F.lane >> 5, gi = F.wave >> 1;
    const LAS bf16_t* xa = D + r * 520 + gi * 128 + 8 * hh;
#pragma unroll
    for (int q = 0; q < 2; ++q) { const int n = (2 * (F.wave & 1) + q) * 32 + r;
        const bf16_t* wrow = WTP + ((size_t)gi * 128 + n) * 128 + 8 * hh;
        bf16x8 wq[8];
#pragma unroll
        for (int s2 = 0; s2 < 8; ++s2) wq[s2] = *(const bf16x8*)(wrow + 16 * s2);
        const int col = gi * 128 + n; const float sc = psc[col];
        __builtin_amdgcn_sched_barrier(0);
        f32x16 acc;
#pragma unroll
        for (int i = 0; i < 16; ++i) acc[i] = 0.f;
#pragma unroll
        for (int s2 = 0; s2 < 8; ++s2) acc = MFMA32(*(const LAS bf16x8*)(xa + 16 * s2), wq[s2], acc);
#pragma unroll
        for (int i = 0; i < 16; ++i) { const int m = m0 + (i & 3) + 8 * (i >> 2) + 4 * hh; MIXp[(size_t)m * (4 * MIX) + 2 * MIX + col] = (bf16_t)f2bf(acc[i] * sc); }
        __builtin_amdgcn_sched_barrier(0); }
    __syncthreads();
}

DI float gelu_tanh(float y) { const float u = 0.7978845608028654f * (y + 0.044715f * y * y * y); return y * (1.0f - __builtin_amdgcn_rcpf(1.0f + __expf(2.0f * u))); }

DI void ssm_seq_item(const Frame& F, unsigned char* ws, const In& in, int l, int item) {
    const bf16_t* ZS = (const bf16_t*)(ws + WS_ZS); bf16_t* YSB = (bf16_t*)(ws + WS_YSB);
    const int task = item * 8 + F.wave, g = task >> 1, bp = task & 1;
    const int r = F.lane & 31, hh = F.lane >> 5;
    constexpr int XP = 136;
    LAS bf16_t* Xl = (LAS bf16_t*)(F.lds + F.wave * 8704);
    float lr[2], li[2]; bf16x8 Bf[4];
#pragma unroll
    for (int ps = 0; ps < 2; ++ps) { const int p = r + 32 * ps;
        const float are = in[19][((size_t)l * 32 + g) * 64 + p], aim = in[20][((size_t)l * 32 + g) * 64 + p];
        const float dt = __expf(in[21][l * 32 + g]);
        const float er = __expf(are * dt); float sn, cs; sincosf(aim * dt, &sn, &cs);
        lr[ps] = er * cs; li[ps] = er * sn;
        const float nr = lr[ps] - 1.0f, ni = li[ps], den = are * are + aim * aim;
        const float cr = (nr * are + ni * aim) / den, ci = (ni * are - nr * aim) / den;
        const float* bre = in[22] + (((size_t)l * 32 + g) * 64 + p) * 16 + 8 * hh; const float* bim = in[23] + (((size_t)l * 32 + g) * 64 + p) * 16 + 8 * hh;
        float vr[8], vi[8];
#pragma unroll
        for (int j = 0; j < 8; ++j) { const float x = bre[j], y = bim[j]; vr[j] = cr * x - ci * y; vi[j] = cr * y + ci * x; }
        Bf[2 * ps] = pack8(vr[0], vr[1], vr[2], vr[3], vr[4], vr[5], vr[6], vr[7]); Bf[2 * ps + 1] = pack8(vi[0], vi[1], vi[2], vi[3], vi[4], vi[5], vi[6], vi[7]); }
    bf16x8 Cf[8];
    { const float* cre = in[24] + (((size_t)l * 32 + g) * 16 + (r & 15)) * 64; const float* cim = in[25] + (((size_t)l * 32 + g) * 16 + (r & 15)) * 64;
#pragma unroll
      for (int s2 = 0; s2 < 8; ++s2) { const int q = s2 >> 1, n0 = 16 * (s2 & 1) + 8 * hh + 32 * (q >> 1); float v[8];
#pragma unroll
          for (int j = 0; j < 8; ++j) { const float x = (q & 1) ? -cim[n0 + j] : cre[n0 + j]; v[j] = (r < 16) ? x : 0.f; }
          Cf[s2] = pack8(v[0], v[1], v[2], v[3], v[4], v[5], v[6], v[7]); } }
    const float dsk = in[26][l * MIX + g * 16 + (r & 15)];
    bf16x8 Dg;
    { float v[8];
#pragma unroll
      for (int j = 0; j < 8; ++j) v[j] = (r < 16 && 8 * hh + j == r) ? dsk : 0.f;
      Dg = pack8(v[0], v[1], v[2], v[3], v[4], v[5], v[6], v[7]); }
    float xr0 = 0.f, xi0 = 0.f, xr1 = 0.f, xi1 = 0.f;
    const int hr = (r >> 2) & 1, ir = 4 * (r >> 3) + (r & 3);
    const bf16_t* usrc = ZS + (size_t)((bp + 2 * hr) * SEQ + ir) * ZS_COLS + ZO_D + g * 16 + 8 * hh;
    bf16x8 unx = *(const bf16x8*)usrc;
    const size_t ebase = (size_t)((bp + 2 * hh) * SEQ) ;
    bf16_t* yout = YSB + ebase * MIX + g * 16 + (r & 15);
#pragma unroll 1
    for (int tile = 0; tile < SEQ / 16; ++tile) {
        const bf16x8 Au = unx;
        if (tile + 1 < SEQ / 16) unx = *(const bf16x8*)(usrc + (size_t)(tile + 1) * 16 * ZS_COLS);
        f32x16 z16;
#pragma unroll
        for (int i = 0; i < 16; ++i) z16[i] = 0.f;
        f32x16 a0 = MFMA32(Au, Bf[0], z16), a1 = MFMA32(Au, Bf[1], z16), a2 = MFMA32(Au, Bf[2], z16), a3 = MFMA32(Au, Bf[3], z16);
#pragma unroll
        for (int i = 0; i < 16; ++i) {
            const float n0r = lr[0] * xr0 - li[0] * xi0 + a0[i], n0i = lr[0] * xi0 + li[0] * xr0 + a1[i]; xr0 = n0r; xi0 = n0i; a0[i] = n0r; a1[i] = n0i;
            const float n1r = lr[1] * xr1 - li[1] * xi1 + a2[i], n1i = lr[1] * xi1 + li[1] * xr1 + a3[i]; xr1 = n1r; xi1 = n1i; a2[i] = n1r; a3[i] = n1i; }
#pragma unroll
        for (int i = 0; i < 16; ++i) { const int rho = (i & 3) + 8 * (i >> 2) + 4 * hh; LAS bf16_t* row = Xl + rho * XP + r;
            row[0] = (bf16_t)f2bf(a0[i]); row[32] = (bf16_t)f2bf(a1[i]); row[64] = (bf16_t)f2bf(a2[i]); row[96] = (bf16_t)f2bf(a3[i]); }
        LDS_WAIT(); asm volatile("" ::: "memory");
        f32x16 ay = MFMA32(Au, Dg, z16);
#pragma unroll
        for (int s2 = 0; s2 < 8; ++s2) ay = MFMA32(*(const LAS bf16x8*)(Xl + r * XP + 16 * s2 + 8 * hh), Cf[s2], ay);
        if (r < 16) {
#pragma unroll
            for (int i = 0; i < 16; ++i) yout[(size_t)(tile * 16 + i) * MIX] = (bf16_t)f2bf(gelu_tanh(ay[i])); }
        LDS_WAIT(); asm volatile("" ::: "memory");
    }
}

DI float vmul_(float a, float b) { float d; asm("v_mul_f32 %0, %1, %2" : "=v"(d) : "v"(a), "v"(b)); return d; }
DI float vfma_(float a, float b, float c) { float d; asm("v_fma_f32 %0, %1, %2, %3" : "=v"(d) : "v"(a), "v"(b), "v"(c)); return d; }
DI void row16_sum2(float& x0, float& x1) {
    asm("s_nop 1\n\t"
        "v_add_f32_dpp %0, %0, %0 quad_perm:[1,0,3,2] row_mask:0xf bank_mask:0xf bound_ctrl:1\n\tv_add_f32_dpp %1, %1, %1 quad_perm:[1,0,3,2] row_mask:0xf bank_mask:0xf bound_ctrl:1\n\ts_nop 0\n\t"
        "v_add_f32_dpp %0, %0, %0 quad_perm:[2,3,0,1] row_mask:0xf bank_mask:0xf bound_ctrl:1\n\tv_add_f32_dpp %1, %1, %1 quad_perm:[2,3,0,1] row_mask:0xf bank_mask:0xf bound_ctrl:1\n\ts_nop 0\n\t"
        "v_add_f32_dpp %0, %0, %0 row_half_mirror row_mask:0xf bank_mask:0xf bound_ctrl:1\n\tv_add_f32_dpp %1, %1, %1 row_half_mirror row_mask:0xf bank_mask:0xf bound_ctrl:1\n\ts_nop 0\n\t"
        "v_add_f32_dpp %0, %0, %0 row_mirror row_mask:0xf bank_mask:0xf bound_ctrl:1\n\tv_add_f32_dpp %1, %1, %1 row_mirror row_mask:0xf bank_mask:0xf bound_ctrl:1\n\ts_nop 1"
        : "+v"(x0), "+v"(x1));
}
DI void row16_sum4(float& x0, float& x1, float& x2, float& x3) {
#define R4(ctl) "v_add_f32_dpp %0, %0, %0 " ctl " row_mask:0xf bank_mask:0xf bound_ctrl:1\n\tv_add_f32_dpp %1, %1, %1 " ctl " row_mask:0xf bank_mask:0xf bound_ctrl:1\n\t" \
                "v_add_f32_dpp %2, %2, %2 " ctl " row_mask:0xf bank_mask:0xf bound_ctrl:1\n\tv_add_f32_dpp %3, %3, %3 " ctl " row_mask:0xf bank_mask:0xf bound_ctrl:1\n\t"
    asm("s_nop 1\n\t" R4("quad_perm:[1,0,3,2]") R4("quad_perm:[2,3,0,1]") R4("row_half_mirror") R4("row_mirror") "s_nop 0"
        : "+v"(x0), "+v"(x1), "+v"(x2), "+v"(x3));
#undef R4
}
DI void row_update(float (&S)[4], float sa, float v, const f32x4& w, const f32x4& b, const f32x4& k) {
    float t0, t1, t2, t3;
    asm("v_mul_f32 %4, %9, %18\n\tv_mul_f32 %5, %9, %19\n\tv_mul_f32 %6, %9, %20\n\tv_mul_f32 %7, %9, %21\n\t"
        "v_fma_f32 %4, %8, %14, %4\n\tv_fma_f32 %5, %8, %15, %5\n\tv_fma_f32 %6, %8, %16, %6\n\tv_fma_f32 %7, %8, %17, %7\n\t"
        "v_fma_f32 %0, %0, %10, %4\n\tv_fma_f32 %1, %1, %11, %5\n\tv_fma_f32 %2, %2, %12, %6\n\tv_fma_f32 %3, %3, %13, %7"
        : "+v"(S[0]), "+v"(S[1]), "+v"(S[2]), "+v"(S[3]), "=&v"(t0), "=&v"(t1), "=&v"(t2), "=&v"(t3)
        : "v"(sa), "v"(v), "v"(w[0]), "v"(w[1]), "v"(w[2]), "v"(w[3]), "v"(b[0]), "v"(b[1]), "v"(b[2]), "v"(b[3]), "v"(k[0]), "v"(k[1]), "v"(k[2]), "v"(k[3]));
}
DI void row_dots(const float (&S0)[4], const float (&S1)[4], const f32x4& r, const f32x4& an, float& y0, float& y1, float& s0, float& s1) {
    asm("v_mul_f32 %0, %4, %12\n\tv_mul_f32 %1, %8, %12\n\tv_mul_f32 %2, %4, %16\n\tv_mul_f32 %3, %8, %16\n\t"
        "v_fma_f32 %0, %5, %13, %0\n\tv_fma_f32 %1, %9, %13, %1\n\tv_fma_f32 %2, %5, %17, %2\n\tv_fma_f32 %3, %9, %17, %3\n\t"
        "v_fma_f32 %0, %6, %14, %0\n\tv_fma_f32 %1, %10, %14, %1\n\tv_fma_f32 %2, %6, %18, %2\n\tv_fma_f32 %3, %10, %18, %3\n\t"
        "v_fma_f32 %0, %7, %15, %0\n\tv_fma_f32 %1, %11, %15, %1\n\tv_fma_f32 %2, %7, %19, %2\n\tv_fma_f32 %3, %11, %19, %3"
        : "=&v"(y0), "=&v"(y1), "=&v"(s0), "=&v"(s1)
        : "v"(S0[0]), "v"(S0[1]), "v"(S0[2]), "v"(S0[3]), "v"(S1[0]), "v"(S1[1]), "v"(S1[2]), "v"(S1[3]),
          "v"(r[0]), "v"(r[1]), "v"(r[2]), "v"(r[3]), "v"(an[0]), "v"(an[1]), "v"(an[2]), "v"(an[3]));
}
DI void row_dots1(const float (&S)[4], const f32x4& r, const f32x4& an, float& y, float& sn) {
    asm("v_mul_f32 %0, %2, %6\n\tv_mul_f32 %1, %2, %10\n\tv_fma_f32 %0, %3, %7, %0\n\tv_fma_f32 %1, %3, %11, %1\n\t"
        "v_fma_f32 %0, %4, %8, %0\n\tv_fma_f32 %1, %4, %12, %1\n\tv_fma_f32 %0, %5, %9, %0\n\tv_fma_f32 %1, %5, %13, %1"
        : "=&v"(y), "=&v"(sn)
        : "v"(S[0]), "v"(S[1]), "v"(S[2]), "v"(S[3]), "v"(r[0]), "v"(r[1]), "v"(r[2]), "v"(r[3]), "v"(an[0]), "v"(an[1]), "v"(an[2]), "v"(an[3]));
}
DI void rwkv_scan_item(const Frame& F, unsigned char* ws, int item) {
    const float* RW = (const float*)(ws + WS_RW); constexpr size_t RS = RW_STRIDE / 4;
    float* YRAW = (float*)(ws + WS_YRAW);
    constexpr int TC = 32, NCH = SEQ / TC;
    const int bh = item >> 1, b = bh >> 3, h = bh & 7;
    const int rg = F.lane >> 4, jq = F.lane & 15, row = (item & 1) * 32 + F.wave * 4 + rg;
    LAS float* BUF = (LAS float*)F.lds;
    constexpr int BUFSZ = 6 * TC * 64;
    const int st = F.tid >> 4, sq = F.tid & 15;
    const float* gsrc = RW + (size_t)(b * SEQ + st) * MIX + h * 64 + 4 * sq;
    f32x4 pre[6];
#pragma unroll
    for (int a = 0; a < 6; ++a) pre[a] = *(const f32x4*)(gsrc + a * RS);
#pragma unroll
    for (int a = 0; a < 6; ++a) *(LAS f32x4*)(BUF + (a * TC + st) * 64 + 4 * sq) = pre[a];
    __syncthreads();
    float S[4] = {0.f, 0.f, 0.f, 0.f};
    float* yout = YRAW + (size_t)(b * SEQ) * MIX + h * 64 + row;
#pragma unroll 1
    for (int c = 0; c < NCH; ++c) {
        if (c + 1 < NCH) {
#pragma unroll
            for (int a = 0; a < 6; ++a) pre[a] = *(const f32x4*)(gsrc + a * RS + (size_t)(c + 1) * TC * MIX);
        }
        const LAS float* P = BUF + (c & 1) * BUFSZ;
        float sp, yp = 0.f;
        { const f32x4 a4 = *(const LAS f32x4*)(P + (4 * TC) * 64 + 4 * jq); float d; row_dots1(S, a4, a4, d, sp); }
#pragma unroll 1
        for (int t16 = 0; t16 < TC; t16 += 16) {
            float yk = 0.f;
#pragma unroll 4
            for (int tt = 0; tt < 16; ++tt) { const int t = t16 + tt;
                const f32x4 k4 = *(const LAS f32x4*)(P + (2 * TC + t) * 64 + 4 * jq);
                const float v = P[(3 * TC + t) * 64 + row];
                const f32x4 b4 = *(const LAS f32x4*)(P + (5 * TC + t) * 64 + 4 * jq);
                const f32x4 w4 = *(const LAS f32x4*)(P + (1 * TC + t) * 64 + 4 * jq);
                const f32x4 r4 = *(const LAS f32x4*)(P + (0 * TC + t) * 64 + 4 * jq);
                const f32x4 an = *(const LAS f32x4*)(P + (4 * TC + ((t + 1) & (TC - 1))) * 64 + 4 * jq);
                row16_sum2(sp, yp);
                if (tt > 0) yk = ((tt - 1) == jq) ? yp : yk;
                row_update(S, sp, v, w4, b4, k4);
                row_dots1(S, r4, an, yp, sp); }
            { float d = 0.f, q = yp; row16_sum2(d, q); yk = (jq == 15) ? q : yk; yp = 0.f; }
            yout[(size_t)(c * TC + t16 + jq) * MIX] = yk;
        }
        if (c + 1 < NCH) {
            LAS float* Q = BUF + ((c + 1) & 1) * BUFSZ;
#pragma unroll
            for (int a = 0; a < 6; ++a) *(LAS f32x4*)(Q + (a * TC + st) * 64 + 4 * sq) = pre[a];
        }
        __syncthreads();
    }
}
DI void rwkv_post_rows(const Frame& F, unsigned char* ws, const In& in, int l, int w0, int nw) {
    const float* RW = (const float*)(ws + WS_RW); constexpr size_t RS = RW_STRIDE / 4;
    const float* YRAW = (const float*)(ws + WS_YRAW); bf16_t* MIXp = (bf16_t*)(ws + WS_MIX);
    const float* r_k = in[14] + l * MIX; const float* lng = in[15] + l * MIX; const float* lnb = in[16] + l * MIX;
    for (int e0 = w0; e0 < MTOK * 8; e0 += 4 * nw) {
        float y[4], r0[4], r2[4], r3[4], r6[4], gw[4], gb[4], rk[4];
#pragma unroll
        for (int k = 0; k < 4; ++k) { int e = e0 + k * nw; e = e < MTOK * 8 ? e : e0; const int m = e >> 3, h = e & 7, ch = h * 64 + F.lane; const size_t o = (size_t)m * MIX + ch;
            y[k] = YRAW[o]; r0[k] = RW[0 * RS + o]; r2[k] = RW[2 * RS + o]; r3[k] = RW[3 * RS + o]; r6[k] = RW[6 * RS + o]; gw[k] = lng[ch]; gb[k] = lnb[ch]; rk[k] = r_k[ch]; }
        __builtin_amdgcn_sched_barrier(0);
#pragma unroll
        for (int k = 0; k < 4; ++k) { const int e = e0 + k * nw; const int m = e >> 3, h = e & 7, ch = h * 64 + F.lane;
            const float mean = wave_sum(y[k]) * (1.f / 64.f); const float d = y[k] - mean; const float var = wave_sum(d * d) * (1.f / 64.f);
            const float yn = d * (1.0f / sqrtf(var + GN_EPS)) * gw[k] + gb[k];
            const float bon = wave_sum(r0[k] * r2[k] * rk[k]) * r3[k];
            if (e < MTOK * 8) MIXp[(size_t)m * (4 * MIX) + MIX + ch] = (bf16_t)f2bf((yn + bon) * r6[k]); }
        __builtin_amdgcn_sched_barrier(0);
    }
}

DI unsigned wave_sum_u32(unsigned x) {
    float f = __builtin_bit_cast(float, x); (void)f;
    int v = (int)x;
    v += __builtin_amdgcn_update_dpp(0, v, 0xB1, 0xF, 0xF, true); v += __builtin_amdgcn_update_dpp(0, v, 0x4E, 0xF, 0xF, true);
    v += __builtin_amdgcn_update_dpp(0, v, 0x141, 0xF, 0xF, true); v += __builtin_amdgcn_update_dpp(0, v, 0x140, 0xF, 0xF, true);
    return (unsigned)(__builtin_amdgcn_readlane(v, 0) + __builtin_amdgcn_readlane(v, 16) + __builtin_amdgcn_readlane(v, 32) + __builtin_amdgcn_readlane(v, 48));
}
DI unsigned fkey(float v) { unsigned u = __builtin_bit_cast(unsigned, v); if (u == 0x80000000u) u = 0u; return (u & 0x80000000u) ? ~u : (u | 0x80000000u); }
struct AttTile { bf16x8 kf[4]; bf16x8 vf[4]; unsigned mw; };
DI void att_load(AttTile& T, const bf16_t* kp, const bf16_t* vp, const unsigned* mp, int kt) {
#pragma unroll
    for (int s = 0; s < 4; ++s) T.kf[s] = *(const bf16x8*)(kp + ((size_t)kt * 4 + s) * 512);
#pragma unroll
    for (int s2 = 0; s2 < 2; ++s2) { const bf16_t* v = vp + ((size_t)kt * 4 + 2 * s2) * 512;
        T.vf[2 * s2 + 0] = *(const bf16x8*)(v); T.vf[2 * s2 + 1] = *(const bf16x8*)(v + 512); }
    T.mw = mp[kt];
}
DI void att_tile(const AttTile& T, const bf16x8 (&qf)[4], f32x16& o0, f32x16& o1, float& mrun, float& lrun, int hh) {
    f32x16 sa;
#pragma unroll
    for (int i = 0; i < 16; ++i) sa[i] = 0.f;
#pragma unroll
    for (int s = 0; s < 4; ++s) sa = MFMA32(T.kf[s], qf[s], sa);
    float mx = -1e30f;
#pragma unroll
    for (int i = 0; i < 16; ++i) { const int kr = (i & 3) + 8 * (i >> 2) + 4 * hh; const bool on = (T.mw >> kr) & 1u; sa[i] = on ? sa[i] : -1e30f; mx = fmaxf(mx, sa[i]); }
    mx = fmaxf(mx, __shfl_xor(mx, 32));
    const float mnew = fmaxf(mrun, mx);
    if (__any(mnew > mrun)) {
        const float alpha = __expf(mrun - mnew); lrun *= alpha;
#pragma unroll
        for (int i = 0; i < 16; ++i) { o0[i] *= alpha; o1[i] *= alpha; }
        mrun = mnew; }
    float p[16], ps = 0.f;
#pragma unroll
    for (int i = 0; i < 16; ++i) { p[i] = (sa[i] > -1e29f) ? __expf(sa[i] - mrun) : 0.f; ps += p[i]; }
    lrun += ps;
#pragma unroll
    for (int s2 = 0; s2 < 2; ++s2) {
        const bf16x8 pb = pack8(p[8 * s2], p[8 * s2 + 1], p[8 * s2 + 2], p[8 * s2 + 3], p[8 * s2 + 4], p[8 * s2 + 5], p[8 * s2 + 6], p[8 * s2 + 7]);
        o0 = MFMA32(T.vf[2 * s2], pb, o0); o1 = MFMA32(T.vf[2 * s2 + 1], pb, o1); }
}
DI void dsa_item(const Frame& F, unsigned char* ws, int item) {
    const bf16_t* Q = (const bf16_t*)(ws + WS_Q); const bf16_t* Kb = (const bf16_t*)(ws + WS_K); const bf16_t* VT = (const bf16_t*)(ws + WS_VT);
    const bf16_t* QI = (const bf16_t*)(ws + WS_QI); const bf16_t* KI = (const bf16_t*)(ws + WS_KI); const float* WI = (const float*)(ws + WS_WI);
    float* SC = (float*)(ws + WS_SC); unsigned* MASK = (unsigned*)(ws + WS_MASK); bf16_t* MIXp = (bf16_t*)(ws + WS_MIX);
    const int b = item >> 6, qb = item & 63, q0 = qb * 32, m0 = b * SEQ + q0;
    const int r = F.lane & 31, hh = F.lane >> 5;
    {
        float wv[4];
#pragma unroll
        for (int hd = 0; hd < 4; ++hd) wv[hd] = WI[(size_t)(m0 + r) * 4 + hd];
        LAS unsigned char* QL = F.lds;
#pragma unroll
        for (int k = 0; k < 2; ++k) { const int f = 2 * F.wave + k; *(LAS bf16x8*)(QL + f * 1024 + (r * 2 + hh) * 16) = *(const bf16x8*)(QI + (size_t)(m0 + r) * 256 + (f >> 2) * 64 + 16 * (f & 3) + 8 * hh); }
        __syncthreads();
        const LAS unsigned char* ql = QL + (r * 2 + hh) * 16;
        const bf16_t* kip = KI + ((size_t)b * 64 * 4 * 32 + r) * 16 + hh * 8;
        bf16x8 kf[4], kn[4];
        if (F.wave <= qb) {
#pragma unroll
            for (int s = 0; s < 4; ++s) kf[s] = *(const bf16x8*)(kip + ((size_t)F.wave * 4 + s) * 512); }
        for (int kt = F.wave; kt <= qb; kt += 8) {
            if (kt + 8 <= qb) {
#pragma unroll
                for (int s = 0; s < 4; ++s) kn[s] = *(const bf16x8*)(kip + ((size_t)(kt + 8) * 4 + s) * 512); }
            f32x16 sc;
#pragma unroll
            for (int i = 0; i < 16; ++i) sc[i] = 0.f;
#pragma unroll
            for (int hd = 0; hd < 4; ++hd) { f32x16 a; bf16x8 qf[4]; asm volatile("" ::: "memory");
#pragma unroll
                for (int s = 0; s < 4; ++s) qf[s] = *(const LAS bf16x8*)(ql + (hd * 4 + s) * 1024);
#pragma unroll
                for (int i = 0; i < 16; ++i) a[i] = 0.f;
#pragma unroll
                for (int s = 0; s < 4; ++s) a = MFMA32(kf[s], qf[s], a);
#pragma unroll
                for (int i = 0; i < 16; ++i) sc[i] += wv[hd] * fmaxf(a[i], 0.f); }
#pragma unroll
            for (int g = 0; g < 4; ++g) *(f32x4*)(SC + (size_t)(m0 + r) * SEQ + kt * 32 + 8 * g + 4 * hh) = (f32x4){sc[4 * g], sc[4 * g + 1], sc[4 * g + 2], sc[4 * g + 3]};
#pragma unroll
            for (int s = 0; s < 4; ++s) kf[s] = kn[s];
        }
    }
    VM_WAIT(); __syncthreads();
    for (int qq = 0; qq < 4; ++qq) {
        const int rq = F.wave * 4 + qq, t = q0 + rq, m = m0 + rq;
        unsigned* mrow = MASK + (size_t)m * 64;
        if (t + 1 <= 256) {
            for (int j = 0; j < 32; ++j) { const unsigned long long bm = __ballot(F.lane + 64 * j <= t); if (F.lane == 0) { mrow[2 * j] = (unsigned)bm; mrow[2 * j + 1] = (unsigned)(bm >> 32); } }
        } else {
            unsigned key[32];
#pragma unroll
            for (int j = 0; j < 32; ++j) { const int s = F.lane + 64 * j; const float sv = SC[(size_t)m * SEQ + s]; key[j] = __builtin_bit_cast(unsigned, sv); }
            __builtin_amdgcn_sched_barrier(0);
#pragma unroll
            for (int j = 0; j < 32; ++j) { const int s = F.lane + 64 * j; key[j] = (s <= t) ? fkey(__builtin_bit_cast(float, key[j])) : 0u; }
            unsigned T = 0u;
            const int jmax = t >> 6;
#pragma unroll 1
            for (int bit = 31; bit >= 0; --bit) { const unsigned cand = T | (1u << bit); unsigned cl0 = 0u, cl1 = 0u;
#pragma unroll
                for (int j0 = 0; j0 < 32; j0 += 8) { if (j0 <= jmax) {
#pragma unroll
                    for (int j = j0; j < j0 + 8; j += 4) { unsigned long long c0, c1, c2, c3;
                        asm("v_cmp_le_u32_e64 %2, %10, %6\n\tv_cmp_le_u32_e64 %3, %10, %7\n\tv_cmp_le_u32_e64 %4, %10, %8\n\tv_cmp_le_u32_e64 %5, %10, %9\n\t"
                            "v_addc_co_u32_e64 %0, %2, 0, %0, %2\n\tv_addc_co_u32_e64 %1, %3, 0, %1, %3\n\tv_addc_co_u32_e64 %0, %4, 0, %0, %4\n\tv_addc_co_u32_e64 %1, %5, 0, %1, %5"
                            : "+v"(cl0), "+v"(cl1), "=&s"(c0), "=&s"(c1), "=&s"(c2), "=&s"(c3) : "v"(key[j]), "v"(key[j + 1]), "v"(key[j + 2]), "v"(key[j + 3]), "s"(cand)); }
                    __builtin_amdgcn_sched_barrier(0); } }
                unsigned cl = cl0 + cl1;
                asm("s_nop 1" : "+v"(cl));
                const int cnt = (int)wave_sum_u32(cl);
                if (cnt >= 256) T = cand;
                if (cnt == 256) break; }
            unsigned cg = 0u;
#pragma unroll
            for (int j = 0; j < 32; ++j) cg += (key[j] > T) ? 1u : 0u;
            const int cgt = (int)wave_sum_u32(cg);
            const int need = 256 - cgt; int run = 0;
            const unsigned long long lt = (1ull << F.lane) - 1ull;
#pragma unroll
            for (int j = 0; j < 32; ++j) {
                const unsigned long long eq = __ballot(key[j] == T), gt = __ballot(key[j] > T);
                const int pre = run + __popcll(eq & lt);
                const unsigned long long se = __ballot(key[j] == T && pre < need);
                const unsigned long long bm = gt | se; run += __popcll(eq);
                if (F.lane == 0) { mrow[2 * j] = (unsigned)bm; mrow[2 * j + 1] = (unsigned)(bm >> 32); }
                if ((j & 3) == 3) __builtin_amdgcn_sched_barrier(0); }
        }
    }
    VM_WAIT(); __syncthreads();
    {
        const int hd = F.wave;
        bf16x8 qf[4];
#pragma unroll
        for (int s = 0; s < 4; ++s) qf[s] = *(const bf16x8*)(Q + (size_t)(m0 + r) * 512 + hd * 64 + 16 * s + 8 * hh);
        f32x16 o0, o1;
#pragma unroll
        for (int i = 0; i < 16; ++i) { o0[i] = 0.f; o1[i] = 0.f; }
        float mrun = -1e30f, lrun = 0.f;
        const bf16_t* kp = Kb + ((size_t)(b * 8 + hd) * 64 * 4 * 32 + r) * 16 + hh * 8;
        const bf16_t* vp = VT + ((size_t)(b * 8 + hd) * 64 * 4 * 32 + r) * 16 + hh * 8;
        const unsigned* mp = MASK + (size_t)(m0 + r) * 64;
        AttTile A, B, C;
        att_load(A, kp, vp, mp, 0);
        if (1 <= qb) att_load(B, kp, vp, mp, 1);
        for (int kt = 0; kt <= qb; kt += 3) {
            if (kt + 2 <= qb) att_load(C, kp, vp, mp, kt + 2);
            att_tile(A, qf, o0, o1, mrun, lrun, hh);
            if (kt + 1 <= qb) {
                if (kt + 3 <= qb) att_load(A, kp, vp, mp, kt + 3);
                att_tile(B, qf, o0, o1, mrun, lrun, hh);
                if (kt + 2 <= qb) {
                    if (kt + 4 <= qb) att_load(B, kp, vp, mp, kt + 4);
                    att_tile(C, qf, o0, o1, mrun, lrun, hh); } }
        }
        const float inv = 1.0f / (lrun + __shfl_xor(lrun, 32));
        bf16_t* orow = MIXp + (size_t)(m0 + r) * (4 * MIX) + hd * 64;
#pragma unroll
        for (int g = 0; g < 4; ++g) {
            u32x2 w0; w0.x = pk2(o0[4 * g] * inv, o0[4 * g + 1] * inv); w0.y = pk2(o0[4 * g + 2] * inv, o0[4 * g + 3] * inv);
            u32x2 w1; w1.x = pk2(o1[4 * g] * inv, o1[4 * g + 1] * inv); w1.y = pk2(o1[4 * g + 2] * inv, o1[4 * g + 3] * inv);
            *(u32x2*)(orow + 8 * g + 4 * hh) = w0; *(u32x2*)(orow + 32 + 8 * g + 4 * hh) = w1; }
    }
    __syncthreads();
}

DI float siluf_(float x) { return x * sigmoidf_(x); }
DI void conv_phase(const Frame& F, unsigned char* ws, const In& in, int l) {
    const bf16_t* U = (const bf16_t*)(ws + WS_U); bf16_t* ACT = (bf16_t*)(ws + WS_ACT);
    const float* cw = in[33] + (size_t)l * 3 * DFF2; const float* cb = in[34] + (size_t)l * DFF2;
    constexpr int NCG = DFF / 8;
    const long total = (long)NCG * (MTOK / 32);
    for (long e = (long)F.bid * NTHR + F.tid; e < total; e += (long)F.G * NTHR) {
        const int cg = (int)(e % NCG), tg = (int)(e / NCG); const int f0 = cg * 8, m0 = tg * 32; const bool first = (m0 % SEQ) == 0;
        float wg[3][8], wv[3][8], bg[8], bv[8];
#pragma unroll
        for (int j = 0; j < 3; ++j)
#pragma unroll
            for (int i = 0; i < 8; ++i) { wg[j][i] = cw[(size_t)j * DFF2 + f0 + i]; wv[j][i] = cw[(size_t)j * DFF2 + DFF + f0 + i]; }
#pragma unroll
        for (int i = 0; i < 8; ++i) { bg[i] = cb[f0 + i]; bv[i] = cb[DFF + f0 + i]; }
        float g1[8], g2[8], v1[8], v2[8];
#pragma unroll
        for (int i = 0; i < 8; ++i) { g1[i] = 0.f; g2[i] = 0.f; v1[i] = 0.f; v2[i] = 0.f; }
        if (!first) {
            const u32x4 a = *(const u32x4*)(U + (size_t)(m0 - 1) * DFF2 + f0), b = *(const u32x4*)(U + (size_t)(m0 - 2) * DFF2 + f0);
            const u32x4 c = *(const u32x4*)(U + (size_t)(m0 - 1) * DFF2 + DFF + f0), d = *(const u32x4*)(U + (size_t)(m0 - 2) * DFF2 + DFF + f0);
#pragma unroll
            for (int i = 0; i < 4; ++i) { g1[2 * i] = bf2f(a[i] & 0xffffu); g1[2 * i + 1] = bf2f(a[i] >> 16); g2[2 * i] = bf2f(b[i] & 0xffffu); g2[2 * i + 1] = bf2f(b[i] >> 16);
                v1[2 * i] = bf2f(c[i] & 0xffffu); v1[2 * i + 1] = bf2f(c[i] >> 16); v2[2 * i] = bf2f(d[i] & 0xffffu); v2[2 * i + 1] = bf2f(d[i] >> 16); }
        }
        u32x4 ua[4], uc[4];
#pragma unroll
        for (int q = 0; q < 4; ++q) { ua[q] = *(const u32x4*)(U + (size_t)(m0 + q) * DFF2 + f0); uc[q] = *(const u32x4*)(U + (size_t)(m0 + q) * DFF2 + DFF + f0); }
#pragma unroll 1
        for (int tb = 0; tb < 8; ++tb) {
            u32x4 na[4], nc[4];
            const int tn = tb < 7 ? 4 * tb + 4 : 4 * tb;
#pragma unroll
            for (int q = 0; q < 4; ++q) { na[q] = *(const u32x4*)(U + (size_t)(m0 + tn + q) * DFF2 + f0); nc[q] = *(const u32x4*)(U + (size_t)(m0 + tn + q) * DFF2 + DFF + f0); }
            __builtin_amdgcn_sched_barrier(0);
#pragma unroll
            for (int q = 0; q < 4; ++q) { const int t = 4 * tb + q; const u32x4 a = ua[q], c = uc[q];
                float g0[8], v0[8], o[8];
#pragma unroll
                for (int i = 0; i < 4; ++i) { g0[2 * i] = bf2f(a[i] & 0xffffu); g0[2 * i + 1] = bf2f(a[i] >> 16); v0[2 * i] = bf2f(c[i] & 0xffffu); v0[2 * i + 1] = bf2f(c[i] >> 16); }
#pragma unroll
                for (int i = 0; i < 8; ++i) { const float gc = bg[i] + wg[0][i] * g2[i] + wg[1][i] * g1[i] + wg[2][i] * g0[i]; const float vc = bv[i] + wv[0][i] * v2[i] + wv[1][i] * v1[i] + wv[2][i] * v0[i];
                    o[i] = siluf_(gc) * vc; g2[i] = g1[i]; g1[i] = g0[i]; v2[i] = v1[i]; v1[i] = v0[i]; }
                u32x4 w; w.x = pk2(o[0], o[1]); w.y = pk2(o[2], o[3]); w.z = pk2(o[4], o[5]); w.w = pk2(o[6], o[7]);
                *(u32x4*)(ACT + (size_t)(m0 + t) * DFF + f0) = w; }
            __builtin_amdgcn_sched_barrier(0);
#pragma unroll
            for (int q = 0; q < 4; ++q) { ua[q] = na[q]; uc[q] = nc[q]; }
        }
    }
}

DI void final_phase(const Frame& F, unsigned char* ws, const float* gfin, float* out) {
    const float* Y = (const float*)(ws + WS_Y); const float* part = (const float*)(ws + WS_PARTA);
    const int gw = F.bid * NWAVES + F.wave, NGW = F.G * NWAVES;
    f32x4 gv[8];
#pragma unroll
    for (int j = 0; j < 8; ++j) gv[j] = *(const f32x4*)(gfin + (j * 64 + F.lane) * 4);
    for (int m0 = gw; m0 < MTOK; m0 += 2 * NGW) {
        f32x4 yv[2][8]; float pv[2];
#pragma unroll
        for (int k = 0; k < 2; ++k) { const int m = (m0 + k * NGW) < MTOK ? m0 + k * NGW : m0;
            pv[k] = part[(size_t)m * 32 + (F.lane & 31)];
#pragma unroll
            for (int j = 0; j < 8; ++j) yv[k][j] = *(const f32x4*)(Y + (size_t)m * DM + (j * 64 + F.lane) * 4); }
        __builtin_amdgcn_sched_barrier(0);
#pragma unroll
        for (int k = 0; k < 2; ++k) { const int m = m0 + k * NGW;
            float s = (F.lane < 32) ? pv[k] : 0.f; s = wave_sum(s);
            const float rs = 1.0f / sqrtf(s * (1.0f / DM) + RMS_EPS);
            if (m < MTOK) {
#pragma unroll
                for (int j = 0; j < 8; ++j) *(f32x4*)(out + (size_t)m * DM + (j * 64 + F.lane) * 4) = yv[k][j] * rs * gv[j]; } }
        __builtin_amdgcn_sched_barrier(0);
    }
}

struct Args { InTab in; float* out; unsigned char* ws; int ph_lo, ph_hi; };
constexpr int ZG1_UNITS = 24 * 32, ZG2_UNITS = 28 * 32;
constexpr int PH_PER_LAYER = 9, N_PHASES = 1 + NL * PH_PER_LAYER + 1;

__global__ void __launch_bounds__(NTHR, 2) hybrid_fwd(Args args) {
    extern __shared__ __attribute__((aligned(16))) unsigned char lds_raw[];
    Frame F0; F0.lds = (LAS unsigned char*)lds_raw; F0.tid = threadIdx.x; F0.lane = F0.tid & 63; F0.wave = __builtin_amdgcn_readfirstlane(F0.tid >> 6); F0.bid = blockIdx.x; F0.G = gridDim.x;
    unsigned char* ws0 = args.ws; In in0; in0.t = (CAS const gfptr_t*)__builtin_amdgcn_kernarg_segment_ptr();
    const int lo = args.ph_lo, hi = args.ph_hi;
    volatile LAS unsigned* MISC = (volatile LAS unsigned*)(F0.lds + MISC_OFF);
    if (F0.tid < 16) MISC[F0.tid] = 0u;
    __syncthreads();
    XcdBarrier bar; bar.bar = (unsigned*)(ws0 + WS_CTL) + CW_BAR; bar.x = 0; bar.st = nullptr;
    const bool multi = (hi - lo) > 1;
    if (multi) bar = xcd_barrier_post((unsigned*)(ws0 + WS_CTL) + CW_BAR, MISC + 8);
#ifndef SUBMASK
#define SUBMASK 7
#endif
#ifndef DUPSUB
#define DUPSUB 0
#endif
#ifndef DUPMASK
#define DUPMASK 0u
#endif
#define NREP(j) (((DUPMASK >> (j)) & 1u) ? 2 : 1)
#ifndef PHMASK
#define PHMASK 0xFFFFFFFFu
#endif
#define IN_PH(k) (lo <= (k) && (k) < hi)
#define ON(j) ((PHMASK >> (j)) & 1u)
#define LAYER_PTRS unsigned char* wt = ws + WS_WT + (size_t)l * WT_LAYER; float* Y = (float*)(ws + WS_Y); bf16_t* YB = (bf16_t*)(ws + WS_YB); float* PA = (float*)(ws + WS_PARTA); float* PB = (float*)(ws + WS_PARTB); const LAS float* rsT = (const LAS float*)(F.lds + RST_OFF); (void)wt; (void)Y; (void)YB; (void)PA; (void)PB; (void)rsT;
#define SEAM(k) do { if (IN_PH(k) && IN_PH((k) + 1)) xcd_barrier(bar); } while (0)

    if (ON(0) && IN_PH(0)) for (int rep = 0; rep < NREP(0); ++rep) { if (rep) xcd_barrier(bar); const In in = in_fresh(in0); const Frame F = fresh(F0); unsigned char* ws = fresh_ptr(ws0); p0_prologue(F, in, ws); }
    SEAM(0);

    for (int l = 0; l < NL; ++l) {
        const int pb = 1 + l * PH_PER_LAYER;
        if (ON(1) && IN_PH(pb + 0)) for (int rep = 0; rep < NREP(1); ++rep) { if (rep) xcd_barrier(bar); const In in = in_fresh(in0); const Frame F = fresh(F0); unsigned char* ws = fresh_ptr(ws0); LAYER_PTRS
            pg8::Gemm g{YB, (const bf16_t*)(wt + WT_IN), DM, DM, DM}; const pg8::OrderLin S{F.bid, F.G, ZG1_UNITS, 0, DM, DM};
            pg8::Unit u0; int pm0 = -1; if (S.next(0, u0)) pm0 = u0.pm;
            if (pm0 >= 0) rs_table(F, PA, pm0); else __syncthreads();
            pg8::EpiZ E{(bf16_t*)(ws + WS_ZS), (bf16_t*)(ws + WS_G), in[4] + (size_t)l * GCOLS, PA, rsT, pm0};
            pg8::gemm_phase<pg8::EpiZ, pg8::OrderLin, true>(F.lds, F.tid, g, S, E);
        }
        SEAM(pb + 0);
        if (ON(2) && IN_PH(pb + 1)) for (int rep = 0; rep < NREP(2); ++rep) { if (rep) xcd_barrier(bar); const In in = in_fresh(in0); const Frame F = fresh(F0); unsigned char* ws = fresh_ptr(ws0); LAYER_PTRS
            { float* RSg = (float*)(ws + WS_RS);
              for (int m = F.bid * NTHR + F.tid; m < MTOK; m += F.G * NTHR) { float sq = 0.f;
#pragma unroll
                  for (int i = 0; i < 8; ++i) { const f32x4 v = *(const f32x4*)(PA + (size_t)m * 32 + 4 * i); sq += (v[0] + v[1]) + (v[2] + v[3]); }
                  RSg[m] = 1.0f / sqrtf(sq * (1.0f / DM) + RMS_EPS); } }
            for (int it = F.bid; it < 768; it += F.G) {
                if (it < 256) { dsa_prep_item(F, ws, in[5] + l * 64, it); if (DUPSUB & 64) dsa_prep_item(F, ws, in[5] + l * 64, it); }
                else if (it < 512) { rwkv_prep_item(F, ws, in, l, it - 256); if (DUPSUB & 16) rwkv_prep_item(F, ws, in, l, it - 256); }
                else { pool_item(F, ws, in, l, it - 512); if (DUPSUB & 32) pool_item(F, ws, in, l, it - 512); }
            }
        }
        SEAM(pb + 1);
        if (ON(3) && IN_PH(pb + 2)) for (int rep = 0; rep < NREP(3); ++rep) { if (rep) xcd_barrier(bar); const In in = in_fresh(in0); const Frame F = fresh(F0); unsigned char* ws = fresh_ptr(ws0); LAYER_PTRS
            constexpr int NRW = 64, NSS = 8;
            if (SUBMASK & 1) { const Frame Fa = fresh(F0);
                for (int it = Fa.bid; it < NRW; it += Fa.G) { rwkv_scan_item(Fa, ws, it); if (DUPSUB & 1) rwkv_scan_item(Fa, ws, it); } }
            if (SUBMASK & 4) { const Frame Fc = fresh(F0);
                if (Fc.G >= NRW + NSS) { const int it = Fc.bid - NRW; if (it >= 0 && it < NSS) { ssm_seq_item(Fc, fresh_ptr(ws0), in_fresh(in0), l, it); if (DUPSUB & 4) ssm_seq_item(Fc, fresh_ptr(ws0), in_fresh(in0), l, it); } }
                else for (int it = Fc.bid; it < NSS; it += Fc.G) ssm_seq_item(Fc, fresh_ptr(ws0), in_fresh(in0), l, it);
                __syncthreads(); }
            if (SUBMASK & 2) { const Frame Fb = fresh(F0);
                if (Fb.G > NRW + NSS) { const int nb = Fb.G - NRW - NSS, b0 = Fb.bid - NRW - NSS;
                    if (b0 >= 0) { if (b0 < 256) { const int b = b0 & 3, qb = 63 - (b0 >> 2); dsa_item(Fb, ws, b * 64 + qb); }
                        const int it2 = nb + (nb - 1 - b0);
                        if (it2 >= nb && it2 < 256) { const int b = it2 & 3, qb = 63 - (it2 >> 2); dsa_item(Fb, ws, b * 64 + qb); }
                        for (int it = b0 + 2 * nb; it < 256; it += nb) { const int b = it & 3, qb = 63 - (it >> 2); dsa_item(Fb, ws, b * 64 + qb); } } }
                else for (int it = Fb.bid; it < 256; it += Fb.G) { const int b = it & 3, qb = 63 - (it >> 2); dsa_item(Fb, ws, b * 64 + qb); } }
            { const Frame Fd = fresh(F0); unsigned char* wsd = fresh_ptr(ws0); const In ind = in_fresh(in0);
                unsigned char* wtd = wsd + WS_WT + (size_t)l * WT_LAYER;
                pg8::Gemm g{(const bf16_t*)(wsd + WS_YB), (const bf16_t*)(wtd + WT_IN), DM, DM, DM};
                const int xg = Fd.bid & 7;
                const pg8::OrderQueue S{(unsigned*)(wsd + WS_CTL) + CW_QUEUE + 64 * (l * 8 + xg), (volatile LAS unsigned*)(Fd.lds + MISC_OFF + 64), Fd.tid, ZG2_UNITS / 8, 24, DM, DM, xg};
                S.setup();
                pg8::EpiZq E{(bf16_t*)(wsd + WS_ZS), (bf16_t*)(wsd + WS_G), ind[4] + (size_t)l * GCOLS, (const float*)(wsd + WS_RS)};
                pg8::gemm_phase<pg8::EpiZq, pg8::OrderQueue, true>(Fd.lds, Fd.tid, g, S, E);
                conv_w_drain(fresh(F0), in_fresh(in0), fresh_ptr(ws0), l + 1, CV_S1, CV_S2, 0); }
        }
        SEAM(pb + 2);
        if (ON(4) && IN_PH(pb + 3)) for (int rep = 0; rep < NREP(4); ++rep) { if (rep) xcd_barrier(bar); const In in = in_fresh(in0); const Frame F = fresh(F0); unsigned char* ws = fresh_ptr(ws0); LAYER_PTRS
            pg8::Gemm g{(const bf16_t*)(ws + WS_YSB), (const bf16_t*)(wt + WT_GLU), MIX, MIX, MIX}; pg8::Order S; S.init(MTOK / 256, MIX / 256, F.G, F.bid, MIX, MIX);
            pg8::EpiGlu E{(const bf16_t*)(ws + WS_YSB), in[28] + l * MIX, (bf16_t*)(ws + WS_MIX)};
            pg8::gemm_phase<pg8::EpiGlu, pg8::Order, true>(F.lds, F.tid, g, S, E);
            { const Frame Fp = fresh(F0); const int ng = (Fp.G > 64) ? 64 : 0;
              if (Fp.bid >= ng) rwkv_post_rows(Fp, fresh_ptr(ws0), in_fresh(in0), l, (Fp.bid - ng) * NWAVES + Fp.wave, (Fp.G - ng) * NWAVES); }
            { const Frame Fv = fresh(F0); conv_w_drain(Fv, in_fresh(in0), fresh_ptr(ws0), l + 1, CV_S2, CV_S3, 1); conv_w_drain(Fv, in_fresh(in0), fresh_ptr(ws0), l + 1, CV_S4, CV_LAYER, 3); }
        }
        SEAM(pb + 3);
        if (ON(5) && IN_PH(pb + 4)) for (int rep = 0; rep < NREP(5); ++rep) { if (rep) xcd_barrier(bar); const In in = in_fresh(in0); const Frame F = fresh(F0); unsigned char* ws = fresh_ptr(ws0); LAYER_PTRS
            pg8::Gemm g{(const bf16_t*)(ws + WS_MIX), (const bf16_t*)(wt + WT_BR), 4 * MIX, MIX, MIX}; pg8::Order S; S.init(MTOK / 256, DM / 256, F.G, F.bid, 4 * MIX, MIX, 4, MIX, DM);
            pg8::EpiMerge E{(const bf16_t*)(ws + WS_G), (bf16_t*)(ws + WS_MF), (bf16_t*)(ws + WS_MERGED)};
            pg8::gemm_phase<pg8::EpiMerge, pg8::Order, true>(F.lds, F.tid, g, S, E);
        }
        SEAM(pb + 4);
        if (ON(6) && IN_PH(pb + 5)) for (int rep = 0; rep < NREP(6); ++rep) { if (rep) xcd_barrier(bar); const In in = in_fresh(in0); const Frame F = fresh(F0); unsigned char* ws = fresh_ptr(ws0); LAYER_PTRS
            pg8::Gemm g{(const bf16_t*)(ws + WS_MERGED), (const bf16_t*)(wt + WT_OUT), DM, DM, DM}; pg8::Order S; S.init(MTOK / 256, DM / 256, F.G, F.bid, DM, DM);
            pg8::EpiRes E{l == 0 ? in[0] : Y, Y, YB, PB};
            pg8::gemm_phase<pg8::EpiRes, pg8::Order, true>(F.lds, F.tid, g, S, E);
        }
        SEAM(pb + 5);
        if (ON(7) && IN_PH(pb + 6)) for (int rep = 0; rep < NREP(7); ++rep) { if (rep) xcd_barrier(bar); const In in = in_fresh(in0); const Frame F = fresh(F0); unsigned char* ws = fresh_ptr(ws0); LAYER_PTRS
            pg8::Gemm g{YB, (const bf16_t*)(wt + WT_UP), DM, DM, DM}; pg8::Order S; S.init(MTOK / 256, DFF2 / 256, F.G, F.bid, DM, DM);
            pg8::Unit u0; int pm0 = -1; if (S.next(0, u0)) pm0 = u0.pm;
            if (pm0 >= 0) rs_table(F, PB, pm0); else __syncthreads();
            pg8::EpiU E{(bf16_t*)(ws + WS_U), DFF2, PB, rsT, pm0};
            pg8::gemm_phase<pg8::EpiU, pg8::Order, true>(F.lds, F.tid, g, S, E);
            conv_w_drain(fresh(F0), in_fresh(in0), fresh_ptr(ws0), l + 1, CV_S3, CV_S4, 2);
        }
        SEAM(pb + 6);
        if (ON(8) && IN_PH(pb + 7)) for (int rep = 0; rep < NREP(8); ++rep) { if (rep) xcd_barrier(bar); const In in = in_fresh(in0); const Frame F = fresh(F0); unsigned char* ws = fresh_ptr(ws0); LAYER_PTRS conv_phase(F, ws, in, l); }
        SEAM(pb + 7);
        if (ON(9) && IN_PH(pb + 8)) for (int rep = 0; rep < NREP(9); ++rep) { if (rep) xcd_barrier(bar); const In in = in_fresh(in0); const Frame F = fresh(F0); unsigned char* ws = fresh_ptr(ws0); LAYER_PTRS
            pg8::Gemm g{(const bf16_t*)(ws + WS_ACT), (const bf16_t*)(wt + WT_DOWN), DFF, DFF, DFF}; pg8::Order S; S.init(MTOK / 256, DM / 256, F.G, F.bid, DFF, DFF);
            pg8::EpiRes E{Y, Y, YB, PA};
            pg8::gemm_phase<pg8::EpiRes, pg8::Order, true>(F.lds, F.tid, g, S, E);
        }
        SEAM(pb + 8);
    }
    if (ON(10) && IN_PH(N_PHASES - 1)) { const In in = in_fresh(in0); const Frame F = fresh(F0); unsigned char* ws = fresh_ptr(ws0); final_phase(F, ws, in[36], args.out); }
#ifdef DBG_STOP
    if (lo == 100) { const Frame F = fresh(F0); unsigned char* ws = fresh_ptr(ws0);
        for (size_t e = (size_t)F.bid * NTHR + F.tid; e < (size_t)MTOK * DM; e += (size_t)F.G * NTHR) {
            const int m = (int)(e / DM), c = (int)(e % DM); float v;
            if (DBG_BUF == 0) v = bf2f(((const bf16_t*)(ws + WS_MIX))[e]);
            else if (DBG_BUF == 1) v = ((const float*)(ws + WS_ZS))[(size_t)m * ZS_COLS + c];
            else if (DBG_BUF == 2) v = ((const float*)(ws + WS_ZS))[(size_t)m * ZS_COLS + 2048 + c];
            else if (DBG_BUF == 3) v = bf2f(((const bf16_t*)(ws + WS_G))[(size_t)m * GCOLS + c]);
            else if (DBG_BUF == 4) v = ((const float*)(ws + WS_Y))[e];
            else v = bf2f(((const bf16_t*)(ws + WS_MERGED))[e]);
            args.out[e] = v; } }
#endif
#undef IN_PH
#undef SEAM
}

extern "C" void kernel_launch(void* const* d_in, const int* in_sizes, int n_in, void* d_out, int out_size, void* d_ws, size_t ws_size, hipStream_t stream) {
    static int grid = 0;
    if (grid == 0) {
        if (n_in != 37 || out_size != MTOK * DM || ws_size < WS_END) { fprintf(stderr, "kernel_launch: unexpected problem (n_in %d, out %d, ws %zu < %zu)\n", n_in, out_size, ws_size, (size_t)WS_END); grid = -1; return; }
        int dev = 0, cus = 0, per_cu = 0;
        if (hipGetDevice(&dev) != hipSuccess || hipDeviceGetAttribute(&cus, hipDeviceAttributeMultiprocessorCount, dev) != hipSuccess) { grid = -1; return; }
        if (hipFuncSetAttribute((const void*)hybrid_fwd, hipFuncAttributeMaxDynamicSharedMemorySize, LDS_BYTES) != hipSuccess) { fprintf(stderr, "kernel_launch: hipFuncSetAttribute failed\n"); grid = -1; return; }
        if (hipOccupancyMaxActiveBlocksPerMultiprocessor(&per_cu, (const void*)hybrid_fwd, NTHR, LDS_BYTES) != hipSuccess || per_cu < 1) fprintf(stderr, "kernel_launch: occupancy query says %d\n", per_cu);
        (void)hipGetLastError();
        grid = cus >= 256 ? 256 : cus;
    }
    if (grid < 0) return;
    (void)hipMemsetAsync((char*)d_ws + WS_CTL, 0, CTL_ZERO_BYTES, stream);
    Args a{};
    for (int i = 0; i < 37; ++i) a.in.p[i] = (const float*)d_in[i];
    a.out = (float*)d_out; a.ws = (unsigned char*)d_ws;
#ifdef DBG_STOP
    for (int k = 0; k < DBG_STOP; ++k) { a.ph_lo = k; a.ph_hi = k + 1; hipLaunchKernelGGL(hybrid_fwd, dim3(grid), dim3(NTHR), LDS_BYTES, stream, a); }
    a.ph_lo = 100; a.ph_hi = 101; hipLaunchKernelGGL(hybrid_fwd, dim3(grid), dim3(NTHR), LDS_BYTES, stream, a);
#elif MK_N_LAUNCHES == 1
    a.ph_lo = 0; a.ph_hi = N_PHASES;
    hipLaunchKernelGGL(hybrid_fwd, dim3(grid), dim3(NTHR), LDS_BYTES, stream, a);
#else
    for (int k = 0; k < N_PHASES; ++k) { a.ph_lo = k; a.ph_hi = k + 1; hipLaunchKernelGGL(hybrid_fwd, dim3(grid), dim3(NTHR), LDS_BYTES, stream, a); }
#endif
}
```

```cpp
#include <hip/hip_runtime.h>
#include <cstdio>
#include <cstdint>

#ifndef MK_N_LAUNCHES
#define MK_N_LAUNCHES 1
#endif

#define LAS __attribute__((address_space(3)))
#define GAS __attribute__((address_space(1)))
typedef unsigned short bf16_t;
typedef short bf16x8 __attribute__((ext_vector_type(8)));
typedef short s16x4 __attribute__((ext_vector_type(4)));
typedef float f32x4 __attribute__((ext_vector_type(4)));
typedef float f32x2 __attribute__((ext_vector_type(2)));
typedef float f32x16 __attribute__((ext_vector_type(16)));
typedef unsigned u32x4 __attribute__((ext_vector_type(4)));
typedef unsigned u32x2 __attribute__((ext_vector_type(2)));
#define DI __device__ __forceinline__

constexpr int NB = 4, SEQ = 2048, DM = 2048, MTOK = NB * SEQ, NL = 4, MIX = 512, DFF = 5504, DFF2 = 2 * DFF;
constexpr int IN_COLS = 13060, NZ = 13312, ZS_COLS = 5120, GCOLS = 8192;
constexpr int B_COLS = 1984;
constexpr int ZO_R = 0, ZO_K = 512, ZO_V = 1024, ZO_LW = 1536, ZO_LA = 1632, ZO_LG = 1728;
constexpr int ZO_Q = 2048, ZO_AK = 2560, ZO_AV = 3072, ZO_QI = 3584, ZO_KI = 3840, ZO_WI = 3904, ZO_C = 4096, ZO_D = 4608;
constexpr float RMS_EPS = 1e-6f, GN_EPS = 64e-5f;

constexpr size_t MiB = 1u << 20;
constexpr size_t WS_CTL = 0, CTL_ZERO_BYTES = 1 * MiB;
constexpr size_t WS_ROPE = 1 * MiB;
constexpr size_t WS_PARTA = 2 * MiB;
constexpr size_t WS_PARTB = 3 * MiB;
constexpr size_t WS_SSTATE = 4 * MiB;
constexpr size_t WS_WI = 5 * MiB;
constexpr size_t WS_RS = 5 * MiB + 256 * 1024;
constexpr size_t WS_KI = 6 * MiB;
constexpr size_t WS_MASK = 7 * MiB;
constexpr size_t WS_QI = 9 * MiB;
constexpr size_t WS_Q = 13 * MiB;
constexpr size_t WS_K = 21 * MiB;
constexpr size_t WS_VT = 29 * MiB;
constexpr size_t WS_Y = 37 * MiB;
constexpr size_t WS_YB = 101 * MiB;
constexpr size_t WS_MIX = 133 * MiB;
constexpr size_t WS_MERGED = 165 * MiB;
constexpr size_t WS_YS = 197 * MiB;
constexpr size_t WS_YSB = 213 * MiB;
constexpr size_t WS_RW = 221 * MiB;
constexpr size_t RW_STRIDE = 16 * MiB;
constexpr size_t WS_SC = 333 * MiB;
constexpr size_t WS_MF = 1368 * MiB;
constexpr size_t WS_ZS = 461 * MiB;
constexpr size_t WS_G = 621 * MiB;
constexpr size_t WS_U = 461 * MiB;
constexpr size_t WS_ACT = 749 * MiB;
constexpr size_t WS_WT = 836 * MiB;
constexpr size_t WT_IN = 0, WT_BR = 52 * MiB, WT_OUT = 60 * MiB, WT_UP = 68 * MiB, WT_DOWN = 111 * MiB, WT_GLU = 111 * MiB + 22544384, WT_LAYER = 133 * MiB;
constexpr size_t WS_YRAW = WS_MF + 192 * MiB;
constexpr size_t WS_WTL = WS_YRAW + 16 * MiB;
constexpr size_t WS_WTP = WS_WTL + 2 * MiB;
constexpr size_t WS_END = WS_WTP + 1 * MiB;
static_assert(WS_WT + 4 * WT_LAYER == WS_MF, "ws map");
static_assert(WT_GLU + 524288 <= WT_LAYER, "wt map");
static_assert(WS_U + (size_t)MTOK * DFF2 * 2 <= WS_ACT && WS_ACT + (size_t)MTOK * DFF * 2 <= WS_WT, "ws map");

constexpr int CW_BAR = 4096;
constexpr int CW_CONV = 12288;
constexpr int CW_QUEUE = 8192;

constexpr int RING_BYTES = 131072;
constexpr int MISC_OFF = RING_BYTES;
constexpr int RST_OFF = RING_BYTES + 1024;
constexpr int LDS_BYTES = 147456;
constexpr int NWAVES = 8, NTHR = 512;

DI unsigned f2bf(float f) { unsigned u = __builtin_bit_cast(unsigned, f); return (u + 0x7fffu + ((u >> 16) & 1u)) >> 16; }
DI unsigned cvt_pk_bf16(float lo, float hi);
DI unsigned pk2(float lo, float hi) { return cvt_pk_bf16(lo, hi); }
DI float bf2f(unsigned b) { return __builtin_bit_cast(float, b << 16); }
typedef __bf16 bf16x2v __attribute__((ext_vector_type(2)));
DI unsigned cvt_pk_bf16(float lo, float hi) { const f32x2 v = {lo, hi}; const bf16x2v b = __builtin_convertvector(v, bf16x2v); return __builtin_bit_cast(unsigned, b); }
DI float wave_sum(float v) {
#pragma unroll
    for (int o = 1; o < 64; o <<= 1) v += __shfl_xor(v, o);
    return v;
}
template <int CTRL> DI float dpp_xadd(float x) { const int r = __builtin_amdgcn_update_dpp(0, __builtin_bit_cast(int, x), CTRL, 0xF, 0xF, true); return x + __builtin_bit_cast(float, r); }
DI float row16_sum(float x) { x = dpp_xadd<0xB1>(x); x = dpp_xadd<0x4E>(x); x = dpp_xadd<0x141>(x); x = dpp_xadd<0x140>(x); return x; }
DI bf16x8 pack8(float a0, float a1, float a2, float a3, float a4, float a5, float a6, float a7) {
    u32x4 p; p.x = pk2(a0, a1); p.y = pk2(a2, a3); p.z = pk2(a4, a5); p.w = pk2(a6, a7); return __builtin_bit_cast(bf16x8, p); }
DI f32x4 ld4bf(const bf16_t* p) { const u32x2 w = *(const u32x2*)p; return (f32x4){bf2f(w.x & 0xffffu), bf2f(w.x >> 16), bf2f(w.y & 0xffffu), bf2f(w.y >> 16)}; }
DI float sigmoidf_(float x) { return __builtin_amdgcn_rcpf(1.0f + __expf(-x)); }
#define LDS_WAIT() asm volatile("s_waitcnt lgkmcnt(0)" ::: "memory")
#define VM_WAIT() asm volatile("s_waitcnt vmcnt(0)" ::: "memory")
#define MFMA32(a, b, c) __builtin_amdgcn_mfma_f32_32x32x16_bf16((a), (b), (c), 0, 0, 0)

#define XB_TMO      128
#define XB_XCNT(j)  (256  + 64 * (j))
#define XB_XSUB(j)  (1280 + 64 * (j))
#define XB_XGEN(j)  (2304 + 64 * (j))
#define XB_TOP      3328
#define XB_TOPGEN   3392
#define XCD_BAR_WORDS 3456
#define XB_SPIN_CAP (1u << 21)
DI unsigned xb_ld(unsigned* p)              { return __hip_atomic_load(p, __ATOMIC_RELAXED, __HIP_MEMORY_SCOPE_AGENT); }
DI unsigned xb_add(unsigned* p, unsigned v) { return __hip_atomic_fetch_add(p, v, __ATOMIC_RELAXED, __HIP_MEMORY_SCOPE_AGENT); }
DI unsigned xb_xcc_id() { return (unsigned)__builtin_amdgcn_s_getreg((3 << 11) | 20) & 0xFu; }
#define XB_SPIN(cond, bar) do { unsigned _sp = 0; while (cond) { __builtin_amdgcn_s_sleep(1); \
    if ((++_sp & 255u) == 0u) { if (xb_ld(&(bar)[XB_TMO])) break; if (_sp > XB_SPIN_CAP) { atomicAdd(&(bar)[XB_TMO], 1u); break; } } } } while (0)
struct XcdBarrier { unsigned* bar; unsigned x; volatile LAS unsigned* st; };
DI XcdBarrier xcd_barrier_post(unsigned* bar, volatile LAS unsigned* st) {
    XcdBarrier b; b.bar = bar; b.x = xb_xcc_id(); b.st = st;
    if (threadIdx.x == 0) (void)xb_add(&bar[XB_XCNT(b.x)], 1u);
    return b;
}
DI void xcd_barrier_complete(unsigned* bar, unsigned x, unsigned& nloc, unsigned& nx) {
    const unsigned G = gridDim.x * gridDim.y * gridDim.z;
    unsigned sum, cnt, mine, sp = 0u;
    for (;;) {
        sum = 0u; cnt = 0u; mine = 0u;
#pragma unroll
        for (unsigned j = 0; j < 16; ++j) { const unsigned c = xb_ld(&bar[XB_XCNT(j)]); sum += c; cnt += (c > 0u) ? 1u : 0u; mine = (j == x) ? c : mine; }
        if (sum == G) break;
        __builtin_amdgcn_s_sleep(1);
        if ((++sp & 255u) == 0u) { if (xb_ld(&bar[XB_TMO])) break; if (sp > XB_SPIN_CAP) { atomicAdd(&bar[XB_TMO], 1u); break; } }
    }
    nloc = mine > 0u ? mine : 1u; nx = cnt > 0u ? cnt : 1u;
}
DI void xcd_barrier(const XcdBarrier& b) {
    asm volatile("s_waitcnt vmcnt(0)" ::: "memory");
    __syncthreads();
    if (threadIdx.x == 0) {
        unsigned* bar = b.bar;
        __builtin_amdgcn_s_waitcnt(0);
        unsigned nloc = b.st[0], nx = b.st[1];
        if (nloc == 0u) { xcd_barrier_complete(bar, b.x, nloc, nx); b.st[0] = nloc; b.st[1] = nx; }
        const unsigned old = xb_add(&bar[XB_XSUB(b.x)], 1u);
        const unsigned gen = old / nloc;
        if (old + 1u == (gen + 1u) * nloc) {
            __builtin_amdgcn_fence(__ATOMIC_RELEASE, "agent");
            asm volatile("s_waitcnt vmcnt(0)" ::: "memory");
            const unsigned og = xb_add(&bar[XB_TOP], 1u);
            const unsigned tg = og / nx;
            if (og + 1u == (tg + 1u) * nx) xb_add(&bar[XB_TOPGEN], 1u);
            else XB_SPIN(xb_ld(&bar[XB_TOPGEN]) == tg, bar);
            __builtin_amdgcn_fence(__ATOMIC_ACQUIRE, "agent");
            xb_add(&bar[XB_XGEN(b.x)], 1u);
            asm volatile("s_waitcnt vmcnt(0)" ::: "memory");
        } else {
            XB_SPIN(xb_ld(&bar[XB_XGEN(b.x)]) == gen, bar);
            __builtin_amdgcn_fence(__ATOMIC_ACQUIRE, "agent");
            asm volatile("s_waitcnt vmcnt(0)" ::: "memory");
        }
    }
    __syncthreads();
}

namespace pg8 {
constexpr int BM = 256, BK = 64, HALF = 128, HTB = HALF * BK * 2, STAGE_BYTES = 8 * HTB, NXCD = 8, WGM = 8;
DI int lds_byte(int r, int c) { const int st = (r >> 4) * 2 + (c >> 5), rr = r & 15, cc = c & 31, ob = rr * 64 + cc * 2; return st * 1024 + (ob ^ (((ob >> 9) & 1) << 5)); }
DI void stage_rc(int b, int& R, int& C) { const int st = b / 1024, sb = b % 1024, swz = sb ^ (((sb >> 9) & 1) << 5); R = (st >> 1) * 16 + swz / 64; C = (st & 1) * 32 + (swz % 64) / 2; }
DI int perm32(int rho) { const int n = rho >> 4, i = rho & 15; return 8 * (i >> 2) + 4 * n + (i & 3); }

struct Unit { int pm, pn, sub; long offA, offB; };
struct Gemm { const bf16_t* A; const bf16_t* Bt; int lda, ldb, K; };

struct Order {
    int nM, nN, nwg, G, c, lda, ldb, nsub, subA, subB;
    DI void init(int nM_, int nN_, int G_, int c_, int lda_, int ldb_, int nsub_ = 1, int subA_ = 0, int subB_ = 0) { nM = nM_; nN = nN_; nwg = nM * nN; G = G_; c = c_; lda = lda_; ldb = ldb_; nsub = nsub_; subA = subA_; subB = subB_; }
    DI bool next(int i, Unit& u) const {
        const int ti = i / nsub, sub = i - ti * nsub;
        const long L = (long)ti * G + c; if (L >= nwg) return false;
        int wgid = (int)L; { const int q = nwg / NXCD, r = nwg % NXCD, xcd = wgid % NXCD, off = wgid / NXCD; wgid = (xcd < r ? xcd * (q + 1) : r * (q + 1) + (xcd - r) * q) + off; }
        const int nig = WGM * nN, gid = wgid / nig, fm = gid * WGM, gsz = (nM - fm) < WGM ? (nM - fm) : WGM;
        u.pm = fm + ((wgid % nig) % gsz); u.pn = (wgid % nig) / gsz; u.sub = sub;
        u.offA = ((long)u.pm * BM * lda + (long)sub * subA) * 2; u.offB = ((long)u.pn * BM + (long)sub * subB) * (long)ldb * 2;
        return true;
    }
};

struct OrderLin {
    int c, G, nu, pnbase, lda, ldb;
    DI bool next(int i, Unit& u) const { const int v = c + i * G; if (v >= nu) return false; u.pm = v & 31; u.pn = pnbase + (v >> 5); u.sub = 0;
        u.offA = (long)u.pm * BM * lda * 2; u.offB = (long)u.pn * BM * (long)ldb * 2; return true; }
};
struct OrderTri {
    int pm, k, pnbase, lda, ldb;
    DI bool next(int i, Unit& u) const { int cnt, st;
        if (pm < 24) { cnt = k + 1; st = (k * (k + 1)) / 2; }
        else { cnt = k == 0 ? 3 : (k < 6 ? k + 2 : 0); st = k == 0 ? 0 : (k < 6 ? 3 + ((k - 1) * (k + 4)) / 2 : 28); }
        if (i >= cnt) return false; u.pm = pm; u.pn = pnbase + st + i; u.sub = 0;
        u.offA = (long)u.pm * BM * lda * 2; u.offB = (long)u.pn * BM * (long)ldb * 2; return true; }
};
struct OrderQueue {
    unsigned* head; volatile LAS unsigned* slot; int tid, nu, pnbase, lda, ldb, xg;
    mutable unsigned pend;
    DI void draw() const { const unsigned one = 1u; asm volatile("global_atomic_add %0, %1, %2, off sc0" : "=v"(pend) : "v"(head), "v"(one) : "memory"); }
    DI void setup() const { if (tid == 0) { slot[0] = __hip_atomic_fetch_add(head, 1u, __ATOMIC_RELAXED, __HIP_MEMORY_SCOPE_AGENT); draw(); }
        asm volatile("s_waitcnt lgkmcnt(0)" ::: "memory"); __syncthreads(); }
    DI bool next(int i, Unit& u) const {
        const unsigned v = slot[i & 1];
        if (tid == 0) { asm volatile("s_waitcnt vmcnt(0)" : "+v"(pend) :: "memory"); const unsigned p = pend; slot[(i + 1) & 1] = p;
            if (p < (unsigned)nu) draw(); }
        asm volatile("s_waitcnt lgkmcnt(0)" ::: "memory");
        if (v >= (unsigned)nu) return false;
        u.pm = xg + 8 * (int)(v & 3u); u.pn = pnbase + (int)(v >> 2); u.sub = 0;
        u.offA = (long)u.pm * BM * lda * 2; u.offB = (long)u.pn * BM * (long)ldb * 2; return true; }
};
template <class Epi, class Sched, bool ALIGN_EPI>
DI void gemm_phase(LAS unsigned char* lds, const int tid, const Gemm g, const Sched& S, const Epi& E) {
    const int wid = __builtin_amdgcn_readfirstlane(tid >> 6), lane = tid & 63, wr = wid >> 2, wc = wid & 3, fr = lane & 15, fq = lane >> 4;
    const int K = g.K, nt = K / BK;
    unsigned voffA[2], voffB[2];
#pragma unroll
    for (int i = 0; i < 2; ++i) { int R, C; stage_rc(tid * 16 + i * 8192, R, C); const int Rb = Epi::PERM ? ((R & ~31) + perm32(R & 31)) : R;
        voffA[i] = (unsigned)(R * g.lda + C) * 2u; voffB[i] = (unsigned)(Rb * g.ldb + C) * 2u; }
    const size_t kstep = (size_t)(BK * 2);
    const size_t hstepA = (size_t)HALF * g.lda * 2, hstepB = (size_t)HALF * g.ldb * 2;
    const unsigned ldsw = (unsigned)wid * 1024u;
    const int aoff = lds_byte(wr * 64 + fr, fq * 8), boff = lds_byte(wc * 32 + fr, fq * 8);
#define PG8_SA(b, h) (((b) * 2 + (h)) * HTB)
#define PG8_SB(b, h) ((4 + (b) * 2 + (h)) * HTB)
#define PG8_STAGE(bufoff, gbase, voff) do { _Pragma("unroll") for (int _i = 0; _i < 2; ++_i) \
        __builtin_amdgcn_global_load_lds((const unsigned*)((const char*)(gbase) + (voff)[_i]), (LAS unsigned*)(lds + (bufoff) + ldsw + _i * 8192), 16, 0, 0); } while (0)
#define PG8_LDA(dst, b, h) do { _Pragma("unroll") for (int m = 0; m < 4; ++m) _Pragma("unroll") for (int k = 0; k < 2; ++k) dst[m][k] = *(const LAS bf16x8*)(lds + PG8_SA(b, h) + aoff + m * 2048 + k * 1024); } while (0)
#define PG8_LDB(dst, b, h) do { _Pragma("unroll") for (int n = 0; n < 2; ++n) _Pragma("unroll") for (int k = 0; k < 2; ++k) dst[n][k] = *(const LAS bf16x8*)(lds + PG8_SB(b, h) + boff + n * 2048 + k * 1024); } while (0)
#define PG8_MMA(ai, bj, At, Bt) do { __builtin_amdgcn_s_setprio(1); _Pragma("unroll") for (int m = 0; m < 4; ++m) _Pragma("unroll") for (int n = 0; n < 2; ++n) _Pragma("unroll") for (int k = 0; k < 2; ++k) \
        acc[ai][bj][m][n] = __builtin_amdgcn_mfma_f32_16x16x32_bf16(Bt[n][k], At[m][k], acc[ai][bj][m][n], 0, 0, 0); __builtin_amdgcn_s_setprio(0); } while (0)
#define PG8_WAIT_V(n) asm volatile("s_waitcnt vmcnt(" #n ")" ::: "memory")
#define PG8_WAIT_L(n) asm volatile("s_waitcnt lgkmcnt(" #n ")" ::: "memory")
#define PG8_BAR __builtin_amdgcn_s_barrier()
#define PG8_SCHED __builtin_amdgcn_sched_barrier(0)
    Unit cur, nxt; int ui = 0;
    if (!S.next(0, cur)) return;
    f32x4 acc[2][2][4][2];
#pragma unroll
    for (int a = 0; a < 2; ++a)
#pragma unroll
        for (int b = 0; b < 2; ++b)
#pragma unroll
            for (int m = 0; m < 4; ++m)
#pragma unroll
                for (int n = 0; n < 2; ++n) acc[a][b][m][n] = (f32x4){0.f, 0.f, 0.f, 0.f};
    bf16x8 At[4][2], B0[2][2], B1[2][2];
    const char* cA = (const char*)g.A + cur.offA; const char* cB = (const char*)g.Bt + cur.offB;
    PG8_STAGE(PG8_SB(0, 0), cB, voffB); PG8_STAGE(PG8_SB(0, 1), cB + hstepB, voffB); PG8_STAGE(PG8_SA(0, 0), cA, voffA); PG8_STAGE(PG8_SA(0, 1), cA + hstepA, voffA);
    if (wr == 1) PG8_BAR;
    PG8_WAIT_V(2); PG8_BAR;
    PG8_STAGE(PG8_SB(1, 0), cB + kstep, voffB); PG8_STAGE(PG8_SA(1, 0), cA + kstep, voffA); PG8_STAGE(PG8_SB(1, 1), cB + hstepB + kstep, voffB);
    PG8_WAIT_V(6); PG8_BAR;
    for (;;) {
        const bool has_next = S.next(ui + 1, nxt);
        const char* nA = has_next ? (const char*)g.A + nxt.offA : cA; const char* nB = has_next ? (const char*)g.Bt + nxt.offB : cB;
        for (int t = 0; t < nt; t += 2) {
            const bool last = (t == nt - 2);
            const char* a1 = cA + (size_t)(t + 1) * kstep;
            const char* a2 = last ? nA : cA + (size_t)(t + 2) * kstep; const char* b2 = last ? nB : cB + (size_t)(t + 2) * kstep;
            const char* a3 = a2 + kstep; const char* b3 = b2 + kstep;
            PG8_LDB(B0, 0, 0); PG8_LDB(B1, 0, 1); PG8_SCHED; PG8_LDA(At, 0, 0); PG8_STAGE(PG8_SA(1, 1), a1 + hstepA, voffA);
            PG8_WAIT_V(8); PG8_WAIT_L(0); PG8_BAR; PG8_MMA(0, 0, At, B0); PG8_MMA(0, 1, At, B1); PG8_BAR; PG8_SCHED;
            PG8_LDA(At, 0, 1); PG8_STAGE(PG8_SB(0, 0), b2, voffB); PG8_STAGE(PG8_SB(0, 1), b2 + hstepB, voffB); PG8_STAGE(PG8_SA(0, 0), a2, voffA);
            PG8_WAIT_V(8); PG8_WAIT_L(0); PG8_BAR; PG8_MMA(1, 0, At, B0); PG8_MMA(1, 1, At, B1); PG8_BAR; PG8_SCHED;
            PG8_LDB(B0, 1, 0); PG8_LDB(B1, 1, 1); PG8_SCHED; PG8_LDA(At, 1, 0); PG8_STAGE(PG8_SA(0, 1), a2 + hstepA, voffA);
            PG8_WAIT_V(8); PG8_WAIT_L(0); PG8_BAR; PG8_MMA(0, 0, At, B0); PG8_MMA(0, 1, At, B1); PG8_BAR; PG8_SCHED;
            PG8_LDA(At, 1, 1); PG8_STAGE(PG8_SB(1, 0), b3, voffB); PG8_STAGE(PG8_SB(1, 1), b3 + hstepB, voffB); PG8_STAGE(PG8_SA(1, 0), a3, voffA);
            PG8_WAIT_V(8); PG8_WAIT_L(0); PG8_BAR; PG8_MMA(1, 0, At, B0); PG8_MMA(1, 1, At, B1); PG8_BAR; PG8_SCHED;
        }
        if constexpr (ALIGN_EPI) { if (wr == 0) PG8_BAR; }
        E(acc, cur, wr, wc, fr, fq);
        if (!has_next) break;
#pragma unroll
        for (int a = 0; a < 2; ++a)
#pragma unroll
            for (int b = 0; b < 2; ++b)
#pragma unroll
                for (int m = 0; m < 4; ++m)
#pragma unroll
                    for (int n = 0; n < 2; ++n) acc[a][b][m][n] = (f32x4){0.f, 0.f, 0.f, 0.f};
        cur = nxt; cA = nA; cB = nB; ++ui;
        if constexpr (ALIGN_EPI) { if (wr == 1) PG8_BAR; }
    }
    PG8_WAIT_V(0);
    if constexpr (!ALIGN_EPI) { if (wr == 0) PG8_BAR; }
    PG8_BAR;
#undef PG8_SA
#undef PG8_SB
#undef PG8_STAGE
#undef PG8_LDA
#undef PG8_LDB
#undef PG8_MMA
#undef PG8_WAIT_V
#undef PG8_WAIT_L
#undef PG8_BAR
#undef PG8_SCHED
}

typedef const f32x4 (&AccRef)[2][2][4][2];
DI float row_scale_slow(const float* part, int row) { float s = 0.f; for (int i = 0; i < 32; ++i) s += part[(size_t)row * 32 + i]; return 1.0f / sqrtf(s * (1.0f / DM) + RMS_EPS); }

#define EPI_SB() __builtin_amdgcn_sched_barrier(0)
DI void epi_z_store(AccRef acc, const Unit& u, int wr, int wc, int fr, int fq, bf16_t* ZS, bf16_t* G, const f32x4 (&bb)[2][2], const float (&sv)[2][4]) {
#pragma unroll
    for (int ai = 0; ai < 2; ++ai)
#pragma unroll
        for (int m = 0; m < 4; ++m) {
            const int row = u.pm * BM + ai * HALF + wr * 64 + m * 16 + fr; const float s = sv[ai][m];
#pragma unroll
            for (int bj = 0; bj < 2; ++bj) {
                const int col0 = u.pn * BM + bj * HALF + wc * 32 + 8 * fq;
                f32x4 v0 = acc[ai][bj][m][0] * s, v1 = acc[ai][bj][m][1] * s;
                if (u.pn < 20) { u32x4 w; w.x = cvt_pk_bf16(v0[0], v0[1]); w.y = cvt_pk_bf16(v0[2], v0[3]); w.z = cvt_pk_bf16(v1[0], v1[1]); w.w = cvt_pk_bf16(v1[2], v1[3]); *(u32x4*)(ZS + (size_t)row * ZS_COLS + col0) = w; }
                else { const int gc = col0 - ZS_COLS;
                    v0 += bb[bj][0]; v1 += bb[bj][1];
                    u32x4 w; w.x = cvt_pk_bf16(sigmoidf_(v0[0]), sigmoidf_(v0[1])); w.y = cvt_pk_bf16(sigmoidf_(v0[2]), sigmoidf_(v0[3]));
                    w.z = cvt_pk_bf16(sigmoidf_(v1[0]), sigmoidf_(v1[1])); w.w = cvt_pk_bf16(sigmoidf_(v1[2]), sigmoidf_(v1[3]));
                    *(u32x4*)(G + (size_t)row * GCOLS + gc) = w; }
            }
        }
}
DI void epi_z_bias(f32x4 (&bb)[2][2], const float* bgate, const Unit& u, int wc, int fq) {
#pragma unroll
    for (int bj = 0; bj < 2; ++bj) { bb[bj][0] = (f32x4){0.f, 0.f, 0.f, 0.f}; bb[bj][1] = bb[bj][0]; }
    if (u.pn >= 20) {
#pragma unroll
        for (int bj = 0; bj < 2; ++bj) { const int gc = u.pn * BM + bj * HALF + wc * 32 + 8 * fq - ZS_COLS; bb[bj][0] = *(const f32x4*)(bgate + gc); bb[bj][1] = *(const f32x4*)(bgate + gc + 4); } }
}
struct EpiZ {
    static constexpr bool PERM = true;
    bf16_t* ZS; bf16_t* G; const float* bgate; const float* part; const LAS float* rsT; int pm0;
    DI void operator()(AccRef acc, const Unit& u, int wr, int wc, int fr, int fq) const {
        f32x4 bb[2][2]; float sv[2][4];
        epi_z_bias(bb, bgate, u, wc, fq);
#pragma unroll
        for (int ai = 0; ai < 2; ++ai)
#pragma unroll
            for (int m = 0; m < 4; ++m) { const int lr = ai * HALF + wr * 64 + m * 16 + fr; sv[ai][m] = (u.pm == pm0) ? rsT[lr] : row_scale_slow(part, u.pm * BM + lr); }
        EPI_SB();
        epi_z_store(acc, u, wr, wc, fr, fq, ZS, G, bb, sv);
    }
};
struct EpiZq {
    static constexpr bool PERM = true;
    bf16_t* ZS; bf16_t* G; const float* bgate; const float* rsg;
    DI void operator()(AccRef acc, const Unit& u, int wr, int wc, int fr, int fq) const {
        f32x4 bb[2][2]; float sv[2][4];
        epi_z_bias(bb, bgate, u, wc, fq);
#pragma unroll
        for (int ai = 0; ai < 2; ++ai)
#pragma unroll
            for (int m = 0; m < 4; ++m) sv[ai][m] = rsg[u.pm * BM + ai * HALF + wr * 64 + m * 16 + fr];
        EPI_SB();
        epi_z_store(acc, u, wr, wc, fr, fq, ZS, G, bb, sv);
    }
};
struct EpiU {
    static constexpr bool PERM = true;
    bf16_t* U; int ldc; const float* part; const LAS float* rsT; int pm0;
    DI void operator()(AccRef acc, const Unit& u, int wr, int wc, int fr, int fq) const {
#pragma unroll
        for (int ai = 0; ai < 2; ++ai)
#pragma unroll
            for (int m = 0; m < 4; ++m) {
                const int lr = ai * HALF + wr * 64 + m * 16 + fr, row = u.pm * BM + lr;
                const float s = (u.pm == pm0) ? rsT[lr] : row_scale_slow(part, row);
#pragma unroll
                for (int bj = 0; bj < 2; ++bj) {
                    const int col0 = u.pn * BM + bj * HALF + wc * 32 + 8 * fq;
                    const f32x4 v0 = acc[ai][bj][m][0] * s, v1 = acc[ai][bj][m][1] * s;
                    u32x4 w; w.x = cvt_pk_bf16(v0[0], v0[1]); w.y = cvt_pk_bf16(v0[2], v0[3]); w.z = cvt_pk_bf16(v1[0], v1[1]); w.w = cvt_pk_bf16(v1[2], v1[3]);
                    *(u32x4*)(U + (size_t)row * ldc + col0) = w;
                }
            }
    }
};
struct EpiRes {
    static constexpr bool PERM = false;
    const float* Yin; float* Y; bf16_t* YB; float* part;
    DI void operator()(AccRef acc, const Unit& u, int wr, int wc, int fr, int fq) const {
#pragma unroll
        for (int ai = 0; ai < 2; ++ai)
#pragma unroll
            for (int mp = 0; mp < 2; ++mp) {
                f32x4 yin[2][2][2];
#pragma unroll
                for (int mm = 0; mm < 2; ++mm) { const int row = u.pm * BM + ai * HALF + wr * 64 + (2 * mp + mm) * 16 + fr;
#pragma unroll
                    for (int bj = 0; bj < 2; ++bj)
#pragma unroll
                        for (int n = 0; n < 2; ++n) yin[mm][bj][n] = *(const f32x4*)(Yin + (size_t)row * DM + u.pn * BM + bj * HALF + wc * 32 + 16 * n + 4 * fq); }
                EPI_SB();
#pragma unroll
                for (int mm = 0; mm < 2; ++mm) { const int m = 2 * mp + mm; const int row = u.pm * BM + ai * HALF + wr * 64 + m * 16 + fr;
                    float ss = 0.f;
#pragma unroll
                    for (int bj = 0; bj < 2; ++bj)
#pragma unroll
                        for (int n = 0; n < 2; ++n) {
                            const int col = u.pn * BM + bj * HALF + wc * 32 + 16 * n + 4 * fq;
                            const size_t o = (size_t)row * DM + col;
                            const f32x4 y = yin[mm][bj][n] + acc[ai][bj][m][n];
                            *(f32x4*)(Y + o) = y;
                            u32x2 w; w.x = cvt_pk_bf16(y[0], y[1]); w.y = cvt_pk_bf16(y[2], y[3]);
                            *(u32x2*)(YB + o) = w;
                            ss += (y[0] * y[0] + y[1] * y[1]) + (y[2] * y[2] + y[3] * y[3]);
                        }
                    ss += __shfl_xor(ss, 16); ss += __shfl_xor(ss, 32);
                    if (fq == 0) part[(size_t)row * 32 + u.pn * 4 + wc] = ss; }
                EPI_SB();
            }
    }
};
struct EpiGlu {
    static constexpr bool PERM = true;
    const bf16_t* YB16; const float* bias; bf16_t* MIXp;
    DI void operator()(AccRef acc, const Unit& u, int wr, int wc, int fr, int fq) const {
        f32x4 bb[2][2];
#pragma unroll
        for (int bj = 0; bj < 2; ++bj) { const int col0 = u.pn * BM + bj * HALF + wc * 32 + 8 * fq; bb[bj][0] = *(const f32x4*)(bias + col0); bb[bj][1] = *(const f32x4*)(bias + col0 + 4); }
#pragma unroll
        for (int ai = 0; ai < 2; ++ai) {
            u32x4 yw[4][2];
#pragma unroll
            for (int m = 0; m < 4; ++m)
#pragma unroll
                for (int bj = 0; bj < 2; ++bj) yw[m][bj] = *(const u32x4*)(YB16 + (size_t)(u.pm * BM + ai * HALF + wr * 64 + m * 16 + fr) * MIX + u.pn * BM + bj * HALF + wc * 32 + 8 * fq);
            EPI_SB();
#pragma unroll
            for (int m = 0; m < 4; ++m) {
                const int row = u.pm * BM + ai * HALF + wr * 64 + m * 16 + fr;
#pragma unroll
                for (int bj = 0; bj < 2; ++bj) {
                    const int col0 = u.pn * BM + bj * HALF + wc * 32 + 8 * fq;
                    const u32x4 t = yw[m][bj];
                    const f32x4 y0 = (f32x4){bf2f(t.x & 0xffffu), bf2f(t.x >> 16), bf2f(t.y & 0xffffu), bf2f(t.y >> 16)}, y1 = (f32x4){bf2f(t.z & 0xffffu), bf2f(t.z >> 16), bf2f(t.w & 0xffffu), bf2f(t.w >> 16)};
                    const f32x4 v0 = acc[ai][bj][m][0] + bb[bj][0], v1 = acc[ai][bj][m][1] + bb[bj][1];
                    u32x4 w; w.x = cvt_pk_bf16(y0[0] * sigmoidf_(v0[0]), y0[1] * sigmoidf_(v0[1])); w.y = cvt_pk_bf16(y0[2] * sigmoidf_(v0[2]), y0[3] * sigmoidf_(v0[3]));
                    w.z = cvt_pk_bf16(y1[0] * sigmoidf_(v1[0]), y1[1] * sigmoidf_(v1[1])); w.w = cvt_pk_bf16(y1[2] * sigmoidf_(v1[2]), y1[3] * sigmoidf_(v1[3]));
                    *(u32x4*)(MIXp + (size_t)row * (4 * MIX) + 3 * MIX + col0) = w;
                }
            }
            EPI_SB();
        }
    }
};
struct EpiMerge {
    static constexpr bool PERM = true;
    const bf16_t* G; bf16_t* MFh; bf16_t* MERGED;
    DI void operator()(AccRef acc, const Unit& u, int wr, int wc, int fr, int fq) const {
        constexpr size_t SL = (size_t)MTOK * DM;
        if (u.sub < 3) {
#pragma unroll
            for (int ai = 0; ai < 2; ++ai) {
                u32x4 gw[4][2];
#pragma unroll
                for (int m = 0; m < 4; ++m)
#pragma unroll
                    for (int bj = 0; bj < 2; ++bj) gw[m][bj] = *(const u32x4*)(G + (size_t)(u.pm * BM + ai * HALF + wr * 64 + m * 16 + fr) * GCOLS + u.sub * DM + u.pn * BM + bj * HALF + wc * 32 + 8 * fq);
                EPI_SB();
#pragma unroll
                for (int m = 0; m < 4; ++m) { const int row = u.pm * BM + ai * HALF + wr * 64 + m * 16 + fr;
#pragma unroll
                    for (int bj = 0; bj < 2; ++bj) { const int col0 = u.pn * BM + bj * HALF + wc * 32 + 8 * fq; const u32x4 g = gw[m][bj];
                        f32x4 v0 = acc[ai][bj][m][0], v1 = acc[ai][bj][m][1];
                        v0[0] *= bf2f(g.x & 0xffffu); v0[1] *= bf2f(g.x >> 16); v0[2] *= bf2f(g.y & 0xffffu); v0[3] *= bf2f(g.y >> 16);
                        v1[0] *= bf2f(g.z & 0xffffu); v1[1] *= bf2f(g.z >> 16); v1[2] *= bf2f(g.w & 0xffffu); v1[3] *= bf2f(g.w >> 16);
                        u32x4 w; w.x = cvt_pk_bf16(v0[0], v0[1]); w.y = cvt_pk_bf16(v0[2], v0[3]); w.z = cvt_pk_bf16(v1[0], v1[1]); w.w = cvt_pk_bf16(v1[2], v1[3]);
                        *(u32x4*)(MFh + u.sub * SL + (size_t)row * DM + col0) = w; } }
                EPI_SB();
            }
        } else {
#pragma unroll
            for (int ai = 0; ai < 2; ++ai)
#pragma unroll
                for (int m = 0; m < 4; ++m) { const int row = u.pm * BM + ai * HALF + wr * 64 + m * 16 + fr;
                    u32x4 gw[2], t[2][3];
#pragma unroll
                    for (int bj = 0; bj < 2; ++bj) { const int col0 = u.pn * BM + bj * HALF + wc * 32 + 8 * fq;
                        gw[bj] = *(const u32x4*)(G + (size_t)row * GCOLS + 3 * DM + col0);
#pragma unroll
                        for (int q = 0; q < 3; ++q) t[bj][q] = *(const u32x4*)(MFh + q * SL + (size_t)row * DM + col0); }
                    EPI_SB();
#pragma unroll
                    for (int bj = 0; bj < 2; ++bj) { const int col0 = u.pn * BM + bj * HALF + wc * 32 + 8 * fq; const u32x4 g = gw[bj];
                        f32x4 v0 = acc[ai][bj][m][0], v1 = acc[ai][bj][m][1];
                        v0[0] *= bf2f(g.x & 0xffffu); v0[1] *= bf2f(g.x >> 16); v0[2] *= bf2f(g.y & 0xffffu); v0[3] *= bf2f(g.y >> 16);
                        v1[0] *= bf2f(g.z & 0xffffu); v1[1] *= bf2f(g.z >> 16); v1[2] *= bf2f(g.w & 0xffffu); v1[3] *= bf2f(g.w >> 16);
#pragma unroll
                        for (int q = 0; q < 3; ++q) { const u32x4 tt = t[bj][q];
                            v0[0] += bf2f(tt.x & 0xffffu); v0[1] += bf2f(tt.x >> 16); v0[2] += bf2f(tt.y & 0xffffu); v0[3] += bf2f(tt.y >> 16);
                            v1[0] += bf2f(tt.z & 0xffffu); v1[1] += bf2f(tt.z >> 16); v1[2] += bf2f(tt.w & 0xffffu); v1[3] += bf2f(tt.w >> 16); }
                        u32x4 w; w.x = cvt_pk_bf16(v0[0], v0[1]); w.y = cvt_pk_bf16(v0[2], v0[3]); w.z = cvt_pk_bf16(v1[0], v1[1]); w.w = cvt_pk_bf16(v1[2], v1[3]);
                        *(u32x4*)(MERGED + (size_t)row * DM + col0) = w; }
                    EPI_SB(); }
        }
    }
};
}

struct Frame { LAS unsigned char* lds; int tid, lane, wave, bid, G; };

DI Frame fresh(const Frame& F0) { Frame F = F0; int tid = F0.tid, bid = F0.bid, G = F0.G, wave = F0.wave; unsigned lo = (unsigned)(size_t)F0.lds;
    asm volatile("" : "+v"(tid)); asm volatile("" : "+s"(bid), "+s"(G), "+s"(wave), "+s"(lo));
    F.tid = tid; F.lane = tid & 63; F.wave = wave; F.bid = bid; F.G = G; F.lds = (LAS unsigned char*)(size_t)lo; return F; }
DI unsigned char* fresh_ptr(unsigned char* p) { size_t z = 0; asm volatile("" : "+s"(z)); return p + z; }
DI void rs_table(const Frame& F, const float* part, int pm) {
    LAS float* rsT = (LAS float*)(F.lds + RST_OFF);
    if (F.tid < 256) { const int row = pm * 256 + F.tid; float s = 0.f;
#pragma unroll
        for (int i = 0; i < 8; ++i) { const f32x4 v = *(const f32x4*)(part + (size_t)row * 32 + 4 * i); s += (v[0] + v[1]) + (v[2] + v[3]); }
        rsT[F.tid] = 1.0f / sqrtf(s * (1.0f / DM) + RMS_EPS); }
    __syncthreads();
}

DI int head_perm(int c) { const int h = c >> 6, p = c & 63; const int dim = p < 16 ? ((p >> 1) + 8 * (p & 1)) : p; return (h << 6) + dim; }
DI int zin_colmap(int n) {
    if (n < B_COLS) return 1860 + n;
    if (n < 2048) return -1;
    if (n < 2560) return head_perm(n - 2048);
    if (n < 3072) return 512 + head_perm(n - 2560);
    if (n < 3584) return 1024 + (n - 3072);
    if (n < 3840) return 1536 + head_perm(n - 3584);
    if (n < 3904) return 1792 + head_perm(n - 3840);
    if (n < 3908) return 1856 + (n - 3904);
    if (n < 4096) return -1;
    if (n < 4608) return 3844 + (n - 4096);
    if (n < 5120) return 4356 + (n - 4608);
    return 4868 + (n - 5120);
}
template <int MODE>
DI void tr_item(const float* W, int ldw, const float* ksc, bf16_t* WT, int K, LAS float* scr, int kb, int nb, int lane) {
    const int k0 = 64 * kb, n0 = 32 * nb, nn = n0 + (lane & 31);
    const int col = MODE == 1 ? zin_colmap(nn) : nn;
    float tv[32];
    if (col >= 0) {
#pragma unroll
        for (int i = 0; i < 32; ++i) tv[i] = W[(size_t)(k0 + 2 * i + (lane >> 5)) * ldw + col];
        if (ksc) {
#pragma unroll
            for (int i = 0; i < 32; ++i) tv[i] *= ksc[k0 + 2 * i + (lane >> 5)]; }
    } else {
#pragma unroll
        for (int i = 0; i < 32; ++i) tv[i] = 0.f; }
#pragma unroll
    for (int i = 0; i < 32; ++i) scr[(2 * i + (lane >> 5)) * 33 + (lane & 31)] = tv[i];
    LDS_WAIT(); asm volatile("" ::: "memory");
    const int c = lane & 7;
#pragma unroll
    for (int j = 0; j < 4; ++j) { const int n = (lane >> 3) + 8 * j; const LAS float* s = scr + (8 * c) * 33 + n;
        u32x4 o; o.x = pk2(s[0 * 33], s[1 * 33]); o.y = pk2(s[2 * 33], s[3 * 33]); o.z = pk2(s[4 * 33], s[5 * 33]); o.w = pk2(s[6 * 33], s[7 * 33]);
        *(u32x4*)(WT + (size_t)(n0 + n) * K + k0 + 8 * c) = o; }
    LDS_WAIT(); asm volatile("" ::: "memory");
}
struct InTab { const float* p[37]; };
#define CAS __attribute__((address_space(4)))
typedef const float* fptr_t;
typedef GAS const float* gfptr_t;
struct In { CAS const gfptr_t* t; DI fptr_t operator[](int i) const { return (fptr_t)t[i]; } };
DI In in_fresh(In in) { CAS const gfptr_t* t = in.t; asm volatile("" : "+s"(t)); In r; r.t = t; return r; }
constexpr int CV_IN = 32 * (NZ / 32), CV_BR = 4 * 8 * 64, CV_OUT = 32 * 64, CV_GLU = 8 * 16, CV_UP = 32 * (DFF2 / 32), CV_DN = 86 * 64;
constexpr int CV_S1 = 0, CV_S2 = CV_IN, CV_S3 = CV_S2 + CV_BR + CV_OUT + CV_GLU, CV_S4 = CV_S3 + CV_UP, CV_LAYER = CV_S4 + CV_DN;
DI void conv_w_item(const In& in, unsigned char* ws, LAS float* scr, int l, int r, int lane) {
    unsigned char* wt = ws + WS_WT + (size_t)l * WT_LAYER;
    if (r < CV_IN) { const int nbk = NZ / 32; tr_item<1>(in[3] + (size_t)l * DM * IN_COLS, IN_COLS, in[2] + l * DM, (bf16_t*)(wt + WT_IN), DM, scr, r / nbk, r % nbk, lane); return; } r -= CV_IN;
    if (r < CV_BR) { const int n = r / 512, rr = r % 512; tr_item<0>(in[29] + ((size_t)l * 4 + n) * MIX * DM, DM, nullptr, (bf16_t*)(wt + WT_BR) + (size_t)n * DM * MIX, MIX, scr, rr / 64, rr % 64, lane); return; } r -= CV_BR;
    if (r < CV_OUT) { tr_item<0>(in[30] + (size_t)l * DM * DM, DM, nullptr, (bf16_t*)(wt + WT_OUT), DM, scr, r / 64, r % 64, lane); return; } r -= CV_OUT;
    if (r < CV_GLU) { tr_item<0>(in[27] + (size_t)l * MIX * MIX, MIX, nullptr, (bf16_t*)(wt + WT_GLU), MIX, scr, r / 16, r % 16, lane); return; } r -= CV_GLU;
    if (r < CV_UP) { const int nbk = DFF2 / 32; tr_item<0>(in[32] + (size_t)l * DM * DFF2, DFF2, in[31] + l * DM, (bf16_t*)(wt + WT_UP), DM, scr, r / nbk, r % nbk, lane); return; } r -= CV_UP;
    tr_item<0>(in[35] + (size_t)l * DFF * DM, DM, nullptr, (bf16_t*)(wt + WT_DOWN), DFF, scr, r / 64, r % 64, lane);
}
DI void conv_w_drain(const Frame& F, const In& in, unsigned char* ws, int l, int lo, int hi, int sec) {
    if (l >= NL) return;
    unsigned* cnt = (unsigned*)(ws + WS_CTL) + CW_CONV + 64 * (l * 4 + sec);
    LAS float* scr = (LAS float*)(F.lds + F.wave * 16384);
    for (;;) { unsigned bt = 0u; if (F.lane == 0) bt = __hip_atomic_fetch_add(cnt, 1u, __ATOMIC_RELAXED, __HIP_MEMORY_SCOPE_AGENT);
        bt = (unsigned)__builtin_amdgcn_readfirstlane((int)bt);
        const int r0 = lo + (int)bt * 16; if (r0 >= hi) break;
        for (int r = r0; r < r0 + 16 && r < hi; ++r) conv_w_item(in, ws, scr, l, r, F.lane); }
}
DI void p0_prologue(const Frame& F, const In& in, unsigned char* ws) {
    LAS float* scr = (LAS float*)(F.lds + F.wave * 16384);
    const int gw = F.bid * NWAVES + F.wave, NGW = F.G * NWAVES;
    for (int it = gw; it < CV_LAYER; it += NGW) conv_w_item(in, ws, scr, 0, it, F.lane);
    { bf16_t* WTL = (bf16_t*)(ws + WS_WTL);
      for (int e = F.bid * NTHR + F.tid; e < NL * 56 * MIX; e += F.G * NTHR) { const int n = e % MIX, k8 = (e / MIX) % 56, l = e / (MIX * 56); const int k0 = k8 * 8;
          const float* src = k0 < 96 ? in[8] + ((size_t)l * 96 + k0) * MIX : (k0 < 192 ? in[10] + ((size_t)l * 96 + (k0 - 96)) * MIX : in[11] + ((size_t)l * 256 + (k0 - 192)) * MIX);
          u32x4 o; o.x = pk2(src[n], src[MIX + n]); o.y = pk2(src[2 * MIX + n], src[3 * MIX + n]); o.z = pk2(src[4 * MIX + n], src[5 * MIX + n]); o.w = pk2(src[6 * MIX + n], src[7 * MIX + n]);
          *(u32x4*)(WTL + ((size_t)l * MIX + n) * 448 + k0) = o; } }
    { bf16_t* WTP = (bf16_t*)(ws + WS_WTP);
      for (int e = F.bid * NTHR + F.tid; e < NL * 4 * 128 * 16; e += F.G * NTHR) { const int n = e & 127, k8 = (e >> 7) & 15, lg = e >> 11;
          const float* src = in[17] + ((size_t)lg * 128 + k8 * 8) * 128 + n;
          u32x4 o; o.x = pk2(src[0], src[128]); o.y = pk2(src[256], src[384]); o.z = pk2(src[512], src[640]); o.w = pk2(src[768], src[896]);
          *(u32x4*)(WTP + ((size_t)lg * 128 + n) * 128 + k8 * 8) = o; } }
    const int* pos = (const int*)in[1];
    float* rope = (float*)(ws + WS_ROPE);
    for (int e = F.bid * NTHR + F.tid; e < MTOK * 8; e += F.G * NTHR) { const int m = e >> 3, i = e & 7;
        const float inv = exp2f(-(float)i * 0.125f * 18.931568569324174f);
        const float ang = (float)pos[m] * inv; float sn, cs; sincosf(ang, &sn, &cs);
        rope[m * 16 + i] = cs; rope[m * 16 + 8 + i] = sn; }
    const float* x = in[0]; bf16_t* YB = (bf16_t*)(ws + WS_YB); float* pa = (float*)(ws + WS_PARTA);
    for (int m = gw; m < MTOK; m += NGW) { float s = 0.f;
        f32x4 xv[8];
#pragma unroll
        for (int j = 0; j < 8; ++j) xv[j] = *(const f32x4*)(x + (size_t)m * DM + (j * 64 + F.lane) * 4);
        __builtin_amdgcn_sched_barrier(0);
#pragma unroll
        for (int j = 0; j < 8; ++j) { const f32x4 v = xv[j]; s += (v[0] * v[0] + v[1] * v[1]) + (v[2] * v[2] + v[3] * v[3]);
            u32x2 w; w.x = pk2(v[0], v[1]); w.y = pk2(v[2], v[3]); *(u32x2*)(YB + (size_t)m * DM + (j * 64 + F.lane) * 4) = w; }
        s = wave_sum(s);
        if (F.lane < 32) pa[(size_t)m * 32 + F.lane] = (F.lane == 0) ? s : 0.f; }
}

DI void dsa_prep_item(const Frame& F, unsigned char* ws, const float* idxg, int item) {
    const bf16_t* ZS = (const bf16_t*)(ws + WS_ZS); const float* rope = (const float*)(ws + WS_ROPE);
    bf16_t* Q = (bf16_t*)(ws + WS_Q); bf16_t* Kb = (bf16_t*)(ws + WS_K); bf16_t* VT = (bf16_t*)(ws + WS_VT); bf16_t* QI = (bf16_t*)(ws + WS_QI); bf16_t* KI = (bf16_t*)(ws + WS_KI); float* WI = (float*)(ws + WS_WI);
    const int m0 = item * 32;
    int tid_ = F.tid; asm volatile("" : "+v"(tid_));
    const int wv4 = F.wave * 4;
    float kx[4], wx[4];
#pragma unroll
    for (int tt = 0; tt < 4; ++tt) { const int m = m0 + wv4 + tt; kx[tt] = bf2f(ZS[(size_t)m * ZS_COLS + ZO_KI + F.lane]); wx[tt] = bf2f(ZS[(size_t)m * ZS_COLS + ZO_WI + (F.lane & 3)]); }
#pragma unroll
    for (int hb = 0; hb < 2; ++hb) {
        u32x4 raw[5]; f32x4 cs[5], sn[5];
#pragma unroll
        for (int q = 0; q < 5; ++q) { const int e = tid_ + (5 * hb + q) * NTHR; const int t = e / 160, pc = e % 160; const int m = m0 + t;
            const int zc = pc < 64 ? ZO_Q + 8 * pc : (pc < 128 ? ZO_AK + 8 * (pc - 64) : ZO_QI + 8 * (pc - 128));
            raw[q] = *(const u32x4*)(ZS + (size_t)m * ZS_COLS + zc);
            cs[q] = *(const f32x4*)(rope + (size_t)m * 16 + 4 * (pc & 1)); sn[q] = *(const f32x4*)(rope + (size_t)m * 16 + 8 + 4 * (pc & 1)); }
        __builtin_amdgcn_sched_barrier(0);
#pragma unroll
        for (int q = 0; q < 5; ++q) { const int e = tid_ + (5 * hb + q) * NTHR; const int t = e / 160, pc = e % 160; const int m = m0 + t;
            const int c8 = pc & 7; const bool rot = c8 < 2; const float sc = pc < 64 ? 0.125f : 1.0f;
            float o[8];
#pragma unroll
            for (int i = 0; i < 4; ++i) { const unsigned wi = raw[q][i]; const float x1 = bf2f(wi & 0xffffu), x2 = bf2f(wi >> 16); const float r1 = x1 * cs[q][i] - x2 * sn[q][i], r2 = x2 * cs[q][i] + x1 * sn[q][i];
                o[2 * i] = (rot ? r1 : x1) * sc; o[2 * i + 1] = (rot ? r2 : x2) * sc; }
            u32x4 w; w.x = pk2(o[0], o[1]); w.y = pk2(o[2], o[3]); w.z = pk2(o[4], o[5]); w.w = pk2(o[6], o[7]);
            if (pc < 64) *(u32x4*)(Q + (size_t)m * 512 + 8 * pc) = w;
            else if (pc < 128) { const int oc = 8 * (pc - 64), tq = m % SEQ, hq = oc >> 6, pq = oc & 63;
                *(u32x4*)(Kb + (((((size_t)(m / SEQ) * 8 + hq) * 64 + (tq >> 5)) * 4 + (pq >> 4)) * 32 + (tq & 31)) * 16 + ((pq >> 3) & 1) * 8) = w; }
            else *(u32x4*)(QI + (size_t)m * 256 + 8 * (pc - 128)) = w; }
        __builtin_amdgcn_sched_barrier(0);
    }
    { const int dim = F.lane < 16 ? ((F.lane >> 1) + 8 * (F.lane & 1)) : F.lane; const float gn = idxg[dim];
      float csv[4], snv[4];
#pragma unroll
      for (int tt = 0; tt < 4; ++tt) { const int m = m0 + wv4 + tt; csv[tt] = rope[m * 16 + ((F.lane >> 1) & 7)]; snv[tt] = rope[m * 16 + 8 + ((F.lane >> 1) & 7)]; }
      __builtin_amdgcn_sched_barrier(0);
#pragma unroll
      for (int tt = 0; tt < 4; ++tt) { const int m = m0 + wv4 + tt;
        const float xv = kx[tt];
        const float ss = wave_sum(xv * xv);
        float y = xv * (1.0f / sqrtf(ss * (1.0f / 64.f) + RMS_EPS)) * gn;
        const float pr = __shfl_xor(y, 1);
        if (F.lane < 16) y = (F.lane & 1) ? (y * csv[tt] + pr * snv[tt]) : (y * csv[tt] - pr * snv[tt]);
        { const int tq = m % SEQ, pq = F.lane; KI[((((size_t)(m / SEQ) * 64 + (tq >> 5)) * 4 + (pq >> 4)) * 32 + (tq & 31)) * 16 + ((pq >> 3) & 1) * 8 + (pq & 7)] = (bf16_t)f2bf(y); }
        if (F.lane < 4) WI[(size_t)m * 4 + F.lane] = wx[tt]; } }
    LAS unsigned char* L = F.lds;
    for (int e = F.tid; e < 32 * 128; e += NTHR) { const int t = e >> 7, c4 = (e & 127) * 4;
        *(LAS u32x2*)(L + t * 1040 + c4 * 2) = *(const u32x2*)(ZS + (size_t)(m0 + t) * ZS_COLS + ZO_AV + c4); }
    __syncthreads();
    { const int b = m0 / SEQ, kt = (m0 % SEQ) >> 5;
      for (int e = F.tid; e < 512 * 4; e += NTHR) { const int c = e >> 2, s2 = (e >> 1) & 1, hq = e & 1;
          unsigned short vals[8];
#pragma unroll
          for (int j = 0; j < 8; ++j) vals[j] = *(const LAS unsigned short*)(L + (16 * s2 + 8 * (j >> 2) + 4 * hq + (j & 3)) * 1040 + c * 2);
          u32x4 o; o.x = vals[0] | ((unsigned)vals[1] << 16); o.y = vals[2] | ((unsigned)vals[3] << 16); o.z = vals[4] | ((unsigned)vals[5] << 16); o.w = vals[6] | ((unsigned)vals[7] << 16);
          const int hv = c >> 6, d = c & 63;
          *(u32x4*)(VT + ((((((size_t)b * 8 + hv) * 64 + kt) * 2 + s2) * 2 + (d >> 5)) * 32 + (d & 31)) * 16 + hq * 8) = o; } }
    __syncthreads();
}

DI float softplusf_(float x) { return fmaxf(x, 0.f) + __logf(1.0f + __expf(-fabsf(x))); }
DI float tanhf_(float x) { return 1.0f - 2.0f * __builtin_amdgcn_rcpf(1.0f + __expf(2.0f * x)); }
DI float half32_sum(float x) { x = row16_sum(x); return x + __shfl_xor(x, 16); }
DI f32x4 cv4bf(const u32x2 w) { return (f32x4){bf2f(w.x & 0xffffu), bf2f(w.x >> 16), bf2f(w.y & 0xffffu), bf2f(w.y >> 16)}; }
struct RwG { u32x2 zr, zk, zv, pr, pk, pv; };
DI void rwg_load(RwG& G, const bf16_t* zc_, const bf16_t* zp_, int n) {
    G.zr = *(const u32x2*)(zc_ + ZO_R + n); G.zk = *(const u32x2*)(zc_ + ZO_K + n); G.zv = *(const u32x2*)(zc_ + ZO_V + n);
    G.pr = *(const u32x2*)(zp_ + ZO_R + n); G.pk = *(const u32x2*)(zp_ + ZO_K + n); G.pv = *(const u32x2*)(zp_ + ZO_V + n);
}
DI void rwkv_prep_item(const Frame& F, unsigned char* ws, const In& in, int l, int item) {
    const bf16_t* ZS = (const bf16_t*)(ws + WS_ZS);
    const float* mu = in[6] + l * B_COLS; const float* w0 = in[7] + l * MIX; const float* a0 = in[9] + l * MIX; const float* k_k = in[12] + l * MIX; const float* k_a = in[13] + l * MIX;
    const bf16_t* WTL = (const bf16_t*)(ws + WS_WTL) + (size_t)l * MIX * 448;
    float* RW = (float*)(ws + WS_RW); constexpr size_t RS = RW_STRIDE / 4;
    const int m0 = item * 32; const bool first = (m0 % SEQ) == 0;
    constexpr int XP = 456;
    LAS bf16_t* X = (LAS bf16_t*)F.lds;
    LAS float* PT = (LAS float*)(F.lds + 32768);
    { u32x2 zc7[7], zp7[7]; f32x4 mv7[7]; float pt7[7];
#pragma unroll
      for (int it = 0; it < 7; ++it) { const int e = F.tid + it * NTHR; const int t = e / 112, c = (e % 112) * 4; const int m = m0 + t, zc = ZO_LW + c; const bool nop = first && t == 0;
          zc7[it] = *(const u32x2*)(ZS + (size_t)m * ZS_COLS + zc); zp7[it] = *(const u32x2*)(ZS + (size_t)(nop ? m : m - 1) * ZS_COLS + zc); mv7[it] = *(const f32x4*)(mu + zc); }
      pt7[0] = mu[ZO_R + F.tid]; pt7[1] = mu[ZO_K + F.tid]; pt7[2] = mu[ZO_V + F.tid]; pt7[3] = w0[F.tid]; pt7[4] = a0[F.tid]; pt7[5] = k_k[F.tid]; pt7[6] = k_a[F.tid];
      __builtin_amdgcn_sched_barrier(0);
#pragma unroll
      for (int a = 0; a < 7; ++a) PT[a * 512 + F.tid] = pt7[a];
#pragma unroll
      for (int it = 0; it < 7; ++it) { const int e = F.tid + it * NTHR; const int t = e / 112, c = (e % 112) * 4; const bool nop = first && t == 0;
          const f32x4 z = cv4bf(zc7[it]); f32x4 zp = cv4bf(zp7[it]);
          if (nop) zp = (f32x4){0.f, 0.f, 0.f, 0.f};
          const f32x4 xs = z + (zp - z) * mv7[it]; float o[4];
          const float ea = c < 96 ? 2.0f : -1.0f;
#pragma unroll
          for (int i = 0; i < 4; ++i) { const float rc = __builtin_amdgcn_rcpf(1.0f + __expf(ea * xs[i])); o[i] = c < 96 ? (1.0f - 2.0f * rc) : (c < 192 ? xs[i] : rc); }
          *(LAS u32x2*)(X + t * XP + c) = (u32x2){pk2(o[0], o[1]), pk2(o[2], o[3])}; } }
    __syncthreads();
    const int r = F.lane & 31, hh = F.lane >> 5, h = F.wave, m = m0 + r;
    const bool nop = first && r == 0;
    const bf16_t* zc_ = ZS + (size_t)m * ZS_COLS; const bf16_t* zp_ = ZS + (size_t)(nop ? m : m - 1) * ZS_COLS;
    float ss = 0.f;
    { u32x2 zk8[8], pk8[8];
#pragma unroll
      for (int q = 0; q < 8; ++q) { const int n = h * 64 + (q >> 2) * 32 + 8 * (q & 3) + 4 * hh; zk8[q] = *(const u32x2*)(zc_ + ZO_K + n); pk8[q] = *(const u32x2*)(zp_ + ZO_K + n); }
      __builtin_amdgcn_sched_barrier(0);
#pragma unroll
      for (int q = 0; q < 8; ++q) { const int n = h * 64 + (q >> 2) * 32 + 8 * (q & 3) + 4 * hh;
          const f32x4 zk = cv4bf(zk8[q]); f32x4 pk = cv4bf(pk8[q]); if (nop) pk = (f32x4){0.f, 0.f, 0.f, 0.f};
          const f32x4 kk = (zk + (pk - zk) * *(const LAS f32x4*)(PT + 512 + n)) * *(const LAS f32x4*)(PT + 5 * 512 + n);
          ss += (kk[0] * kk[0] + kk[1] * kk[1]) + (kk[2] * kk[2] + kk[3] * kk[3]); } }
    ss += __shfl_xor(ss, 32);
    const float inv = 1.0f / fmaxf(sqrtf(ss), 1e-12f);
    const LAS bf16_t* xb = X + r * XP + 8 * hh;
#pragma unroll 1
    for (int nt = 0; nt < 2; ++nt) { const bf16_t* wrow = WTL + (size_t)(h * 64 + nt * 32 + r) * 448 + 8 * hh;
        f32x16 aw, aa, ag;
#pragma unroll
        for (int i = 0; i < 16; ++i) { aw[i] = 0.f; aa[i] = 0.f; ag[i] = 0.f; }
        bf16x8 wA[7], wB[7];
#define RW_LOAD(dst, b) _Pragma("unroll") for (int q = 0; q < 7; ++q) dst[q] = *(const bf16x8*)(wrow + 16 * (7 * (b) + q))
#define RW_MMA(src, b) _Pragma("unroll") for (int q = 0; q < 7; ++q) { const int j = 7 * (b) + q; const bf16x8 xv = *(const LAS bf16x8*)(xb + 16 * j); \
            if (j < 6) aw = MFMA32(src[q], xv, aw); else if (j < 12) aa = MFMA32(src[q], xv, aa); else ag = MFMA32(src[q], xv, ag); }
        RW_LOAD(wA, 0); RW_LOAD(wB, 1); __builtin_amdgcn_sched_barrier(0);
        RW_MMA(wA, 0); __builtin_amdgcn_sched_barrier(0); RW_LOAD(wA, 2); __builtin_amdgcn_sched_barrier(0);
        RW_MMA(wB, 1); __builtin_amdgcn_sched_barrier(0); RW_LOAD(wB, 3); __builtin_amdgcn_sched_barrier(0);
        RW_MMA(wA, 2); __builtin_amdgcn_sched_barrier(0);
        RwG G0; rwg_load(G0, zc_, zp_, h * 64 + nt * 32 + 4 * hh); __builtin_amdgcn_sched_barrier(0);
        RW_MMA(wB, 3); __builtin_amdgcn_sched_barrier(0);
#undef RW_LOAD
#undef RW_MMA
#pragma unroll
        for (int g = 0; g < 4; ++g) { const int n = h * 64 + nt * 32 + 8 * g + 4 * hh;
            const RwG G = G0;
            if (g < 3) rwg_load(G0, zc_, zp_, n + 8);
            __builtin_amdgcn_sched_barrier(0);
            const f32x4 zr = cv4bf(G.zr), zk = cv4bf(G.zk), zv = cv4bf(G.zv);
            f32x4 pr = cv4bf(G.pr), pk = cv4bf(G.pk), pv = cv4bf(G.pv);
            if (nop) { pr = (f32x4){0.f, 0.f, 0.f, 0.f}; pk = pr; pv = pr; }
            const f32x4 rr = zr + (pr - zr) * *(const LAS f32x4*)(PT + n), k = zk + (pk - zk) * *(const LAS f32x4*)(PT + 512 + n), v = zv + (pv - zv) * *(const LAS f32x4*)(PT + 2 * 512 + n);
            const f32x4 w0v = *(const LAS f32x4*)(PT + 3 * 512 + n), a0v = *(const LAS f32x4*)(PT + 4 * 512 + n), kkv = *(const LAS f32x4*)(PT + 5 * 512 + n), kav = *(const LAS f32x4*)(PT + 6 * 512 + n);
            f32x4 dec, k2, nkk, kka, gg;
#pragma unroll
            for (int j = 0; j < 4; ++j) { const int i = 4 * g + j;
                const float wlog = -softplusf_(-(w0v[j] + aw[i])) - 0.5f; dec[j] = __expf(-__expf(wlog));
                const float a = sigmoidf_(a0v[j] + aa[i]); const float kk = k[j] * kkv[j] * inv;
                k2[j] = k[j] * (1.0f + (a - 1.0f) * kav[j]); nkk[j] = -kk; kka[j] = kk * a; gg[j] = ag[i]; }
            const size_t o = (size_t)m * MIX + n;
            *(f32x4*)(RW + 0 * RS + o) = rr; *(f32x4*)(RW + 1 * RS + o) = dec; *(f32x4*)(RW + 2 * RS + o) = k2; *(f32x4*)(RW + 3 * RS + o) = v;
            *(f32x4*)(RW + 4 * RS + o) = nkk; *(f32x4*)(RW + 5 * RS + o) = kka; *(f32x4*)(RW + 6 * RS + o) = gg;
            __builtin_amdgcn_sched_barrier(0); } }
    __syncthreads();
}

template <int LV> DI void pool_windows(const float (&z)[47], int t0, LAS bf16_t* D, int j) {
    float s[47];
#pragma unroll
    for (int i = 0; i < 47; ++i) s[i] = z[i];
#pragma unroll
    for (int lv = 0; lv < LV; ++lv) {
#pragma unroll
        for (int i = 46; i >= 0; --i) { const int o = i - (1 << lv); s[i] = s[i] + (o >= 0 ? s[o] : 0.f); } }
#pragma unroll
    for (int t = 0; t < 32; ++t) { const int ta = t0 + t; const int cnt = (ta + 1) < (1 << LV) ? (ta + 1) : (1 << LV);
        D[t * 520 + j] = (bf16_t)f2bf(s[15 + t] / (float)cnt - z[15 + t]); }
}
DI void pool_item(const Frame& F, unsigned char* ws, const In& in, int l, int item) {
    const bf16_t* ZS = (const bf16_t*)(ws + WS_ZS); bf16_t* MIXp = (bf16_t*)(ws + WS_MIX);
    const bf16_t* WTP = (const bf16_t*)(ws + WS_WTP) + (size_t)l * 4 * 128 * 128; const float* psc = in[18] + l * MIX;
    const int m0 = item * 32, t0 = m0 % SEQ;
    LAS bf16_t* D = (LAS bf16_t*)F.lds;
    { const int j = F.tid, gi = j >> 7;
      float z[47];
#pragma unroll
      for (int i = 0; i < 47; ++i) { const int ta = t0 - 15 + i; z[i] = bf2f(ZS[(size_t)(m0 - 15 + (ta >= 0 ? i : 15)) * ZS_COLS + ZO_C + j]); if (ta < 0) z[i] = 0.f; }
      if (gi == 0) pool_windows<1>(z, t0, D, j); else if (gi == 1) pool_windows<2>(z, t0, D, j); else if (gi == 2) pool_windows<3>(z, t0, D, j); else pool_windows<4>(z, t0, D, j); }
    __syncthreads();
    const int r = F.lane & 31, hh = F.lane >> 5, gi = F.wave >> 1;
    const LAS bf16_t* xa = D + r * 520 + gi * 128 + 8 * hh;
#pragma unroll
    for (int q = 0; q < 2; ++q) { const int n = (2 * (F.wave & 1) + q) * 32 + r;
        const bf16_t* wrow = WTP + ((size_t)gi * 128 + n) * 128 + 8 * hh;
        bf16x8 wq[8];
#pragma unroll
        for (int s2 = 0; s2 < 8; ++s2) wq[s2] = *(const bf16x8*)(wrow + 16 * s2);
        const int col = gi * 128 + n; const float sc = psc[col];
        __builtin_amdgcn_sched_barrier(0);
        f32x16 acc;
#pragma unroll
        for (int i = 0; i < 16; ++i) acc[i] = 0.f;
#pragma unroll
        for (int s2 = 0; s2 < 8; ++s2) acc = MFMA32(*(const LAS bf16x8*)(xa + 16 * s2), wq[s2], acc);
#pragma unroll
        for (int i = 0; i < 16; ++i) { const int m = m0 + (i & 3) + 8 * (i >> 2) + 4 * hh; MIXp[(size_t)m * (4 * MIX) + 2 * MIX + col] = (bf16_t)f2bf(acc[i] * sc); }
        __builtin_amdgcn_sched_barrier(0); }
    __syncthreads();
}

DI float gelu_tanh(float y) { const float u = 0.7978845608028654f * (y + 0.044715f * y * y * y); return y * (1.0f - __builtin_amdgcn_rcpf(1.0f + __expf(2.0f * u))); }

DI void ssm_seq_item(const Frame& F, unsigned char* ws, const In& in, int l, int item) {
    const bf16_t* ZS = (const bf16_t*)(ws + WS_ZS); bf16_t* YSB = (bf16_t*)(ws + WS_YSB);
    const int task = item * 8 + F.wave, g = task >> 1, bp = task & 1;
    const int r = F.lane & 31, hh = F.lane >> 5;
    constexpr int XP = 136;
    LAS bf16_t* Xl = (LAS bf16_t*)(F.lds + F.wave * 8704);
    float lr[2], li[2]; bf16x8 Bf[4];
#pragma unroll
    for (int ps = 0; ps < 2; ++ps) { const int p = r + 32 * ps;
        const float are = in[19][((size_t)l * 32 + g) * 64 + p], aim = in[20][((size_t)l * 32 + g) * 64 + p];
        const float dt = __expf(in[21][l * 32 + g]);
        const float er = __expf(are * dt); float sn, cs; sincosf(aim * dt, &sn, &cs);
        lr[ps] = er * cs; li[ps] = er * sn;
        const float nr = lr[ps] - 1.0f, ni = li[ps], den = are * are + aim * aim;
        const float cr = (nr * are + ni * aim) / den, ci = (ni * are - nr * aim) / den;
        const float* bre = in[22] + (((size_t)l * 32 + g) * 64 + p) * 16 + 8 * hh; const float* bim = in[23] + (((size_t)l * 32 + g) * 64 + p) * 16 + 8 * hh;
        float vr[8], vi[8];
#pragma unroll
        for (int j = 0; j < 8; ++j) { const float x = bre[j], y = bim[j]; vr[j] = cr * x - ci * y; vi[j] = cr * y + ci * x; }
        Bf[2 * ps] = pack8(vr[0], vr[1], vr[2], vr[3], vr[4], vr[5], vr[6], vr[7]); Bf[2 * ps + 1] = pack8(vi[0], vi[1], vi[2], vi[3], vi[4], vi[5], vi[6], vi[7]); }
    bf16x8 Cf[8];
    { const float* cre = in[24] + (((size_t)l * 32 + g) * 16 + (r & 15)) * 64; const float* cim = in[25] + (((size_t)l * 32 + g) * 16 + (r & 15)) * 64;
#pragma unroll
      for (int s2 = 0; s2 < 8; ++s2) { const int q = s2 >> 1, n0 = 16 * (s2 & 1) + 8 * hh + 32 * (q >> 1); float v[8];
#pragma unroll
          for (int j = 0; j < 8; ++j) { const float x = (q & 1) ? -cim[n0 + j] : cre[n0 + j]; v[j] = (r < 16) ? x : 0.f; }
          Cf[s2] = pack8(v[0], v[1], v[2], v[3], v[4], v[5], v[6], v[7]); } }
    const float dsk = in[26][l * MIX + g * 16 + (r & 15)];
    bf16x8 Dg;
    { float v[8];
#pragma unroll
      for (int j = 0; j < 8; ++j) v[j] = (r < 16 && 8 * hh + j == r) ? dsk : 0.f;
      Dg = pack8(v[0], v[1], v[2], v[3], v[4], v[5], v[6], v[7]); }
    float xr0 = 0.f, xi0 = 0.f, xr1 = 0.f, xi1 = 0.f;
    const int hr = (r >> 2) & 1, ir = 4 * (r >> 3) + (r & 3);
    const bf16_t* usrc = ZS + (size_t)((bp + 2 * hr) * SEQ + ir) * ZS_COLS + ZO_D + g * 16 + 8 * hh;
    bf16x8 unx = *(const bf16x8*)usrc;
    const size_t ebase = (size_t)((bp + 2 * hh) * SEQ) ;
    bf16_t* yout = YSB + ebase * MIX + g * 16 + (r & 15);
#pragma unroll 1
    for (int tile = 0; tile < SEQ / 16; ++tile) {
        const bf16x8 Au = unx;
        if (tile + 1 < SEQ / 16) unx = *(const bf16x8*)(usrc + (size_t)(tile + 1) * 16 * ZS_COLS);
        f32x16 z16;
#pragma unroll
        for (int i = 0; i < 16; ++i) z16[i] = 0.f;
        f32x16 a0 = MFMA32(Au, Bf[0], z16), a1 = MFMA32(Au, Bf[1], z16), a2 = MFMA32(Au, Bf[2], z16), a3 = MFMA32(Au, Bf[3], z16);
#pragma unroll
        for (int i = 0; i < 16; ++i) {
            const float n0r = lr[0] * xr0 - li[0] * xi0 + a0[i], n0i = lr[0] * xi0 + li[0] * xr0 + a1[i]; xr0 = n0r; xi0 = n0i; a0[i] = n0r; a1[i] = n0i;
            const float n1r = lr[1] * xr1 - li[1] * xi1 + a2[i], n1i = lr[1] * xi1 + li[1] * xr1 + a3[i]; xr1 = n1r; xi1 = n1i; a2[i] = n1r; a3[i] = n1i; }
#pragma unroll
        for (int i = 0; i < 16; ++i) { const int rho = (i & 3) + 8 * (i >> 2) + 4 * hh; LAS bf16_t* row = Xl + rho * XP + r;
            row[0] = (bf16_t)f2bf(a0[i]); row[32] = (bf16_t)f2bf(a1[i]); row[64] = (bf16_t)f2bf(a2[i]); row[96] = (bf16_t)f2bf(a3[i]); }
        LDS_WAIT(); asm volatile("" ::: "memory");
        f32x16 ay = MFMA32(Au, Dg, z16);
#pragma unroll
        for (int s2 = 0; s2 < 8; ++s2) ay = MFMA32(*(const LAS bf16x8*)(Xl + r * XP + 16 * s2 + 8 * hh), Cf[s2], ay);
        if (r < 16) {
#pragma unroll
            for (int i = 0; i < 16; ++i) yout[(size_t)(tile * 16 + i) * MIX] = (bf16_t)f2bf(gelu_tanh(ay[i])); }
        LDS_WAIT(); asm volatile("" ::: "memory");
    }
}

DI float vmul_(float a, float b) { float d; asm("v_mul_f32 %0, %1, %2" : "=v"(d) : "v"(a), "v"(b)); return d; }
DI float vfma_(float a, float b, float c) { float d; asm("v_fma_f32 %0, %1, %2, %3" : "=v"(d) : "v"(a), "v"(b), "v"(c)); return d; }
DI void row16_sum2(float& x0, float& x1) {
    asm("s_nop 1\n\t"
        "v_add_f32_dpp %0, %0, %0 quad_perm:[1,0,3,2] row_mask:0xf bank_mask:0xf bound_ctrl:1\n\tv_add_f32_dpp %1, %1, %1 quad_perm:[1,0,3,2] row_mask:0xf bank_mask:0xf bound_ctrl:1\n\ts_nop 0\n\t"
        "v_add_f32_dpp %0, %0, %0 quad_perm:[2,3,0,1] row_mask:0xf bank_mask:0xf bound_ctrl:1\n\tv_add_f32_dpp %1, %1, %1 quad_perm:[2,3,0,1] row_mask:0xf bank_mask:0xf bound_ctrl:1\n\ts_nop 0\n\t"
        "v_add_f32_dpp %0, %0, %0 row_half_mirror row_mask:0xf bank_mask:0xf bound_ctrl:1\n\tv_add_f32_dpp %1, %1, %1 row_half_mirror row_mask:0xf bank_mask:0xf bound_ctrl:1\n\ts_nop 0\n\t"
        "v_add_f32_dpp %0, %0, %0 row_mirror row_mask:0xf bank_mask:0xf bound_ctrl:1\n\tv_add_f32_dpp %1, %1, %1 row_mirror row_mask:0xf bank_mask:0xf bound_ctrl:1\n\ts_nop 1"
        : "+v"(x0), "+v"(x1));
}
DI void row16_sum4(float& x0, float& x1, float& x2, float& x3) {
#define R4(ctl) "v_add_f32_dpp %0, %0, %0 " ctl " row_mask:0xf bank_mask:0xf bound_ctrl:1\n\tv_add_f32_dpp %1, %1, %1 " ctl " row_mask:0xf bank_mask:0xf bound_ctrl:1\n\t" \
                "v_add_f32_dpp %2, %2, %2 " ctl " row_mask:0xf bank_mask:0xf bound_ctrl:1\n\tv_add_f32_dpp %3, %3, %3 " ctl " row_mask:0xf bank_mask:0xf bound_ctrl:1\n\t"
    asm("s_nop 1\n\t" R4("quad_perm:[1,0,3,2]") R4("quad_perm:[2,3,0,1]") R4("row_half_mirror") R4("row_mirror") "s_nop 0"
        : "+v"(x0), "+v"(x1), "+v"(x2), "+v"(x3));
#undef R4
}
DI void row_update(float (&S)[4], float sa, float v, const f32x4& w, const f32x4& b, const f32x4& k) {
    float t0, t1, t2, t3;
    asm("v_mul_f32 %4, %9, %18\n\tv_mul_f32 %5, %9, %19\n\tv_mul_f32 %6, %9, %20\n\tv_mul_f32 %7, %9, %21\n\t"
        "v_fma_f32 %4, %8, %14, %4\n\tv_fma_f32 %5, %8, %15, %5\n\tv_fma_f32 %6, %8, %16, %6\n\tv_fma_f32 %7, %8, %17, %7\n\t"
        "v_fma_f32 %0, %0, %10, %4\n\tv_fma_f32 %1, %1, %11, %5\n\tv_fma_f32 %2, %2, %12, %6\n\tv_fma_f32 %3, %3, %13, %7"
        : "+v"(S[0]), "+v"(S[1]), "+v"(S[2]), "+v"(S[3]), "=&v"(t0), "=&v"(t1), "=&v"(t2), "=&v"(t3)
        : "v"(sa), "v"(v), "v"(w[0]), "v"(w[1]), "v"(w[2]), "v"(w[3]), "v"(b[0]), "v"(b[1]), "v"(b[2]), "v"(b[3]), "v"(k[0]), "v"(k[1]), "v"(k[2]), "v"(k[3]));
}
DI void row_dots(const float (&S0)[4], const float (&S1)[4], const f32x4& r, const f32x4& an, float& y0, float& y1, float& s0, float& s1) {
    asm("v_mul_f32 %0, %4, %12\n\tv_mul_f32 %1, %8, %12\n\tv_mul_f32 %2, %4, %16\n\tv_mul_f32 %3, %8, %16\n\t"
        "v_fma_f32 %0, %5, %13, %0\n\tv_fma_f32 %1, %9, %13, %1\n\tv_fma_f32 %2, %5, %17, %2\n\tv_fma_f32 %3, %9, %17, %3\n\t"
        "v_fma_f32 %0, %6, %14, %0\n\tv_fma_f32 %1, %10, %14, %1\n\tv_fma_f32 %2, %6, %18, %2\n\tv_fma_f32 %3, %10, %18, %3\n\t"
        "v_fma_f32 %0, %7, %15, %0\n\tv_fma_f32 %1, %11, %15, %1\n\tv_fma_f32 %2, %7, %19, %2\n\tv_fma_f32 %3, %11, %19, %3"
        : "=&v"(y0), "=&v"(y1), "=&v"(s0), "=&v"(s1)
        : "v"(S0[0]), "v"(S0[1]), "v"(S0[2]), "v"(S0[3]), "v"(S1[0]), "v"(S1[1]), "v"(S1[2]), "v"(S1[3]),
          "v"(r[0]), "v"(r[1]), "v"(r[2]), "v"(r[3]), "v"(an[0]), "v"(an[1]), "v"(an[2]), "v"(an[3]));
}
DI void row_dots1(const float (&S)[4], const f32x4& r, const f32x4& an, float& y, float& sn) {
    asm("v_mul_f32 %0, %2, %6\n\tv_mul_f32 %1, %2, %10\n\tv_fma_f32 %0, %3, %7, %0\n\tv_fma_f32 %1, %3, %11, %1\n\t"
        "v_fma_f32 %0, %4, %8, %0\n\tv_fma_f32 %1, %4, %12, %1\n\tv_fma_f32 %0, %5, %9, %0\n\tv_fma_f32 %1, %5, %13, %1"
        : "=&v"(y), "=&v"(sn)
        : "v"(S[0]), "v"(S[1]), "v"(S[2]), "v"(S[3]), "v"(r[0]), "v"(r[1]), "v"(r[2]), "v"(r[3]), "v"(an[0]), "v"(an[1]), "v"(an[2]), "v"(an[3]));
}
DI void rwkv_scan_item(const Frame& F, unsigned char* ws, int item) {
    const float* RW = (const float*)(ws + WS_RW); constexpr size_t RS = RW_STRIDE / 4;
    float* YRAW = (float*)(ws + WS_YRAW);
    constexpr int TC = 32, NCH = SEQ / TC;
    const int bh = item >> 1, b = bh >> 3, h = bh & 7;
    const int rg = F.lane >> 4, jq = F.lane & 15, row = (item & 1) * 32 + F.wave * 4 + rg;
    LAS float* BUF = (LAS float*)F.lds;
    constexpr int BUFSZ = 6 * TC * 64;
    const int st = F.tid >> 4, sq = F.tid & 15;
    const float* gsrc = RW + (size_t)(b * SEQ + st) * MIX + h * 64 + 4 * sq;
    f32x4 pre[6];
#pragma unroll
    for (int a = 0; a < 6; ++a) pre[a] = *(const f32x4*)(gsrc + a * RS);
#pragma unroll
    for (int a = 0; a < 6; ++a) *(LAS f32x4*)(BUF + (a * TC + st) * 64 + 4 * sq) = pre[a];
    __syncthreads();
    float S[4] = {0.f, 0.f, 0.f, 0.f};
    float* yout = YRAW + (size_t)(b * SEQ) * MIX + h * 64 + row;
#pragma unroll 1
    for (int c = 0; c < NCH; ++c) {
        if (c + 1 < NCH) {
#pragma unroll
            for (int a = 0; a < 6; ++a) pre[a] = *(const f32x4*)(gsrc + a * RS + (size_t)(c + 1) * TC * MIX);
        }
        const LAS float* P = BUF + (c & 1) * BUFSZ;
        float sp, yp = 0.f;
        { const f32x4 a4 = *(const LAS f32x4*)(P + (4 * TC) * 64 + 4 * jq); float d; row_dots1(S, a4, a4, d, sp); }
#pragma unroll 1
        for (int t16 = 0; t16 < TC; t16 += 16) {
            float yk = 0.f;
#pragma unroll 4
            for (int tt = 0; tt < 16; ++tt) { const int t = t16 + tt;
                const f32x4 k4 = *(const LAS f32x4*)(P + (2 * TC + t) * 64 + 4 * jq);
                const float v = P[(3 * TC + t) * 64 + row];
                const f32x4 b4 = *(const LAS f32x4*)(P + (5 * TC + t) * 64 + 4 * jq);
                const f32x4 w4 = *(const LAS f32x4*)(P + (1 * TC + t) * 64 + 4 * jq);
                const f32x4 r4 = *(const LAS f32x4*)(P + (0 * TC + t) * 64 + 4 * jq);
                const f32x4 an = *(const LAS f32x4*)(P + (4 * TC + ((t + 1) & (TC - 1))) * 64 + 4 * jq);
                row16_sum2(sp, yp);
                if (tt > 0) yk = ((tt - 1) == jq) ? yp : yk;
                row_update(S, sp, v, w4, b4, k4);
                row_dots1(S, r4, an, yp, sp); }
            { float d = 0.f, q = yp; row16_sum2(d, q); yk = (jq == 15) ? q : yk; yp = 0.f; }
            yout[(size_t)(c * TC + t16 + jq) * MIX] = yk;
        }
        if (c + 1 < NCH) {
            LAS float* Q = BUF + ((c + 1) & 1) * BUFSZ;
#pragma unroll
            for (int a = 0; a < 6; ++a) *(LAS f32x4*)(Q + (a * TC + st) * 64 + 4 * sq) = pre[a];
        }
        __syncthreads();
    }
}
DI void rwkv_post_rows(const Frame& F, unsigned char* ws, const In& in, int l, int w0, int nw) {
    const float* RW = (const float*)(ws + WS_RW); constexpr size_t RS = RW_STRIDE / 4;
    const float* YRAW = (const float*)(ws + WS_YRAW); bf16_t* MIXp = (bf16_t*)(ws + WS_MIX);
    const float* r_k = in[14] + l * MIX; const float* lng = in[15] + l * MIX; const float* lnb = in[16] + l * MIX;
    for (int e0 = w0; e0 < MTOK * 8; e0 += 4 * nw) {
        float y[4], r0[4], r2[4], r3[4], r6[4], gw[4], gb[4], rk[4];
#pragma unroll
        for (int k = 0; k < 4; ++k) { int e = e0 + k * nw; e = e < MTOK * 8 ? e : e0; const int m = e >> 3, h = e & 7, ch = h * 64 + F.lane; const size_t o = (size_t)m * MIX + ch;
            y[k] = YRAW[o]; r0[k] = RW[0 * RS + o]; r2[k] = RW[2 * RS + o]; r3[k] = RW[3 * RS + o]; r6[k] = RW[6 * RS + o]; gw[k] = lng[ch]; gb[k] = lnb[ch]; rk[k] = r_k[ch]; }
        __builtin_amdgcn_sched_barrier(0);
#pragma unroll
        for (int k = 0; k < 4; ++k) { const int e = e0 + k * nw; const int m = e >> 3, h = e & 7, ch = h * 64 + F.lane;
            const float mean = wave_sum(y[k]) * (1.f / 64.f); const float d = y[k] - mean; const float var = wave_sum(d * d) * (1.f / 64.f);
            const float yn = d * (1.0f / sqrtf(var + GN_EPS)) * gw[k] + gb[k];
            const float bon = wave_sum(r0[k] * r2[k] * rk[k]) * r3[k];
            if (e < MTOK * 8) MIXp[(size_t)m * (4 * MIX) + MIX + ch] = (bf16_t)f2bf((yn + bon) * r6[k]); }
        __builtin_amdgcn_sched_barrier(0);
    }
}

DI unsigned wave_sum_u32(unsigned x) {
    float f = __builtin_bit_cast(float, x); (void)f;
    int v = (int)x;
    v += __builtin_amdgcn_update_dpp(0, v, 0xB1, 0xF, 0xF, true); v += __builtin_amdgcn_update_dpp(0, v, 0x4E, 0xF, 0xF, true);
    v += __builtin_amdgcn_update_dpp(0, v, 0x141, 0xF, 0xF, true); v += __builtin_amdgcn_update_dpp(0, v, 0x140, 0xF, 0xF, true);
    return (unsigned)(__builtin_amdgcn_readlane(v, 0) + __builtin_amdgcn_readlane(v, 16) + __builtin_amdgcn_readlane(v, 32) + __builtin_amdgcn_readlane(v, 48));
}
DI unsigned fkey(float v) { unsigned u = __builtin_bit_cast(unsigned, v); if (u == 0x80000000u) u = 0u; return (u & 0x80000000u) ? ~u : (u | 0x80000000u); }
struct AttTile { bf16x8 kf[4]; bf16x8 vf[4]; unsigned mw; };
DI void att_load(AttTile& T, const bf16_t* kp, const bf16_t* vp, const unsigned* mp, int kt) {
#pragma unroll
    for (int s = 0; s < 4; ++s) T.kf[s] = *(const bf16x8*)(kp + ((size_t)kt * 4 + s) * 512);
#pragma unroll
    for (int s2 = 0; s2 < 2; ++s2) { const bf16_t* v = vp + ((size_t)kt * 4 + 2 * s2) * 512;
        T.vf[2 * s2 + 0] = *(const bf16x8*)(v); T.vf[2 * s2 + 1] = *(const bf16x8*)(v + 512); }
    T.mw = mp[kt];
}
DI void att_tile(const AttTile& T, const bf16x8 (&qf)[4], f32x16& o0, f32x16& o1, float& mrun, float& lrun, int hh) {
    f32x16 sa;
#pragma unroll
    for (int i = 0; i < 16; ++i) sa[i] = 0.f;
#pragma unroll
    for (int s = 0; s < 4; ++s) sa = MFMA32(T.kf[s], qf[s], sa);
    float mx = -1e30f;
#pragma unroll
    for (int i = 0; i < 16; ++i) { const int kr = (i & 3) + 8 * (i >> 2) + 4 * hh; const bool on = (T.mw >> kr) & 1u; sa[i] = on ? sa[i] : -1e30f; mx = fmaxf(mx, sa[i]); }
    mx = fmaxf(mx, __shfl_xor(mx, 32));
    const float mnew = fmaxf(mrun, mx);
    if (__any(mnew > mrun)) {
        const float alpha = __expf(mrun - mnew); lrun *= alpha;
#pragma unroll
        for (int i = 0; i < 16; ++i) { o0[i] *= alpha; o1[i] *= alpha; }
        mrun = mnew; }
    float p[16], ps = 0.f;
#pragma unroll
    for (int i = 0; i < 16; ++i) { p[i] = (sa[i] > -1e29f) ? __expf(sa[i] - mrun) : 0.f; ps += p[i]; }
    lrun += ps;
#pragma unroll
    for (int s2 = 0; s2 < 2; ++s2) {
        const bf16x8 pb = pack8(p[8 * s2], p[8 * s2 + 1], p[8 * s2 + 2], p[8 * s2 + 3], p[8 * s2 + 4], p[8 * s2 + 5], p[8 * s2 + 6], p[8 * s2 + 7]);
        o0 = MFMA32(T.vf[2 * s2], pb, o0); o1 = MFMA32(T.vf[2 * s2 + 1], pb, o1); }
}
DI void dsa_item(const Frame& F, unsigned char* ws, int item) {
    const bf16_t* Q = (const bf16_t*)(ws + WS_Q); const bf16_t* Kb = (const bf16_t*)(ws + WS_K); const bf16_t* VT = (const bf16_t*)(ws + WS_VT);
    const bf16_t* QI = (const bf16_t*)(ws + WS_QI); const bf16_t* KI = (const bf16_t*)(ws + WS_KI); const float* WI = (const float*)(ws + WS_WI);
    float* SC = (float*)(ws + WS_SC); unsigned* MASK = (unsigned*)(ws + WS_MASK); bf16_t* MIXp = (bf16_t*)(ws + WS_MIX);
    const int b = item >> 6, qb = item & 63, q0 = qb * 32, m0 = b * SEQ + q0;
    const int r = F.lane & 31, hh = F.lane >> 5;
    {
        float wv[4];
#pragma unroll
        for (int hd = 0; hd < 4; ++hd) wv[hd] = WI[(size_t)(m0 + r) * 4 + hd];
        LAS unsigned char* QL = F.lds;
#pragma unroll
        for (int k = 0; k < 2; ++k) { const int f = 2 * F.wave + k; *(LAS bf16x8*)(QL + f * 1024 + (r * 2 + hh) * 16) = *(const bf16x8*)(QI + (size_t)(m0 + r) * 256 + (f >> 2) * 64 + 16 * (f & 3) + 8 * hh); }
        __syncthreads();
        const LAS unsigned char* ql = QL + (r * 2 + hh) * 16;
        const bf16_t* kip = KI + ((size_t)b * 64 * 4 * 32 + r) * 16 + hh * 8;
        bf16x8 kf[4], kn[4];
        if (F.wave <= qb) {
#pragma unroll
            for (int s = 0; s < 4; ++s) kf[s] = *(const bf16x8*)(kip + ((size_t)F.wave * 4 + s) * 512); }
        for (int kt = F.wave; kt <= qb; kt += 8) {
            if (kt + 8 <= qb) {
#pragma unroll
                for (int s = 0; s < 4; ++s) kn[s] = *(const bf16x8*)(kip + ((size_t)(kt + 8) * 4 + s) * 512); }
            f32x16 sc;
#pragma unroll
            for (int i = 0; i < 16; ++i) sc[i] = 0.f;
#pragma unroll
            for (int hd = 0; hd < 4; ++hd) { f32x16 a; bf16x8 qf[4]; asm volatile("" ::: "memory");
#pragma unroll
                for (int s = 0; s < 4; ++s) qf[s] = *(const LAS bf16x8*)(ql + (hd * 4 + s) * 1024);
#pragma unroll
                for (int i = 0; i < 16; ++i) a[i] = 0.f;
#pragma unroll
                for (int s = 0; s < 4; ++s) a = MFMA32(kf[s], qf[s], a);
#pragma unroll
                for (int i = 0; i < 16; ++i) sc[i] += wv[hd] * fmaxf(a[i], 0.f); }
#pragma unroll
            for (int g = 0; g < 4; ++g) *(f32x4*)(SC + (size_t)(m0 + r) * SEQ + kt * 32 + 8 * g + 4 * hh) = (f32x4){sc[4 * g], sc[4 * g + 1], sc[4 * g + 2], sc[4 * g + 3]};
#pragma unroll
            for (int s = 0; s < 4; ++s) kf[s] = kn[s];
        }
    }
    VM_WAIT(); __syncthreads();
    for (int qq = 0; qq < 4; ++qq) {
        const int rq = F.wave * 4 + qq, t = q0 + rq, m = m0 + rq;
        unsigned* mrow = MASK + (size_t)m * 64;
        if (t + 1 <= 256) {
            for (int j = 0; j < 32; ++j) { const unsigned long long bm = __ballot(F.lane + 64 * j <= t); if (F.lane == 0) { mrow[2 * j] = (unsigned)bm; mrow[2 * j + 1] = (unsigned)(bm >> 32); } }
        } else {
            unsigned key[32];
#pragma unroll
            for (int j = 0; j < 32; ++j) { const int s = F.lane + 64 * j; const float sv = SC[(size_t)m * SEQ + s]; key[j] = __builtin_bit_cast(unsigned, sv); }
            __builtin_amdgcn_sched_barrier(0);
#pragma unroll
            for (int j = 0; j < 32; ++j) { const int s = F.lane + 64 * j; key[j] = (s <= t) ? fkey(__builtin_bit_cast(float, key[j])) : 0u; }
            unsigned T = 0u;
            const int jmax = t >> 6;
#pragma unroll 1
            for (int bit = 31; bit >= 0; --bit) { const unsigned cand = T | (1u << bit); unsigned cl0 = 0u, cl1 = 0u;
#pragma unroll
                for (int j0 = 0; j0 < 32; j0 += 8) { if (j0 <= jmax) {
#pragma unroll
                    for (int j = j0; j < j0 + 8; j += 4) { unsigned long long c0, c1, c2, c3;
                        asm("v_cmp_le_u32_e64 %2, %10, %6\n\tv_cmp_le_u32_e64 %3, %10, %7\n\tv_cmp_le_u32_e64 %4, %10, %8\n\tv_cmp_le_u32_e64 %5, %10, %9\n\t"
                            "v_addc_co_u32_e64 %0, %2, 0, %0, %2\n\tv_addc_co_u32_e64 %1, %3, 0, %1, %3\n\tv_addc_co_u32_e64 %0, %4, 0, %0, %4\n\tv_addc_co_u32_e64 %1, %5, 0, %1, %5"
                            : "+v"(cl0), "+v"(cl1), "=&s"(c0), "=&s"(c1), "=&s"(c2), "=&s"(c3) : "v"(key[j]), "v"(key[j + 1]), "v"(key[j + 2]), "v"(key[j + 3]), "s"(cand)); }
                    __builtin_amdgcn_sched_barrier(0); } }
                unsigned cl = cl0 + cl1;
                asm("s_nop 1" : "+v"(cl));
                const int cnt = (int)wave_sum_u32(cl);
                if (cnt >= 256) T = cand;
                if (cnt == 256) break; }
            unsigned cg = 0u;
#pragma unroll
            for (int j = 0; j < 32; ++j) cg += (key[j] > T) ? 1u : 0u;
            const int cgt = (int)wave_sum_u32(cg);
            const int need = 256 - cgt; int run = 0;
            const unsigned long long lt = (1ull << F.lane) - 1ull;
#pragma unroll
            for (int j = 0; j < 32; ++j) {
                const unsigned long long eq = __ballot(key[j] == T), gt = __ballot(key[j] > T);
                const int pre = run + __popcll(eq & lt);
                const unsigned long long se = __ballot(key[j] == T && pre < need);
                const unsigned long long bm = gt | se; run += __popcll(eq);
                if (F.lane == 0) { mrow[2 * j] = (unsigned)bm; mrow[2 * j + 1] = (unsigned)(bm >> 32); }
                if ((j & 3) == 3) __builtin_amdgcn_sched_barrier(0); }
        }
    }
    VM_WAIT(); __syncthreads();
    {
        const int hd = F.wave;
        bf16x8 qf[4];
#pragma unroll
        for (int s = 0; s < 4; ++s) qf[s] = *(const bf16x8*)(Q + (size_t)(m0 + r) * 512 + hd * 64 + 16 * s + 8 * hh);
        f32x16 o0, o1;
#pragma unroll
        for (int i = 0; i < 16; ++i) { o0[i] = 0.f; o1[i] = 0.f; }
        float mrun = -1e30f, lrun = 0.f;
        const bf16_t* kp = Kb + ((size_t)(b * 8 + hd) * 64 * 4 * 32 + r) * 16 + hh * 8;
        const bf16_t* vp = VT + ((size_t)(b * 8 + hd) * 64 * 4 * 32 + r) * 16 + hh * 8;
        const unsigned* mp = MASK + (size_t)(m0 + r) * 64;
        AttTile A, B, C;
        att_load(A, kp, vp, mp, 0);
        if (1 <= qb) att_load(B, kp, vp, mp, 1);
        for (int kt = 0; kt <= qb; kt += 3) {
            if (kt + 2 <= qb) att_load(C, kp, vp, mp, kt + 2);
            att_tile(A, qf, o0, o1, mrun, lrun, hh);
            if (kt + 1 <= qb) {
                if (kt + 3 <= qb) att_load(A, kp, vp, mp, kt + 3);
                att_tile(B, qf, o0, o1, mrun, lrun, hh);
                if (kt + 2 <= qb) {
                    if (kt + 4 <= qb) att_load(B, kp, vp, mp, kt + 4);
                    att_tile(C, qf, o0, o1, mrun, lrun, hh); } }
        }
        const float inv = 1.0f / (lrun + __shfl_xor(lrun, 32));
        bf16_t* orow = MIXp + (size_t)(m0 + r) * (4 * MIX) + hd * 64;
#pragma unroll
        for (int g = 0; g < 4; ++g) {
            u32x2 w0; w0.x = pk2(o0[4 * g] * inv, o0[4 * g + 1] * inv); w0.y = pk2(o0[4 * g + 2] * inv, o0[4 * g + 3] * inv);
            u32x2 w1; w1.x = pk2(o1[4 * g] * inv, o1[4 * g + 1] * inv); w1.y = pk2(o1[4 * g + 2] * inv, o1[4 * g + 3] * inv);
            *(u32x2*)(orow + 8 * g + 4 * hh) = w0; *(u32x2*)(orow + 32 + 8 * g + 4 * hh) = w1; }
    }
    __syncthreads();
}

DI float siluf_(float x) { return x * sigmoidf_(x); }
DI void conv_phase(const Frame& F, unsigned char* ws, const In& in, int l) {
    const bf16_t* U = (const bf16_t*)(ws + WS_U); bf16_t* ACT = (bf16_t*)(ws + WS_ACT);
    const float* cw = in[33] + (size_t)l * 3 * DFF2; const float* cb = in[34] + (size_t)l * DFF2;
    constexpr int NCG = DFF / 8;
    const long total = (long)NCG * (MTOK / 32);
    for (long e = (long)F.bid * NTHR + F.tid; e < total; e += (long)F.G * NTHR) {
        const int cg = (int)(e % NCG), tg = (int)(e / NCG); const int f0 = cg * 8, m0 = tg * 32; const bool first = (m0 % SEQ) == 0;
        float wg[3][8], wv[3][8], bg[8], bv[8];
#pragma unroll
        for (int j = 0; j < 3; ++j)
#pragma unroll
            for (int i = 0; i < 8; ++i) { wg[j][i] = cw[(size_t)j * DFF2 + f0 + i]; wv[j][i] = cw[(size_t)j * DFF2 + DFF + f0 + i]; }
#pragma unroll
        for (int i = 0; i < 8; ++i) { bg[i] = cb[f0 + i]; bv[i] = cb[DFF + f0 + i]; }
        float g1[8], g2[8], v1[8], v2[8];
#pragma unroll
        for (int i = 0; i < 8; ++i) { g1[i] = 0.f; g2[i] = 0.f; v1[i] = 0.f; v2[i] = 0.f; }
        if (!first) {
            const u32x4 a = *(const u32x4*)(U + (size_t)(m0 - 1) * DFF2 + f0), b = *(const u32x4*)(U + (size_t)(m0 - 2) * DFF2 + f0);
            const u32x4 c = *(const u32x4*)(U + (size_t)(m0 - 1) * DFF2 + DFF + f0), d = *(const u32x4*)(U + (size_t)(m0 - 2) * DFF2 + DFF + f0);
#pragma unroll
            for (int i = 0; i < 4; ++i) { g1[2 * i] = bf2f(a[i] & 0xffffu); g1[2 * i + 1] = bf2f(a[i] >> 16); g2[2 * i] = bf2f(b[i] & 0xffffu); g2[2 * i + 1] = bf2f(b[i] >> 16);
                v1[2 * i] = bf2f(c[i] & 0xffffu); v1[2 * i + 1] = bf2f(c[i] >> 16); v2[2 * i] = bf2f(d[i] & 0xffffu); v2[2 * i + 1] = bf2f(d[i] >> 16); }
        }
        u32x4 ua[4], uc[4];
#pragma unroll
        for (int q = 0; q < 4; ++q) { ua[q] = *(const u32x4*)(U + (size_t)(m0 + q) * DFF2 + f0); uc[q] = *(const u32x4*)(U + (size_t)(m0 + q) * DFF2 + DFF + f0); }
#pragma unroll 1
        for (int tb = 0; tb < 8; ++tb) {
            u32x4 na[4], nc[4];
            const int tn = tb < 7 ? 4 * tb + 4 : 4 * tb;
#pragma unroll
            for (int q = 0; q < 4; ++q) { na[q] = *(const u32x4*)(U + (size_t)(m0 + tn + q) * DFF2 + f0); nc[q] = *(const u32x4*)(U + (size_t)(m0 + tn + q) * DFF2 + DFF + f0); }
            __builtin_amdgcn_sched_barrier(0);
#pragma unroll
            for (int q = 0; q < 4; ++q) { const int t = 4 * tb + q; const u32x4 a = ua[q], c = uc[q];
                float g0[8], v0[8], o[8];
#pragma unroll
                for (int i = 0; i < 4; ++i) { g0[2 * i] = bf2f(a[i] & 0xffffu); g0[2 * i + 1] = bf2f(a[i] >> 16); v0[2 * i] = bf2f(c[i] & 0xffffu); v0[2 * i + 1] = bf2f(c[i] >> 16); }
#pragma unroll
                for (int i = 0; i < 8; ++i) { const float gc = bg[i] + wg[0][i] * g2[i] + wg[1][i] * g1[i] + wg[2][i] * g0[i]; const float vc = bv[i] + wv[0][i] * v2[i] + wv[1][i] * v1[i] + wv[2][i] * v0[i];
                    o[i] = siluf_(gc) * vc; g2[i] = g1[i]; g1[i] = g0[i]; v2[i] = v1[i]; v1[i] = v0[i]; }
                u32x4 w; w.x = pk2(o[0], o[1]); w.y = pk2(o[2], o[3]); w.z = pk2(o[4], o[5]); w.w = pk2(o[6], o[7]);
                *(u32x4*)(ACT + (size_t)(m0 + t) * DFF + f0) = w; }
            __builtin_amdgcn_sched_barrier(0);
#pragma unroll
            for (int q = 0; q < 4; ++q) { ua[q] = na[q]; uc[q] = nc[q]; }
        }
    }
}

DI void final_phase(const Frame& F, unsigned char* ws, const float* gfin, float* out) {
    const float* Y = (const float*)(ws + WS_Y); const float* part = (const float*)(ws + WS_PARTA);
    const int gw = F.bid * NWAVES + F.wave, NGW = F.G * NWAVES;
    f32x4 gv[8];
#pragma unroll
    for (int j = 0; j < 8; ++j) gv[j] = *(const f32x4*)(gfin + (j * 64 + F.lane) * 4);
    for (int m0 = gw; m0 < MTOK; m0 += 2 * NGW) {
        f32x4 yv[2][8]; float pv[2];
#pragma unroll
        for (int k = 0; k < 2; ++k) { const int m = (m0 + k * NGW) < MTOK ? m0 + k * NGW : m0;
            pv[k] = part[(size_t)m * 32 + (F.lane & 31)];
#pragma unroll
            for (int j = 0; j < 8; ++j) yv[k][j] = *(const f32x4*)(Y + (size_t)m * DM + (j * 64 + F.lane) * 4); }
        __builtin_amdgcn_sched_barrier(0);
#pragma unroll
        for (int k = 0; k < 2; ++k) { const int m = m0 + k * NGW;
            float s = (F.lane < 32) ? pv[k] : 0.f; s = wave_sum(s);
            const float rs = 1.0f / sqrtf(s * (1.0f / DM) + RMS_EPS);
            if (m < MTOK) {
#pragma unroll
                for (int j = 0; j < 8; ++j) *(f32x4*)(out + (size_t)m * DM + (j * 64 + F.lane) * 4) = yv[k][j] * rs * gv[j]; } }
        __builtin_amdgcn_sched_barrier(0);
    }
}

struct Args { InTab in; float* out; unsigned char* ws; int ph_lo, ph_hi; };
constexpr int ZG1_UNITS = 24 * 32, ZG2_UNITS = 28 * 32;
constexpr int PH_PER_LAYER = 9, N_PHASES = 1 + NL * PH_PER_LAYER + 1;

__global__ void __launch_bounds__(NTHR, 2) hybrid_fwd(Args args) {
    extern __shared__ __attribute__((aligned(16))) unsigned char lds_raw[];
    Frame F0; F0.lds = (LAS unsigned char*)lds_raw; F0.tid = threadIdx.x; F0.lane = F0.tid & 63; F0.wave = __builtin_amdgcn_readfirstlane(F0.tid >> 6); F0.bid = blockIdx.x; F0.G = gridDim.x;
    unsigned char* ws0 = args.ws; In in0; in0.t = (CAS const gfptr_t*)__builtin_amdgcn_kernarg_segment_ptr();
    const int lo = args.ph_lo, hi = args.ph_hi;
    volatile LAS unsigned* MISC = (volatile LAS unsigned*)(F0.lds + MISC_OFF);
    if (F0.tid < 16) MISC[F0.tid] = 0u;
    __syncthreads();
    XcdBarrier bar; bar.bar = (unsigned*)(ws0 + WS_CTL) + CW_BAR; bar.x = 0; bar.st = nullptr;
    const bool multi = (hi - lo) > 1;
    if (multi) bar = xcd_barrier_post((unsigned*)(ws0 + WS_CTL) + CW_BAR, MISC + 8);
#ifndef SUBMASK
#define SUBMASK 7
#endif
#ifndef DUPSUB
#define DUPSUB 0
#endif
#ifndef DUPMASK
#define DUPMASK 0u
#endif
#define NREP(j) (((DUPMASK >> (j)) & 1u) ? 2 : 1)
#ifndef PHMASK
#define PHMASK 0xFFFFFFFFu
#endif
#define IN_PH(k) (lo <= (k) && (k) < hi)
#define ON(j) ((PHMASK >> (j)) & 1u)
#define LAYER_PTRS unsigned char* wt = ws + WS_WT + (size_t)l * WT_LAYER; float* Y = (float*)(ws + WS_Y); bf16_t* YB = (bf16_t*)(ws + WS_YB); float* PA = (float*)(ws + WS_PARTA); float* PB = (float*)(ws + WS_PARTB); const LAS float* rsT = (const LAS float*)(F.lds + RST_OFF); (void)wt; (void)Y; (void)YB; (void)PA; (void)PB; (void)rsT;
#define SEAM(k) do { if (IN_PH(k) && IN_PH((k) + 1)) xcd_barrier(bar); } while (0)

    if (ON(0) && IN_PH(0)) for (int rep = 0; rep < NREP(0); ++rep) { if (rep) xcd_barrier(bar); const In in = in_fresh(in0); const Frame F = fresh(F0); unsigned char* ws = fresh_ptr(ws0); p0_prologue(F, in, ws); }
    SEAM(0);

    for (int l = 0; l < NL; ++l) {
        const int pb = 1 + l * PH_PER_LAYER;
        if (ON(1) && IN_PH(pb + 0)) for (int rep = 0; rep < NREP(1); ++rep) { if (rep) xcd_barrier(bar); const In in = in_fresh(in0); const Frame F = fresh(F0); unsigned char* ws = fresh_ptr(ws0); LAYER_PTRS
            pg8::Gemm g{YB, (const bf16_t*)(wt + WT_IN), DM, DM, DM}; const pg8::OrderLin S{F.bid, F.G, ZG1_UNITS, 0, DM, DM};
            pg8::Unit u0; int pm0 = -1; if (S.next(0, u0)) pm0 = u0.pm;
            if (pm0 >= 0) rs_table(F, PA, pm0); else __syncthreads();
            pg8::EpiZ E{(bf16_t*)(ws + WS_ZS), (bf16_t*)(ws + WS_G), in[4] + (size_t)l * GCOLS, PA, rsT, pm0};
            pg8::gemm_phase<pg8::EpiZ, pg8::OrderLin, true>(F.lds, F.tid, g, S, E);
        }
        SEAM(pb + 0);
        if (ON(2) && IN_PH(pb + 1)) for (int rep = 0; rep < NREP(2); ++rep) { if (rep) xcd_barrier(bar); const In in = in_fresh(in0); const Frame F = fresh(F0); unsigned char* ws = fresh_ptr(ws0); LAYER_PTRS
            { float* RSg = (float*)(ws + WS_RS);
              for (int m = F.bid * NTHR + F.tid; m < MTOK; m += F.G * NTHR) { float sq = 0.f;
#pragma unroll
                  for (int i = 0; i < 8; ++i) { const f32x4 v = *(const f32x4*)(PA + (size_t)m * 32 + 4 * i); sq += (v[0] + v[1]) + (v[2] + v[3]); }
                  RSg[m] = 1.0f / sqrtf(sq * (1.0f / DM) + RMS_EPS); } }
            for (int it = F.bid; it < 768; it += F.G) {
                if (it < 256) { dsa_prep_item(F, ws, in[5] + l * 64, it); if (DUPSUB & 64) dsa_prep_item(F, ws, in[5] + l * 64, it); }
                else if (it < 512) { rwkv_prep_item(F, ws, in, l, it - 256); if (DUPSUB & 16) rwkv_prep_item(F, ws, in, l, it - 256); }
                else { pool_item(F, ws, in, l, it - 512); if (DUPSUB & 32) pool_item(F, ws, in, l, it - 512); }
            }
        }
        SEAM(pb + 1);
        if (ON(3) && IN_PH(pb + 2)) for (int rep = 0; rep < NREP(3); ++rep) { if (rep) xcd_barrier(bar); const In in = in_fresh(in0); const Frame F = fresh(F0); unsigned char* ws = fresh_ptr(ws0); LAYER_PTRS
            constexpr int NRW = 64, NSS = 8;
            if (SUBMASK & 1) { const Frame Fa = fresh(F0);
                for (int it = Fa.bid; it < NRW; it += Fa.G) { rwkv_scan_item(Fa, ws, it); if (DUPSUB & 1) rwkv_scan_item(Fa, ws, it); } }
            if (SUBMASK & 4) { const Frame Fc = fresh(F0);
                if (Fc.G >= NRW + NSS) { const int it = Fc.bid - NRW; if (it >= 0 && it < NSS) { ssm_seq_item(Fc, fresh_ptr(ws0), in_fresh(in0), l, it); if (DUPSUB & 4) ssm_seq_item(Fc, fresh_ptr(ws0), in_fresh(in0), l, it); } }
                else for (int it = Fc.bid; it < NSS; it += Fc.G) ssm_seq_item(Fc, fresh_ptr(ws0), in_fresh(in0), l, it);
                __syncthreads(); }
            if (SUBMASK & 2) { const Frame Fb = fresh(F0);
                if (Fb.G > NRW + NSS) { const int nb = Fb.G - NRW - NSS, b0 = Fb.bid - NRW - NSS;
                    if (b0 >= 0) { if (b0 < 256) { const int b = b0 & 3, qb = 63 - (b0 >> 2); dsa_item(Fb, ws, b * 64 + qb); }
                        const int it2 = nb + (nb - 1 - b0);
                        if (it2 >= nb && it2 < 256) { const int b = it2 & 3, qb = 63 - (it2 >> 2); dsa_item(Fb, ws, b * 64 + qb); }
                        for (int it = b0 + 2 * nb; it < 256; it += nb) { const int b = it & 3, qb = 63 - (it >> 2); dsa_item(Fb, ws, b * 64 + qb); } } }
                else for (int it = Fb.bid; it < 256; it += Fb.G) { const int b = it & 3, qb = 63 - (it >> 2); dsa_item(Fb, ws, b * 64 + qb); } }
            { const Frame Fd = fresh(F0); unsigned char* wsd = fresh_ptr(ws0); const In ind = in_fresh(in0);
                unsigned char* wtd = wsd + WS_WT + (size_t)l * WT_LAYER;
                pg8::Gemm g{(const bf16_t*)(wsd + WS_YB), (const bf16_t*)(wtd + WT_IN), DM, DM, DM};
                const int xg = Fd.bid & 7;
                const pg8::OrderQueue S{(unsigned*)(wsd + WS_CTL) + CW_QUEUE + 64 * (l * 8 + xg), (volatile LAS unsigned*)(Fd.lds + MISC_OFF + 64), Fd.tid, ZG2_UNITS / 8, 24, DM, DM, xg, 0u};
                S.setup();
                pg8::EpiZq E{(bf16_t*)(wsd + WS_ZS), (bf16_t*)(wsd + WS_G), ind[4] + (size_t)l * GCOLS, (const float*)(wsd + WS_RS)};
                pg8::gemm_phase<pg8::EpiZq, pg8::OrderQueue, true>(Fd.lds, Fd.tid, g, S, E);
                conv_w_drain(fresh(F0), in_fresh(in0), fresh_ptr(ws0), l + 1, CV_S1, CV_S2, 0); }
        }
        SEAM(pb + 2);
        if (ON(4) && IN_PH(pb + 3)) for (int rep = 0; rep < NREP(4); ++rep) { if (rep) xcd_barrier(bar); const In in = in_fresh(in0); const Frame F = fresh(F0); unsigned char* ws = fresh_ptr(ws0); LAYER_PTRS
            pg8::Gemm g{(const bf16_t*)(ws + WS_YSB), (const bf16_t*)(wt + WT_GLU), MIX, MIX, MIX}; pg8::Order S; S.init(MTOK / 256, MIX / 256, F.G, F.bid, MIX, MIX);
            pg8::EpiGlu E{(const bf16_t*)(ws + WS_YSB), in[28] + l * MIX, (bf16_t*)(ws + WS_MIX)};
            pg8::gemm_phase<pg8::EpiGlu, pg8::Order, true>(F.lds, F.tid, g, S, E);
            { const Frame Fp = fresh(F0); const int ng = (Fp.G > 64) ? 64 : 0;
              if (Fp.bid >= ng) rwkv_post_rows(Fp, fresh_ptr(ws0), in_fresh(in0), l, (Fp.bid - ng) * NWAVES + Fp.wave, (Fp.G - ng) * NWAVES); }
            { const Frame Fv = fresh(F0); conv_w_drain(Fv, in_fresh(in0), fresh_ptr(ws0), l + 1, CV_S2, CV_S3, 1); conv_w_drain(Fv, in_fresh(in0), fresh_ptr(ws0), l + 1, CV_S4, CV_LAYER, 3); }
        }
        SEAM(pb + 3);
        if (ON(5) && IN_PH(pb + 4)) for (int rep = 0; rep < NREP(5); ++rep) { if (rep) xcd_barrier(bar); const In in = in_fresh(in0); const Frame F = fresh(F0); unsigned char* ws = fresh_ptr(ws0); LAYER_PTRS
            pg8::Gemm g{(const bf16_t*)(ws + WS_MIX), (const bf16_t*)(wt + WT_BR), 4 * MIX, MIX, MIX}; pg8::Order S; S.init(MTOK / 256, DM / 256, F.G, F.bid, 4 * MIX, MIX, 4, MIX, DM);
            pg8::EpiMerge E{(const bf16_t*)(ws + WS_G), (bf16_t*)(ws + WS_MF), (bf16_t*)(ws + WS_MERGED)};
            pg8::gemm_phase<pg8::EpiMerge, pg8::Order, true>(F.lds, F.tid, g, S, E);
        }
        SEAM(pb + 4);
        if (ON(6) && IN_PH(pb + 5)) for (int rep = 0; rep < NREP(6); ++rep) { if (rep) xcd_barrier(bar); const In in = in_fresh(in0); const Frame F = fresh(F0); unsigned char* ws = fresh_ptr(ws0); LAYER_PTRS
            pg8::Gemm g{(const bf16_t*)(ws + WS_MERGED), (const bf16_t*)(wt + WT_OUT), DM, DM, DM}; pg8::Order S; S.init(MTOK / 256, DM / 256, F.G, F.bid, DM, DM);
            pg8::EpiRes E{l == 0 ? in[0] : Y, Y, YB, PB};
            pg8::gemm_phase<pg8::EpiRes, pg8::Order, true>(F.lds, F.tid, g, S, E);
        }
        SEAM(pb + 5);
        if (ON(7) && IN_PH(pb + 6)) for (int rep = 0; rep < NREP(7); ++rep) { if (rep) xcd_barrier(bar); const In in = in_fresh(in0); const Frame F = fresh(F0); unsigned char* ws = fresh_ptr(ws0); LAYER_PTRS
            pg8::Gemm g{YB, (const bf16_t*)(wt + WT_UP), DM, DM, DM}; pg8::Order S; S.init(MTOK / 256, DFF2 / 256, F.G, F.bid, DM, DM);
            pg8::Unit u0; int pm0 = -1; if (S.next(0, u0)) pm0 = u0.pm;
            if (pm0 >= 0) rs_table(F, PB, pm0); else __syncthreads();
            pg8::EpiU E{(bf16_t*)(ws + WS_U), DFF2, PB, rsT, pm0};
            pg8::gemm_phase<pg8::EpiU, pg8::Order, true>(F.lds, F.tid, g, S, E);
            conv_w_drain(fresh(F0), in_fresh(in0), fresh_ptr(ws0), l + 1, CV_S3, CV_S4, 2);
        }
        SEAM(pb + 6);
        if (ON(8) && IN_PH(pb + 7)) for (int rep = 0; rep < NREP(8); ++rep) { if (rep) xcd_barrier(bar); const In in = in_fresh(in0); const Frame F = fresh(F0); unsigned char* ws = fresh_ptr(ws0); LAYER_PTRS conv_phase(F, ws, in, l); }
        SEAM(pb + 7);
        if (ON(9) && IN_PH(pb + 8)) for (int rep = 0; rep < NREP(9); ++rep) { if (rep) xcd_barrier(bar); const In in = in_fresh(in0); const Frame F = fresh(F0); unsigned char* ws = fresh_ptr(ws0); LAYER_PTRS
            pg8::Gemm g{(const bf16_t*)(ws + WS_ACT), (const bf16_t*)(wt + WT_DOWN), DFF, DFF, DFF}; pg8::Order S; S.init(MTOK / 256, DM / 256, F.G, F.bid, DFF, DFF);
            pg8::EpiRes E{Y, Y, YB, PA};
            pg8::gemm_phase<pg8::EpiRes, pg8::Order, true>(F.lds, F.tid, g, S, E);
        }
        SEAM(pb + 8);
    }
    if (ON(10) && IN_PH(N_PHASES - 1)) { const In in = in_fresh(in0); const Frame F = fresh(F0); unsigned char* ws = fresh_ptr(ws0); final_phase(F, ws, in[36], args.out); }
#ifdef DBG_STOP
    if (lo == 100) { const Frame F = fresh(F0); unsigned char* ws = fresh_ptr(ws0);
        for (size_t e = (size_t)F.bid * NTHR + F.tid; e < (size_t)MTOK * DM; e += (size_t)F.G * NTHR) {
            const int m = (int)(e / DM), c = (int)(e % DM); float v;
            if (DBG_BUF == 0) v = bf2f(((const bf16_t*)(ws + WS_MIX))[e]);
            else if (DBG_BUF == 1) v = ((const float*)(ws + WS_ZS))[(size_t)m * ZS_COLS + c];
            else if (DBG_BUF == 2) v = ((const float*)(ws + WS_ZS))[(size_t)m * ZS_COLS + 2048 + c];
            else if (DBG_BUF == 3) v = bf2f(((const bf16_t*)(ws + WS_G))[(size_t)m * GCOLS + c]);
            else if (DBG_BUF == 4) v = ((const float*)(ws + WS_Y))[e];
            else v = bf2f(((const bf16_t*)(ws + WS_MERGED))[e]);
            args.out[e] = v; } }
#endif
#undef IN_PH
#undef SEAM
}

extern "C" void kernel_launch(void* const* d_in, const int* in_sizes, int n_in, void* d_out, int out_size, void* d_ws, size_t ws_size, hipStream_t stream) {
    static int grid = 0;
    if (grid == 0) {
        if (n_in != 37 || out_size != MTOK * DM || ws_size < WS_END) { fprintf(stderr, "kernel_launch: unexpected problem (n_in %d, out %d, ws %zu < %zu)\n", n_in, out_size, ws_size, (size_t)WS_END); grid = -1; return; }
        int dev = 0, cus = 0, per_cu = 0;
        if (hipGetDevice(&dev) != hipSuccess || hipDeviceGetAttribute(&cus, hipDeviceAttributeMultiprocessorCount, dev) != hipSuccess) { grid = -1; return; }
        if (hipFuncSetAttribute((const void*)hybrid_fwd, hipFuncAttributeMaxDynamicSharedMemorySize, LDS_BYTES) != hipSuccess) { fprintf(stderr, "kernel_launch: hipFuncSetAttribute failed\n"); grid = -1; return; }
        if (hipOccupancyMaxActiveBlocksPerMultiprocessor(&per_cu, (const void*)hybrid_fwd, NTHR, LDS_BYTES) != hipSuccess || per_cu < 1) fprintf(stderr, "kernel_launch: occupancy query says %d\n", per_cu);
        (void)hipGetLastError();
        grid = cus >= 256 ? 256 : cus;
    }
    if (grid < 0) return;
    (void)hipMemsetAsync((char*)d_ws + WS_CTL, 0, CTL_ZERO_BYTES, stream);
    Args a{};
    for (int i = 0; i < 37; ++i) a.in.p[i] = (const float*)d_in[i];
    a.out = (float*)d_out; a.ws = (unsigned char*)d_ws;
#ifdef DBG_STOP
    for (int k = 0; k < DBG_STOP; ++k) { a.ph_lo = k; a.ph_hi = k + 1; hipLaunchKernelGGL(hybrid_fwd, dim3(grid), dim3(NTHR), LDS_BYTES, stream, a); }
    a.ph_lo = 100; a.ph_hi = 101; hipLaunchKernelGGL(hybrid_fwd, dim3(grid), dim3(NTHR), LDS_BYTES, stream, a);
#elif MK_N_LAUNCHES == 1
    a.ph_lo = 0; a.ph_hi = N_PHASES;
    hipLaunchKernelGGL(hybrid_fwd, dim3(grid), dim3(NTHR), LDS_BYTES, stream, a);
#else
    for (int k = 0; k < N_PHASES; ++k) { a.ph_lo = k; a.ph_hi = k + 1; hipLaunchKernelGGL(hybrid_fwd, dim3(grid), dim3(NTHR), LDS_BYTES, stream, a); }
#endif
}
```

```cpp
#include <hip/hip_runtime.h>
#include <cstdio>
#include <cstdint>

#ifndef MK_N_LAUNCHES
#define MK_N_LAUNCHES 1
#endif

#define LAS __attribute__((address_space(3)))
#define GAS __attribute__((address_space(1)))
typedef unsigned short bf16_t;
typedef short bf16x8 __attribute__((ext_vector_type(8)));
typedef short s16x4 __attribute__((ext_vector_type(4)));
typedef float f32x4 __attribute__((ext_vector_type(4)));
typedef float f32x2 __attribute__((ext_vector_type(2)));
typedef float f32x16 __attribute__((ext_vector_type(16)));
typedef unsigned u32x4 __attribute__((ext_vector_type(4)));
typedef unsigned u32x2 __attribute__((ext_vector_type(2)));
#define DI __device__ __forceinline__

constexpr int NB = 4, SEQ = 2048, DM = 2048, MTOK = NB * SEQ, NL = 4, MIX = 512, DFF = 5504, DFF2 = 2 * DFF;
constexpr int IN_COLS = 13060, NZ = 13312, ZS_COLS = 5120, GCOLS = 8192;
constexpr int B_COLS = 1984;
constexpr int ZO_R = 0, ZO_K = 512, ZO_V = 1024, ZO_LW = 1536, ZO_LA = 1632, ZO_LG = 1728;
constexpr int ZO_Q = 2048, ZO_AK = 2560, ZO_AV = 3072, ZO_QI = 3584, ZO_KI = 3840, ZO_WI = 3904, ZO_C = 4096, ZO_D = 4608;
constexpr float RMS_EPS = 1e-6f, GN_EPS = 64e-5f;

constexpr size_t MiB = 1u << 20;
constexpr size_t WS_CTL = 0, CTL_ZERO_BYTES = 1 * MiB;
constexpr size_t WS_ROPE = 1 * MiB;
constexpr size_t WS_PARTA = 2 * MiB;
constexpr size_t WS_PARTB = 3 * MiB;
constexpr size_t WS_SSTATE = 4 * MiB;
constexpr size_t WS_WI = 5 * MiB;
constexpr size_t WS_RS = 5 * MiB + 256 * 1024;
constexpr size_t WS_KI = 6 * MiB;
constexpr size_t WS_MASK = 7 * MiB;
constexpr size_t WS_QI = 9 * MiB;
constexpr size_t WS_Q = 13 * MiB;
constexpr size_t WS_K = 21 * MiB;
constexpr size_t WS_VT = 29 * MiB;
constexpr size_t WS_Y = 37 * MiB;
constexpr size_t WS_YB = 101 * MiB;
constexpr size_t WS_MIX = 133 * MiB;
constexpr size_t WS_MERGED = 165 * MiB;
constexpr size_t WS_YS = 197 * MiB;
constexpr size_t WS_YSB = 213 * MiB;
constexpr size_t WS_RW = 221 * MiB;
constexpr size_t RW_STRIDE = 16 * MiB;
constexpr size_t WS_SC = 333 * MiB;
constexpr size_t WS_MF = 1368 * MiB;
constexpr size_t WS_ZS = 461 * MiB;
constexpr size_t WS_G = 621 * MiB;
constexpr size_t WS_U = 461 * MiB;
constexpr size_t WS_ACT = 749 * MiB;
constexpr size_t WS_WT = 836 * MiB;
constexpr size_t WT_IN = 0, WT_BR = 52 * MiB, WT_OUT = 60 * MiB, WT_UP = 68 * MiB, WT_DOWN = 111 * MiB, WT_GLU = 111 * MiB + 22544384, WT_LAYER = 133 * MiB;
constexpr size_t WS_YRAW = WS_MF + 192 * MiB;
constexpr size_t WS_WTL = WS_YRAW + 16 * MiB;
constexpr size_t WS_WTP = WS_WTL + 2 * MiB;
constexpr size_t WS_END = WS_WTP + 1 * MiB;
static_assert(WS_WT + 4 * WT_LAYER == WS_MF, "ws map");
static_assert(WT_GLU + 524288 <= WT_LAYER, "wt map");
static_assert(WS_U + (size_t)MTOK * DFF2 * 2 <= WS_ACT && WS_ACT + (size_t)MTOK * DFF * 2 <= WS_WT, "ws map");

constexpr int CW_BAR = 4096;
constexpr int CW_CONV = 12288;
constexpr int CW_QUEUE = 8192;

constexpr int RING_BYTES = 131072;
constexpr int MISC_OFF = RING_BYTES;
constexpr int RST_OFF = RING_BYTES + 1024;
constexpr int LDS_BYTES = 147456;
constexpr int NWAVES = 8, NTHR = 512;

DI unsigned f2bf(float f) { unsigned u = __builtin_bit_cast(unsigned, f); return (u + 0x7fffu + ((u >> 16) & 1u)) >> 16; }
DI unsigned cvt_pk_bf16(float lo, float hi);
DI unsigned pk2(float lo, float hi) { return cvt_pk_bf16(lo, hi); }
DI float bf2f(unsigned b) { return __builtin_bit_cast(float, b << 16); }
typedef __bf16 bf16x2v __attribute__((ext_vector_type(2)));
DI unsigned cvt_pk_bf16(float lo, float hi) { const f32x2 v = {lo, hi}; const bf16x2v b = __builtin_convertvector(v, bf16x2v); return __builtin_bit_cast(unsigned, b); }
DI float wave_sum(float v) {
#pragma unroll
    for (int o = 1; o < 64; o <<= 1) v += __shfl_xor(v, o);
    return v;
}
template <int CTRL> DI float dpp_xadd(float x) { const int r = __builtin_amdgcn_update_dpp(0, __builtin_bit_cast(int, x), CTRL, 0xF, 0xF, true); return x + __builtin_bit_cast(float, r); }
DI float row16_sum(float x) { x = dpp_xadd<0xB1>(x); x = dpp_xadd<0x4E>(x); x = dpp_xadd<0x141>(x); x = dpp_xadd<0x140>(x); return x; }
DI bf16x8 pack8(float a0, float a1, float a2, float a3, float a4, float a5, float a6, float a7) {
    u32x4 p; p.x = pk2(a0, a1); p.y = pk2(a2, a3); p.z = pk2(a4, a5); p.w = pk2(a6, a7); return __builtin_bit_cast(bf16x8, p); }
DI f32x4 ld4bf(const bf16_t* p) { const u32x2 w = *(const u32x2*)p; return (f32x4){bf2f(w.x & 0xffffu), bf2f(w.x >> 16), bf2f(w.y & 0xffffu), bf2f(w.y >> 16)}; }
DI float sigmoidf_(float x) { return __builtin_amdgcn_rcpf(1.0f + __expf(-x)); }
#define LDS_WAIT() asm volatile("s_waitcnt lgkmcnt(0)" ::: "memory")
#define VM_WAIT() asm volatile("s_waitcnt vmcnt(0)" ::: "memory")
#define MFMA32(a, b, c) __builtin_amdgcn_mfma_f32_32x32x16_bf16((a), (b), (c), 0, 0, 0)

#define XB_TMO      128
#define XB_XCNT(j)  (256  + 64 * (j))
#define XB_XSUB(j)  (1280 + 64 * (j))
#define XB_XGEN(j)  (2304 + 64 * (j))
#define XB_TOP      3328
#define XB_TOPGEN   3392
#define XCD_BAR_WORDS 3456
#define XB_SPIN_CAP (1u << 21)
DI unsigned xb_ld(unsigned* p)              { return __hip_atomic_load(p, __ATOMIC_RELAXED, __HIP_MEMORY_SCOPE_AGENT); }
DI unsigned xb_add(unsigned* p, unsigned v) { return __hip_atomic_fetch_add(p, v, __ATOMIC_RELAXED, __HIP_MEMORY_SCOPE_AGENT); }
DI unsigned xb_xcc_id() { return (unsigned)__builtin_amdgcn_s_getreg((3 << 11) | 20) & 0xFu; }
#define XB_SPIN(cond, bar) do { unsigned _sp = 0; while (cond) { __builtin_amdgcn_s_sleep(1); \
    if ((++_sp & 255u) == 0u) { if (xb_ld(&(bar)[XB_TMO])) break; if (_sp > XB_SPIN_CAP) { atomicAdd(&(bar)[XB_TMO], 1u); break; } } } } while (0)
struct XcdBarrier { unsigned* bar; unsigned x; volatile LAS unsigned* st; };
DI XcdBarrier xcd_barrier_post(unsigned* bar, volatile LAS unsigned* st) {
    XcdBarrier b; b.bar = bar; b.x = xb_xcc_id(); b.st = st;
    if (threadIdx.x == 0) (void)xb_add(&bar[XB_XCNT(b.x)], 1u);
    return b;
}
DI void xcd_barrier_complete(unsigned* bar, unsigned x, unsigned& nloc, unsigned& nx) {
    const unsigned G = gridDim.x * gridDim.y * gridDim.z;
    unsigned sum, cnt, mine, sp = 0u;
    for (;;) {
        sum = 0u; cnt = 0u; mine = 0u;
#pragma unroll
        for (unsigned j = 0; j < 16; ++j) { const unsigned c = xb_ld(&bar[XB_XCNT(j)]); sum += c; cnt += (c > 0u) ? 1u : 0u; mine = (j == x) ? c : mine; }
        if (sum == G) break;
        __builtin_amdgcn_s_sleep(1);
        if ((++sp & 255u) == 0u) { if (xb_ld(&bar[XB_TMO])) break; if (sp > XB_SPIN_CAP) { atomicAdd(&bar[XB_TMO], 1u); break; } }
    }
    nloc = mine > 0u ? mine : 1u; nx = cnt > 0u ? cnt : 1u;
}
DI void xcd_barrier(const XcdBarrier& b) {
    asm volatile("s_waitcnt vmcnt(0)" ::: "memory");
    __syncthreads();
    if (threadIdx.x == 0) {
        unsigned* bar = b.bar;
        __builtin_amdgcn_s_waitcnt(0);
        unsigned nloc = b.st[0], nx = b.st[1];
        if (nloc == 0u) { xcd_barrier_complete(bar, b.x, nloc, nx); b.st[0] = nloc; b.st[1] = nx; }
        const unsigned old = xb_add(&bar[XB_XSUB(b.x)], 1u);
        const unsigned gen = old / nloc;
        if (old + 1u == (gen + 1u) * nloc) {
            __builtin_amdgcn_fence(__ATOMIC_RELEASE, "agent");
            asm volatile("s_waitcnt vmcnt(0)" ::: "memory");
            const unsigned og = xb_add(&bar[XB_TOP], 1u);
            const unsigned tg = og / nx;
            if (og + 1u == (tg + 1u) * nx) xb_add(&bar[XB_TOPGEN], 1u);
            else XB_SPIN(xb_ld(&bar[XB_TOPGEN]) == tg, bar);
            __builtin_amdgcn_fence(__ATOMIC_ACQUIRE, "agent");
            xb_add(&bar[XB_XGEN(b.x)], 1u);
            asm volatile("s_waitcnt vmcnt(0)" ::: "memory");
        } else {
            XB_SPIN(xb_ld(&bar[XB_XGEN(b.x)]) == gen, bar);
            __builtin_amdgcn_fence(__ATOMIC_ACQUIRE, "agent");
            asm volatile("s_waitcnt vmcnt(0)" ::: "memory");
        }
    }
    __syncthreads();
}

namespace pg8 {
constexpr int BM = 256, BK = 64, HALF = 128, HTB = HALF * BK * 2, STAGE_BYTES = 8 * HTB, NXCD = 8, WGM = 8;
DI int lds_byte(int r, int c) { const int st = (r >> 4) * 2 + (c >> 5), rr = r & 15, cc = c & 31, ob = rr * 64 + cc * 2; return st * 1024 + (ob ^ (((ob >> 9) & 1) << 5)); }
DI void stage_rc(int b, int& R, int& C) { const int st = b / 1024, sb = b % 1024, swz = sb ^ (((sb >> 9) & 1) << 5); R = (st >> 1) * 16 + swz / 64; C = (st & 1) * 32 + (swz % 64) / 2; }
DI int perm32(int rho) { const int n = rho >> 4, i = rho & 15; return 8 * (i >> 2) + 4 * n + (i & 3); }

struct Unit { int pm, pn, sub; long offA, offB; };
struct Gemm { const bf16_t* A; const bf16_t* Bt; int lda, ldb, K; };

struct Order {
    int nM, nN, nwg, G, c, lda, ldb, nsub, subA, subB;
    DI void init(int nM_, int nN_, int G_, int c_, int lda_, int ldb_, int nsub_ = 1, int subA_ = 0, int subB_ = 0) { nM = nM_; nN = nN_; nwg = nM * nN; G = G_; c = c_; lda = lda_; ldb = ldb_; nsub = nsub_; subA = subA_; subB = subB_; }
    DI bool next(int i, Unit& u) const {
        const int ti = i / nsub, sub = i - ti * nsub;
        const long L = (long)ti * G + c; if (L >= nwg) return false;
        int wgid = (int)L; { const int q = nwg / NXCD, r = nwg % NXCD, xcd = wgid % NXCD, off = wgid / NXCD; wgid = (xcd < r ? xcd * (q + 1) : r * (q + 1) + (xcd - r) * q) + off; }
        const int nig = WGM * nN, gid = wgid / nig, fm = gid * WGM, gsz = (nM - fm) < WGM ? (nM - fm) : WGM;
        u.pm = fm + ((wgid % nig) % gsz); u.pn = (wgid % nig) / gsz; u.sub = sub;
        u.offA = ((long)u.pm * BM * lda + (long)sub * subA) * 2; u.offB = ((long)u.pn * BM + (long)sub * subB) * (long)ldb * 2;
        return true;
    }
};

struct OrderLin {
    int c, G, nu, pnbase, lda, ldb;
    DI bool next(int i, Unit& u) const { const int v = c + i * G; if (v >= nu) return false; u.pm = v & 31; u.pn = pnbase + (v >> 5); u.sub = 0;
        u.offA = (long)u.pm * BM * lda * 2; u.offB = (long)u.pn * BM * (long)ldb * 2; return true; }
};
struct OrderTri {
    int pm, k, pnbase, lda, ldb;
    DI bool next(int i, Unit& u) const { int cnt, st;
        if (pm < 24) { cnt = k + 1; st = (k * (k + 1)) / 2; }
        else { cnt = k == 0 ? 3 : (k < 6 ? k + 2 : 0); st = k == 0 ? 0 : (k < 6 ? 3 + ((k - 1) * (k + 4)) / 2 : 28); }
        if (i >= cnt) return false; u.pm = pm; u.pn = pnbase + st + i; u.sub = 0;
        u.offA = (long)u.pm * BM * lda * 2; u.offB = (long)u.pn * BM * (long)ldb * 2; return true; }
};
struct OrderQueue {
    unsigned* head; volatile LAS unsigned* slot; int tid, nu, pnbase, lda, ldb, xg;
    mutable unsigned pend;
    DI void draw() const { const unsigned one = 1u; asm volatile("global_atomic_add %0, %1, %2, off sc0" : "=v"(pend) : "v"(head), "v"(one) : "memory"); }
    DI void setup() const { if (tid == 0) { slot[0] = __hip_atomic_fetch_add(head, 1u, __ATOMIC_RELAXED, __HIP_MEMORY_SCOPE_AGENT); draw(); }
        asm volatile("s_waitcnt lgkmcnt(0)" ::: "memory"); __syncthreads(); }
    DI bool next(int i, Unit& u) const {
        const unsigned v = slot[i & 1];
        if (tid == 0) { asm volatile("s_waitcnt vmcnt(0)" : "+v"(pend) :: "memory"); const unsigned p = pend; slot[(i + 1) & 1] = p;
            if (p < (unsigned)nu) draw(); }
        asm volatile("s_waitcnt lgkmcnt(0)" ::: "memory");
        if (v >= (unsigned)nu) return false;
        u.pm = xg + 8 * (int)(v & 3u); u.pn = pnbase + (int)(v >> 2); u.sub = 0;
        u.offA = (long)u.pm * BM * lda * 2; u.offB = (long)u.pn * BM * (long)ldb * 2; return true; }
};
template <class Epi, class Sched, bool ALIGN_EPI>
DI void gemm_phase(LAS unsigned char* lds, const int tid, const Gemm g, const Sched& S, const Epi& E) {
    const int wid = __builtin_amdgcn_readfirstlane(tid >> 6), lane = tid & 63, wr = wid >> 2, wc = wid & 3, fr = lane & 15, fq = lane >> 4;
    const int K = g.K, nt = K / BK;
    unsigned voffA[2], voffB[2];
#pragma unroll
    for (int i = 0; i < 2; ++i) { int R, C; stage_rc(tid * 16 + i * 8192, R, C); const int Rb = Epi::PERM ? ((R & ~31) + perm32(R & 31)) : R;
        voffA[i] = (unsigned)(R * g.lda + C) * 2u; voffB[i] = (unsigned)(Rb * g.ldb + C) * 2u; }
    const size_t kstep = (size_t)(BK * 2);
    const size_t hstepA = (size_t)HALF * g.lda * 2, hstepB = (size_t)HALF * g.ldb * 2;
    const unsigned ldsw = (unsigned)wid * 1024u;
    const int aoff = lds_byte(wr * 64 + fr, fq * 8), boff = lds_byte(wc * 32 + fr, fq * 8);
#define PG8_SA(b, h) (((b) * 2 + (h)) * HTB)
#define PG8_SB(b, h) ((4 + (b) * 2 + (h)) * HTB)
#define PG8_STAGE(bufoff, gbase, voff) do { _Pragma("unroll") for (int _i = 0; _i < 2; ++_i) \
        __builtin_amdgcn_global_load_lds((const unsigned*)((const char*)(gbase) + (voff)[_i]), (LAS unsigned*)(lds + (bufoff) + ldsw + _i * 8192), 16, 0, 0); } while (0)
#define PG8_LDA(dst, b, h) do { _Pragma("unroll") for (int m = 0; m < 4; ++m) _Pragma("unroll") for (int k = 0; k < 2; ++k) dst[m][k] = *(const LAS bf16x8*)(lds + PG8_SA(b, h) + aoff + m * 2048 + k * 1024); } while (0)
#define PG8_LDB(dst, b, h) do { _Pragma("unroll") for (int n = 0; n < 2; ++n) _Pragma("unroll") for (int k = 0; k < 2; ++k) dst[n][k] = *(const LAS bf16x8*)(lds + PG8_SB(b, h) + boff + n * 2048 + k * 1024); } while (0)
#define PG8_MMA(ai, bj, At, Bt) do { __builtin_amdgcn_s_setprio(1); _Pragma("unroll") for (int m = 0; m < 4; ++m) _Pragma("unroll") for (int n = 0; n < 2; ++n) _Pragma("unroll") for (int k = 0; k < 2; ++k) \
        acc[ai][bj][m][n] = __builtin_amdgcn_mfma_f32_16x16x32_bf16(Bt[n][k], At[m][k], acc[ai][bj][m][n], 0, 0, 0); __builtin_amdgcn_s_setprio(0); } while (0)
#define PG8_WAIT_V(n) asm volatile("s_waitcnt vmcnt(" #n ")" ::: "memory")
#define PG8_WAIT_L(n) asm volatile("s_waitcnt lgkmcnt(" #n ")" ::: "memory")
#define PG8_BAR __builtin_amdgcn_s_barrier()
#define PG8_SCHED __builtin_amdgcn_sched_barrier(0)
    Unit cur, nxt; int ui = 0;
    if (!S.next(0, cur)) return;
    f32x4 acc[2][2][4][2];
#pragma unroll
    for (int a = 0; a < 2; ++a)
#pragma unroll
        for (int b = 0; b < 2; ++b)
#pragma unroll
            for (int m = 0; m < 4; ++m)
#pragma unroll
                for (int n = 0; n < 2; ++n) acc[a][b][m][n] = (f32x4){0.f, 0.f, 0.f, 0.f};
    bf16x8 At[4][2], B0[2][2], B1[2][2];
    const char* cA = (const char*)g.A + cur.offA; const char* cB = (const char*)g.Bt + cur.offB;
    PG8_STAGE(PG8_SB(0, 0), cB, voffB); PG8_STAGE(PG8_SB(0, 1), cB + hstepB, voffB); PG8_STAGE(PG8_SA(0, 0), cA, voffA); PG8_STAGE(PG8_SA(0, 1), cA + hstepA, voffA);
    if (wr == 1) PG8_BAR;
    PG8_WAIT_V(2); PG8_BAR;
    PG8_STAGE(PG8_SB(1, 0), cB + kstep, voffB); PG8_STAGE(PG8_SA(1, 0), cA + kstep, voffA); PG8_STAGE(PG8_SB(1, 1), cB + hstepB + kstep, voffB);
    PG8_WAIT_V(6); PG8_BAR;
    for (;;) {
        const bool has_next = S.next(ui + 1, nxt);
        const char* nA = has_next ? (const char*)g.A + nxt.offA : cA; const char* nB = has_next ? (const char*)g.Bt + nxt.offB : cB;
        for (int t = 0; t < nt; t += 2) {
            const bool last = (t == nt - 2);
            const char* a1 = cA + (size_t)(t + 1) * kstep;
            const char* a2 = last ? nA : cA + (size_t)(t + 2) * kstep; const char* b2 = last ? nB : cB + (size_t)(t + 2) * kstep;
            const char* a3 = a2 + kstep; const char* b3 = b2 + kstep;
            PG8_LDB(B0, 0, 0); PG8_LDB(B1, 0, 1); PG8_SCHED; PG8_LDA(At, 0, 0); PG8_STAGE(PG8_SA(1, 1), a1 + hstepA, voffA);
            PG8_WAIT_V(8); PG8_WAIT_L(0); PG8_BAR; PG8_MMA(0, 0, At, B0); PG8_MMA(0, 1, At, B1); PG8_BAR; PG8_SCHED;
            PG8_LDA(At, 0, 1); PG8_STAGE(PG8_SB(0, 0), b2, voffB); PG8_STAGE(PG8_SB(0, 1), b2 + hstepB, voffB); PG8_STAGE(PG8_SA(0, 0), a2, voffA);
            PG8_WAIT_V(8); PG8_WAIT_L(0); PG8_BAR; PG8_MMA(1, 0, At, B0); PG8_MMA(1, 1, At, B1); PG8_BAR; PG8_SCHED;
            PG8_LDB(B0, 1, 0); PG8_LDB(B1, 1, 1); PG8_SCHED; PG8_LDA(At, 1, 0); PG8_STAGE(PG8_SA(0, 1), a2 + hstepA, voffA);
            PG8_WAIT_V(8); PG8_WAIT_L(0); PG8_BAR; PG8_MMA(0, 0, At, B0); PG8_MMA(0, 1, At, B1); PG8_BAR; PG8_SCHED;
            PG8_LDA(At, 1, 1); PG8_STAGE(PG8_SB(1, 0), b3, voffB); PG8_STAGE(PG8_SB(1, 1), b3 + hstepB, voffB); PG8_STAGE(PG8_SA(1, 0), a3, voffA);
            PG8_WAIT_V(8); PG8_WAIT_L(0); PG8_BAR; PG8_MMA(1, 0, At, B0); PG8_MMA(1, 1, At, B1); PG8_BAR; PG8_SCHED;
        }
        if constexpr (ALIGN_EPI) { if (wr == 0) PG8_BAR; }
        E(acc, cur, wr, wc, fr, fq);
        if (!has_next) break;
        if (!Epi::keep(cur)) {
#pragma unroll
        for (int a = 0; a < 2; ++a)
#pragma unroll
            for (int b = 0; b < 2; ++b)
#pragma unroll
                for (int m = 0; m < 4; ++m)
#pragma unroll
                    for (int n = 0; n < 2; ++n) acc[a][b][m][n] = (f32x4){0.f, 0.f, 0.f, 0.f}; }
        cur = nxt; cA = nA; cB = nB; ++ui;
        if constexpr (ALIGN_EPI) { if (wr == 1) PG8_BAR; }
    }
    PG8_WAIT_V(0);
    if constexpr (!ALIGN_EPI) { if (wr == 0) PG8_BAR; }
    PG8_BAR;
#undef PG8_SA
#undef PG8_SB
#undef PG8_STAGE
#undef PG8_LDA
#undef PG8_LDB
#undef PG8_MMA
#undef PG8_WAIT_V
#undef PG8_WAIT_L
#undef PG8_BAR
#undef PG8_SCHED
}

typedef const f32x4 (&AccRef)[2][2][4][2];
DI float row_scale_slow(const float* part, int row) { float s = 0.f; for (int i = 0; i < 32; ++i) s += part[(size_t)row * 32 + i]; return 1.0f / sqrtf(s * (1.0f / DM) + RMS_EPS); }

#define EPI_SB() __builtin_amdgcn_sched_barrier(0)
DI void epi_z_store(AccRef acc, const Unit& u, int wr, int wc, int fr, int fq, bf16_t* ZS, bf16_t* G, const f32x4 (&bb)[2][2], const float (&sv)[2][4]) {
#pragma unroll
    for (int ai = 0; ai < 2; ++ai)
#pragma unroll
        for (int m = 0; m < 4; ++m) {
            const int row = u.pm * BM + ai * HALF + wr * 64 + m * 16 + fr; const float s = sv[ai][m];
#pragma unroll
            for (int bj = 0; bj < 2; ++bj) {
                const int col0 = u.pn * BM + bj * HALF + wc * 32 + 8 * fq;
                f32x4 v0 = acc[ai][bj][m][0] * s, v1 = acc[ai][bj][m][1] * s;
                if (u.pn < 20) { u32x4 w; w.x = cvt_pk_bf16(v0[0], v0[1]); w.y = cvt_pk_bf16(v0[2], v0[3]); w.z = cvt_pk_bf16(v1[0], v1[1]); w.w = cvt_pk_bf16(v1[2], v1[3]); *(u32x4*)(ZS + (size_t)row * ZS_COLS + col0) = w; }
                else { const int gc = col0 - ZS_COLS;
                    v0 += bb[bj][0]; v1 += bb[bj][1];
                    u32x4 w; w.x = cvt_pk_bf16(sigmoidf_(v0[0]), sigmoidf_(v0[1])); w.y = cvt_pk_bf16(sigmoidf_(v0[2]), sigmoidf_(v0[3]));
                    w.z = cvt_pk_bf16(sigmoidf_(v1[0]), sigmoidf_(v1[1])); w.w = cvt_pk_bf16(sigmoidf_(v1[2]), sigmoidf_(v1[3]));
                    *(u32x4*)(G + (size_t)row * GCOLS + gc) = w; }
            }
        }
}
DI void epi_z_bias(f32x4 (&bb)[2][2], const float* bgate, const Unit& u, int wc, int fq) {
#pragma unroll
    for (int bj = 0; bj < 2; ++bj) { bb[bj][0] = (f32x4){0.f, 0.f, 0.f, 0.f}; bb[bj][1] = bb[bj][0]; }
    if (u.pn >= 20) {
#pragma unroll
        for (int bj = 0; bj < 2; ++bj) { const int gc = u.pn * BM + bj * HALF + wc * 32 + 8 * fq - ZS_COLS; bb[bj][0] = *(const f32x4*)(bgate + gc); bb[bj][1] = *(const f32x4*)(bgate + gc + 4); } }
}
struct EpiZ {
    static constexpr bool PERM = true;
    DI static bool keep(const Unit&) { return false; }
    bf16_t* ZS; bf16_t* G; const float* bgate; const float* part; const LAS float* rsT; int pm0;
    DI void operator()(AccRef acc, const Unit& u, int wr, int wc, int fr, int fq) const {
        f32x4 bb[2][2]; float sv[2][4];
        epi_z_bias(bb, bgate, u, wc, fq);
#pragma unroll
        for (int ai = 0; ai < 2; ++ai)
#pragma unroll
            for (int m = 0; m < 4; ++m) { const int lr = ai * HALF + wr * 64 + m * 16 + fr; sv[ai][m] = (u.pm == pm0) ? rsT[lr] : row_scale_slow(part, u.pm * BM + lr); }
        EPI_SB();
        epi_z_store(acc, u, wr, wc, fr, fq, ZS, G, bb, sv);
    }
};
struct EpiZq {
    static constexpr bool PERM = true;
    DI static bool keep(const Unit&) { return false; }
    bf16_t* ZS; bf16_t* G; const float* bgate; const float* rsg;
    DI void operator()(AccRef acc, const Unit& u, int wr, int wc, int fr, int fq) const {
        f32x4 bb[2][2]; float sv[2][4];
        epi_z_bias(bb, bgate, u, wc, fq);
#pragma unroll
        for (int ai = 0; ai < 2; ++ai)
#pragma unroll
            for (int m = 0; m < 4; ++m) sv[ai][m] = rsg[u.pm * BM + ai * HALF + wr * 64 + m * 16 + fr];
        EPI_SB();
        epi_z_store(acc, u, wr, wc, fr, fq, ZS, G, bb, sv);
    }
};
struct EpiU {
    static constexpr bool PERM = true;
    DI static bool keep(const Unit&) { return false; }
    bf16_t* U; int ldc; const float* part; const LAS float* rsT; int pm0;
    DI void operator()(AccRef acc, const Unit& u, int wr, int wc, int fr, int fq) const {
#pragma unroll
        for (int ai = 0; ai < 2; ++ai)
#pragma unroll
            for (int m = 0; m < 4; ++m) {
                const int lr = ai * HALF + wr * 64 + m * 16 + fr, row = u.pm * BM + lr;
                const float s = (u.pm == pm0) ? rsT[lr] : row_scale_slow(part, row);
#pragma unroll
                for (int bj = 0; bj < 2; ++bj) {
                    const int col0 = u.pn * BM + bj * HALF + wc * 32 + 8 * fq;
                    const f32x4 v0 = acc[ai][bj][m][0] * s, v1 = acc[ai][bj][m][1] * s;
                    u32x4 w; w.x = cvt_pk_bf16(v0[0], v0[1]); w.y = cvt_pk_bf16(v0[2], v0[3]); w.z = cvt_pk_bf16(v1[0], v1[1]); w.w = cvt_pk_bf16(v1[2], v1[3]);
                    *(u32x4*)(U + (size_t)row * ldc + col0) = w;
                }
            }
    }
};
struct EpiRes {
    static constexpr bool PERM = false;
    DI static bool keep(const Unit&) { return false; }
    const float* Yin; float* Y; bf16_t* YB; float* part;
    DI void operator()(AccRef acc, const Unit& u, int wr, int wc, int fr, int fq) const {
#pragma unroll
        for (int ai = 0; ai < 2; ++ai)
#pragma unroll
            for (int mp = 0; mp < 2; ++mp) {
                f32x4 yin[2][2][2];
#pragma unroll
                for (int mm = 0; mm < 2; ++mm) { const int row = u.pm * BM + ai * HALF + wr * 64 + (2 * mp + mm) * 16 + fr;
#pragma unroll
                    for (int bj = 0; bj < 2; ++bj)
#pragma unroll
                        for (int n = 0; n < 2; ++n) yin[mm][bj][n] = *(const f32x4*)(Yin + (size_t)row * DM + u.pn * BM + bj * HALF + wc * 32 + 16 * n + 4 * fq); }
                EPI_SB();
#pragma unroll
                for (int mm = 0; mm < 2; ++mm) { const int m = 2 * mp + mm; const int row = u.pm * BM + ai * HALF + wr * 64 + m * 16 + fr;
                    float ss = 0.f;
#pragma unroll
                    for (int bj = 0; bj < 2; ++bj)
#pragma unroll
                        for (int n = 0; n < 2; ++n) {
                            const int col = u.pn * BM + bj * HALF + wc * 32 + 16 * n + 4 * fq;
                            const size_t o = (size_t)row * DM + col;
                            const f32x4 y = yin[mm][bj][n] + acc[ai][bj][m][n];
                            *(f32x4*)(Y + o) = y;
                            u32x2 w; w.x = cvt_pk_bf16(y[0], y[1]); w.y = cvt_pk_bf16(y[2], y[3]);
                            *(u32x2*)(YB + o) = w;
                            ss += (y[0] * y[0] + y[1] * y[1]) + (y[2] * y[2] + y[3] * y[3]);
                        }
                    ss += __shfl_xor(ss, 16); ss += __shfl_xor(ss, 32);
                    if (fq == 0) part[(size_t)row * 32 + u.pn * 4 + wc] = ss; }
                EPI_SB();
            }
    }
};
struct EpiGlu {
    static constexpr bool PERM = true;
    DI static bool keep(const Unit&) { return false; }
    const bf16_t* YB16; const float* bias; bf16_t* MIXp;
    DI void operator()(AccRef acc, const Unit& u, int wr, int wc, int fr, int fq) const {
        f32x4 bb[2][2];
#pragma unroll
        for (int bj = 0; bj < 2; ++bj) { const int col0 = u.pn * BM + bj * HALF + wc * 32 + 8 * fq; bb[bj][0] = *(const f32x4*)(bias + col0); bb[bj][1] = *(const f32x4*)(bias + col0 + 4); }
#pragma unroll
        for (int ai = 0; ai < 2; ++ai) {
            u32x4 yw[4][2];
#pragma unroll
            for (int m = 0; m < 4; ++m)
#pragma unroll
                for (int bj = 0; bj < 2; ++bj) yw[m][bj] = *(const u32x4*)(YB16 + (size_t)(u.pm * BM + ai * HALF + wr * 64 + m * 16 + fr) * MIX + u.pn * BM + bj * HALF + wc * 32 + 8 * fq);
            EPI_SB();
#pragma unroll
            for (int m = 0; m < 4; ++m) {
                const int row = u.pm * BM + ai * HALF + wr * 64 + m * 16 + fr;
#pragma unroll
                for (int bj = 0; bj < 2; ++bj) {
                    const int col0 = u.pn * BM + bj * HALF + wc * 32 + 8 * fq;
                    const u32x4 t = yw[m][bj];
                    const f32x4 y0 = (f32x4){bf2f(t.x & 0xffffu), bf2f(t.x >> 16), bf2f(t.y & 0xffffu), bf2f(t.y >> 16)}, y1 = (f32x4){bf2f(t.z & 0xffffu), bf2f(t.z >> 16), bf2f(t.w & 0xffffu), bf2f(t.w >> 16)};
                    const f32x4 v0 = acc[ai][bj][m][0] + bb[bj][0], v1 = acc[ai][bj][m][1] + bb[bj][1];
                    u32x4 w; w.x = cvt_pk_bf16(y0[0] * sigmoidf_(v0[0]), y0[1] * sigmoidf_(v0[1])); w.y = cvt_pk_bf16(y0[2] * sigmoidf_(v0[2]), y0[3] * sigmoidf_(v0[3]));
                    w.z = cvt_pk_bf16(y1[0] * sigmoidf_(v1[0]), y1[1] * sigmoidf_(v1[1])); w.w = cvt_pk_bf16(y1[2] * sigmoidf_(v1[2]), y1[3] * sigmoidf_(v1[3]));
                    *(u32x4*)(MIXp + (size_t)row * (4 * MIX) + 3 * MIX + col0) = w;
                }
            }
            EPI_SB();
        }
    }
};
struct EpiMerge {
    static constexpr bool PERM = true;
    const bf16_t* G; bf16_t* MERGED;
    DI static bool keep(const Unit& u) { return u.sub < 3; }
    DI void operator()(f32x4 (&acc)[2][2][4][2], const Unit& u, int wr, int wc, int fr, int fq) const {
        if (u.sub < 3) {
#pragma unroll
            for (int ai = 0; ai < 2; ++ai)
#pragma unroll
                for (int mp = 0; mp < 2; ++mp) {
                    u32x4 ga[2][2], gb[2][2];
#pragma unroll
                    for (int mm = 0; mm < 2; ++mm)
#pragma unroll
                        for (int bj = 0; bj < 2; ++bj) { const bf16_t* gp = G + (size_t)(u.pm * BM + ai * HALF + wr * 64 + (2 * mp + mm) * 16 + fr) * GCOLS + u.sub * DM + u.pn * BM + bj * HALF + wc * 32 + 8 * fq;
                            ga[mm][bj] = *(const u32x4*)gp; gb[mm][bj] = *(const u32x4*)(gp + DM); }
                    EPI_SB();
#pragma unroll
                    for (int mm = 0; mm < 2; ++mm)
#pragma unroll
                        for (int bj = 0; bj < 2; ++bj) { const int m = 2 * mp + mm; const u32x4 a = ga[mm][bj], b = gb[mm][bj];
#pragma unroll
                            for (int q = 0; q < 4; ++q) { const unsigned aw = a[q], bw = b[q];
                                const float r0 = bf2f(aw & 0xffffu) * __builtin_amdgcn_rcpf(fmaxf(bf2f(bw & 0xffffu), 1e-30f)), r1 = bf2f(aw >> 16) * __builtin_amdgcn_rcpf(fmaxf(bf2f(bw >> 16), 1e-30f));
                                acc[ai][bj][m][q >> 1][2 * (q & 1)] *= r0; acc[ai][bj][m][q >> 1][2 * (q & 1) + 1] *= r1; } }
                    EPI_SB();
                }
        } else {
#pragma unroll
            for (int ai = 0; ai < 2; ++ai) {
                u32x4 gw[4][2];
#pragma unroll
                for (int m = 0; m < 4; ++m)
#pragma unroll
                    for (int bj = 0; bj < 2; ++bj) gw[m][bj] = *(const u32x4*)(G + (size_t)(u.pm * BM + ai * HALF + wr * 64 + m * 16 + fr) * GCOLS + 3 * DM + u.pn * BM + bj * HALF + wc * 32 + 8 * fq);
                EPI_SB();
#pragma unroll
                for (int m = 0; m < 4; ++m) { const int row = u.pm * BM + ai * HALF + wr * 64 + m * 16 + fr;
#pragma unroll
                    for (int bj = 0; bj < 2; ++bj) { const int col0 = u.pn * BM + bj * HALF + wc * 32 + 8 * fq; const u32x4 g = gw[m][bj];
                        f32x4 v0 = acc[ai][bj][m][0], v1 = acc[ai][bj][m][1];
                        v0[0] *= fmaxf(bf2f(g.x & 0xffffu), 1e-30f); v0[1] *= fmaxf(bf2f(g.x >> 16), 1e-30f); v0[2] *= fmaxf(bf2f(g.y & 0xffffu), 1e-30f); v0[3] *= fmaxf(bf2f(g.y >> 16), 1e-30f);
                        v1[0] *= fmaxf(bf2f(g.z & 0xffffu), 1e-30f); v1[1] *= fmaxf(bf2f(g.z >> 16), 1e-30f); v1[2] *= fmaxf(bf2f(g.w & 0xffffu), 1e-30f); v1[3] *= fmaxf(bf2f(g.w >> 16), 1e-30f);
                        u32x4 w; w.x = cvt_pk_bf16(v0[0], v0[1]); w.y = cvt_pk_bf16(v0[2], v0[3]); w.z = cvt_pk_bf16(v1[0], v1[1]); w.w = cvt_pk_bf16(v1[2], v1[3]);
                        *(u32x4*)(MERGED + (size_t)row * DM + col0) = w; } }
                EPI_SB();
            }
        }
    }
};
}

struct Frame { LAS unsigned char* lds; int tid, lane, wave, bid, G; };

DI Frame fresh(const Frame& F0) { Frame F = F0; int tid = F0.tid, bid = F0.bid, G = F0.G, wave = F0.wave; unsigned lo = (unsigned)(size_t)F0.lds;
    asm volatile("" : "+v"(tid)); asm volatile("" : "+s"(bid), "+s"(G), "+s"(wave), "+s"(lo));
    F.tid = tid; F.lane = tid & 63; F.wave = wave; F.bid = bid; F.G = G; F.lds = (LAS unsigned char*)(size_t)lo; return F; }
DI unsigned char* fresh_ptr(unsigned char* p) { size_t z = 0; asm volatile("" : "+s"(z)); return p + z; }
DI void rs_table(const Frame& F, const float* part, int pm) {
    LAS float* rsT = (LAS float*)(F.lds + RST_OFF);
    if (F.tid < 256) { const int row = pm * 256 + F.tid; float s = 0.f;
#pragma unroll
        for (int i = 0; i < 8; ++i) { const f32x4 v = *(const f32x4*)(part + (size_t)row * 32 + 4 * i); s += (v[0] + v[1]) + (v[2] + v[3]); }
        rsT[F.tid] = 1.0f / sqrtf(s * (1.0f / DM) + RMS_EPS); }
    __syncthreads();
}

DI int head_perm(int c) { const int h = c >> 6, p = c & 63; const int dim = p < 16 ? ((p >> 1) + 8 * (p & 1)) : p; return (h << 6) + dim; }
DI int zin_colmap(int n) {
    if (n < B_COLS) return 1860 + n;
    if (n < 2048) return -1;
    if (n < 2560) return head_perm(n - 2048);
    if (n < 3072) return 512 + head_perm(n - 2560);
    if (n < 3584) return 1024 + (n - 3072);
    if (n < 3840) return 1536 + head_perm(n - 3584);
    if (n < 3904) return 1792 + head_perm(n - 3840);
    if (n < 3908) return 1856 + (n - 3904);
    if (n < 4096) return -1;
    if (n < 4608) return 3844 + (n - 4096);
    if (n < 5120) return 4356 + (n - 4608);
    return 4868 + (n - 5120);
}
template <int MODE>
DI void tr_item(const float* W, int ldw, const float* ksc, bf16_t* WT, int K, LAS float* scr, int kb, int nb, int lane) {
    const int k0 = 64 * kb, n0 = 32 * nb, nn = n0 + (lane & 31);
    const int col = MODE == 1 ? zin_colmap(nn) : nn;
    float tv[32];
    if (col >= 0) {
#pragma unroll
        for (int i = 0; i < 32; ++i) tv[i] = W[(size_t)(k0 + 2 * i + (lane >> 5)) * ldw + col];
        if (ksc) {
#pragma unroll
            for (int i = 0; i < 32; ++i) tv[i] *= ksc[k0 + 2 * i + (lane >> 5)]; }
    } else {
#pragma unroll
        for (int i = 0; i < 32; ++i) tv[i] = 0.f; }
#pragma unroll
    for (int i = 0; i < 32; ++i) scr[(2 * i + (lane >> 5)) * 33 + (lane & 31)] = tv[i];
    LDS_WAIT(); asm volatile("" ::: "memory");
    const int c = lane & 7;
#pragma unroll
    for (int j = 0; j < 4; ++j) { const int n = (lane >> 3) + 8 * j; const LAS float* s = scr + (8 * c) * 33 + n;
        u32x4 o; o.x = pk2(s[0 * 33], s[1 * 33]); o.y = pk2(s[2 * 33], s[3 * 33]); o.z = pk2(s[4 * 33], s[5 * 33]); o.w = pk2(s[6 * 33], s[7 * 33]);
        *(u32x4*)(WT + (size_t)(n0 + n) * K + k0 + 8 * c) = o; }
    LDS_WAIT(); asm volatile("" ::: "memory");
}
struct InTab { const float* p[37]; };
#define CAS __attribute__((address_space(4)))
typedef const float* fptr_t;
typedef GAS const float* gfptr_t;
struct In { CAS const gfptr_t* t; DI fptr_t operator[](int i) const { return (fptr_t)t[i]; } };
DI In in_fresh(In in) { CAS const gfptr_t* t = in.t; asm volatile("" : "+s"(t)); In r; r.t = t; return r; }
constexpr int CV_IN = 32 * (NZ / 32), CV_BR = 4 * 8 * 64, CV_OUT = 32 * 64, CV_GLU = 8 * 16, CV_UP = 32 * (DFF2 / 32), CV_DN = 86 * 64;
constexpr int CV_S1 = 0, CV_S2 = CV_IN, CV_S3 = CV_S2 + CV_BR + CV_OUT + CV_GLU, CV_S4 = CV_S3 + CV_UP, CV_LAYER = CV_S4 + CV_DN;
DI void conv_w_item(const In& in, unsigned char* ws, LAS float* scr, int l, int r, int lane) {
    unsigned char* wt = ws + WS_WT + (size_t)l * WT_LAYER;
    if (r < CV_IN) { const int nbk = NZ / 32; tr_item<1>(in[3] + (size_t)l * DM * IN_COLS, IN_COLS, in[2] + l * DM, (bf16_t*)(wt + WT_IN), DM, scr, r / nbk, r % nbk, lane); return; } r -= CV_IN;
    if (r < CV_BR) { const int n = r / 512, rr = r % 512; tr_item<0>(in[29] + ((size_t)l * 4 + n) * MIX * DM, DM, nullptr, (bf16_t*)(wt + WT_BR) + (size_t)n * DM * MIX, MIX, scr, rr / 64, rr % 64, lane); return; } r -= CV_BR;
    if (r < CV_OUT) { tr_item<0>(in[30] + (size_t)l * DM * DM, DM, nullptr, (bf16_t*)(wt + WT_OUT), DM, scr, r / 64, r % 64, lane); return; } r -= CV_OUT;
    if (r < CV_GLU) { tr_item<0>(in[27] + (size_t)l * MIX * MIX, MIX, nullptr, (bf16_t*)(wt + WT_GLU), MIX, scr, r / 16, r % 16, lane); return; } r -= CV_GLU;
    if (r < CV_UP) { const int nbk = DFF2 / 32; tr_item<0>(in[32] + (size_t)l * DM * DFF2, DFF2, in[31] + l * DM, (bf16_t*)(wt + WT_UP), DM, scr, r / nbk, r % nbk, lane); return; } r -= CV_UP;
    tr_item<0>(in[35] + (size_t)l * DFF * DM, DM, nullptr, (bf16_t*)(wt + WT_DOWN), DFF, scr, r / 64, r % 64, lane);
}
DI void conv_w_drain(const Frame& F, const In& in, unsigned char* ws, int l, int lo, int hi, int sec) {
    if (l >= NL) return;
    unsigned* cnt = (unsigned*)(ws + WS_CTL) + CW_CONV + 64 * (l * 4 + sec);
    LAS float* scr = (LAS float*)(F.lds + F.wave * 16384);
    for (;;) { unsigned bt = 0u; if (F.lane == 0) bt = __hip_atomic_fetch_add(cnt, 1u, __ATOMIC_RELAXED, __HIP_MEMORY_SCOPE_AGENT);
        bt = (unsigned)__builtin_amdgcn_readfirstlane((int)bt);
        const int r0 = lo + (int)bt * 16; if (r0 >= hi) break;
        for (int r = r0; r < r0 + 16 && r < hi; ++r) conv_w_item(in, ws, scr, l, r, F.lane); }
}
DI void p0_prologue(const Frame& F, const In& in, unsigned char* ws) {
    LAS float* scr = (LAS float*)(F.lds + F.wave * 16384);
    const int gw = F.bid * NWAVES + F.wave, NGW = F.G * NWAVES;
    for (int it = gw; it < CV_LAYER; it += NGW) conv_w_item(in, ws, scr, 0, it, F.lane);
    { bf16_t* WTL = (bf16_t*)(ws + WS_WTL);
      for (int e = F.bid * NTHR + F.tid; e < NL * 56 * MIX; e += F.G * NTHR) { const int n = e % MIX, k8 = (e / MIX) % 56, l = e / (MIX * 56); const int k0 = k8 * 8;
          const float* src = k0 < 96 ? in[8] + ((size_t)l * 96 + k0) * MIX : (k0 < 192 ? in[10] + ((size_t)l * 96 + (k0 - 96)) * MIX : in[11] + ((size_t)l * 256 + (k0 - 192)) * MIX);
          u32x4 o; o.x = pk2(src[n], src[MIX + n]); o.y = pk2(src[2 * MIX + n], src[3 * MIX + n]); o.z = pk2(src[4 * MIX + n], src[5 * MIX + n]); o.w = pk2(src[6 * MIX + n], src[7 * MIX + n]);
          *(u32x4*)(WTL + ((size_t)l * MIX + n) * 448 + k0) = o; } }
    { bf16_t* WTP = (bf16_t*)(ws + WS_WTP);
      for (int e = F.bid * NTHR + F.tid; e < NL * 4 * 128 * 16; e += F.G * NTHR) { const int n = e & 127, k8 = (e >> 7) & 15, lg = e >> 11;
          const float* src = in[17] + ((size_t)lg * 128 + k8 * 8) * 128 + n;
          u32x4 o; o.x = pk2(src[0], src[128]); o.y = pk2(src[256], src[384]); o.z = pk2(src[512], src[640]); o.w = pk2(src[768], src[896]);
          *(u32x4*)(WTP + ((size_t)lg * 128 + n) * 128 + k8 * 8) = o; } }
    const int* pos = (const int*)in[1];
    float* rope = (float*)(ws + WS_ROPE);
    for (int e = F.bid * NTHR + F.tid; e < MTOK * 8; e += F.G * NTHR) { const int m = e >> 3, i = e & 7;
        const float inv = exp2f(-(float)i * 0.125f * 18.931568569324174f);
        const float ang = (float)pos[m] * inv; float sn, cs; sincosf(ang, &sn, &cs);
        rope[m * 16 + i] = cs; rope[m * 16 + 8 + i] = sn; }
    const float* x = in[0]; bf16_t* YB = (bf16_t*)(ws + WS_YB); float* pa = (float*)(ws + WS_PARTA);
    for (int m = gw; m < MTOK; m += NGW) { float s = 0.f;
        f32x4 xv[8];
#pragma unroll
        for (int j = 0; j < 8; ++j) xv[j] = *(const f32x4*)(x + (size_t)m * DM + (j * 64 + F.lane) * 4);
        __builtin_amdgcn_sched_barrier(0);
#pragma unroll
        for (int j = 0; j < 8; ++j) { const f32x4 v = xv[j]; s += (v[0] * v[0] + v[1] * v[1]) + (v[2] * v[2] + v[3] * v[3]);
            u32x2 w; w.x = pk2(v[0], v[1]); w.y = pk2(v[2], v[3]); *(u32x2*)(YB + (size_t)m * DM + (j * 64 + F.lane) * 4) = w; }
        s = wave_sum(s);
        if (F.lane < 32) pa[(size_t)m * 32 + F.lane] = (F.lane == 0) ? s : 0.f; }
}

DI void dsa_prep_item(const Frame& F, unsigned char* ws, const float* idxg, int item) {
    const bf16_t* ZS = (const bf16_t*)(ws + WS_ZS); const float* rope = (const float*)(ws + WS_ROPE);
    bf16_t* Q = (bf16_t*)(ws + WS_Q); bf16_t* Kb = (bf16_t*)(ws + WS_K); bf16_t* VT = (bf16_t*)(ws + WS_VT); bf16_t* QI = (bf16_t*)(ws + WS_QI); bf16_t* KI = (bf16_t*)(ws + WS_KI); float* WI = (float*)(ws + WS_WI);
    const int m0 = item * 32;
    int tid_ = F.tid; asm volatile("" : "+v"(tid_));
    const int wv4 = F.wave * 4;
    float kx[4], wx[4];
#pragma unroll
    for (int tt = 0; tt < 4; ++tt) { const int m = m0 + wv4 + tt; kx[tt] = bf2f(ZS[(size_t)m * ZS_COLS + ZO_KI + F.lane]); wx[tt] = bf2f(ZS[(size_t)m * ZS_COLS + ZO_WI + (F.lane & 3)]); }
#pragma unroll
    for (int hb = 0; hb < 2; ++hb) {
        u32x4 raw[5]; f32x4 cs[5], sn[5];
#pragma unroll
        for (int q = 0; q < 5; ++q) { const int e = tid_ + (5 * hb + q) * NTHR; const int t = e / 160, pc = e % 160; const int m = m0 + t;
            const int zc = pc < 64 ? ZO_Q + 8 * pc : (pc < 128 ? ZO_AK + 8 * (pc - 64) : ZO_QI + 8 * (pc - 128));
            raw[q] = *(const u32x4*)(ZS + (size_t)m * ZS_COLS + zc);
            cs[q] = *(const f32x4*)(rope + (size_t)m * 16 + 4 * (pc & 1)); sn[q] = *(const f32x4*)(rope + (size_t)m * 16 + 8 + 4 * (pc & 1)); }
        __builtin_amdgcn_sched_barrier(0);
#pragma unroll
        for (int q = 0; q < 5; ++q) { const int e = tid_ + (5 * hb + q) * NTHR; const int t = e / 160, pc = e % 160; const int m = m0 + t;
            const int c8 = pc & 7; const bool rot = c8 < 2; const float sc = pc < 64 ? 0.125f : 1.0f;
            float o[8];
#pragma unroll
            for (int i = 0; i < 4; ++i) { const unsigned wi = raw[q][i]; const float x1 = bf2f(wi & 0xffffu), x2 = bf2f(wi >> 16); const float r1 = x1 * cs[q][i] - x2 * sn[q][i], r2 = x2 * cs[q][i] + x1 * sn[q][i];
                o[2 * i] = (rot ? r1 : x1) * sc; o[2 * i + 1] = (rot ? r2 : x2) * sc; }
            u32x4 w; w.x = pk2(o[0], o[1]); w.y = pk2(o[2], o[3]); w.z = pk2(o[4], o[5]); w.w = pk2(o[6], o[7]);
            if (pc < 64) *(u32x4*)(Q + (size_t)m * 512 + 8 * pc) = w;
            else if (pc < 128) { const int oc = 8 * (pc - 64), tq = m % SEQ, hq = oc >> 6, pq = oc & 63;
                *(u32x4*)(Kb + (((((size_t)(m / SEQ) * 8 + hq) * 64 + (tq >> 5)) * 4 + (pq >> 4)) * 32 + (tq & 31)) * 16 + ((pq >> 3) & 1) * 8) = w; }
            else *(u32x4*)(QI + (size_t)m * 256 + 8 * (pc - 128)) = w; }
        __builtin_amdgcn_sched_barrier(0);
    }
    { const int dim = F.lane < 16 ? ((F.lane >> 1) + 8 * (F.lane & 1)) : F.lane; const float gn = idxg[dim];
      float csv[4], snv[4];
#pragma unroll
      for (int tt = 0; tt < 4; ++tt) { const int m = m0 + wv4 + tt; csv[tt] = rope[m * 16 + ((F.lane >> 1) & 7)]; snv[tt] = rope[m * 16 + 8 + ((F.lane >> 1) & 7)]; }
      __builtin_amdgcn_sched_barrier(0);
#pragma unroll
      for (int tt = 0; tt < 4; ++tt) { const int m = m0 + wv4 + tt;
        const float xv = kx[tt];
        const float ss = wave_sum(xv * xv);
        float y = xv * (1.0f / sqrtf(ss * (1.0f / 64.f) + RMS_EPS)) * gn;
        const float pr = __shfl_xor(y, 1);
        if (F.lane < 16) y = (F.lane & 1) ? (y * csv[tt] + pr * snv[tt]) : (y * csv[tt] - pr * snv[tt]);
        { const int tq = m % SEQ, pq = F.lane; KI[((((size_t)(m / SEQ) * 64 + (tq >> 5)) * 4 + (pq >> 4)) * 32 + (tq & 31)) * 16 + ((pq >> 3) & 1) * 8 + (pq & 7)] = (bf16_t)f2bf(y); }
        if (F.lane < 4) WI[(size_t)m * 4 + F.lane] = wx[tt]; } }
    LAS unsigned char* L = F.lds;
    for (int e = F.tid; e < 32 * 128; e += NTHR) { const int t = e >> 7, c4 = (e & 127) * 4;
        *(LAS u32x2*)(L + t * 1040 + c4 * 2) = *(const u32x2*)(ZS + (size_t)(m0 + t) * ZS_COLS + ZO_AV + c4); }
    __syncthreads();
    { const int b = m0 / SEQ, kt = (m0 % SEQ) >> 5;
      for (int e = F.tid; e < 512 * 4; e += NTHR) { const int c = e >> 2, s2 = (e >> 1) & 1, hq = e & 1;
          unsigned short vals[8];
#pragma unroll
          for (int j = 0; j < 8; ++j) vals[j] = *(const LAS unsigned short*)(L + (16 * s2 + 8 * (j >> 2) + 4 * hq + (j & 3)) * 1040 + c * 2);
          u32x4 o; o.x = vals[0] | ((unsigned)vals[1] << 16); o.y = vals[2] | ((unsigned)vals[3] << 16); o.z = vals[4] | ((unsigned)vals[5] << 16); o.w = vals[6] | ((unsigned)vals[7] << 16);
          const int hv = c >> 6, d = c & 63;
          *(u32x4*)(VT + ((((((size_t)b * 8 + hv) * 64 + kt) * 2 + s2) * 2 + (d >> 5)) * 32 + (d & 31)) * 16 + hq * 8) = o; } }
    __syncthreads();
}

DI float softplusf_(float x) { return fmaxf(x, 0.f) + __logf(1.0f + __expf(-fabsf(x))); }
DI float tanhf_(float x) { return 1.0f - 2.0f * __builtin_amdgcn_rcpf(1.0f + __expf(2.0f * x)); }
DI float half32_sum(float x) { x = row16_sum(x); return x + __shfl_xor(x, 16); }
DI f32x4 cv4bf(const u32x2 w) { return (f32x4){bf2f(w.x & 0xffffu), bf2f(w.x >> 16), bf2f(w.y & 0xffffu), bf2f(w.y >> 16)}; }
struct RwG { u32x2 zr, zk, zv, pr, pk, pv; };
DI void rwg_load(RwG& G, const bf16_t* zc_, const bf16_t* zp_, int n) {
    G.zr = *(const u32x2*)(zc_ + ZO_R + n); G.zk = *(const u32x2*)(zc_ + ZO_K + n); G.zv = *(const u32x2*)(zc_ + ZO_V + n);
    G.pr = *(const u32x2*)(zp_ + ZO_R + n); G.pk = *(const u32x2*)(zp_ + ZO_K + n); G.pv = *(const u32x2*)(zp_ + ZO_V + n);
}
DI void rwkv_prep_item(const Frame& F, unsigned char* ws, const In& in, int l, int item) {
    const bf16_t* ZS = (const bf16_t*)(ws + WS_ZS);
    const float* mu = in[6] + l * B_COLS; const float* w0 = in[7] + l * MIX; const float* a0 = in[9] + l * MIX; const float* k_k = in[12] + l * MIX; const float* k_a = in[13] + l * MIX;
    const bf16_t* WTL = (const bf16_t*)(ws + WS_WTL) + (size_t)l * MIX * 448;
    float* RW = (float*)(ws + WS_RW); constexpr size_t RS = RW_STRIDE / 4;
    const int m0 = item * 32; const bool first = (m0 % SEQ) == 0;
    constexpr int XP = 456;
    LAS bf16_t* X = (LAS bf16_t*)F.lds;
    LAS float* PT = (LAS float*)(F.lds + 32768);
    { u32x2 zc7[7], zp7[7]; f32x4 mv7[7]; float pt7[7];
#pragma unroll
      for (int it = 0; it < 7; ++it) { const int e = F.tid + it * NTHR; const int t = e / 112, c = (e % 112) * 4; const int m = m0 + t, zc = ZO_LW + c; const bool nop = first && t == 0;
          zc7[it] = *(const u32x2*)(ZS + (size_t)m * ZS_COLS + zc); zp7[it] = *(const u32x2*)(ZS + (size_t)(nop ? m : m - 1) * ZS_COLS + zc); mv7[it] = *(const f32x4*)(mu + zc); }
      pt7[0] = mu[ZO_R + F.tid]; pt7[1] = mu[ZO_K + F.tid]; pt7[2] = mu[ZO_V + F.tid]; pt7[3] = w0[F.tid]; pt7[4] = a0[F.tid]; pt7[5] = k_k[F.tid]; pt7[6] = k_a[F.tid];
      __builtin_amdgcn_sched_barrier(0);
#pragma unroll
      for (int a = 0; a < 7; ++a) PT[a * 512 + F.tid] = pt7[a];
#pragma unroll
      for (int it = 0; it < 7; ++it) { const int e = F.tid + it * NTHR; const int t = e / 112, c = (e % 112) * 4; const bool nop = first && t == 0;
          const f32x4 z = cv4bf(zc7[it]); f32x4 zp = cv4bf(zp7[it]);
          if (nop) zp = (f32x4){0.f, 0.f, 0.f, 0.f};
          const f32x4 xs = z + (zp - z) * mv7[it]; float o[4];
          const float ea = c < 96 ? 2.0f : -1.0f;
#pragma unroll
          for (int i = 0; i < 4; ++i) { const float rc = __builtin_amdgcn_rcpf(1.0f + __expf(ea * xs[i])); o[i] = c < 96 ? (1.0f - 2.0f * rc) : (c < 192 ? xs[i] : rc); }
          *(LAS u32x2*)(X + t * XP + c) = (u32x2){pk2(o[0], o[1]), pk2(o[2], o[3])}; } }
    __syncthreads();
    const int r = F.lane & 31, hh = F.lane >> 5, h = F.wave, m = m0 + r;
    const bool nop = first && r == 0;
    const bf16_t* zc_ = ZS + (size_t)m * ZS_COLS; const bf16_t* zp_ = ZS + (size_t)(nop ? m : m - 1) * ZS_COLS;
    float ss = 0.f;
    { u32x2 zk8[8], pk8[8];
#pragma unroll
      for (int q = 0; q < 8; ++q) { const int n = h * 64 + (q >> 2) * 32 + 8 * (q & 3) + 4 * hh; zk8[q] = *(const u32x2*)(zc_ + ZO_K + n); pk8[q] = *(const u32x2*)(zp_ + ZO_K + n); }
      __builtin_amdgcn_sched_barrier(0);
#pragma unroll
      for (int q = 0; q < 8; ++q) { const int n = h * 64 + (q >> 2) * 32 + 8 * (q & 3) + 4 * hh;
          const f32x4 zk = cv4bf(zk8[q]); f32x4 pk = cv4bf(pk8[q]); if (nop) pk = (f32x4){0.f, 0.f, 0.f, 0.f};
          const f32x4 kk = (zk + (pk - zk) * *(const LAS f32x4*)(PT + 512 + n)) * *(const LAS f32x4*)(PT + 5 * 512 + n);
          ss += (kk[0] * kk[0] + kk[1] * kk[1]) + (kk[2] * kk[2] + kk[3] * kk[3]); } }
    ss += __shfl_xor(ss, 32);
    const float inv = 1.0f / fmaxf(sqrtf(ss), 1e-12f);
    const LAS bf16_t* xb = X + r * XP + 8 * hh;
#pragma unroll 1
    for (int nt = 0; nt < 2; ++nt) { const bf16_t* wrow = WTL + (size_t)(h * 64 + nt * 32 + r) * 448 + 8 * hh;
        f32x16 aw, aa, ag;
#pragma unroll
        for (int i = 0; i < 16; ++i) { aw[i] = 0.f; aa[i] = 0.f; ag[i] = 0.f; }
        bf16x8 wA[7], wB[7];
#define RW_LOAD(dst, b) _Pragma("unroll") for (int q = 0; q < 7; ++q) dst[q] = *(const bf16x8*)(wrow + 16 * (7 * (b) + q))
#define RW_MMA(src, b) _Pragma("unroll") for (int q = 0; q < 7; ++q) { const int j = 7 * (b) + q; const bf16x8 xv = *(const LAS bf16x8*)(xb + 16 * j); \
            if (j < 6) aw = MFMA32(src[q], xv, aw); else if (j < 12) aa = MFMA32(src[q], xv, aa); else ag = MFMA32(src[q], xv, ag); }
        RW_LOAD(wA, 0); RW_LOAD(wB, 1); __builtin_amdgcn_sched_barrier(0);
        RW_MMA(wA, 0); __builtin_amdgcn_sched_barrier(0); RW_LOAD(wA, 2); __builtin_amdgcn_sched_barrier(0);
        RW_MMA(wB, 1); __builtin_amdgcn_sched_barrier(0); RW_LOAD(wB, 3); __builtin_amdgcn_sched_barrier(0);
        RW_MMA(wA, 2); __builtin_amdgcn_sched_barrier(0);
        RwG G0; rwg_load(G0, zc_, zp_, h * 64 + nt * 32 + 4 * hh); __builtin_amdgcn_sched_barrier(0);
        RW_MMA(wB, 3); __builtin_amdgcn_sched_barrier(0);
#undef RW_LOAD
#undef RW_MMA
#pragma unroll
        for (int g = 0; g < 4; ++g) { const int n = h * 64 + nt * 32 + 8 * g + 4 * hh;
            const RwG G = G0;
            if (g < 3) rwg_load(G0, zc_, zp_, n + 8);
            __builtin_amdgcn_sched_barrier(0);
            const f32x4 zr = cv4bf(G.zr), zk = cv4bf(G.zk), zv = cv4bf(G.zv);
            f32x4 pr = cv4bf(G.pr), pk = cv4bf(G.pk), pv = cv4bf(G.pv);
            if (nop) { pr = (f32x4){0.f, 0.f, 0.f, 0.f}; pk = pr; pv = pr; }
            const f32x4 rr = zr + (pr - zr) * *(const LAS f32x4*)(PT + n), k = zk + (pk - zk) * *(const LAS f32x4*)(PT + 512 + n), v = zv + (pv - zv) * *(const LAS f32x4*)(PT + 2 * 512 + n);
            const f32x4 w0v = *(const LAS f32x4*)(PT + 3 * 512 + n), a0v = *(const LAS f32x4*)(PT + 4 * 512 + n), kkv = *(const LAS f32x4*)(PT + 5 * 512 + n), kav = *(const LAS f32x4*)(PT + 6 * 512 + n);
            f32x4 dec, k2, nkk, kka, gg;
#pragma unroll
            for (int j = 0; j < 4; ++j) { const int i = 4 * g + j;
                const float wlog = -softplusf_(-(w0v[j] + aw[i])) - 0.5f; dec[j] = __expf(-__expf(wlog));
                const float a = sigmoidf_(a0v[j] + aa[i]); const float kk = k[j] * kkv[j] * inv;
                k2[j] = k[j] * (1.0f + (a - 1.0f) * kav[j]); nkk[j] = -kk; kka[j] = kk * a; gg[j] = ag[i]; }
            const size_t o = (size_t)m * MIX + n;
            *(f32x4*)(RW + 0 * RS + o) = rr; *(f32x4*)(RW + 1 * RS + o) = dec; *(f32x4*)(RW + 2 * RS + o) = k2; *(f32x4*)(RW + 3 * RS + o) = v;
            *(f32x4*)(RW + 4 * RS + o) = nkk; *(f32x4*)(RW + 5 * RS + o) = kka; *(f32x4*)(RW + 6 * RS + o) = gg;
            __builtin_amdgcn_sched_barrier(0); } }
    __syncthreads();
}

template <int LV> DI void pool_windows(const float (&z)[47], int t0, LAS bf16_t* D, int j) {
    float s[47];
#pragma unroll
    for (int i = 0; i < 47; ++i) s[i] = z[i];
#pragma unroll
    for (int lv = 0; lv < LV; ++lv) {
#pragma unroll
        for (int i = 46; i >= 0; --i) { const int o = i - (1 << lv); s[i] = s[i] + (o >= 0 ? s[o] : 0.f); } }
#pragma unroll
    for (int t = 0; t < 32; ++t) { const int ta = t0 + t; const int cnt = (ta + 1) < (1 << LV) ? (ta + 1) : (1 << LV);
        D[t * 520 + j] = (bf16_t)f2bf(s[15 + t] / (float)cnt - z[15 + t]); }
}
DI void pool_item(const Frame& F, unsigned char* ws, const In& in, int l, int item) {
    const bf16_t* ZS = (const bf16_t*)(ws + WS_ZS); bf16_t* MIXp = (bf16_t*)(ws + WS_MIX);
    const bf16_t* WTP = (const bf16_t*)(ws + WS_WTP) + (size_t)l * 4 * 128 * 128; const float* psc = in[18] + l * MIX;
    const int m0 = item * 32, t0 = m0 % SEQ;
    LAS bf16_t* D = (LAS bf16_t*)F.lds;
    { const int j = F.tid, gi = j >> 7;
      float z[47];
#pragma unroll
      for (int i = 0; i < 47; ++i) { const int ta = t0 - 15 + i; z[i] = bf2f(ZS[(size_t)(m0 - 15 + (ta >= 0 ? i : 15)) * ZS_COLS + ZO_C + j]); if (ta < 0) z[i] = 0.f; }
      if (gi == 0) pool_windows<1>(z, t0, D, j); else if (gi == 1) pool_windows<2>(z, t0, D, j); else if (gi == 2) pool_windows<3>(z, t0, D, j); else pool_windows<4>(z, t0, D, j); }
    __syncthreads();
    const int r = F.lane & 31, hh = F.lane >> 5, gi = F.wave >> 1;
    const LAS bf16_t* xa = D + r * 520 + gi * 128 + 8 * hh;
#pragma unroll
    for (int q = 0; q < 2; ++q) { const int n = (2 * (F.wave & 1) + q) * 32 + r;
        const bf16_t* wrow = WTP + ((size_t)gi * 128 + n) * 128 + 8 * hh;
        bf16x8 wq[8];
#pragma unroll
        for (int s2 = 0; s2 < 8; ++s2) wq[s2] = *(const bf16x8*)(wrow + 16 * s2);
        const int col = gi * 128 + n; const float sc = psc[col];
        __builtin_amdgcn_sched_barrier(0);
        f32x16 acc;
#pragma unroll
        for (int i = 0; i < 16; ++i) acc[i] = 0.f;
#pragma unroll
        for (int s2 = 0; s2 < 8; ++s2) acc = MFMA32(*(const LAS bf16x8*)(xa + 16 * s2), wq[s2], acc);
#pragma unroll
        for (int i = 0; i < 16; ++i) { const int m = m0 + (i & 3) + 8 * (i >> 2) + 4 * hh; MIXp[(size_t)m * (4 * MIX) + 2 * MIX + col] = (bf16_t)f2bf(acc[i] * sc); }
        __builtin_amdgcn_sched_barrier(0); }
    __syncthreads();
}

DI float gelu_tanh(float y) { const float u = 0.7978845608028654f * (y + 0.044715f * y * y * y); return y * (1.0f - __builtin_amdgcn_rcpf(1.0f + __expf(2.0f * u))); }

DI void ssm_seq_item(const Frame& F, unsigned char* ws, const In& in, int l, int item) {
    const bf16_t* ZS = (const bf16_t*)(ws + WS_ZS); bf16_t* YSB = (bf16_t*)(ws + WS_YSB);
    const int task = item * 8 + F.wave, g = task >> 1, bp = task & 1;
    const int r = F.lane & 31, hh = F.lane >> 5;
    constexpr int XP = 136;
    LAS bf16_t* Xl = (LAS bf16_t*)(F.lds + F.wave * 8704);
    float lr[2], li[2]; bf16x8 Bf[4];
#pragma unroll
    for (int ps = 0; ps < 2; ++ps) { const int p = r + 32 * ps;
        const float are = in[19][((size_t)l * 32 + g) * 64 + p], aim = in[20][((size_t)l * 32 + g) * 64 + p];
        const float dt = __expf(in[21][l * 32 + g]);
        const float er = __expf(are * dt); float sn, cs; sincosf(aim * dt, &sn, &cs);
        lr[ps] = er * cs; li[ps] = er * sn;
        const float nr = lr[ps] - 1.0f, ni = li[ps], den = are * are + aim * aim;
        const float cr = (nr * are + ni * aim) / den, ci = (ni * are - nr * aim) / den;
        const float* bre = in[22] + (((size_t)l * 32 + g) * 64 + p) * 16 + 8 * hh; const float* bim = in[23] + (((size_t)l * 32 + g) * 64 + p) * 16 + 8 * hh;
        float vr[8], vi[8];
#pragma unroll
        for (int j = 0; j < 8; ++j) { const float x = bre[j], y = bim[j]; vr[j] = cr * x - ci * y; vi[j] = cr * y + ci * x; }
        Bf[2 * ps] = pack8(vr[0], vr[1], vr[2], vr[3], vr[4], vr[5], vr[6], vr[7]); Bf[2 * ps + 1] = pack8(vi[0], vi[1], vi[2], vi[3], vi[4], vi[5], vi[6], vi[7]); }
    bf16x8 Cf[8];
    { const float* cre = in[24] + (((size_t)l * 32 + g) * 16 + (r & 15)) * 64; const float* cim = in[25] + (((size_t)l * 32 + g) * 16 + (r & 15)) * 64;
#pragma unroll
      for (int s2 = 0; s2 < 8; ++s2) { const int q = s2 >> 1, n0 = 16 * (s2 & 1) + 8 * hh + 32 * (q >> 1); float v[8];
#pragma unroll
          for (int j = 0; j < 8; ++j) { const float x = (q & 1) ? -cim[n0 + j] : cre[n0 + j]; v[j] = (r < 16) ? x : 0.f; }
          Cf[s2] = pack8(v[0], v[1], v[2], v[3], v[4], v[5], v[6], v[7]); } }
    const float dsk = in[26][l * MIX + g * 16 + (r & 15)];
    bf16x8 Dg;
    { float v[8];
#pragma unroll
      for (int j = 0; j < 8; ++j) v[j] = (r < 16 && 8 * hh + j == r) ? dsk : 0.f;
      Dg = pack8(v[0], v[1], v[2], v[3], v[4], v[5], v[6], v[7]); }
    float xr0 = 0.f, xi0 = 0.f, xr1 = 0.f, xi1 = 0.f;
    const int hr = (r >> 2) & 1, ir = 4 * (r >> 3) + (r & 3);
    const bf16_t* usrc = ZS + (size_t)((bp + 2 * hr) * SEQ + ir) * ZS_COLS + ZO_D + g * 16 + 8 * hh;
    bf16x8 unx = *(const bf16x8*)usrc;
    const size_t ebase = (size_t)((bp + 2 * hh) * SEQ) ;
    bf16_t* yout = YSB + ebase * MIX + g * 16 + (r & 15);
#pragma unroll 1
    for (int tile = 0; tile < SEQ / 16; ++tile) {
        const bf16x8 Au = unx;
        if (tile + 1 < SEQ / 16) unx = *(const bf16x8*)(usrc + (size_t)(tile + 1) * 16 * ZS_COLS);
        f32x16 z16;
#pragma unroll
        for (int i = 0; i < 16; ++i) z16[i] = 0.f;
        f32x16 a0 = MFMA32(Au, Bf[0], z16), a1 = MFMA32(Au, Bf[1], z16), a2 = MFMA32(Au, Bf[2], z16), a3 = MFMA32(Au, Bf[3], z16);
#pragma unroll
        for (int i = 0; i < 16; ++i) {
            const float n0r = lr[0] * xr0 - li[0] * xi0 + a0[i], n0i = lr[0] * xi0 + li[0] * xr0 + a1[i]; xr0 = n0r; xi0 = n0i; a0[i] = n0r; a1[i] = n0i;
            const float n1r = lr[1] * xr1 - li[1] * xi1 + a2[i], n1i = lr[1] * xi1 + li[1] * xr1 + a3[i]; xr1 = n1r; xi1 = n1i; a2[i] = n1r; a3[i] = n1i; }
#pragma unroll
        for (int i = 0; i < 16; ++i) { const int rho = (i & 3) + 8 * (i >> 2) + 4 * hh; LAS bf16_t* row = Xl + rho * XP + r;
            row[0] = (bf16_t)f2bf(a0[i]); row[32] = (bf16_t)f2bf(a1[i]); row[64] = (bf16_t)f2bf(a2[i]); row[96] = (bf16_t)f2bf(a3[i]); }
        LDS_WAIT(); asm volatile("" ::: "memory");
        f32x16 ay = MFMA32(Au, Dg, z16);
#pragma unroll
        for (int s2 = 0; s2 < 8; ++s2) ay = MFMA32(*(const LAS bf16x8*)(Xl + r * XP + 16 * s2 + 8 * hh), Cf[s2], ay);
        if (r < 16) {
#pragma unroll
            for (int i = 0; i < 16; ++i) yout[(size_t)(tile * 16 + i) * MIX] = (bf16_t)f2bf(gelu_tanh(ay[i])); }
        LDS_WAIT(); asm volatile("" ::: "memory");
    }
}

DI float vmul_(float a, float b) { float d; asm("v_mul_f32 %0, %1, %2" : "=v"(d) : "v"(a), "v"(b)); return d; }
DI float vfma_(float a, float b, float c) { float d; asm("v_fma_f32 %0, %1, %2, %3" : "=v"(d) : "v"(a), "v"(b), "v"(c)); return d; }
DI void row16_sum2(float& x0, float& x1) {
    asm("s_nop 1\n\t"
        "v_add_f32_dpp %0, %0, %0 quad_perm:[1,0,3,2] row_mask:0xf bank_mask:0xf bound_ctrl:1\n\tv_add_f32_dpp %1, %1, %1 quad_perm:[1,0,3,2] row_mask:0xf bank_mask:0xf bound_ctrl:1\n\ts_nop 0\n\t"
        "v_add_f32_dpp %0, %0, %0 quad_perm:[2,3,0,1] row_mask:0xf bank_mask:0xf bound_ctrl:1\n\tv_add_f32_dpp %1, %1, %1 quad_perm:[2,3,0,1] row_mask:0xf bank_mask:0xf bound_ctrl:1\n\ts_nop 0\n\t"
        "v_add_f32_dpp %0, %0, %0 row_half_mirror row_mask:0xf bank_mask:0xf bound_ctrl:1\n\tv_add_f32_dpp %1, %1, %1 row_half_mirror row_mask:0xf bank_mask:0xf bound_ctrl:1\n\ts_nop 0\n\t"
        "v_add_f32_dpp %0, %0, %0 row_mirror row_mask:0xf bank_mask:0xf bound_ctrl:1\n\tv_add_f32_dpp %1, %1, %1 row_mirror row_mask:0xf bank_mask:0xf bound_ctrl:1\n\ts_nop 1"
        : "+v"(x0), "+v"(x1));
}
DI void row16_sum4(float& x0, float& x1, float& x2, float& x3) {
#define R4(ctl) "v_add_f32_dpp %0, %0, %0 " ctl " row_mask:0xf bank_mask:0xf bound_ctrl:1\n\tv_add_f32_dpp %1, %1, %1 " ctl " row_mask:0xf bank_mask:0xf bound_ctrl:1\n\t" \
                "v_add_f32_dpp %2, %2, %2 " ctl " row_mask:0xf bank_mask:0xf bound_ctrl:1\n\tv_add_f32_dpp %3, %3, %3 " ctl " row_mask:0xf bank_mask:0xf bound_ctrl:1\n\t"
    asm("s_nop 1\n\t" R4("quad_perm:[1,0,3,2]") R4("quad_perm:[2,3,0,1]") R4("row_half_mirror") R4("row_mirror") "s_nop 0"
        : "+v"(x0), "+v"(x1), "+v"(x2), "+v"(x3));
#undef R4
}
DI void row_update(float (&S)[4], float sa, float v, const f32x4& w, const f32x4& b, const f32x4& k) {
    float t0, t1, t2, t3;
    asm("v_mul_f32 %4, %9, %18\n\tv_mul_f32 %5, %9, %19\n\tv_mul_f32 %6, %9, %20\n\tv_mul_f32 %7, %9, %21\n\t"
        "v_fma_f32 %4, %8, %14, %4\n\tv_fma_f32 %5, %8, %15, %5\n\tv_fma_f32 %6, %8, %16, %6\n\tv_fma_f32 %7, %8, %17, %7\n\t"
        "v_fma_f32 %0, %0, %10, %4\n\tv_fma_f32 %1, %1, %11, %5\n\tv_fma_f32 %2, %2, %12, %6\n\tv_fma_f32 %3, %3, %13, %7"
        : "+v"(S[0]), "+v"(S[1]), "+v"(S[2]), "+v"(S[3]), "=&v"(t0), "=&v"(t1), "=&v"(t2), "=&v"(t3)
        : "v"(sa), "v"(v), "v"(w[0]), "v"(w[1]), "v"(w[2]), "v"(w[3]), "v"(b[0]), "v"(b[1]), "v"(b[2]), "v"(b[3]), "v"(k[0]), "v"(k[1]), "v"(k[2]), "v"(k[3]));
}
DI void row_dots(const float (&S0)[4], const float (&S1)[4], const f32x4& r, const f32x4& an, float& y0, float& y1, float& s0, float& s1) {
    asm("v_mul_f32 %0, %4, %12\n\tv_mul_f32 %1, %8, %12\n\tv_mul_f32 %2, %4, %16\n\tv_mul_f32 %3, %8, %16\n\t"
        "v_fma_f32 %0, %5, %13, %0\n\tv_fma_f32 %1, %9, %13, %1\n\tv_fma_f32 %2, %5, %17, %2\n\tv_fma_f32 %3, %9, %17, %3\n\t"
        "v_fma_f32 %0, %6, %14, %0\n\tv_fma_f32 %1, %10, %14, %1\n\tv_fma_f32 %2, %6, %18, %2\n\tv_fma_f32 %3, %10, %18, %3\n\t"
        "v_fma_f32 %0, %7, %15, %0\n\tv_fma_f32 %1, %11, %15, %1\n\tv_fma_f32 %2, %7, %19, %2\n\tv_fma_f32 %3, %11, %19, %3"
        : "=&v"(y0), "=&v"(y1), "=&v"(s0), "=&v"(s1)
        : "v"(S0[0]), "v"(S0[1]), "v"(S0[2]), "v"(S0[3]), "v"(S1[0]), "v"(S1[1]), "v"(S1[2]), "v"(S1[3]),
          "v"(r[0]), "v"(r[1]), "v"(r[2]), "v"(r[3]), "v"(an[0]), "v"(an[1]), "v"(an[2]), "v"(an[3]));
}
DI void row_dots1(const float (&S)[4], const f32x4& r, const f32x4& an, float& y, float& sn) {
    asm("v_mul_f32 %0, %2, %6\n\tv_mul_f32 %1, %2, %10\n\tv_fma_f32 %0, %3, %7, %0\n\tv_fma_f32 %1, %3, %11, %1\n\t"
        "v_fma_f32 %0, %4, %8, %0\n\tv_fma_f32 %1, %4, %12, %1\n\tv_fma_f32 %0, %5, %9, %0\n\tv_fma_f32 %1, %5, %13, %1"
        : "=&v"(y), "=&v"(sn)
        : "v"(S[0]), "v"(S[1]), "v"(S[2]), "v"(S[3]), "v"(r[0]), "v"(r[1]), "v"(r[2]), "v"(r[3]), "v"(an[0]), "v"(an[1]), "v"(an[2]), "v"(an[3]));
}
DI void rwkv_scan_item(const Frame& F, unsigned char* ws, int item) {
    const float* RW = (const float*)(ws + WS_RW); constexpr size_t RS = RW_STRIDE / 4;
    float* YRAW = (float*)(ws + WS_YRAW);
    constexpr int TC = 32, NCH = SEQ / TC;
    const int bh = item >> 1, b = bh >> 3, h = bh & 7;
    const int rg = F.lane >> 4, jq = F.lane & 15, row = (item & 1) * 32 + F.wave * 4 + rg;
    LAS float* BUF = (LAS float*)F.lds;
    constexpr int BUFSZ = 6 * TC * 64;
    const int st = F.tid >> 4, sq = F.tid & 15;
    const float* gsrc = RW + (size_t)(b * SEQ + st) * MIX + h * 64 + 4 * sq;
    f32x4 pre[6];
#pragma unroll
    for (int a = 0; a < 6; ++a) pre[a] = *(const f32x4*)(gsrc + a * RS);
#pragma unroll
    for (int a = 0; a < 6; ++a) *(LAS f32x4*)(BUF + (a * TC + st) * 64 + 4 * sq) = pre[a];
    __syncthreads();
    float S[4] = {0.f, 0.f, 0.f, 0.f};
    float* yout = YRAW + (size_t)(b * SEQ) * MIX + h * 64 + row;
#pragma unroll 1
    for (int c = 0; c < NCH; ++c) {
        if (c + 1 < NCH) {
#pragma unroll
            for (int a = 0; a < 6; ++a) pre[a] = *(const f32x4*)(gsrc + a * RS + (size_t)(c + 1) * TC * MIX);
        }
        const LAS float* P = BUF + (c & 1) * BUFSZ;
        float sp, yp = 0.f;
        { const f32x4 a4 = *(const LAS f32x4*)(P + (4 * TC) * 64 + 4 * jq); float d; row_dots1(S, a4, a4, d, sp); }
#pragma unroll 1
        for (int t16 = 0; t16 < TC; t16 += 16) {
            float yk = 0.f;
#pragma unroll 4
            for (int tt = 0; tt < 16; ++tt) { const int t = t16 + tt;
                const f32x4 k4 = *(const LAS f32x4*)(P + (2 * TC + t) * 64 + 4 * jq);
                const float v = P[(3 * TC + t) * 64 + row];
                const f32x4 b4 = *(const LAS f32x4*)(P + (5 * TC + t) * 64 + 4 * jq);
                const f32x4 w4 = *(const LAS f32x4*)(P + (1 * TC + t) * 64 + 4 * jq);
                const f32x4 r4 = *(const LAS f32x4*)(P + (0 * TC + t) * 64 + 4 * jq);
                const f32x4 an = *(const LAS f32x4*)(P + (4 * TC + ((t + 1) & (TC - 1))) * 64 + 4 * jq);
                row16_sum2(sp, yp);
                if (tt > 0) yk = ((tt - 1) == jq) ? yp : yk;
                row_update(S, sp, v, w4, b4, k4);
                row_dots1(S, r4, an, yp, sp); }
            { float d = 0.f, q = yp; row16_sum2(d, q); yk = (jq == 15) ? q : yk; yp = 0.f; }
            yout[(size_t)(c * TC + t16 + jq) * MIX] = yk;
        }
        if (c + 1 < NCH) {
            LAS float* Q = BUF + ((c + 1) & 1) * BUFSZ;
#pragma unroll
            for (int a = 0; a < 6; ++a) *(LAS f32x4*)(Q + (a * TC + st) * 64 + 4 * sq) = pre[a];
        }
        __syncthreads();
    }
}
DI void rwkv_post_rows(const Frame& F, unsigned char* ws, const In& in, int l, int w0, int nw) {
    const float* RW = (const float*)(ws + WS_RW); constexpr size_t RS = RW_STRIDE / 4;
    const float* YRAW = (const float*)(ws + WS_YRAW); bf16_t* MIXp = (bf16_t*)(ws + WS_MIX);
    const float* r_k = in[14] + l * MIX; const float* lng = in[15] + l * MIX; const float* lnb = in[16] + l * MIX;
    for (int e0 = w0; e0 < MTOK * 8; e0 += 4 * nw) {
        float y[4], r0[4], r2[4], r3[4], r6[4], gw[4], gb[4], rk[4];
#pragma unroll
        for (int k = 0; k < 4; ++k) { int e = e0 + k * nw; e = e < MTOK * 8 ? e : e0; const int m = e >> 3, h = e & 7, ch = h * 64 + F.lane; const size_t o = (size_t)m * MIX + ch;
            y[k] = YRAW[o]; r0[k] = RW[0 * RS + o]; r2[k] = RW[2 * RS + o]; r3[k] = RW[3 * RS + o]; r6[k] = RW[6 * RS + o]; gw[k] = lng[ch]; gb[k] = lnb[ch]; rk[k] = r_k[ch]; }
        __builtin_amdgcn_sched_barrier(0);
#pragma unroll
        for (int k = 0; k < 4; ++k) { const int e = e0 + k * nw; const int m = e >> 3, h = e & 7, ch = h * 64 + F.lane;
            const float mean = wave_sum(y[k]) * (1.f / 64.f); const float d = y[k] - mean; const float var = wave_sum(d * d) * (1.f / 64.f);
            const float yn = d * (1.0f / sqrtf(var + GN_EPS)) * gw[k] + gb[k];
            const float bon = wave_sum(r0[k] * r2[k] * rk[k]) * r3[k];
            if (e < MTOK * 8) MIXp[(size_t)m * (4 * MIX) + MIX + ch] = (bf16_t)f2bf((yn + bon) * r6[k]); }
        __builtin_amdgcn_sched_barrier(0);
    }
}

DI unsigned wave_sum_u32(unsigned x) {
    float f = __builtin_bit_cast(float, x); (void)f;
    int v = (int)x;
    v += __builtin_amdgcn_update_dpp(0, v, 0xB1, 0xF, 0xF, true); v += __builtin_amdgcn_update_dpp(0, v, 0x4E, 0xF, 0xF, true);
    v += __builtin_amdgcn_update_dpp(0, v, 0x141, 0xF, 0xF, true); v += __builtin_amdgcn_update_dpp(0, v, 0x140, 0xF, 0xF, true);
    return (unsigned)(__builtin_amdgcn_readlane(v, 0) + __builtin_amdgcn_readlane(v, 16) + __builtin_amdgcn_readlane(v, 32) + __builtin_amdgcn_readlane(v, 48));
}
DI unsigned fkey(float v) { unsigned u = __builtin_bit_cast(unsigned, v); if (u == 0x80000000u) u = 0u; return (u & 0x80000000u) ? ~u : (u | 0x80000000u); }
struct AttTile { bf16x8 kf[4]; bf16x8 vf[4]; unsigned mw; };
DI void att_load(AttTile& T, const bf16_t* kp, const bf16_t* vp, const unsigned* mp, int kt) {
#pragma unroll
    for (int s = 0; s < 4; ++s) T.kf[s] = *(const bf16x8*)(kp + ((size_t)kt * 4 + s) * 512);
#pragma unroll
    for (int s2 = 0; s2 < 2; ++s2) { const bf16_t* v = vp + ((size_t)kt * 4 + 2 * s2) * 512;
        T.vf[2 * s2 + 0] = *(const bf16x8*)(v); T.vf[2 * s2 + 1] = *(const bf16x8*)(v + 512); }
    T.mw = mp[kt];
}
DI void att_tile(const AttTile& T, const bf16x8 (&qf)[4], f32x16& o0, f32x16& o1, float& mrun, float& lrun, int hh) {
    f32x16 sa;
#pragma unroll
    for (int i = 0; i < 16; ++i) sa[i] = 0.f;
#pragma unroll
    for (int s = 0; s < 4; ++s) sa = MFMA32(T.kf[s], qf[s], sa);
    float mx = -1e30f;
#pragma unroll
    for (int i = 0; i < 16; ++i) { const int kr = (i & 3) + 8 * (i >> 2) + 4 * hh; const bool on = (T.mw >> kr) & 1u; sa[i] = on ? sa[i] : -1e30f; mx = fmaxf(mx, sa[i]); }
    mx = fmaxf(mx, __shfl_xor(mx, 32));
    const float mnew = fmaxf(mrun, mx);
    if (__any(mnew > mrun)) {
        const float alpha = __expf(mrun - mnew); lrun *= alpha;
#pragma unroll
        for (int i = 0; i < 16; ++i) { o0[i] *= alpha; o1[i] *= alpha; }
        mrun = mnew; }
    float p[16], ps = 0.f;
#pragma unroll
    for (int i = 0; i < 16; ++i) { p[i] = (sa[i] > -1e29f) ? __expf(sa[i] - mrun) : 0.f; ps += p[i]; }
    lrun += ps;
#pragma unroll
    for (int s2 = 0; s2 < 2; ++s2) {
        const bf16x8 pb = pack8(p[8 * s2], p[8 * s2 + 1], p[8 * s2 + 2], p[8 * s2 + 3], p[8 * s2 + 4], p[8 * s2 + 5], p[8 * s2 + 6], p[8 * s2 + 7]);
        o0 = MFMA32(T.vf[2 * s2], pb, o0); o1 = MFMA32(T.vf[2 * s2 + 1], pb, o1); }
}
DI void dsa_item(const Frame& F, unsigned char* ws, int item) {
    const bf16_t* Q = (const bf16_t*)(ws + WS_Q); const bf16_t* Kb = (const bf16_t*)(ws + WS_K); const bf16_t* VT = (const bf16_t*)(ws + WS_VT);
    const bf16_t* QI = (const bf16_t*)(ws + WS_QI); const bf16_t* KI = (const bf16_t*)(ws + WS_KI); const float* WI = (const float*)(ws + WS_WI);
    float* SC = (float*)(ws + WS_SC); unsigned* MASK = (unsigned*)(ws + WS_MASK); bf16_t* MIXp = (bf16_t*)(ws + WS_MIX);
    const int b = item >> 6, qb = item & 63, q0 = qb * 32, m0 = b * SEQ + q0;
    const int r = F.lane & 31, hh = F.lane >> 5;
    {
        float wv[4];
#pragma unroll
        for (int hd = 0; hd < 4; ++hd) wv[hd] = WI[(size_t)(m0 + r) * 4 + hd];
        LAS unsigned char* QL = F.lds;
#pragma unroll
        for (int k = 0; k < 2; ++k) { const int f = 2 * F.wave + k; *(LAS bf16x8*)(QL + f * 1024 + (r * 2 + hh) * 16) = *(const bf16x8*)(QI + (size_t)(m0 + r) * 256 + (f >> 2) * 64 + 16 * (f & 3) + 8 * hh); }
        __syncthreads();
        const LAS unsigned char* ql = QL + (r * 2 + hh) * 16;
        const bf16_t* kip = KI + ((size_t)b * 64 * 4 * 32 + r) * 16 + hh * 8;
        bf16x8 kf[4], kn[4];
        if (F.wave <= qb) {
#pragma unroll
            for (int s = 0; s < 4; ++s) kf[s] = *(const bf16x8*)(kip + ((size_t)F.wave * 4 + s) * 512); }
        for (int kt = F.wave; kt <= qb; kt += 8) {
            if (kt + 8 <= qb) {
#pragma unroll
                for (int s = 0; s < 4; ++s) kn[s] = *(const bf16x8*)(kip + ((size_t)(kt + 8) * 4 + s) * 512); }
            f32x16 sc;
#pragma unroll
            for (int i = 0; i < 16; ++i) sc[i] = 0.f;
#pragma unroll
            for (int hd = 0; hd < 4; ++hd) { f32x16 a; bf16x8 qf[4]; asm volatile("" ::: "memory");
#pragma unroll
                for (int s = 0; s < 4; ++s) qf[s] = *(const LAS bf16x8*)(ql + (hd * 4 + s) * 1024);
#pragma unroll
                for (int i = 0; i < 16; ++i) a[i] = 0.f;
#pragma unroll
                for (int s = 0; s < 4; ++s) a = MFMA32(kf[s], qf[s], a);
#pragma unroll
                for (int i = 0; i < 16; ++i) sc[i] += wv[hd] * fmaxf(a[i], 0.f); }
#pragma unroll
            for (int g = 0; g < 4; ++g) *(f32x4*)(SC + (size_t)(m0 + r) * SEQ + kt * 32 + 8 * g + 4 * hh) = (f32x4){sc[4 * g], sc[4 * g + 1], sc[4 * g + 2], sc[4 * g + 3]};
#pragma unroll
            for (int s = 0; s < 4; ++s) kf[s] = kn[s];
        }
    }
    VM_WAIT(); __syncthreads();
    for (int qq = 0; qq < 4; ++qq) {
        const int rq = F.wave * 4 + qq, t = q0 + rq, m = m0 + rq;
        unsigned* mrow = MASK + (size_t)m * 64;
        if (t + 1 <= 256) {
            for (int j = 0; j < 32; ++j) { const unsigned long long bm = __ballot(F.lane + 64 * j <= t); if (F.lane == 0) { mrow[2 * j] = (unsigned)bm; mrow[2 * j + 1] = (unsigned)(bm >> 32); } }
        } else {
            unsigned key[32];
#pragma unroll
            for (int j = 0; j < 32; ++j) { const int s = F.lane + 64 * j; const float sv = SC[(size_t)m * SEQ + s]; key[j] = __builtin_bit_cast(unsigned, sv); }
            __builtin_amdgcn_sched_barrier(0);
#pragma unroll
            for (int j = 0; j < 32; ++j) { const int s = F.lane + 64 * j; key[j] = (s <= t) ? fkey(__builtin_bit_cast(float, key[j])) : 0u; }
            unsigned T = 0u;
            const int jmax = t >> 6;
#pragma unroll 1
            for (int bit = 31; bit >= 0; --bit) { const unsigned cand = T | (1u << bit); unsigned cl0 = 0u, cl1 = 0u;
#pragma unroll
                for (int j0 = 0; j0 < 32; j0 += 8) { if (j0 <= jmax) {
#pragma unroll
                    for (int j = j0; j < j0 + 8; j += 4) { unsigned long long c0, c1, c2, c3;
                        asm("v_cmp_le_u32_e64 %2, %10, %6\n\tv_cmp_le_u32_e64 %3, %10, %7\n\tv_cmp_le_u32_e64 %4, %10, %8\n\tv_cmp_le_u32_e64 %5, %10, %9\n\t"
                            "v_addc_co_u32_e64 %0, %2, 0, %0, %2\n\tv_addc_co_u32_e64 %1, %3, 0, %1, %3\n\tv_addc_co_u32_e64 %0, %4, 0, %0, %4\n\tv_addc_co_u32_e64 %1, %5, 0, %1, %5"
                            : "+v"(cl0), "+v"(cl1), "=&s"(c0), "=&s"(c1), "=&s"(c2), "=&s"(c3) : "v"(key[j]), "v"(key[j + 1]), "v"(key[j + 2]), "v"(key[j + 3]), "s"(cand)); }
                    __builtin_amdgcn_sched_barrier(0); } }
                unsigned cl = cl0 + cl1;
                asm("s_nop 1" : "+v"(cl));
                const int cnt = (int)wave_sum_u32(cl);
                if (cnt >= 256) T = cand;
                if (cnt == 256) break; }
            unsigned cg = 0u;
#pragma unroll
            for (int j = 0; j < 32; ++j) cg += (key[j] > T) ? 1u : 0u;
            const int cgt = (int)wave_sum_u32(cg);
            const int need = 256 - cgt; int run = 0;
            const unsigned long long lt = (1ull << F.lane) - 1ull;
#pragma unroll
            for (int j = 0; j < 32; ++j) {
                const unsigned long long eq = __ballot(key[j] == T), gt = __ballot(key[j] > T);
                const int pre = run + __popcll(eq & lt);
                const unsigned long long se = __ballot(key[j] == T && pre < need);
                const unsigned long long bm = gt | se; run += __popcll(eq);
                if (F.lane == 0) { mrow[2 * j] = (unsigned)bm; mrow[2 * j + 1] = (unsigned)(bm >> 32); }
                if ((j & 3) == 3) __builtin_amdgcn_sched_barrier(0); }
        }
    }
    VM_WAIT(); __syncthreads();
    {
        const int hd = F.wave;
        bf16x8 qf[4];
#pragma unroll
        for (int s = 0; s < 4; ++s) qf[s] = *(const bf16x8*)(Q + (size_t)(m0 + r) * 512 + hd * 64 + 16 * s + 8 * hh);
        f32x16 o0, o1;
#pragma unroll
        for (int i = 0; i < 16; ++i) { o0[i] = 0.f; o1[i] = 0.f; }
        float mrun = -1e30f, lrun = 0.f;
        const bf16_t* kp = Kb + ((size_t)(b * 8 + hd) * 64 * 4 * 32 + r) * 16 + hh * 8;
        const bf16_t* vp = VT + ((size_t)(b * 8 + hd) * 64 * 4 * 32 + r) * 16 + hh * 8;
        const unsigned* mp = MASK + (size_t)(m0 + r) * 64;
        AttTile A, B, C;
        att_load(A, kp, vp, mp, 0);
        if (1 <= qb) att_load(B, kp, vp, mp, 1);
        for (int kt = 0; kt <= qb; kt += 3) {
            if (kt + 2 <= qb) att_load(C, kp, vp, mp, kt + 2);
            att_tile(A, qf, o0, o1, mrun, lrun, hh);
            if (kt + 1 <= qb) {
                if (kt + 3 <= qb) att_load(A, kp, vp, mp, kt + 3);
                att_tile(B, qf, o0, o1, mrun, lrun, hh);
                if (kt + 2 <= qb) {
                    if (kt + 4 <= qb) att_load(B, kp, vp, mp, kt + 4);
                    att_tile(C, qf, o0, o1, mrun, lrun, hh); } }
        }
        const float inv = 1.0f / (lrun + __shfl_xor(lrun, 32));
        bf16_t* orow = MIXp + (size_t)(m0 + r) * (4 * MIX) + hd * 64;
#pragma unroll
        for (int g = 0; g < 4; ++g) {
            u32x2 w0; w0.x = pk2(o0[4 * g] * inv, o0[4 * g + 1] * inv); w0.y = pk2(o0[4 * g + 2] * inv, o0[4 * g + 3] * inv);
            u32x2 w1; w1.x = pk2(o1[4 * g] * inv, o1[4 * g + 1] * inv); w1.y = pk2(o1[4 * g + 2] * inv, o1[4 * g + 3] * inv);
            *(u32x2*)(orow + 8 * g + 4 * hh) = w0; *(u32x2*)(orow + 32 + 8 * g + 4 * hh) = w1; }
    }
    __syncthreads();
}

DI float siluf_(float x) { return x * sigmoidf_(x); }
DI void conv_phase(const Frame& F, unsigned char* ws, const In& in, int l) {
    const bf16_t* U = (const bf16_t*)(ws + WS_U); bf16_t* ACT = (bf16_t*)(ws + WS_ACT);
    const float* cw = in[33] + (size_t)l * 3 * DFF2; const float* cb = in[34] + (size_t)l * DFF2;
    constexpr int NCG = DFF / 8;
    const long total = (long)NCG * (MTOK / 32);
    for (long e = (long)F.bid * NTHR + F.tid; e < total; e += (long)F.G * NTHR) {
        const int cg = (int)(e % NCG), tg = (int)(e / NCG); const int f0 = cg * 8, m0 = tg * 32; const bool first = (m0 % SEQ) == 0;
        float wg[3][8], wv[3][8], bg[8], bv[8];
#pragma unroll
        for (int j = 0; j < 3; ++j)
#pragma unroll
            for (int i = 0; i < 8; ++i) { wg[j][i] = cw[(size_t)j * DFF2 + f0 + i]; wv[j][i] = cw[(size_t)j * DFF2 + DFF + f0 + i]; }
#pragma unroll
        for (int i = 0; i < 8; ++i) { bg[i] = cb[f0 + i]; bv[i] = cb[DFF + f0 + i]; }
        float g1[8], g2[8], v1[8], v2[8];
#pragma unroll
        for (int i = 0; i < 8; ++i) { g1[i] = 0.f; g2[i] = 0.f; v1[i] = 0.f; v2[i] = 0.f; }
        if (!first) {
            const u32x4 a = *(const u32x4*)(U + (size_t)(m0 - 1) * DFF2 + f0), b = *(const u32x4*)(U + (size_t)(m0 - 2) * DFF2 + f0);
            const u32x4 c = *(const u32x4*)(U + (size_t)(m0 - 1) * DFF2 + DFF + f0), d = *(const u32x4*)(U + (size_t)(m0 - 2) * DFF2 + DFF + f0);
#pragma unroll
            for (int i = 0; i < 4; ++i) { g1[2 * i] = bf2f(a[i] & 0xffffu); g1[2 * i + 1] = bf2f(a[i] >> 16); g2[2 * i] = bf2f(b[i] & 0xffffu); g2[2 * i + 1] = bf2f(b[i] >> 16);
                v1[2 * i] = bf2f(c[i] & 0xffffu); v1[2 * i + 1] = bf2f(c[i] >> 16); v2[2 * i] = bf2f(d[i] & 0xffffu); v2[2 * i + 1] = bf2f(d[i] >> 16); }
        }
        u32x4 ua[4], uc[4];
#pragma unroll
        for (int q = 0; q < 4; ++q) { ua[q] = *(const u32x4*)(U + (size_t)(m0 + q) * DFF2 + f0); uc[q] = *(const u32x4*)(U + (size_t)(m0 + q) * DFF2 + DFF + f0); }
#pragma unroll 1
        for (int tb = 0; tb < 8; ++tb) {
            u32x4 na[4], nc[4];
            const int tn = tb < 7 ? 4 * tb + 4 : 4 * tb;
#pragma unroll
            for (int q = 0; q < 4; ++q) { na[q] = *(const u32x4*)(U + (size_t)(m0 + tn + q) * DFF2 + f0); nc[q] = *(const u32x4*)(U + (size_t)(m0 + tn + q) * DFF2 + DFF + f0); }
            __builtin_amdgcn_sched_barrier(0);
#pragma unroll
            for (int q = 0; q < 4; ++q) { const int t = 4 * tb + q; const u32x4 a = ua[q], c = uc[q];
                float g0[8], v0[8], o[8];
#pragma unroll
                for (int i = 0; i < 4; ++i) { g0[2 * i] = bf2f(a[i] & 0xffffu); g0[2 * i + 1] = bf2f(a[i] >> 16); v0[2 * i] = bf2f(c[i] & 0xffffu); v0[2 * i + 1] = bf2f(c[i] >> 16); }
#pragma unroll
                for (int i = 0; i < 8; ++i) { const float gc = bg[i] + wg[0][i] * g2[i] + wg[1][i] * g1[i] + wg[2][i] * g0[i]; const float vc = bv[i] + wv[0][i] * v2[i] + wv[1][i] * v1[i] + wv[2][i] * v0[i];
                    o[i] = siluf_(gc) * vc; g2[i] = g1[i]; g1[i] = g0[i]; v2[i] = v1[i]; v1[i] = v0[i]; }
                u32x4 w; w.x = pk2(o[0], o[1]); w.y = pk2(o[2], o[3]); w.z = pk2(o[4], o[5]); w.w = pk2(o[6], o[7]);
                *(u32x4*)(ACT + (size_t)(m0 + t) * DFF + f0) = w; }
            __builtin_amdgcn_sched_barrier(0);
#pragma unroll
            for (int q = 0; q < 4; ++q) { ua[q] = na[q]; uc[q] = nc[q]; }
        }
    }
}

DI void final_phase(const Frame& F, unsigned char* ws, const float* gfin, float* out) {
    const float* Y = (const float*)(ws + WS_Y); const float* part = (const float*)(ws + WS_PARTA);
    const int gw = F.bid * NWAVES + F.wave, NGW = F.G * NWAVES;
    f32x4 gv[8];
#pragma unroll
    for (int j = 0; j < 8; ++j) gv[j] = *(const f32x4*)(gfin + (j * 64 + F.lane) * 4);
    for (int m0 = gw; m0 < MTOK; m0 += 2 * NGW) {
        f32x4 yv[2][8]; float pv[2];
#pragma unroll
        for (int k = 0; k < 2; ++k) { const int m = (m0 + k * NGW) < MTOK ? m0 + k * NGW : m0;
            pv[k] = part[(size_t)m * 32 + (F.lane & 31)];
#pragma unroll
            for (int j = 0; j < 8; ++j) yv[k][j] = *(const f32x4*)(Y + (size_t)m * DM + (j * 64 + F.lane) * 4); }
        __builtin_amdgcn_sched_barrier(0);
#pragma unroll
        for (int k = 0; k < 2; ++k) { const int m = m0 + k * NGW;
            float s = (F.lane < 32) ? pv[k] : 0.f; s = wave_sum(s);
            const float rs = 1.0f / sqrtf(s * (1.0f / DM) + RMS_EPS);
            if (m < MTOK) {
#pragma unroll
                for (int j = 0; j < 8; ++j) *(f32x4*)(out + (size_t)m * DM + (j * 64 + F.lane) * 4) = yv[k][j] * rs * gv[j]; } }
        __builtin_amdgcn_sched_barrier(0);
    }
}

struct Args { InTab in; float* out; unsigned char* ws; int ph_lo, ph_hi; };
constexpr int ZG1_UNITS = 24 * 32, ZG2_UNITS = 28 * 32;
constexpr int PH_PER_LAYER = 9, N_PHASES = 1 + NL * PH_PER_LAYER + 1;

__global__ void __launch_bounds__(NTHR, 2) hybrid_fwd(Args args) {
    extern __shared__ __attribute__((aligned(16))) unsigned char lds_raw[];
    Frame F0; F0.lds = (LAS unsigned char*)lds_raw; F0.tid = threadIdx.x; F0.lane = F0.tid & 63; F0.wave = __builtin_amdgcn_readfirstlane(F0.tid >> 6); F0.bid = blockIdx.x; F0.G = gridDim.x;
    unsigned char* ws0 = args.ws; In in0; in0.t = (CAS const gfptr_t*)__builtin_amdgcn_kernarg_segment_ptr();
    const int lo = args.ph_lo, hi = args.ph_hi;
    volatile LAS unsigned* MISC = (volatile LAS unsigned*)(F0.lds + MISC_OFF);
    if (F0.tid < 16) MISC[F0.tid] = 0u;
    __syncthreads();
    XcdBarrier bar; bar.bar = (unsigned*)(ws0 + WS_CTL) + CW_BAR; bar.x = 0; bar.st = nullptr;
    const bool multi = (hi - lo) > 1;
    if (multi) bar = xcd_barrier_post((unsigned*)(ws0 + WS_CTL) + CW_BAR, MISC + 8);
#ifndef SUBMASK
#define SUBMASK 7
#endif
#ifndef DUPSUB
#define DUPSUB 0
#endif
#ifndef DUPMASK
#define DUPMASK 0u
#endif
#define NREP(j) (((DUPMASK >> (j)) & 1u) ? 2 : 1)
#ifndef PHMASK
#define PHMASK 0xFFFFFFFFu
#endif
#define IN_PH(k) (lo <= (k) && (k) < hi)
#define ON(j) ((PHMASK >> (j)) & 1u)
#define LAYER_PTRS unsigned char* wt = ws + WS_WT + (size_t)l * WT_LAYER; float* Y = (float*)(ws + WS_Y); bf16_t* YB = (bf16_t*)(ws + WS_YB); float* PA = (float*)(ws + WS_PARTA); float* PB = (float*)(ws + WS_PARTB); const LAS float* rsT = (const LAS float*)(F.lds + RST_OFF); (void)wt; (void)Y; (void)YB; (void)PA; (void)PB; (void)rsT;
#define SEAM(k) do { if (IN_PH(k) && IN_PH((k) + 1)) xcd_barrier(bar); } while (0)

    if (ON(0) && IN_PH(0)) for (int rep = 0; rep < NREP(0); ++rep) { if (rep) xcd_barrier(bar); const In in = in_fresh(in0); const Frame F = fresh(F0); unsigned char* ws = fresh_ptr(ws0); p0_prologue(F, in, ws); }
    SEAM(0);

    for (int l = 0; l < NL; ++l) {
        const int pb = 1 + l * PH_PER_LAYER;
        if (ON(1) && IN_PH(pb + 0)) for (int rep = 0; rep < NREP(1); ++rep) { if (rep) xcd_barrier(bar); const In in = in_fresh(in0); const Frame F = fresh(F0); unsigned char* ws = fresh_ptr(ws0); LAYER_PTRS
            pg8::Gemm g{YB, (const bf16_t*)(wt + WT_IN), DM, DM, DM}; const pg8::OrderLin S{F.bid, F.G, ZG1_UNITS, 0, DM, DM};
            pg8::Unit u0; int pm0 = -1; if (S.next(0, u0)) pm0 = u0.pm;
            if (pm0 >= 0) rs_table(F, PA, pm0); else __syncthreads();
            pg8::EpiZ E{(bf16_t*)(ws + WS_ZS), (bf16_t*)(ws + WS_G), in[4] + (size_t)l * GCOLS, PA, rsT, pm0};
            pg8::gemm_phase<pg8::EpiZ, pg8::OrderLin, true>(F.lds, F.tid, g, S, E);
        }
        SEAM(pb + 0);
        if (ON(2) && IN_PH(pb + 1)) for (int rep = 0; rep < NREP(2); ++rep) { if (rep) xcd_barrier(bar); const In in = in_fresh(in0); const Frame F = fresh(F0); unsigned char* ws = fresh_ptr(ws0); LAYER_PTRS
            { float* RSg = (float*)(ws + WS_RS);
              for (int m = F.bid * NTHR + F.tid; m < MTOK; m += F.G * NTHR) { float sq = 0.f;
#pragma unroll
                  for (int i = 0; i < 8; ++i) { const f32x4 v = *(const f32x4*)(PA + (size_t)m * 32 + 4 * i); sq += (v[0] + v[1]) + (v[2] + v[3]); }
                  RSg[m] = 1.0f / sqrtf(sq * (1.0f / DM) + RMS_EPS); } }
            for (int it = F.bid; it < 768; it += F.G) {
                if (it < 256) { dsa_prep_item(F, ws, in[5] + l * 64, it); if (DUPSUB & 64) dsa_prep_item(F, ws, in[5] + l * 64, it); }
                else if (it < 512) { rwkv_prep_item(F, ws, in, l, it - 256); if (DUPSUB & 16) rwkv_prep_item(F, ws, in, l, it - 256); }
                else { pool_item(F, ws, in, l, it - 512); if (DUPSUB & 32) pool_item(F, ws, in, l, it - 512); }
            }
        }
        SEAM(pb + 1);
        if (ON(3) && IN_PH(pb + 2)) for (int rep = 0; rep < NREP(3); ++rep) { if (rep) xcd_barrier(bar); const In in = in_fresh(in0); const Frame F = fresh(F0); unsigned char* ws = fresh_ptr(ws0); LAYER_PTRS
            constexpr int NRW = 64, NSS = 8;
            if (SUBMASK & 1) { const Frame Fa = fresh(F0);
                for (int it = Fa.bid; it < NRW; it += Fa.G) { rwkv_scan_item(Fa, ws, it); if (DUPSUB & 1) rwkv_scan_item(Fa, ws, it); } }
            if (SUBMASK & 4) { const Frame Fc = fresh(F0);
                if (Fc.G >= NRW + NSS) { const int it = Fc.bid - NRW; if (it >= 0 && it < NSS) { ssm_seq_item(Fc, fresh_ptr(ws0), in_fresh(in0), l, it); if (DUPSUB & 4) ssm_seq_item(Fc, fresh_ptr(ws0), in_fresh(in0), l, it); } }
                else for (int it = Fc.bid; it < NSS; it += Fc.G) ssm_seq_item(Fc, fresh_ptr(ws0), in_fresh(in0), l, it);
                __syncthreads(); }
            if (SUBMASK & 2) { const Frame Fb = fresh(F0);
                if (Fb.G > NRW + NSS) { const int nb = Fb.G - NRW - NSS, b0 = Fb.bid - NRW - NSS;
                    if (b0 >= 0) { if (b0 < 256) { const int b = b0 & 3, qb = 63 - (b0 >> 2); dsa_item(Fb, ws, b * 64 + qb); }
                        const int it2 = nb + (nb - 1 - b0);
                        if (it2 >= nb && it2 < 256) { const int b = it2 & 3, qb = 63 - (it2 >> 2); dsa_item(Fb, ws, b * 64 + qb); }
                        for (int it = b0 + 2 * nb; it < 256; it += nb) { const int b = it & 3, qb = 63 - (it >> 2); dsa_item(Fb, ws, b * 64 + qb); } } }
                else for (int it = Fb.bid; it < 256; it += Fb.G) { const int b = it & 3, qb = 63 - (it >> 2); dsa_item(Fb, ws, b * 64 + qb); } }
            { const Frame Fd = fresh(F0); unsigned char* wsd = fresh_ptr(ws0); const In ind = in_fresh(in0);
                unsigned char* wtd = wsd + WS_WT + (size_t)l * WT_LAYER;
                pg8::Gemm g{(const bf16_t*)(wsd + WS_YB), (const bf16_t*)(wtd + WT_IN), DM, DM, DM};
                const int xg = Fd.bid & 7;
                const pg8::OrderQueue S{(unsigned*)(wsd + WS_CTL) + CW_QUEUE + 64 * (l * 8 + xg), (volatile LAS unsigned*)(Fd.lds + MISC_OFF + 64), Fd.tid, ZG2_UNITS / 8, 24, DM, DM, xg, 0u};
                S.setup();
                pg8::EpiZq E{(bf16_t*)(wsd + WS_ZS), (bf16_t*)(wsd + WS_G), ind[4] + (size_t)l * GCOLS, (const float*)(wsd + WS_RS)};
                pg8::gemm_phase<pg8::EpiZq, pg8::OrderQueue, true>(Fd.lds, Fd.tid, g, S, E);
                conv_w_drain(fresh(F0), in_fresh(in0), fresh_ptr(ws0), l + 1, CV_S1, CV_S2, 0); }
        }
        SEAM(pb + 2);
        if (ON(4) && IN_PH(pb + 3)) for (int rep = 0; rep < NREP(4); ++rep) { if (rep) xcd_barrier(bar); const In in = in_fresh(in0); const Frame F = fresh(F0); unsigned char* ws = fresh_ptr(ws0); LAYER_PTRS
            pg8::Gemm g{(const bf16_t*)(ws + WS_YSB), (const bf16_t*)(wt + WT_GLU), MIX, MIX, MIX}; pg8::Order S; S.init(MTOK / 256, MIX / 256, F.G, F.bid, MIX, MIX);
            pg8::EpiGlu E{(const bf16_t*)(ws + WS_YSB), in[28] + l * MIX, (bf16_t*)(ws + WS_MIX)};
            pg8::gemm_phase<pg8::EpiGlu, pg8::Order, true>(F.lds, F.tid, g, S, E);
            { const Frame Fp = fresh(F0); const int ng = (Fp.G > 64) ? 64 : 0;
              if (Fp.bid >= ng) rwkv_post_rows(Fp, fresh_ptr(ws0), in_fresh(in0), l, (Fp.bid - ng) * NWAVES + Fp.wave, (Fp.G - ng) * NWAVES); }
            { const Frame Fv = fresh(F0); conv_w_drain(Fv, in_fresh(in0), fresh_ptr(ws0), l + 1, CV_S2, CV_S3, 1); conv_w_drain(Fv, in_fresh(in0), fresh_ptr(ws0), l + 1, CV_S4, CV_LAYER, 3); }
        }
        SEAM(pb + 3);
        if (ON(5) && IN_PH(pb + 4)) for (int rep = 0; rep < NREP(5); ++rep) { if (rep) xcd_barrier(bar); const In in = in_fresh(in0); const Frame F = fresh(F0); unsigned char* ws = fresh_ptr(ws0); LAYER_PTRS
            pg8::Gemm g{(const bf16_t*)(ws + WS_MIX), (const bf16_t*)(wt + WT_BR), 4 * MIX, MIX, MIX}; pg8::Order S; S.init(MTOK / 256, DM / 256, F.G, F.bid, 4 * MIX, MIX, 4, MIX, DM);
            pg8::EpiMerge E{(const bf16_t*)(ws + WS_G), (bf16_t*)(ws + WS_MERGED)};
            pg8::gemm_phase<pg8::EpiMerge, pg8::Order, true>(F.lds, F.tid, g, S, E);
        }
        SEAM(pb + 4);
        if (ON(6) && IN_PH(pb + 5)) for (int rep = 0; rep < NREP(6); ++rep) { if (rep) xcd_barrier(bar); const In in = in_fresh(in0); const Frame F = fresh(F0); unsigned char* ws = fresh_ptr(ws0); LAYER_PTRS
            pg8::Gemm g{(const bf16_t*)(ws + WS_MERGED), (const bf16_t*)(wt + WT_OUT), DM, DM, DM}; pg8::Order S; S.init(MTOK / 256, DM / 256, F.G, F.bid, DM, DM);
            pg8::EpiRes E{l == 0 ? in[0] : Y, Y, YB, PB};
            pg8::gemm_phase<pg8::EpiRes, pg8::Order, true>(F.lds, F.tid, g, S, E);
        }
        SEAM(pb + 5);
        if (ON(7) && IN_PH(pb + 6)) for (int rep = 0; rep < NREP(7); ++rep) { if (rep) xcd_barrier(bar); const In in = in_fresh(in0); const Frame F = fresh(F0); unsigned char* ws = fresh_ptr(ws0); LAYER_PTRS
            pg8::Gemm g{YB, (const bf16_t*)(wt + WT_UP), DM, DM, DM}; pg8::Order S; S.init(MTOK / 256, DFF2 / 256, F.G, F.bid, DM, DM);
            pg8::Unit u0; int pm0 = -1; if (S.next(0, u0)) pm0 = u0.pm;
            if (pm0 >= 0) rs_table(F, PB, pm0); else __syncthreads();
            pg8::EpiU E{(bf16_t*)(ws + WS_U), DFF2, PB, rsT, pm0};
            pg8::gemm_phase<pg8::EpiU, pg8::Order, true>(F.lds, F.tid, g, S, E);
            conv_w_drain(fresh(F0), in_fresh(in0), fresh_ptr(ws0), l + 1, CV_S3, CV_S4, 2);
        }
        SEAM(pb + 6);
        if (ON(8) && IN_PH(pb + 7)) for (int rep = 0; rep < NREP(8); ++rep) { if (rep) xcd_barrier(bar); const In in = in_fresh(in0); const Frame F = fresh(F0); unsigned char* ws = fresh_ptr(ws0); LAYER_PTRS conv_phase(F, ws, in, l); }
        SEAM(pb + 7);
        if (ON(9) && IN_PH(pb + 8)) for (int rep = 0; rep < NREP(9); ++rep) { if (rep) xcd_barrier(bar); const In in = in_fresh(in0); const Frame F = fresh(F0); unsigned char* ws = fresh_ptr(ws0); LAYER_PTRS
            pg8::Gemm g{(const bf16_t*)(ws + WS_ACT), (const bf16_t*)(wt + WT_DOWN), DFF, DFF, DFF}; pg8::Order S; S.init(MTOK / 256, DM / 256, F.G, F.bid, DFF, DFF);
            pg8::EpiRes E{Y, Y, YB, PA};
            pg8::gemm_phase<pg8::EpiRes, pg8::Order, true>(F.lds, F.tid, g, S, E);
        }
        SEAM(pb + 8);
    }
    if (ON(10) && IN_PH(N_PHASES - 1)) { const In in = in_fresh(in0); const Frame F = fresh(F0); unsigned char* ws = fresh_ptr(ws0); final_phase(F, ws, in[36], args.out); }
#ifdef DBG_STOP
    if (lo == 100) { const Frame F = fresh(F0); unsigned char* ws = fresh_ptr(ws0);
        for (size_t e = (size_t)F.bid * NTHR + F.tid; e < (size_t)MTOK * DM; e += (size_t)F.G * NTHR) {
            const int m = (int)(e / DM), c = (int)(e % DM); float v;
            if (DBG_BUF == 0) v = bf2f(((const bf16_t*)(ws + WS_MIX))[e]);
            else if (DBG_BUF == 1) v = ((const float*)(ws + WS_ZS))[(size_t)m * ZS_COLS + c];
            else if (DBG_BUF == 2) v = ((const float*)(ws + WS_ZS))[(size_t)m * ZS_COLS + 2048 + c];
            else if (DBG_BUF == 3) v = bf2f(((const bf16_t*)(ws + WS_G))[(size_t)m * GCOLS + c]);
            else if (DBG_BUF == 4) v = ((const float*)(ws + WS_Y))[e];
            else v = bf2f(((const bf16_t*)(ws + WS_MERGED))[e]);
            args.out[e] = v; } }
#endif
#undef IN_PH
#undef SEAM
}

extern "C" void kernel_launch(void* const* d_in, const int* in_sizes, int n_in, void* d_out, int out_size, void* d_ws, size_t ws_size, hipStream_t stream) {
    static int grid = 0;
    if (grid == 0) {
        if (n_in != 37 || out_size != MTOK * DM || ws_size < WS_END) { fprintf(stderr, "kernel_launch: unexpected problem (n_in %d, out %d, ws %zu < %zu)\n", n_in, out_size, ws_size, (size_t)WS_END); grid = -1; return; }
        int dev = 0, cus = 0, per_cu = 0;
        if (hipGetDevice(&dev) != hipSuccess || hipDeviceGetAttribute(&cus, hipDeviceAttributeMultiprocessorCount, dev) != hipSuccess) { grid = -1; return; }
        if (hipFuncSetAttribute((const void*)hybrid_fwd, hipFuncAttributeMaxDynamicSharedMemorySize, LDS_BYTES) != hipSuccess) { fprintf(stderr, "kernel_launch: hipFuncSetAttribute failed\n"); grid = -1; return; }
        if (hipOccupancyMaxActiveBlocksPerMultiprocessor(&per_cu, (const void*)hybrid_fwd, NTHR, LDS_BYTES) != hipSuccess || per_cu < 1) fprintf(stderr, "kernel_launch: occupancy query says %d\n", per_cu);
        (void)hipGetLastError();
        grid = cus >= 256 ? 256 : cus;
    }
    if (grid < 0) return;
    (void)hipMemsetAsync((char*)d_ws + WS_CTL, 0, CTL_ZERO_BYTES, stream);
    Args a{};
    for (int i = 0; i < 37; ++i) a.in.p[i] = (const float*)d_in[i];
    a.out = (float*)d_out; a.ws = (unsigned char*)d_ws;
#ifdef DBG_STOP
    for (int k = 0; k < DBG_STOP; ++k) { a.ph_lo = k; a.ph_hi = k + 1; hipLaunchKernelGGL(hybrid_fwd, dim3(grid), dim3(NTHR), LDS_BYTES, stream, a); }
    a.ph_lo = 100; a.ph_hi = 101; hipLaunchKernelGGL(hybrid_fwd, dim3(grid), dim3(NTHR), LDS_BYTES, stream, a);
#elif MK_N_LAUNCHES == 1
    a.ph_lo = 0; a.ph_hi = N_PHASES;
    hipLaunchKernelGGL(hybrid_fwd, dim3(grid), dim3(NTHR), LDS_BYTES, stream, a);
#else
    for (int k = 0; k < N_PHASES; ++k) { a.ph_lo = k; a.ph_hi = k + 1; hipLaunchKernelGGL(hybrid_fwd, dim3(grid), dim3(NTHR), LDS_BYTES, stream, a); }
#endif
}
```
